# Optimizing an MI355X kernel written in HIP

```python
import jax, jax.numpy as jnp
from jax import lax
import numpy as np

D_MODEL = 1024
BATCH = 8
SEQ = 4096
DEPTH = 2

N_A_LAYERS = (DEPTH + 1) // 2
N_B_LAYERS = DEPTH - N_A_LAYERS
HGRN_DK = 128
HGRN_DV = 128
HGRN_HEADS = D_MODEL // HGRN_DK
HGRN_WIDTH = HGRN_HEADS * HGRN_DK
HGRN_CHUNK = 64
FOX_HEAD_DIM = 64
FOX_HEADS = D_MODEL // FOX_HEAD_DIM
FOX_WIDTH = FOX_HEADS * FOX_HEAD_DIM
FOX_QBLOCK = 128
FOX_GATE_BIAS_OFFSET = 3.0
D_FF = ((8 * D_MODEL // 3 + 255) // 256) * 256
PLE_DIM = 256
NORM_EPS = 1e-6

kernel_name = "yoco_hgrn2_fox_macaron_hybrid"


def rmsnorm(x, g):
    x32 = x.astype(jnp.float32)
    y = x32 * lax.rsqrt(jnp.mean(jnp.square(x32), axis=-1, keepdims=True) + NORM_EPS)
    return (y * g.astype(jnp.float32)).astype(x.dtype)


def swiglu(x, w_in, w_out):
    gate, up = jnp.split(x @ w_in, 2, axis=-1)
    return (jax.nn.silu(gate) * up) @ w_out


def hgrn2_chunked_scan(q, log_f, k, v):
    b_, s_, h_, dk = q.shape
    dv = v.shape[-1]
    n_chunks = s_ // HGRN_CHUNK

    def to_chunks(t):
        return t.astype(jnp.float32).reshape(b_, n_chunks, HGRN_CHUNK, h_, t.shape[-1]).transpose(1, 0, 3, 2, 4)

    qc, gc, kc, vc = to_chunks(q), to_chunks(log_f), to_chunks(k), to_chunks(v)
    causal = jnp.asarray(np.tril(np.ones((HGRN_CHUNK, HGRN_CHUNK), dtype=bool)))

    def step(state, inp):
        qb, gb, kb, vb = inp
        cum = jnp.cumsum(gb, axis=2)
        o_inter = jnp.einsum('bhtk,bhkv->bhtv', qb * jnp.exp(cum), state)
        rel = cum[:, :, :, None, :] - cum[:, :, None, :, :]
        decay = jnp.exp(jnp.where(causal[:, :, None], rel, -jnp.inf))
        scores = jnp.einsum('bhtk,bhtsk,bhsk->bhts', qb, decay, kb)
        o_intra = jnp.einsum('bhts,bhsv->bhtv', scores, vb)
        last = cum[:, :, -1, :]
        new_state = jnp.exp(last)[..., None] * state + jnp.einsum(
            'bhsk,bhsv->bhkv', kb * jnp.exp(last[:, :, None, :] - cum), vb)
        return new_state, o_inter + o_intra

    state0 = jnp.zeros((b_, h_, dk, dv), jnp.float32)
    _, out = lax.scan(step, state0, (qc, gc, kc, vc))
    return out.transpose(1, 0, 3, 2, 4).reshape(b_, s_, h_, dv)


def hgrn2_mixer(xn, w_in, lb, out_norm, w_out):
    b_, s_, _ = xn.shape
    q, fz, inp, g = jnp.split(xn @ w_in, 4, axis=-1)
    fz32 = fz.astype(jnp.float32)
    log_f = jnp.logaddexp(jnp.log(lb), jnp.log1p(-lb) + jax.nn.log_sigmoid(fz32))
    k = (1.0 - lb) * jax.nn.sigmoid(-fz32)
    heads = lambda t: t.reshape(b_, s_, HGRN_HEADS, -1)
    o = hgrn2_chunked_scan(heads(q), heads(log_f), heads(k), heads(inp))
    o = rmsnorm(o, out_norm).astype(xn.dtype).reshape(b_, s_, HGRN_WIDTH)
    return (o * jax.nn.silu(g)) @ w_out


def shared_kv(h, kv_norm, w_kvf, b_f):
    b_, s_, _ = h.shape
    kvf = rmsnorm(h, kv_norm) @ w_kvf
    k = kvf[..., :FOX_WIDTH].reshape(b_, s_, FOX_HEADS, FOX_HEAD_DIM)
    v = kvf[..., FOX_WIDTH:2 * FOX_WIDTH].reshape(b_, s_, FOX_HEADS, FOX_HEAD_DIM)
    log_f = jax.nn.log_sigmoid((kvf[..., 2 * FOX_WIDTH:] + b_f).astype(jnp.float32))
    c = jnp.cumsum(log_f, axis=1).transpose(0, 2, 1)
    return k, v, c


def forgetting_attention(q, k, v, c):
    s_ = q.shape[1]
    scale = FOX_HEAD_DIM ** -0.5
    outs = []
    for blk in range(s_ // FOX_QBLOCK):
        t0 = blk * FOX_QBLOCK
        t1 = t0 + FOX_QBLOCK
        logits = jnp.einsum('bthd,bshd->bhts', q[:, t0:t1], k[:, :t1]).astype(jnp.float32) * scale
        logits = logits + c[:, :, t0:t1, None] - c[:, :, None, :t1]
        mask = jnp.asarray((t0 + np.arange(FOX_QBLOCK))[:, None] >= np.arange(t1)[None, :])
        logits = jnp.where(mask, logits, -jnp.inf)
        probs = jax.nn.softmax(logits, axis=-1).astype(v.dtype)
        outs.append(jnp.einsum('bhts,bshd->bthd', probs, v[:, :t1]))
    return jnp.concatenate(outs, axis=1)


def fox_mixer(xn, w_qg, w_out, k, v, c):
    b_, s_, _ = xn.shape
    q, g = jnp.split(xn @ w_qg, 2, axis=-1)
    q = q.reshape(b_, s_, FOX_HEADS, FOX_HEAD_DIM)
    o = forgetting_attention(q, k, v, c).reshape(b_, s_, FOX_WIDTH)
    return (o * jax.nn.sigmoid(g)) @ w_out


def setup_inputs(seed: int = 0) -> dict:
    key = jax.random.key(seed)
    ks = iter(jax.random.split(key, 32))
    nrm = lambda shape, scale: jax.random.normal(next(ks), shape, jnp.float32) * scale
    gain = lambda shape: 1.0 + nrm(shape, 0.1)
    return {
        "x": nrm((BATCH, SEQ, D_MODEL), 1.0),
        "p": nrm((DEPTH, BATCH, SEQ, PLE_DIM), 1.0),
        "ffn1_norm_pre": gain((DEPTH, D_MODEL)),
        "ffn1_w_in": nrm((DEPTH, D_MODEL, 2 * D_FF), D_MODEL ** -0.5),
        "ffn1_w_out": nrm((DEPTH, D_FF, D_MODEL), D_FF ** -0.5),
        "ffn1_norm_post": gain((DEPTH, D_MODEL)),
        "mix_norm_pre": gain((DEPTH, D_MODEL)),
        "mix_norm_post": gain((DEPTH, D_MODEL)),
        "ffn2_norm_pre": gain((DEPTH, D_MODEL)),
        "ffn2_w_in": nrm((DEPTH, D_MODEL, 2 * D_FF), D_MODEL ** -0.5),
        "ffn2_w_out": nrm((DEPTH, D_FF, D_MODEL), D_FF ** -0.5),
        "ffn2_norm_post": gain((DEPTH, D_MODEL)),
        "hgrn_w_in": nrm((N_A_LAYERS, D_MODEL, 4 * HGRN_WIDTH), D_MODEL ** -0.5),
        "hgrn_lb_logits": nrm((N_A_LAYERS + 1, HGRN_WIDTH), 0.5),
        "hgrn_out_norm": gain((N_A_LAYERS, HGRN_DV)),
        "hgrn_w_out": nrm((N_A_LAYERS, HGRN_WIDTH, D_MODEL), HGRN_WIDTH ** -0.5),
        "kv_norm": gain((D_MODEL,)),
        "fox_w_kvf": nrm((D_MODEL, 2 * FOX_WIDTH + FOX_HEADS), D_MODEL ** -0.5),
        "fox_b_f": FOX_GATE_BIAS_OFFSET + nrm((FOX_HEADS,), 0.1),
        "fox_w_qg": nrm((N_B_LAYERS, D_MODEL, 2 * FOX_WIDTH), D_MODEL ** -0.5),
        "fox_w_out": nrm((N_B_LAYERS, FOX_WIDTH, D_MODEL), FOX_WIDTH ** -0.5),
        "ple_norm_pre": gain((DEPTH, D_MODEL)),
        "ple_w_gate": nrm((DEPTH, D_MODEL, D_MODEL), D_MODEL ** -0.5),
        "ple_w_proj": nrm((DEPTH, PLE_DIM, D_MODEL), PLE_DIM ** -0.5),
        "ple_norm_post": gain((DEPTH, D_MODEL)),
    }


def reference(x, p, ffn1_norm_pre, ffn1_w_in, ffn1_w_out, ffn1_norm_post,
              mix_norm_pre, mix_norm_post,
              ffn2_norm_pre, ffn2_w_in, ffn2_w_out, ffn2_norm_post,
              hgrn_w_in, hgrn_lb_logits, hgrn_out_norm, hgrn_w_out,
              kv_norm, fox_w_kvf, fox_b_f, fox_w_qg, fox_w_out,
              ple_norm_pre, ple_w_gate, ple_w_proj, ple_norm_post):
    lb_all = jnp.cumsum(jax.nn.softmax(hgrn_lb_logits.astype(jnp.float32), axis=0), axis=0)
    h = x
    k_sh = v_sh = c_sh = None
    for i in range(DEPTH):
        h = h + 0.5 * rmsnorm(swiglu(rmsnorm(h, ffn1_norm_pre[i]), ffn1_w_in[i], ffn1_w_out[i]), ffn1_norm_post[i])
        hn = rmsnorm(h, mix_norm_pre[i])
        if i < N_A_LAYERS:
            mix = hgrn2_mixer(hn, hgrn_w_in[i], lb_all[i], hgrn_out_norm[i], hgrn_w_out[i])
        else:
            j = i - N_A_LAYERS
            mix = fox_mixer(hn, fox_w_qg[j], fox_w_out[j], k_sh, v_sh, c_sh)
        h = h + rmsnorm(mix, mix_norm_post[i])
        h = h + 0.5 * rmsnorm(swiglu(rmsnorm(h, ffn2_norm_pre[i]), ffn2_w_in[i], ffn2_w_out[i]), ffn2_norm_post[i])
        gate = jax.nn.sigmoid(rmsnorm(h, ple_norm_pre[i]) @ ple_w_gate[i])
        h = h + rmsnorm(gate * (p[i] @ ple_w_proj[i]), ple_norm_post[i])
        if i == N_A_LAYERS - 1:
            k_sh, v_sh, c_sh = shared_kv(h, kv_norm, fox_w_kvf, fox_b_f)
    return h
```

```cpp
#include <hip/hip_runtime.h>
#include <hip/hip_cooperative_groups.h>
#include <hip/hip_bf16.h>
#include <cstdio>
#include <cstdint>
#include <cmath>
namespace cg = cooperative_groups;
namespace pg8 {
#define PG8_LAS __attribute__((address_space(3)))
typedef unsigned short bf16_t;
typedef short bf16x8 __attribute__((ext_vector_type(8)));
typedef float f32x4 __attribute__((ext_vector_type(4)));
typedef unsigned u32x4 __attribute__((ext_vector_type(4)));
constexpr int BM = 256, BK = 64, HALF = 128, HTB = HALF * BK * 2  , STAGE_BYTES = 8 * HTB, NXCD = 8, WGM = 8;

__host__ __device__ __forceinline__ int lds_byte(int r, int c) { const int st = (r >> 4) * 2 + (c >> 5), rr = r & 15, cc = c & 31, ob = rr * 64 + cc * 2; return st * 1024 + (ob ^ (((ob >> 9) & 1) << 5)); }
__host__ __device__ __forceinline__ void stage_rc(int b, int& R, int& C) { const int st = b / 1024, sb = b % 1024, swz = sb ^ (((sb >> 9) & 1) << 5); R = (st >> 1) * 16 + swz / 64; C = (st & 1) * 32 + (swz % 64) / 2; }
__host__ __device__ __forceinline__ int perm32(int rho) { const int n = rho >> 4, i = rho & 15; return 8 * (i >> 2) + 4 * n + (i & 3); }

struct Unit { int pm, pn; };
struct Gemm { const bf16_t* A; const bf16_t* Bt; int M, N, K, lda; };

struct StaticOrder {
    int nM, nN, nwg, G, c;
    __host__ __device__ void init(int M, int N, int G_, int c_) { nM = M / BM; nN = N / BM; nwg = nM * nN; G = G_; c = c_; }
    __host__ __device__ bool next(int i, Unit& u) const {
        const long L = (long)i * G + c; if (L >= nwg) return false;
        int wgid = (int)L; { const int q = nwg / NXCD, r = nwg % NXCD, xcd = wgid % NXCD, off = wgid / NXCD; wgid = (xcd < r ? xcd * (q + 1) : r * (q + 1) + (xcd - r) * q) + off; }
        const int nig = WGM * nN, gid = wgid / nig, fm = gid * WGM, gsz = (nM - fm) < WGM ? (nM - fm) : WGM;
        u.pm = fm + ((wgid % nig) % gsz); u.pn = (wgid % nig) / gsz; return true;
    }
    __device__ __forceinline__ void a_ready(const Unit&) const {}
    __device__ __forceinline__ void done(const Unit&) const {}
};

typedef float f32x2cv __attribute__((ext_vector_type(2))); typedef __bf16 bf16x2cv __attribute__((ext_vector_type(2)));
__device__ __forceinline__ unsigned cvt_pk_bf16_asm(float lo, float hi) { unsigned r; asm volatile("v_cvt_pk_bf16_f32 %0, %1, %2" : "=v"(r) : "v"(lo), "v"(hi)); return r; }
__device__ __forceinline__ unsigned cvt_pk_bf16(float lo, float hi) { const f32x2cv v = {lo, hi}; const bf16x2cv b = __builtin_convertvector(v, bf16x2cv); return __builtin_bit_cast(unsigned, b); }
enum { EP_PLAIN = 0, EP_SWIGLU = 1, EP_KVF = 2, EP_QG = 3, EP_PLEGATE = 4 };
__device__ __forceinline__ float fsigmoid(float x) { return __builtin_amdgcn_rcpf(1.0f + __builtin_amdgcn_exp2f(-1.4426950408889634f * x)); }
__device__ __forceinline__ float bflo(unsigned w) { return __uint_as_float(w << 16); }
__device__ __forceinline__ float bfhi(unsigned w) { return __uint_as_float(w & 0xffff0000u); }
template <int MODE, int LDC> struct Epi {
    static constexpr bool PERM = true, AFTER_DRAIN = false;
    bf16_t* O; bf16_t* O2; const bf16_t* aux; float* lf; const float* bfp; float scale0; static constexpr int ldc = LDC;
    __device__ __forceinline__ void operator()(const f32x4 (&acc)[2][2][4][2], const Unit& u, int wr, int wc, int fr, int fq) const {
        asm volatile("s_nop 15\n\ts_nop 15" ::: "memory");
        const int row0 = u.pm * BM + wr * 64 + fr;
        if constexpr (MODE == EP_SWIGLU) {
            const int col0 = u.pn * HALF + wc * 32 + 8 * fq;
#pragma unroll
            for (int ai = 0; ai < 2; ++ai)
#pragma unroll
                for (int m = 0; m < 4; ++m) { bf16_t* rowp = O + (size_t)(row0 + ai * HALF + m * 16) * ldc + col0;
                    const f32x4 g0 = acc[ai][0][m][0], g1 = acc[ai][0][m][1], u0 = acc[ai][1][m][0], u1 = acc[ai][1][m][1]; f32x4 v0, v1;
#pragma unroll
                    for (int j = 0; j < 4; ++j) { v0[j] = g0[j] * fsigmoid(g0[j]) * u0[j]; v1[j] = g1[j] * fsigmoid(g1[j]) * u1[j]; }
                    u32x4 w; w.x = cvt_pk_bf16_asm(v0[0], v0[1]); w.y = cvt_pk_bf16_asm(v0[2], v0[3]); w.z = cvt_pk_bf16_asm(v1[0], v1[1]); w.w = cvt_pk_bf16_asm(v1[2], v1[3]);
                    *(u32x4*)rowp = w; }
        } else {
            bf16_t* base = O; int colt = u.pn * BM; int kind = 0; float sc = 1.f;
            if constexpr (MODE == EP_KVF) { if (u.pn >= 8) kind = 2; else if (u.pn >= 4) { base = O2; colt -= 1024; } }
            if constexpr (MODE == EP_QG) { if (u.pn >= 4) { base = O2; colt -= 1024; kind = 1; } else sc = scale0; }
            if (MODE == EP_KVF && kind == 2) {
                if (wc == 0 && fq < 2) {
#pragma unroll
                    for (int ai = 0; ai < 2; ++ai)
#pragma unroll
                        for (int m = 0; m < 4; ++m) { float* lp = lf + (size_t)(row0 + ai * HALF + m * 16) * 16 + 8 * fq;
#pragma unroll
                            for (int n = 0; n < 2; ++n) { const f32x4 a = acc[ai][0][m][n]; f32x4 o;
#pragma unroll
                                for (int j = 0; j < 4; ++j) { const float x = a[j] + bfp[8 * fq + 4 * n + j]; o[j] = fminf(x, 0.f) - __logf(1.0f + __expf(-fabsf(x))); }
                                *(f32x4*)(lp + 4 * n) = o; } }
                }
                return;
            }
            const int col0 = colt + wc * 32 + 8 * fq;
#pragma unroll
            for (int ai = 0; ai < 2; ++ai)
#pragma unroll
                for (int m = 0; m < 4; ++m) { const size_t roff = (size_t)(row0 + ai * HALF + m * 16) * ldc + col0;
#pragma unroll
                    for (int bj = 0; bj < 2; ++bj) { f32x4 v0 = acc[ai][bj][m][0], v1 = acc[ai][bj][m][1];
                        if (MODE == EP_QG && kind == 1) {
#pragma unroll
                            for (int j = 0; j < 4; ++j) { v0[j] = fsigmoid(v0[j]); v1[j] = fsigmoid(v1[j]); } }
                        else if (MODE == EP_QG) { v0 = v0 * sc; v1 = v1 * sc; }
                        if constexpr (MODE == EP_PLEGATE) { const u32x4 pq = *(const u32x4*)(aux + roff + bj * HALF);
                            v0[0] = fsigmoid(v0[0]) * bflo(pq.x); v0[1] = fsigmoid(v0[1]) * bfhi(pq.x); v0[2] = fsigmoid(v0[2]) * bflo(pq.y); v0[3] = fsigmoid(v0[3]) * bfhi(pq.y);
                            v1[0] = fsigmoid(v1[0]) * bflo(pq.z); v1[1] = fsigmoid(v1[1]) * bfhi(pq.z); v1[2] = fsigmoid(v1[2]) * bflo(pq.w); v1[3] = fsigmoid(v1[3]) * bfhi(pq.w); }
                        u32x4 w; w.x = cvt_pk_bf16_asm(v0[0], v0[1]); w.y = cvt_pk_bf16_asm(v0[2], v0[3]); w.z = cvt_pk_bf16_asm(v1[0], v1[1]); w.w = cvt_pk_bf16_asm(v1[2], v1[3]);
                        *(u32x4*)(base + roff + bj * HALF) = w; } }
        }
    }
};

template <class Epi, class Sched, bool ALIGN_EPI, bool SP2, int KC, int LDA>
__device__ __forceinline__ void gemm_phase(PG8_LAS unsigned char* lds, const Gemm g, const Sched& S, const Epi& E) {
    int tid_o = threadIdx.x; asm volatile("" : "+v"(tid_o)); const int tid = tid_o, wid = __builtin_amdgcn_readfirstlane(tid >> 6), lane = tid & 63, wr = wid >> 2, wc = wid & 3, fr = lane & 15, fq = lane >> 4;
    constexpr int K = KC, nt = K / BK;
    unsigned voffA[2], voffB[2];
#pragma unroll
    for (int i = 0; i < 2; ++i) { int R, C; stage_rc(tid * 16 + i * 8192, R, C); const int Rb = Epi::PERM ? ((R & ~31) + perm32(R & 31)) : R;
        voffA[i] = (unsigned)(R * LDA + C) * 2u; voffB[i] = (unsigned)(Rb * K + C) * 2u; }
    const size_t kstep = (size_t)(BK * 2);
    const size_t hstep = (size_t)HALF * K * 2;
    const size_t tstep = 2 * hstep; const size_t hstepA = (size_t)HALF * LDA * 2, tstepA = 2 * hstepA;
    const unsigned ldsw = (unsigned)wid * 1024u;
    const int aoff = lds_byte(wr * 64 + fr, fq * 8), boff = lds_byte(wc * 32 + fr, fq * 8);
#define PG8_SA(b, h) (((b) * 2 + (h)) * HTB)
#define PG8_SB(b, h) ((4 + (b) * 2 + (h)) * HTB)
#define PG8_STAGE(bufoff, gbase, voff) do { _Pragma("unroll") for (int _i = 0; _i < 2; ++_i) \
        __builtin_amdgcn_global_load_lds((const unsigned*)((const char*)(gbase) + (voff)[_i]), (PG8_LAS unsigned*)(lds + (bufoff) + ldsw + _i * 8192), 16, 0, 0); } while (0)
#define PG8_LDA(dst, b, h) do { _Pragma("unroll") for (int m = 0; m < 4; ++m) _Pragma("unroll") for (int k = 0; k < 2; ++k) dst[m][k] = *(const PG8_LAS bf16x8*)(lds + PG8_SA(b, h) + aoff + m * 2048 + k * 1024); } while (0)
#define PG8_LDB(dst, b, h) do { _Pragma("unroll") for (int n = 0; n < 2; ++n) _Pragma("unroll") for (int k = 0; k < 2; ++k) dst[n][k] = *(const PG8_LAS bf16x8*)(lds + PG8_SB(b, h) + boff + n * 2048 + k * 1024); } while (0)
#define PG8_MMA(ai, bj, At, Bt) do { __builtin_amdgcn_s_setprio(1); _Pragma("unroll") for (int m = 0; m < 4; ++m) _Pragma("unroll") for (int n = 0; n < 2; ++n) _Pragma("unroll") for (int k = 0; k < 2; ++k) \
        acc[ai][bj][m][n] = __builtin_amdgcn_mfma_f32_16x16x32_bf16(Bt[n][k], At[m][k], acc[ai][bj][m][n], 0, 0, 0); __builtin_amdgcn_s_setprio(0); } while (0)
#define PG8_WAIT_V(n) asm volatile("s_waitcnt vmcnt(" #n ")" ::: "memory")
#define PG8_WAIT_L(n) asm volatile("s_waitcnt lgkmcnt(" #n ")" ::: "memory")
#define PG8_BAR __builtin_amdgcn_s_barrier()
#define PG8_SCHED __builtin_amdgcn_sched_barrier(0)
    Unit cur, nxt; int ui = 0;
    if (!S.next(0, cur)) return;
    f32x4 acc[2][2][4][2];
#pragma unroll
    for (int a = 0; a < 2; ++a)
#pragma unroll
        for (int b = 0; b < 2; ++b)
#pragma unroll
            for (int m = 0; m < 4; ++m)
#pragma unroll
                for (int n = 0; n < 2; ++n) acc[a][b][m][n] = (f32x4){0.f, 0.f, 0.f, 0.f};
    bf16x8 At[4][2], B0[2][2], B1[2][2];
    const char* cA = (const char*)g.A + (size_t)cur.pm * tstepA; const char* cB = (const char*)g.Bt + (size_t)cur.pn * tstep;
    S.a_ready(cur);
    if constexpr (SP2) {
        PG8_STAGE(PG8_SB(0, 0), cB, voffB); PG8_STAGE(PG8_SB(0, 1), cB + hstep, voffB); PG8_STAGE(PG8_SA(0, 0), cA, voffA); PG8_STAGE(PG8_SA(0, 1), cA + hstepA, voffA);
        if (wr == 1) PG8_BAR;
        PG8_WAIT_V(2); PG8_BAR;
        PG8_STAGE(PG8_SB(1, 0), cB + kstep, voffB); PG8_STAGE(PG8_SA(1, 0), cA + kstep, voffA); PG8_STAGE(PG8_SB(1, 1), cB + hstep + kstep, voffB);
        PG8_WAIT_V(6); PG8_BAR;
    } else {
        PG8_STAGE(PG8_SB(0, 0), cB, voffB); PG8_STAGE(PG8_SA(0, 0), cA, voffA); PG8_STAGE(PG8_SB(0, 1), cB + hstep, voffB); PG8_STAGE(PG8_SA(0, 1), cA + hstepA, voffA);
        if (wr == 1) PG8_BAR;
        PG8_WAIT_V(4); PG8_BAR;
        PG8_STAGE(PG8_SB(1, 0), cB + kstep, voffB); PG8_STAGE(PG8_SA(1, 0), cA + kstep, voffA); PG8_STAGE(PG8_SB(1, 1), cB + hstep + kstep, voffB);
        PG8_WAIT_V(6); PG8_BAR;
    }
    for (;;) {
        const bool has_next = S.next(ui + 1, nxt);
        const char* nA = has_next ? (const char*)g.A + (size_t)nxt.pm * tstepA : cA; const char* nB = has_next ? (const char*)g.Bt + (size_t)nxt.pn * tstep : cB;
        for (int t = 0; t < nt; t += 2) {
            const bool last = (t == nt - 2);
            const char* a1 = cA + (size_t)(t + 1) * kstep;
            const char* a2 = last ? nA : cA + (size_t)(t + 2) * kstep; const char* b2 = last ? nB : cB + (size_t)(t + 2) * kstep;
            const char* a3 = a2 + kstep; const char* b3 = b2 + kstep;
            if (last && has_next) S.a_ready(nxt);
            if constexpr (SP2) {
            PG8_LDB(B0, 0, 0); PG8_LDB(B1, 0, 1); PG8_SCHED; PG8_LDA(At, 0, 0); PG8_STAGE(PG8_SA(1, 1), a1 + hstepA, voffA);
            PG8_WAIT_V(8); PG8_WAIT_L(0); PG8_BAR; PG8_MMA(0, 0, At, B0); PG8_MMA(0, 1, At, B1); PG8_BAR; PG8_SCHED;
            PG8_LDA(At, 0, 1); PG8_STAGE(PG8_SB(0, 0), b2, voffB); PG8_STAGE(PG8_SB(0, 1), b2 + hstep, voffB); PG8_STAGE(PG8_SA(0, 0), a2, voffA);
            PG8_WAIT_V(8); PG8_WAIT_L(0); PG8_BAR; PG8_MMA(1, 0, At, B0); PG8_MMA(1, 1, At, B1); PG8_BAR; PG8_SCHED;
            PG8_LDB(B0, 1, 0); PG8_LDB(B1, 1, 1); PG8_SCHED; PG8_LDA(At, 1, 0); PG8_STAGE(PG8_SA(0, 1), a2 + hstepA, voffA);
            PG8_WAIT_V(8); PG8_WAIT_L(0); PG8_BAR; PG8_MMA(0, 0, At, B0); PG8_MMA(0, 1, At, B1); PG8_BAR; PG8_SCHED;
            PG8_LDA(At, 1, 1); PG8_STAGE(PG8_SB(1, 0), b3, voffB); PG8_STAGE(PG8_SB(1, 1), b3 + hstep, voffB); PG8_STAGE(PG8_SA(1, 0), a3, voffA);
            PG8_WAIT_V(8); PG8_WAIT_L(0); PG8_BAR; PG8_MMA(1, 0, At, B0); PG8_MMA(1, 1, At, B1); PG8_BAR; PG8_SCHED;
            } else {
            PG8_LDB(B0, 0, 0); PG8_SCHED; PG8_LDA(At, 0, 0); PG8_STAGE(PG8_SA(1, 1), a1 + hstepA, voffA);
            PG8_WAIT_L(8); PG8_BAR; PG8_WAIT_L(0); PG8_MMA(0, 0, At, B0); PG8_BAR; PG8_SCHED;
            PG8_LDB(B1, 0, 1); PG8_STAGE(PG8_SB(0, 0), b2, voffB);
            PG8_BAR; PG8_WAIT_L(0); PG8_MMA(0, 1, At, B1); PG8_BAR;
            PG8_LDA(At, 0, 1); PG8_STAGE(PG8_SA(0, 0), a2, voffA);
            PG8_BAR; PG8_WAIT_L(0); PG8_MMA(1, 0, At, B0); PG8_BAR; PG8_SCHED;
            PG8_STAGE(PG8_SB(0, 1), b2 + hstep, voffB);
            PG8_WAIT_V(6); PG8_BAR; PG8_MMA(1, 1, At, B1); PG8_BAR;
            PG8_LDB(B0, 1, 0); PG8_SCHED; PG8_LDA(At, 1, 0); PG8_STAGE(PG8_SA(0, 1), a2 + hstepA, voffA);
            PG8_WAIT_L(8); PG8_BAR; PG8_WAIT_L(0); PG8_MMA(0, 0, At, B0); PG8_BAR; PG8_SCHED;
            PG8_LDB(B1, 1, 1); PG8_STAGE(PG8_SB(1, 0), b3, voffB);
            PG8_BAR; PG8_WAIT_L(0); PG8_MMA(0, 1, At, B1); PG8_BAR;
            PG8_LDA(At, 1, 1); PG8_STAGE(PG8_SA(1, 0), a3, voffA);
            PG8_BAR; PG8_WAIT_L(0); PG8_MMA(1, 0, At, B0); PG8_BAR; PG8_SCHED;
            PG8_STAGE(PG8_SB(1, 1), b3 + hstep, voffB);
            PG8_WAIT_V(6); PG8_BAR; PG8_MMA(1, 1, At, B1); PG8_BAR;
            }
        }
        if constexpr (ALIGN_EPI) { if (wr == 0) PG8_BAR; }
        if constexpr (!Epi::AFTER_DRAIN) { E(acc, cur, wr, wc, fr, fq); S.done(cur); }
        if (!has_next) break;
#pragma unroll
        for (int a = 0; a < 2; ++a)
#pragma unroll
            for (int b = 0; b < 2; ++b)
#pragma unroll
                for (int m = 0; m < 4; ++m)
#pragma unroll
                    for (int n = 0; n < 2; ++n) acc[a][b][m][n] = (f32x4){0.f, 0.f, 0.f, 0.f};
        cur = nxt; cA = nA; cB = nB; ++ui;
        if constexpr (ALIGN_EPI) { if (wr == 1) PG8_BAR; }
    }
    PG8_WAIT_V(0);
    if constexpr (!ALIGN_EPI) { if (wr == 0) PG8_BAR; }
    PG8_BAR;
    if constexpr (Epi::AFTER_DRAIN) { E.fused(acc, cur, wr, wc, fr, fq, lds, wid, lane); S.done(cur); }
#undef PG8_SA
#undef PG8_SB
#undef PG8_STAGE
#undef PG8_LDA
#undef PG8_LDB
#undef PG8_MMA
#undef PG8_WAIT_V
#undef PG8_WAIT_L
#undef PG8_BAR
#undef PG8_SCHED
}
}
#include <hip/hip_bf16.h>
#include <cmath>
namespace attn_body {
using bf16=__hip_bfloat16;
using bf16x8=__attribute__((ext_vector_type(8)))short;
using s16x4=__attribute__((ext_vector_type(4)))short;
using f32x16=__attribute__((ext_vector_type(16)))float;
using u32x4=__attribute__((ext_vector_type(4)))unsigned;
constexpr int BATCH=8,NHEAD=16,SEQ=4096,D=64,DM=NHEAD*D;
constexpr int NW=8,QBLK=32,QB=QBLK*NW,KVBLK=64,NQB=SEQ/QB;
constexpr int ATTN_PITCH=DM, ATTN_UNIT_ROWS=QB;
__device__ __forceinline__ int crow(int r,int hi){return (r&3)+8*(r>>2)+4*hi;}
#define SBAR() __builtin_amdgcn_sched_barrier(0)
__device__ __forceinline__ void cmask(f32x16&p0,f32x16&p1,int jb,int qrel,int hi){
  const float NEG=-INFINITY; int kb=64*jb+4*hi;
  #pragma unroll
  for(int r=0;r<16;++r){int kv=kb+(r&3)+8*(r>>2); if(kv>qrel)p0[r]=NEG; if(kv+32>qrel)p1[r]=NEG;}
}

constexpr int NSLOT=3, SLOTB=8192;
constexpr int LDS_K=0, LDS_V=NSLOT*SLOTB, LDS_WS=2*NSLOT*SLOTB, LDS_OST=LDS_WS+NW*64*4, LDS_CB=LDS_OST+NW*4096, LDS_BYTES=LDS_CB+SEQ*4;
constexpr float C2=0.125f*1.4426950408889634f;
__device__ __forceinline__ void glds16(const void*gsrc,unsigned lds_dst){unsigned keep;
  asm volatile("s_mov_b32 %0, m0\n\ts_mov_b32 m0, %2\n\ts_nop 0\n\tglobal_load_lds_dwordx4 %1, off\n\ts_mov_b32 m0, %0":"=&s"(keep):"v"(gsrc),"s"(lds_dst):"memory");}
__device__ __forceinline__ float max3f(float a,float b,float c){float r;asm("v_max3_f32 %0, %1, %2, %3":"=v"(r):"v"(a),"v"(b),"v"(c));return r;}
__device__ __forceinline__ float max2f(float a,float b){float r;asm("v_max_f32_e32 %0, %1, %2":"=v"(r):"v"(a),"v"(b));return r;}
__device__ __forceinline__ float fadd_s(float a,float b){float r;asm("v_add_f32_e32 %0, %1, %2":"=v"(r):"v"(a),"v"(b));return r;}
__device__ __forceinline__ float fsub_s(float a,float b){float r;asm("v_sub_f32_e32 %0, %1, %2":"=v"(r):"v"(a),"v"(b));return r;}
typedef float f32x2_t __attribute__((ext_vector_type(2))); typedef __bf16 bf16x2_t __attribute__((ext_vector_type(2)));
__device__ __forceinline__ unsigned cvtpk_s(float lo,float hi){f32x2_t v={lo,hi};bf16x2_t b=__builtin_convertvector(v,bf16x2_t);return __builtin_bit_cast(unsigned,b);}
#define WAIT_BAR(N) asm volatile("s_waitcnt vmcnt(" #N ") lgkmcnt(0)\n\ts_barrier":::"memory")

__device__ __forceinline__ void qkt(f32x16&p0,f32x16&p1,const char*Kslot,const bf16x8*qr,const f32x16&negm,int r32,int hi){
  const char*kb=Kslot+hi*1024+r32*16;
  #pragma unroll
  for(int d0=0;d0<4;++d0){
    const bf16x8 b0=*reinterpret_cast<const bf16x8*>(kb+d0*2048);
    const bf16x8 b1=*reinterpret_cast<const bf16x8*>(kb+d0*2048+512);
    if(d0==0){p0=__builtin_amdgcn_mfma_f32_32x32x16_bf16(b0,qr[0],negm,0,0,0);p1=__builtin_amdgcn_mfma_f32_32x32x16_bf16(b1,qr[0],negm,0,0,0);}
    else{p0=__builtin_amdgcn_mfma_f32_32x32x16_bf16(b0,qr[d0],p0,0,0,0);p1=__builtin_amdgcn_mfma_f32_32x32x16_bf16(b1,qr[d0],p1,0,0,0);}}
}
typedef __attribute__((address_space(3))) const char* lds_cptr;
typedef short v4i16_t __attribute__((ext_vector_type(4)));
__device__ __forceinline__ void kload8(bf16x8*kf,lds_cptr kp){
  kf[0]=*(const __attribute__((address_space(3))) bf16x8*)(kp);      kf[1]=*(const __attribute__((address_space(3))) bf16x8*)(kp+512);
  kf[2]=*(const __attribute__((address_space(3))) bf16x8*)(kp+2048); kf[3]=*(const __attribute__((address_space(3))) bf16x8*)(kp+2560);
  kf[4]=*(const __attribute__((address_space(3))) bf16x8*)(kp+4096); kf[5]=*(const __attribute__((address_space(3))) bf16x8*)(kp+4608);
  kf[6]=*(const __attribute__((address_space(3))) bf16x8*)(kp+6144); kf[7]=*(const __attribute__((address_space(3))) bf16x8*)(kp+6656);
}
__device__ __forceinline__ void kload2(bf16x8*kf,lds_cptr kp,int j){ kf[2*j]=*(const __attribute__((address_space(3))) bf16x8*)(kp+j*2048); kf[2*j+1]=*(const __attribute__((address_space(3))) bf16x8*)(kp+j*2048+512); }
__device__ __forceinline__ s16x4 vtr(lds_cptr p){ return __builtin_bit_cast(s16x4,__builtin_amdgcn_ds_read_tr16_b64_v4i16((__attribute__((address_space(3))) v4i16_t*)p)); }
__device__ __forceinline__ float rowmax(const f32x16&p0,const f32x16&p1){
  float a=max3f(p0[0],p0[1],p1[0]),b=max3f(p0[2],p0[3],p1[1]);a=max3f(a,p1[2],p1[3]);
  #pragma unroll
  for(int r=4;r<16;r+=4){a=max3f(a,p0[r],p0[r+1]);b=max3f(b,p0[r+2],p0[r+3]);a=max3f(a,p1[r],p1[r+1]);b=max3f(b,p1[r+2],p1[r+3]);}
  const float m=max2f(a,b);
  auto rr=__builtin_amdgcn_permlane32_swap(__float_as_uint(m),__float_as_uint(m),false,false);
  return max2f(__uint_as_float(rr[0]),__uint_as_float(rr[1]));
}
__device__ __forceinline__ void pv(f32x16*o,int vb,bf16x8 pa0,bf16x8 pa1,bf16x8 pa2,bf16x8 pa3){
  #pragma unroll
  for(int d0=0;d0<2;++d0){s16x4 lo[4],hi[4];
    #pragma unroll
    for(int ks=0;ks<4;++ks){
      asm volatile("ds_read_b64_tr_b16 %0,%1 offset:%c2":"=&v"(lo[ks]):"v"(vb),"i"(d0*4096+ks*1024):"memory");
      asm volatile("ds_read_b64_tr_b16 %0,%1 offset:%c2":"=&v"(hi[ks]):"v"(vb),"i"(d0*4096+ks*1024+512):"memory");}
    asm volatile("s_waitcnt lgkmcnt(0)":::"memory");SBAR();
    #define PK(k) (bf16x8){lo[k][0],lo[k][1],lo[k][2],lo[k][3],hi[k][0],hi[k][1],hi[k][2],hi[k][3]}
    o[d0]=__builtin_amdgcn_mfma_f32_32x32x16_bf16(pa0,PK(0),o[d0],0,0,0);
    o[d0]=__builtin_amdgcn_mfma_f32_32x32x16_bf16(pa1,PK(1),o[d0],0,0,0);
    o[d0]=__builtin_amdgcn_mfma_f32_32x32x16_bf16(pa2,PK(2),o[d0],0,0,0);
    o[d0]=__builtin_amdgcn_mfma_f32_32x32x16_bf16(pa3,PK(3),o[d0],0,0,0);
    #undef PK
  }
}

#ifndef ATTN_STORE16
#define ATTN_STORE16(p,v) (*(u32x4*)(p)=(v))
#endif
template<int THRL> __device__ __forceinline__ void attn_unit(int b,int h,int qb,const bf16*Q,const bf16*__restrict__ K,const bf16*__restrict__ V,bf16*O,const bf16*__restrict__ Gt,const float*__restrict__ CL,char*shm){
  int tid_o=threadIdx.x; asm volatile("":"+v"(tid_o)); const int tid=tid_o,lane=tid&63,r32=lane&31,hi=lane>>5; const int wid=__builtin_amdgcn_readfirstlane(tid>>6);
  const long rowbase=(long)b*SEQ; const int q0=qb*QB;
  const float*cbh=CL+((long)b*NHEAD+h)*SEQ;
  { typedef float f4_t __attribute__((ext_vector_type(4))); __attribute__((address_space(3))) f4_t*cl4=(__attribute__((address_space(3))) f4_t*)((lds_cptr)shm+LDS_CB);
    for(int i=tid;i<(q0+QB)/4;i+=NW*64)cl4[i]=*(const f4_t*)(cbh+4*i); }
  const float cq=cbh[q0+wid*QBLK+(lane&31)];
  const bf16*Qw=Q+(rowbase+q0+wid*QBLK)*DM+h*D;
  const bf16*Kh=K+rowbase*DM+h*D,*Vh=V+rowbase*DM+h*D;
  const unsigned lds0=(unsigned)(uintptr_t)shm;
  float*wsf=(float*)(shm+LDS_WS)+wid*64;
  const bf16*ksrc=Kh+(long)lane*DM+wid*8;
  const bf16*vsrc=Vh+(long)(16*(wid&3)+(lane>>2))*DM+(wid>>2)*32+(lane&3)*8;
  const unsigned kdst=lds0+LDS_K+wid*1024, vdst=lds0+LDS_V+wid*1024;
  #define DMA_K(t,slot) glds16(ksrc+(long)(t)*KVBLK*DM,(unsigned)__builtin_amdgcn_readfirstlane(kdst+(slot)))
  #define DMA_V(t,slot) glds16(vsrc+(long)(t)*KVBLK*DM,(unsigned)__builtin_amdgcn_readfirstlane(vdst+(slot)))
  const int vb0=(int)(lds0+LDS_V)+((lane>>4)&1)*32+(lane&3)*8+(4*hi+((lane&15)>>2))*64;
  const char*Kbase=shm+LDS_K; bf16x8 kf[8];
  const lds_cptr shm3=(lds_cptr)shm; const lds_cptr kp0=shm3+LDS_K+hi*1024+r32*16; const lds_cptr vp0=shm3+LDS_V+((lane>>4)&1)*32+(lane&3)*8+(4*hi+((lane&15)>>2))*64;
  const int NT=(q0+QB)/KVBLK;
  DMA_K(0,0);DMA_V(0,0);DMA_K(1,SLOTB);
  bf16x8 qr[4];
  #pragma unroll
  for(int d0=0;d0<4;++d0)qr[d0]=*reinterpret_cast<const bf16x8*>(&Qw[(long)r32*DM+d0*16+hi*8]);
  float mhat=0.f,l_reg=0.f;f32x16 o[2];o[0]=f32x16{};o[1]=f32x16{};f32x16 negm;
  #pragma unroll
  for(int r=0;r<16;++r)negm[r]=cq;
  asm volatile("":"+v"(negm));
  typedef float cf4_t __attribute__((ext_vector_type(4))); const __attribute__((address_space(3))) cf4_t*clds=(const __attribute__((address_space(3))) cf4_t*)((lds_cptr)shm+LDS_CB)+hi;
  #define CBIAS(P0,P1,t) do{ const __attribute__((address_space(3))) cf4_t*cp_=clds+16*(t); _Pragma("unroll") for(int j_=0;j_<4;++j_){ const cf4_t a_=cp_[2*j_], b_=cp_[8+2*j_]; \
      P0[4*j_]-=a_[0];P0[4*j_+1]-=a_[1];P0[4*j_+2]-=a_[2];P0[4*j_+3]-=a_[3]; P1[4*j_]-=b_[0];P1[4*j_+1]-=b_[1];P1[4*j_+2]-=b_[2];P1[4*j_+3]-=b_[3]; } }while(0)
  const int qrel=wid*QBLK+r32;
  #define CMASK(P0,P1,t) do{int jb_=(t)-(NT-4); if(jb_>=0)cmask(P0,P1,jb_,qrel,hi);}while(0)
  bool resc=false;
  #define START(P0,P1) do{ const float rm=rowmax(P0,P1); resc=false; \
    { const float dl=rm; mhat=fadd_s(mhat,dl); \
      _Pragma("unroll") for(int r=0;r<16;++r){P0[r]=fsub_s(P0[r],dl);P1[r]=fsub_s(P1[r],dl);} \
      _Pragma("unroll") for(int r=0;r<16;++r)negm[r]=cq-mhat; asm volatile("":"+v"(negm)); } \
    _Pragma("unroll") for(int r=0;r<16;++r)P0[r]=__builtin_amdgcn_exp2f(P0[r]); }while(0)
  #define RESC() do{ if(resc){ asm volatile("s_waitcnt lgkmcnt(0)":::"memory"); \
      _Pragma("unroll") for(int d_=0;d_<2;++d_) _Pragma("unroll") for(int r=0;r<16;++r)o[d_][r]*=wsf[crow(r,hi)]; } }while(0)
  f32x16 pA0,pA1,pB0,pB1;
  int sl_prev=0,sl_cur=0,sl_next=SLOTB;
  #define ROT() do{sl_prev=sl_cur;sl_cur=sl_next;sl_next=(sl_next==(NSLOT-1)*SLOTB)?0:sl_next+SLOTB;}while(0)
  DMA_K(2,2*SLOTB);
  WAIT_BAR(3);
  qkt(pA0,pA1,Kbase,qr,negm,r32,hi);asm volatile("s_nop 15\n\ts_nop 7":"+v"(pA0),"+v"(pA1));CMASK(pA0,pA1,0);CBIAS(pA0,pA1,0);
  START(pA0,pA1);
  _Pragma("unroll") for(int r=0;r<16;++r)pA1[r]=__builtin_amdgcn_exp2f(pA1[r]);
  WAIT_BAR(0);
  DMA_K(3,0);DMA_V(1,SLOTB);
  ROT();
  kload8(kf,kp0+sl_cur);
  WAIT_BAR(2);
  s16x4 vlo[8],vhi[8]; u32x4 pw0,pw1,pw2,pw3;
  #define PKW(P,B) cvtpk_s(P[B],P[B+1])
  #define PAF(k) __builtin_bit_cast(bf16x8,pw##k)
  #define VFR(i) (bf16x8){vlo[i][0],vlo[i][1],vlo[i][2],vlo[i][3],vhi[i][0],vhi[i][1],vhi[i][2],vhi[i][3]}
  #define PIN(x) asm volatile("":"+v"(x))
  #define MX3(a,b,c) __builtin_fmaxf(__builtin_fmaxf((a),(b)),(c))
  #define GAPA(MF,A0,A1,A2,A3,W0,W1,PW) do{ MF; sacc+=A0; sacc+=A1; sacc+=A2; sacc+=A3; PIN(sacc); W0; W1; PIN(PW); SBAR(); }while(0)
  #define EX(v) __builtin_amdgcn_exp2f(v)
  #define GAPB(MF,X,B) do{ MF; X[B]=EX(X[B]); X[B+1]=EX(X[B+1]); X[B+2]=EX(X[B+2]); X[B+3]=EX(X[B+3]); PIN(X); SBAR(); }while(0)
  #define VRD(i) do{ vlo[i]=vtr(vp_+(((i)>>2)*4096+((i)&3)*1024)); vhi[i]=vtr(vp_+(((i)>>2)*4096+((i)&3)*1024+512)); }while(0)
  #define KRD(G,j) do{ if(G){ kload2(kf,kp0+sl_next,j); SBAR(); } }while(0)
  #define STEP(C0,C1,P0,P1,t,GK,GV,GL) do{ SBAR(); \
    const lds_cptr vp_=vp0+sl_prev; \
    VRD(0); SBAR(); float sacc=(P0[0]+P0[1]); \
    GAPA(C0=__builtin_amdgcn_mfma_f32_32x32x16_bf16(kf[0],qr[0],negm,0,0,0), P0[2],P0[3],P0[4],P0[5],     pw0[0]=PKW(P0,0), pw0[1]=PKW(P0,2), pw0); \
    VRD(4); SBAR(); GAPA(C1=__builtin_amdgcn_mfma_f32_32x32x16_bf16(kf[1],qr[0],negm,0,0,0), P0[6],P0[7],P0[8],P0[9],     pw0[2]=PKW(P0,4), pw0[3]=PKW(P0,6), pw0); \
    VRD(1); SBAR(); GAPA(C0=__builtin_amdgcn_mfma_f32_32x32x16_bf16(kf[2],qr[1],C0,0,0,0),   P0[10],P0[11],P0[12],P0[13], pw1[0]=PKW(P0,8), pw1[1]=PKW(P0,10), pw1); \
    VRD(5); SBAR(); GAPA(C1=__builtin_amdgcn_mfma_f32_32x32x16_bf16(kf[3],qr[1],C1,0,0,0),   P0[14],P0[15],P1[0],P1[1],   pw1[2]=PKW(P0,12),pw1[3]=PKW(P0,14), pw1); \
    VRD(2); SBAR(); GAPA(C0=__builtin_amdgcn_mfma_f32_32x32x16_bf16(kf[4],qr[2],C0,0,0,0),   P1[2],P1[3],P1[4],P1[5],     pw2[0]=PKW(P1,0), pw2[1]=PKW(P1,2), pw2); \
    VRD(6); SBAR(); GAPA(C1=__builtin_amdgcn_mfma_f32_32x32x16_bf16(kf[5],qr[2],C1,0,0,0),   P1[6],P1[7],P1[8],P1[9],     pw2[2]=PKW(P1,4), pw2[3]=PKW(P1,6), pw2); \
    VRD(3); SBAR(); GAPA(C0=__builtin_amdgcn_mfma_f32_32x32x16_bf16(kf[6],qr[3],C0,0,0,0),   P1[10],P1[11],P1[12],P1[13], pw3[0]=PKW(P1,8), pw3[1]=PKW(P1,10), pw3); \
    VRD(7); SBAR(); GAPA(C1=__builtin_amdgcn_mfma_f32_32x32x16_bf16(kf[7],qr[3],C1,0,0,0),   P1[14],P1[15],0.f,0.f,       pw3[2]=PKW(P1,12),pw3[3]=PKW(P1,14), pw3); \
    l_reg+=sacc; \
    if(GK){DMA_K((t)+3,sl_cur);} if(GV){DMA_V((t)+1,sl_next);} \
    CMASK(C0,C1,t); CBIAS(C0,C1,t); \
    { float a=MX3(C0[0],C0[1],C1[0]),b=MX3(C0[2],C0[3],C1[1]); a=MX3(a,C1[2],C1[3]); \
      _Pragma("unroll") for(int r=4;r<16;r+=4){a=MX3(a,C0[r],C0[r+1]);b=MX3(b,C0[r+2],C0[r+3]);a=MX3(a,C1[r],C1[r+1]);b=MX3(b,C1[r+2],C1[r+3]);} \
      float rm=__builtin_fmaxf(a,b); { auto rr=__builtin_amdgcn_permlane32_swap(__float_as_uint(rm),__float_as_uint(rm),false,false); rm=__builtin_fmaxf(__uint_as_float(rr[0]),__uint_as_float(rr[1])); } \
      resc=false; \
      if(__builtin_expect(__any(rm>(float)THRL),0)){ const float dl=__builtin_fmaxf(rm,0.f); mhat+=dl; \
        _Pragma("unroll") for(int r=0;r<16;++r){C0[r]-=dl;C1[r]-=dl;} \
        _Pragma("unroll") for(int r=0;r<16;++r)negm[r]=cq-mhat; asm volatile("":"+v"(negm)); \
        const float f=__builtin_amdgcn_exp2f(-dl); l_reg*=f; if(hi==0)wsf[r32]=f; resc=true; } } \
    SBAR(); \
    GAPB(o[0]=__builtin_amdgcn_mfma_f32_32x32x16_bf16(PAF(0),VFR(0),o[0],0,0,0), C0,0); \
    GAPB(o[1]=__builtin_amdgcn_mfma_f32_32x32x16_bf16(PAF(0),VFR(4),o[1],0,0,0), C0,4); \
    KRD(GL,0); GAPB(o[0]=__builtin_amdgcn_mfma_f32_32x32x16_bf16(PAF(1),VFR(1),o[0],0,0,0), C0,8); \
    KRD(GL,1); GAPB(o[1]=__builtin_amdgcn_mfma_f32_32x32x16_bf16(PAF(1),VFR(5),o[1],0,0,0), C0,12); \
    KRD(GL,2); GAPB(o[0]=__builtin_amdgcn_mfma_f32_32x32x16_bf16(PAF(2),VFR(2),o[0],0,0,0), C1,0); \
    KRD(GL,3); GAPB(o[1]=__builtin_amdgcn_mfma_f32_32x32x16_bf16(PAF(2),VFR(6),o[1],0,0,0), C1,4); \
    GAPB(o[0]=__builtin_amdgcn_mfma_f32_32x32x16_bf16(PAF(3),VFR(3),o[0],0,0,0), C1,8); \
    GAPB(o[1]=__builtin_amdgcn_mfma_f32_32x32x16_bf16(PAF(3),VFR(7),o[1],0,0,0), C1,12); \
    }while(0)
  int t=1;
  #undef CMASK
  #define CMASK(P0,P1,t) do{}while(0)
  for(;t+5<NT;t+=2){
    STEP(pB0,pB1,pA0,pA1,t,true,true,true);     WAIT_BAR(2); RESC(); ROT();
    STEP(pA0,pA1,pB0,pB1,t+1,true,true,true);   WAIT_BAR(2); RESC(); ROT();
  }
  #undef CMASK
  #define CMASK(P0,P1,t) do{int jb_=(t)-(NT-4); if(jb_>=0)cmask(P0,P1,jb_,qrel,hi);}while(0)
  #define ENDW(tt) do{ if((tt)+3<NT){WAIT_BAR(2);} else if((tt)+2<NT){WAIT_BAR(1);} else {WAIT_BAR(0);} }while(0)
  for(;t+1<NT;t+=2){
    STEP(pB0,pB1,pA0,pA1,t,(t+3<NT),(t+1<NT),(t+1<NT));       ENDW(t);   RESC(); ROT();
    STEP(pA0,pA1,pB0,pB1,t+1,(t+4<NT),(t+2<NT),(t+2<NT));     ENDW(t+1); RESC(); ROT();
  }
  STEP(pB0,pB1,pA0,pA1,NT-1,false,false,false); RESC();
  { float sacc=pB0[0]+pB0[1]; _Pragma("unroll") for(int r=2;r<16;++r)sacc+=pB0[r]; _Pragma("unroll") for(int r=0;r<16;++r)sacc+=pB1[r]; l_reg+=sacc;
    pw0=(u32x4){PKW(pB0,0),PKW(pB0,2),PKW(pB0,4),PKW(pB0,6)};pw1=(u32x4){PKW(pB0,8),PKW(pB0,10),PKW(pB0,12),PKW(pB0,14)};pw2=(u32x4){PKW(pB1,0),PKW(pB1,2),PKW(pB1,4),PKW(pB1,6)};pw3=(u32x4){PKW(pB1,8),PKW(pB1,10),PKW(pB1,12),PKW(pB1,14)};
    SBAR(); pv(o,vb0+sl_cur,PAF(0),PAF(1),PAF(2),PAF(3)); }
  #undef PKW
  #undef PAF
  #undef VFR
  #undef PIN
  #undef MX3
  #undef GAPA
  #undef GAPB
  #undef EX
  #undef VRD
  #undef KRD
  #undef STEP
  #undef ENDW
  {auto rr=__builtin_amdgcn_permlane32_swap(__float_as_uint(l_reg),__float_as_uint(l_reg),false,false);l_reg=__uint_as_float(rr[0])+__uint_as_float(rr[1]);}
  if(hi==0)wsf[32+r32]=l_reg;asm volatile("s_waitcnt lgkmcnt(0)":::"memory");
  float rli[16];
  #pragma unroll
  for(int r=0;r<16;++r)rli[r]=__builtin_amdgcn_rcpf(wsf[32+crow(r,hi)]);
  bf16*Ow=O+(rowbase+q0+wid*QBLK)*DM+h*D;
  { bf16*stg=(bf16*)(shm+LDS_OST)+wid*2048;
    #pragma unroll
    for(int r=0;r<16;++r){const int orow=crow(r,hi);
      #pragma unroll
      for(int d0=0;d0<2;++d0)stg[orow*64+d0*32+r32]=__float2bfloat16(o[d0][r]*rli[r]);}
    asm volatile("s_waitcnt lgkmcnt(0)":::"memory");
    #pragma unroll
    for(int i=0;i<4;++i){const bf16*Gw=Gt+(rowbase+q0+wid*QBLK)*DM+h*D; const int row=i*8+(lane>>3),ch=lane&7; const u32x4 v=*(const u32x4*)(stg+row*64+ch*8); const u32x4 gq=*(const u32x4*)(Gw+(long)row*DM+ch*8); u32x4 w;
      #pragma unroll
      for(int e=0;e<4;++e){ const float a0=__uint_as_float(v[e]<<16)*__uint_as_float(gq[e]<<16), a1=__uint_as_float(v[e]&0xffff0000u)*__uint_as_float(gq[e]&0xffff0000u); w[e]=cvtpk_s(a0,a1); }
      ATTN_STORE16(Ow+(long)row*DM+ch*8,w);} }
  asm volatile("s_waitcnt lgkmcnt(0)\n\ts_barrier":::"memory");
  #undef CBIAS
  #undef DMA_K
  #undef DMA_V
  #undef CMASK
  #undef START
  #undef RESC
  #undef ROT
}
constexpr int ATTN_LDS_BYTES=LDS_BYTES;
struct AttnTensors { const bf16* Q; const bf16* K; const bf16* V; bf16* O; const bf16* G; const float* CL; };
struct AttnUnit { int bh; int qb; };
struct StaticOrder {
  int vcu, G;
  __device__ __forceinline__ explicit StaticOrder(int grid,int block):vcu((grid%8==0)?(block%8)*(grid/8)+block/8:block),G(grid){}
  __device__ __forceinline__ bool next(int i,AttnUnit&u)const{
    if(G==256){ if(i>=8)return false; const int j=2*(i>>1)+(vcu&1); u.bh=vcu>>1; u.qb=(i&1)?15-j:j; return true; }
    const int idx=i*G+vcu; if(idx>=BATCH*NHEAD*NQB)return false; u.bh=idx/NQB; u.qb=NQB-1-idx%NQB; return true; }
  __device__ __forceinline__ void a_ready(const AttnUnit&)const{}
  __device__ __forceinline__ void done(const AttnUnit&)const{}
};
template<class Sched,int THRL=8> __device__ __forceinline__ void attn_phase(char*lds,const AttnTensors&T,const Sched&S){
  AttnUnit u;
  for(int i=0;S.next(i,u);++i){ S.a_ready(u); attn_unit<THRL>(u.bh/NHEAD,u.bh%NHEAD,u.qb,T.Q,T.K,T.V,T.O,T.G,T.CL,lds); S.done(u); }
}
#undef SBAR
#undef WAIT_BAR
}
#define GAS __attribute__((address_space(1)))
#define LAS __attribute__((address_space(3)))
typedef unsigned short bfu;
typedef unsigned v4u __attribute__((ext_vector_type(4)));
typedef unsigned v2u __attribute__((ext_vector_type(2)));
typedef float f32x4 __attribute__((ext_vector_type(4)));
typedef short bf16x8 __attribute__((ext_vector_type(8)));
#define LDS_WAIT() asm volatile("s_waitcnt lgkmcnt(0)" ::: "memory")
constexpr int NWAVES = 8;
constexpr int BATCH = 8, SEQ = 4096, D = 1024, FF = 2816, T = BATCH * SEQ, PLE = 256, NKVF = 2064, NKVFP = 2304;
constexpr float EPS = 1e-6f, LOG2E = 1.4426950408889634f;
constexpr size_t MiB = 1u << 20;
constexpr size_t E_W1IN = 0, N_WIN = (size_t)2 * FF * D, N_WOUT = (size_t)D * FF;
constexpr size_t E_W1OUT = E_W1IN + 2 * N_WIN, E_W2IN = E_W1OUT + 2 * N_WOUT, E_W2OUT = E_W2IN + 2 * N_WIN, E_WHIN = E_W2OUT + 2 * N_WOUT;
constexpr size_t E_WHOUT = E_WHIN + (size_t)4 * D * D, E_WKVF = E_WHOUT + (size_t)D * D, E_WQG = E_WKVF + (size_t)NKVFP * D, E_WFO = E_WQG + (size_t)2 * D * D;
constexpr size_t E_WPG = E_WFO + (size_t)D * D, E_WPP = E_WPG + (size_t)2 * D * D, E_WEND = E_WPP + (size_t)2 * D * PLE;
static_assert(E_WEND * 2 <= 92 * MiB, "weights fit");
constexpr size_t WS_P = 92 * MiB, WS_LOGF = 124 * MiB, WS_C = 126 * MiB, WS_AY = 128 * MiB, WS_BIG = 192 * MiB, WS_PROJ = 448 * MiB, WS_END = 512 * MiB;
constexpr size_t WS_V = WS_BIG + 192 * MiB, WS_K = WS_PROJ, WS_Q = WS_BIG, WS_G = WS_BIG + 64 * MiB;
constexpr int LDS_BYTES = 147456;

__device__ __forceinline__ float wave_sum(float v) {
#pragma unroll
    for (int o = 1; o < 64; o <<= 1) v += __shfl_xor(v, o);
    return v;
}
__device__ __forceinline__ unsigned pk2(float lo, float hi) { return pg8::cvt_pk_bf16(lo, hi); }
__device__ __forceinline__ float bf2f(unsigned short u) { return __uint_as_float((unsigned)u << 16); }
__device__ __forceinline__ unsigned short f2b(float f) { return (unsigned short)(pk2(f, 0.f) & 0xffffu); }

__device__ __forceinline__ void conv_item(const float* W, int K, int N, bfu* WT, const float* gain, int gmask, int sw, LAS float* scr, int item, int lane) {
    const int nblk = (N + 31) / 32, kb = item / nblk, nb = item % nblk, k0 = 64 * kb, n0 = 32 * nb;
    const int nn = n0 + (lane & 31); const bool nok = nn < N;
#pragma unroll 8
    for (int i = 0; i < 32; ++i) { const int kk = 2 * i + (lane >> 5); float w = nok ? W[(size_t)(k0 + kk) * N + nn] : 0.f; if (gain) w *= gain[(k0 + kk) & gmask]; scr[kk * 33 + (lane & 31)] = w; }
    LDS_WAIT(); asm volatile("" ::: "memory");
    int drow0 = n0; if (sw) { const int j0 = (n0 < FF) ? n0 : n0 - FF; drow0 = 256 * (j0 >> 7) + (j0 & 127) + ((n0 < FF) ? 0 : 128); }
    const int c = lane & 7;
#pragma unroll
    for (int j = 0; j < 4; ++j) { const int n = (lane >> 3) + 8 * j; const LAS float* s = scr + (8 * c) * 33 + n;
        v4u o; o.x = pk2(s[0 * 33], s[1 * 33]); o.y = pk2(s[2 * 33], s[3 * 33]); o.z = pk2(s[4 * 33], s[5 * 33]); o.w = pk2(s[6 * 33], s[7 * 33]);
        *(v4u*)(WT + (size_t)(drow0 + n) * K + k0 + 8 * c) = o; }
    LDS_WAIT(); asm volatile("" ::: "memory");
}
__device__ __forceinline__ void rms_row_to_bf16(const float* xrow, bfu* orow, int lane) {
    const f32x4* xr = (const f32x4*)xrow + lane;
    f32x4 v[4]; float s = 0.f;
#pragma unroll
    for (int j = 0; j < 4; ++j) { v[j] = xr[64 * j]; s += (v[j].x * v[j].x + v[j].y * v[j].y) + (v[j].z * v[j].z + v[j].w * v[j].w); }
    const float r = __builtin_amdgcn_rsqf(wave_sum(s) * (1.f / D) + EPS);
    v2u* o8 = (v2u*)orow + lane;
#pragma unroll
    for (int j = 0; j < 4; ++j) { v2u w; w.x = pk2(v[j].x * r, v[j].y * r); w.y = pk2(v[j].z * r, v[j].w * r); o8[64 * j] = w; }
}
__device__ __forceinline__ void rw_phase(const float* hin, float* hout, const bfu* Y, bfu* A, const float* gain, float scale, int gw, int ngw, int lane) {
    f32x4 g[4];
#pragma unroll
    for (int j = 0; j < 4; ++j) g[j] = *((const f32x4*)gain + lane + 64 * j);
    for (int m = gw; m < T; m += ngw) {
        const f32x4* hr = (const f32x4*)(hin + (size_t)m * D) + lane; const v2u* yr = (const v2u*)(Y + (size_t)m * D) + lane;
        f32x4 v[4], y[4]; float s = 0.f;
#pragma unroll
        for (int j = 0; j < 4; ++j) { v[j] = hr[64 * j]; const v2u w = yr[64 * j]; y[j] = (f32x4){pg8::bflo(w.x), pg8::bfhi(w.x), pg8::bflo(w.y), pg8::bfhi(w.y)};
            s += (y[j].x * y[j].x + y[j].y * y[j].y) + (y[j].z * y[j].z + y[j].w * y[j].w); }
        const float ry = __builtin_amdgcn_rsqf(wave_sum(s) * (1.f / D) + EPS) * scale; float s2 = 0.f;
#pragma unroll
        for (int j = 0; j < 4; ++j) { v[j] = v[j] + y[j] * ry * g[j]; s2 += (v[j].x * v[j].x + v[j].y * v[j].y) + (v[j].z * v[j].z + v[j].w * v[j].w); }
        const float r2 = __builtin_amdgcn_rsqf(wave_sum(s2) * (1.f / D) + EPS);
        f32x4* ho = (f32x4*)(hout + (size_t)m * D) + lane; v2u* ao = (v2u*)(A + (size_t)m * D) + lane;
#pragma unroll
        for (int j = 0; j < 4; ++j) { ho[64 * j] = v[j]; v2u w; w.x = pk2(v[j].x * r2, v[j].y * r2); w.y = pk2(v[j].z * r2, v[j].w * r2); ao[64 * j] = w; }
    }
}

constexpr int HG_QH = 0, HG_QT = 17408, HG_KT = 34816, HG_KHT = 52224, HG_VT = 70656, HG_PP = 89088, HG_ST = 98304, HG_TOT = 133120, HG_DV = 135168, HG_END = 135680;
constexpr int RS = 136, RS2 = 72, OFS = 132;
static_assert(HG_END <= LDS_BYTES, "hgrn lds");
__device__ __forceinline__ f32x4 mfma16(bf16x8 a, bf16x8 b, f32x4 c) { return __builtin_amdgcn_mfma_f32_16x16x32_bf16(a, b, c, 0, 0, 0); }
__device__ __forceinline__ void hgrn_scan(LAS unsigned char* lds, bfu* QZVG, const float* lbl, int bh) {
    int tid_o = threadIdx.x; asm volatile("" : "+v"(tid_o)); const int tid = tid_o, lane = tid & 63, wid = __builtin_amdgcn_readfirstlane(tid >> 6), col = tid & 127, rg = tid >> 7, fr = lane & 15, fq = lane >> 4;
    const int b = bh >> 3, h = bh & 7;
    LAS bfu* QH = (LAS bfu*)(lds + HG_QH); LAS bfu* QT = (LAS bfu*)(lds + HG_QT); LAS bfu* KT = (LAS bfu*)(lds + HG_KT); LAS bfu* KHT = (LAS bfu*)(lds + HG_KHT);
    LAS bfu* VT = (LAS bfu*)(lds + HG_VT); LAS bfu* PP = (LAS bfu*)(lds + HG_PP); LAS bfu* ST = (LAS bfu*)(lds + HG_ST);
    LAS float* TOT = (LAS float*)(lds + HG_TOT); LAS float* DV = (LAS float*)(lds + HG_DV); LAS float* OF = (LAS float*)(lds + HG_QT);
    const float l0 = lbl[h * 128 + col], l1 = lbl[1024 + h * 128 + col];
    const float lb = 1.f / (1.f + __expf(l1 - l0)), omlb = 1.f - lb;
    bfu* base = QZVG + (size_t)b * SEQ * 4096 + h * 128;
    const bfu* pq = base + (size_t)(16 * rg) * 4096 + col; const bfu* pz = pq + 1024; const bfu* pv = pq + 2048;
    const int erow = tid >> 3, eseg = tid & 7;
    const bfu* pg = base + 3072 + (size_t)erow * 4096 + 16 * eseg; bfu* po = base + (size_t)erow * 4096 + 16 * eseg;
    f32x4 Sacc[8];
#pragma unroll
    for (int i = 0; i < 8; ++i) Sacc[i] = (f32x4){0.f, 0.f, 0.f, 0.f};
    for (int i = lane; i < 16 * RS / 2; i += 64) ((LAS unsigned*)(ST + wid * 16 * RS))[i] = 0u;
    unsigned short zr[16], qr[16], vr[16]; v4u gr0, gr1;
#define HG_LOAD() do { _Pragma("unroll") for (int j = 0; j < 16; ++j) { zr[j] = pz[(size_t)j * 4096]; qr[j] = pq[(size_t)j * 4096]; vr[j] = pv[(size_t)j * 4096]; } \
        gr0 = *(const v4u*)pg; gr1 = *(const v4u*)(pg + 8); pz += (size_t)64 * 4096; pq += (size_t)64 * 4096; pv += (size_t)64 * 4096; pg += (size_t)64 * 4096; } while (0)
    HG_LOAD();
    for (int c = 0; c < SEQ / 64; ++c) {
        float kk[16], cum[16], qf[16]; unsigned short vv[16]; const v4u g0 = gr0, g1 = gr1;
        float run = 0.f;
#pragma unroll
        for (int j = 0; j < 16; ++j) { const float z = bf2f(zr[j]); const float k = omlb * __builtin_amdgcn_rcpf(1.f + __expf(z)); run += __logf(1.f - k); cum[j] = run; kk[j] = k; qf[j] = bf2f(qr[j]); vv[j] = vr[j]; }
        TOT[rg * 128 + col] = run;
        if (c + 1 < SEQ / 64) HG_LOAD();
        LDS_WAIT(); __builtin_amdgcn_s_barrier(); asm volatile("" ::: "memory");
        const float t0 = TOT[col], t1 = TOT[128 + col], t2 = TOT[256 + col], t3 = TOT[384 + col];
        const float pre = (rg > 0 ? t0 : 0.f) + (rg > 1 ? t1 : 0.f) + (rg > 2 ? t2 : 0.f), tot = (t0 + t1) + (t2 + t3), mid = t0 + t1;
        unsigned khp[8], vvp[8];
#pragma unroll
        for (int j = 0; j < 16; ++j) { const float cj = pre + cum[j]; const int r = 16 * rg + j;
            QH[r * RS + col] = f2b(qf[j] * __expf(cj)); QT[r * RS + col] = f2b(qf[j] * __expf(cj - mid)); KT[r * RS + col] = f2b(kk[j] * __expf(mid - cj));
            const unsigned short kh = f2b(kk[j] * __expf(tot - cj));
            if (j & 1) { khp[j >> 1] |= (unsigned)kh << 16; vvp[j >> 1] |= (unsigned)vv[j] << 16; } else { khp[j >> 1] = kh; vvp[j >> 1] = vv[j]; } }
        *(LAS v4u*)(KHT + col * RS2 + 16 * rg) = (v4u){khp[0], khp[1], khp[2], khp[3]}; *(LAS v4u*)(KHT + col * RS2 + 16 * rg + 8) = (v4u){khp[4], khp[5], khp[6], khp[7]};
        *(LAS v4u*)(VT + col * RS2 + 16 * rg) = (v4u){vvp[0], vvp[1], vvp[2], vvp[3]}; *(LAS v4u*)(VT + col * RS2 + 16 * rg + 8) = (v4u){vvp[4], vvp[5], vvp[6], vvp[7]};
        if (rg == 0) DV[col] = __expf(tot);
        LDS_WAIT(); __builtin_amdgcn_s_barrier(); asm volatile("" ::: "memory");
        {
            const int tb = wid >> 1;
#pragma unroll
            for (int ss = 0; ss < 2; ++ss) { const int sb = 2 * (wid & 1) + ss; f32x4 sc = (f32x4){0.f, 0.f, 0.f, 0.f};
                if (sb <= tb) {
#pragma unroll
                    for (int ks = 0; ks < 4; ++ks) { const bf16x8 a = *(const LAS bf16x8*)(QT + (16 * tb + fr) * RS + 32 * ks + 8 * fq), bq = *(const LAS bf16x8*)(KT + (16 * sb + fr) * RS + 32 * ks + 8 * fq); sc = mfma16(a, bq, sc); } }
#pragma unroll
                for (int i = 0; i < 4; ++i) { const int t = 16 * tb + 4 * fq + i, s = 16 * sb + fr; PP[t * RS2 + s] = f2b((sb <= tb && s <= t) ? sc[i] : 0.f); } }
        }
        LDS_WAIT(); __builtin_amdgcn_s_barrier(); asm volatile("" ::: "memory");
        {   bf16x8 vtf[2], stf[4];
#pragma unroll
            for (int ks = 0; ks < 2; ++ks) vtf[ks] = *(const LAS bf16x8*)(VT + (16 * wid + fr) * RS2 + 32 * ks + 8 * fq);
#pragma unroll
            for (int ks = 0; ks < 4; ++ks) stf[ks] = *(const LAS bf16x8*)(ST + (16 * wid + fr) * RS + 32 * ks + 8 * fq);
#pragma unroll
            for (int tb = 0; tb < 4; ++tb) { f32x4 o = (f32x4){0.f, 0.f, 0.f, 0.f};
#pragma unroll
                for (int ks = 0; ks < 4; ++ks) o = mfma16(*(const LAS bf16x8*)(QH + (16 * tb + fr) * RS + 32 * ks + 8 * fq), stf[ks], o);
#pragma unroll
                for (int ks = 0; ks < 2; ++ks) o = mfma16(*(const LAS bf16x8*)(PP + (16 * tb + fr) * RS2 + 32 * ks + 8 * fq), vtf[ks], o);
#pragma unroll
                for (int i = 0; i < 4; ++i) OF[(16 * tb + 4 * fq + i) * OFS + 16 * wid + fr] = o[i]; }
#pragma unroll
            for (int kb = 0; kb < 8; ++kb) { const f32x4 d4 = *(const LAS f32x4*)(DV + 16 * kb + 4 * fq); f32x4 s = Sacc[kb] * d4;
#pragma unroll
                for (int ks = 0; ks < 2; ++ks) s = mfma16(*(const LAS bf16x8*)(KHT + (16 * kb + fr) * RS2 + 32 * ks + 8 * fq), vtf[ks], s);
                Sacc[kb] = s; *(LAS v2u*)(ST + (16 * wid + fr) * RS + 16 * kb + 4 * fq) = (v2u){pk2(s[0], s[1]), pk2(s[2], s[3])}; }
        }
        LDS_WAIT(); __builtin_amdgcn_s_barrier(); asm volatile("" ::: "memory");
        {   f32x4 o4[4]; float ss = 0.f;
#pragma unroll
            for (int j = 0; j < 4; ++j) { o4[j] = *(const LAS f32x4*)(OF + erow * OFS + 16 * eseg + 4 * j); ss += (o4[j].x * o4[j].x + o4[j].y * o4[j].y) + (o4[j].z * o4[j].z + o4[j].w * o4[j].w); }
            ss += __shfl_xor(ss, 1); ss += __shfl_xor(ss, 2); ss += __shfl_xor(ss, 4);
            const float rs = __builtin_amdgcn_rsqf(ss * (1.f / 128.f) + EPS);
            unsigned w[8];
#pragma unroll
            for (int j = 0; j < 4; ++j) { const unsigned ga = (j < 2) ? g0[2 * j] : g1[2 * (j - 2)], gb = (j < 2) ? g0[2 * j + 1] : g1[2 * (j - 2) + 1];
                const float a0 = pg8::bflo(ga), a1 = pg8::bfhi(ga), a2 = pg8::bflo(gb), a3 = pg8::bfhi(gb);
                w[2 * j] = pk2(o4[j].x * rs * a0 * pg8::fsigmoid(a0), o4[j].y * rs * a1 * pg8::fsigmoid(a1)); w[2 * j + 1] = pk2(o4[j].z * rs * a2 * pg8::fsigmoid(a2), o4[j].w * rs * a3 * pg8::fsigmoid(a3)); }
            *(v4u*)po = (v4u){w[0], w[1], w[2], w[3]}; *(v4u*)(po + 8) = (v4u){w[4], w[5], w[6], w[7]}; po += (size_t)64 * 4096;
        }
    }
#undef HG_LOAD
    LDS_WAIT(); __builtin_amdgcn_s_barrier(); asm volatile("" ::: "memory");
}

__device__ __forceinline__ void cumsum_bh(LAS unsigned char* lds, const float* LOGF, float* C, int bh) {
    const int tid = threadIdx.x, lane = tid & 63, wid = tid >> 6, b = bh >> 4, h = bh & 15;
    LAS float* wsum = (LAS float*)lds;
    const float* src = LOGF + ((size_t)b * SEQ + 8 * tid) * 16 + h;
    float v[8]; float run = 0.f;
#pragma unroll
    for (int j = 0; j < 8; ++j) { run += src[j * 16]; v[j] = run; }
    float inc = run;
#pragma unroll
    for (int o = 1; o < 64; o <<= 1) { const float t = __shfl_up(inc, o); if (lane >= o) inc += t; }
    if (lane == 63) wsum[wid] = inc;
    LDS_WAIT(); __builtin_amdgcn_s_barrier(); asm volatile("" ::: "memory");
    float off = inc - run;
    for (int w = 0; w < wid; ++w) off += wsum[w];
    float* dst = C + (size_t)bh * SEQ + 8 * tid;
    *(f32x4*)dst = (f32x4){(off + v[0]) * LOG2E, (off + v[1]) * LOG2E, (off + v[2]) * LOG2E, (off + v[3]) * LOG2E};
    *(f32x4*)(dst + 4) = (f32x4){(off + v[4]) * LOG2E, (off + v[5]) * LOG2E, (off + v[6]) * LOG2E, (off + v[7]) * LOG2E};
    LDS_WAIT(); __builtin_amdgcn_s_barrier(); asm volatile("" ::: "memory");
}

struct Args { const float* in[25]; float* out; unsigned char* ws; int st_lo, st_hi; };
constexpr int NSTEP = 29;
__host__ __device__ constexpr bool sync_before(int s) { return !(s == 0 || s == 10 || s == 15 || s == 17 || s == 25); }
enum { K_PRO = 0, K_FFN_IN, K_FFN_OUT, K_RW, K_HGRN_IN, K_HGRN, K_HGRN_OUT, K_PLE_PROJ, K_PLE_GATE, K_KVF, K_CUMSUM, K_QG, K_ATTN, K_FOX_OUT };

__global__ void __launch_bounds__(NWAVES * 64, 2) yoco_fwd(Args args) {
    extern __shared__ __attribute__((aligned(16))) unsigned char lds[];
    cg::grid_group grid = cg::this_grid();
    LAS unsigned char* ldsp = (LAS unsigned char*)lds;
    const int st_lo = args.st_lo, st_hi = args.st_hi;
#define STEP_BEGIN(k) if (st_lo <= (k) && (k) < st_hi) { if ((k) > st_lo && sync_before(k)) { asm volatile("s_waitcnt vmcnt(0) lgkmcnt(0)" ::: "memory"); grid.sync(); __builtin_amdgcn_fence(__ATOMIC_ACQUIRE, "agent"); asm volatile("s_waitcnt vmcnt(0)" ::: "memory"); } \
        const __attribute__((address_space(4))) Args* ap = (const __attribute__((address_space(4))) Args*)__builtin_amdgcn_kernarg_segment_ptr(); asm volatile("" : "+s"(ap)); \
        int tid_k = threadIdx.x; asm volatile("" : "+v"(tid_k)); const int tid = tid_k, lane = tid & 63, wave = __builtin_amdgcn_readfirstlane(tid >> 6); \
        const int G = gridDim.x, bx = blockIdx.x; unsigned char* ws = ap->ws; bfu* Wb = (bfu*)ws; bfu* PB = (bfu*)(ws + WS_P); float* LOGF = (float*)(ws + WS_LOGF); float* CL = (float*)(ws + WS_C); \
        bfu* AY = (bfu*)(ws + WS_AY); bfu* BIG = (bfu*)(ws + WS_BIG); bfu* PROJ = (bfu*)(ws + WS_PROJ); const int gw = bx * NWAVES + wave, ngw = G * NWAVES; \
        (void)tid; (void)lane; (void)Wb; (void)PB; (void)LOGF; (void)CL; (void)AY; (void)BIG; (void)PROJ; (void)gw; (void)ngw;
#define STEP_END }
#define RUN_GEMM(MODE, A_, LDA_, Bt_, N_, K_, O_, LDC_, O2_, AUX_, SC_) do { const pg8::Gemm g{A_, Bt_, T, N_, K_, LDA_}; pg8::StaticOrder S; S.init(T, N_, G, bx); \
        const pg8::Epi<MODE, LDC_> E{O_, O2_, AUX_, LOGF, ap->in[18], SC_}; pg8::gemm_phase<pg8::Epi<MODE, LDC_>, pg8::StaticOrder, true, true, K_, LDA_>(ldsp, g, S, E); } while (0)
#define NOB ((bfu*)nullptr)
#define S_FFN_IN(k, L, w)  STEP_BEGIN(k) RUN_GEMM(pg8::EP_SWIGLU, AY, D, Wb + ((w) == 1 ? E_W1IN : E_W2IN) + (L) * N_WIN, 2 * FF, D, BIG, FF, NOB, NOB, 1.f); STEP_END
#define S_FFN_OUT(k, L, w) STEP_BEGIN(k) RUN_GEMM(pg8::EP_PLAIN, BIG, FF, Wb + ((w) == 1 ? E_W1OUT : E_W2OUT) + (L) * N_WOUT, D, FF, AY, D, NOB, NOB, 1.f); STEP_END
#define S_PLE_PROJ(k, L)   STEP_BEGIN(k) RUN_GEMM(pg8::EP_PLAIN, PB + (size_t)(L) * T * PLE, PLE, Wb + E_WPP + (size_t)(L) * PLE * D, D, PLE, PROJ, D, NOB, NOB, 1.f); STEP_END
#define S_PLE_GATE(k, L)   STEP_BEGIN(k) RUN_GEMM(pg8::EP_PLEGATE, AY, D, Wb + E_WPG + (size_t)(L) * D * D, D, D, BIG, D, NOB, PROJ, 1.f); STEP_END
#define S_RW(k, L, w)      STEP_BEGIN(k) { const float* hin = ((L) == 0 && (w) == 0) ? ap->in[0] : ap->out; const bfu* Y = ((w) == 3) ? BIG : AY; \
        const float* gain = ((w) == 0 ? ap->in[5] : (w) == 1 ? ap->in[7] : (w) == 2 ? ap->in[11] : ap->in[24]) + (L) * D; \
        rw_phase(hin, ap->out, Y, AY, gain, ((w) == 0 || (w) == 2) ? 0.5f : 1.0f, gw, ngw, lane); } STEP_END

    STEP_BEGIN(0) {
        LAS float* scr = (LAS float*)(ldsp + wave * 16384);
        for (int it = gw;; it += ngw) {
            int r = it;
#define CONV(src, K_, N_, dst, gain, gmask, sw) { constexpr int NI = ((K_) / 64) * (((N_) + 31) / 32); if (r < NI) { conv_item(src, K_, N_, dst, gain, gmask, sw, scr, r, lane); continue; } r -= NI; }
            CONV(ap->in[3], D, 2 * FF, Wb + E_W1IN, ap->in[2], 1023, 1)
            CONV(ap->in[3] + N_WIN, D, 2 * FF, Wb + E_W1IN + N_WIN, ap->in[2] + D, 1023, 1)
            CONV(ap->in[9], D, 2 * FF, Wb + E_W2IN, ap->in[8], 1023, 1)
            CONV(ap->in[9] + N_WIN, D, 2 * FF, Wb + E_W2IN + N_WIN, ap->in[8] + D, 1023, 1)
            CONV(ap->in[4], FF, D, Wb + E_W1OUT, (const float*)nullptr, 0, 0)
            CONV(ap->in[4] + N_WOUT, FF, D, Wb + E_W1OUT + N_WOUT, (const float*)nullptr, 0, 0)
            CONV(ap->in[10], FF, D, Wb + E_W2OUT, (const float*)nullptr, 0, 0)
            CONV(ap->in[10] + N_WOUT, FF, D, Wb + E_W2OUT + N_WOUT, (const float*)nullptr, 0, 0)
            CONV(ap->in[12], D, 4 * D, Wb + E_WHIN, ap->in[6], 1023, 0)
            CONV(ap->in[15], D, D, Wb + E_WHOUT, ap->in[14], 127, 0)
            CONV(ap->in[17], D, NKVF, Wb + E_WKVF, ap->in[16], 1023, 0)
            CONV(ap->in[19], D, 2 * D, Wb + E_WQG, ap->in[6] + D, 1023, 0)
            CONV(ap->in[20], D, D, Wb + E_WFO, (const float*)nullptr, 0, 0)
            CONV(ap->in[22], D, D, Wb + E_WPG, ap->in[21], 1023, 0)
            CONV(ap->in[22] + (size_t)D * D, D, D, Wb + E_WPG + (size_t)D * D, ap->in[21] + D, 1023, 0)
            CONV(ap->in[23], PLE, D, Wb + E_WPP, (const float*)nullptr, 0, 0)
            CONV(ap->in[23] + (size_t)PLE * D, PLE, D, Wb + E_WPP + (size_t)PLE * D, (const float*)nullptr, 0, 0)
#undef CONV
            break;
        }
        {   const float* p = ap->in[1]; const size_t n8 = (size_t)2 * T * PLE / 8;
            for (size_t i = (size_t)bx * 512 + tid; i < n8; i += (size_t)G * 512) { const f32x4 a = *((const f32x4*)p + 2 * i), c = *((const f32x4*)p + 2 * i + 1);
                *((v4u*)PB + i) = (v4u){pk2(a.x, a.y), pk2(a.z, a.w), pk2(c.x, c.y), pk2(c.z, c.w)}; } }
        const float* x = ap->in[0];
        for (int m = gw; m < T; m += ngw) rms_row_to_bf16(x + (size_t)m * D, AY + (size_t)m * D, lane);
    } STEP_END
    S_FFN_IN(1, 0, 1) S_FFN_OUT(2, 0, 1) S_RW(3, 0, 0)
    STEP_BEGIN(4) RUN_GEMM(pg8::EP_PLAIN, AY, D, Wb + E_WHIN, 4 * D, D, BIG, 4 * D, NOB, NOB, 1.f); STEP_END
    STEP_BEGIN(5) { const float* lbl = ap->in[13]; for (int bh = bx; bh < BATCH * 8; bh += G) hgrn_scan(ldsp, BIG, lbl, bh); } STEP_END
    STEP_BEGIN(6) RUN_GEMM(pg8::EP_PLAIN, BIG, 4 * D, Wb + E_WHOUT, D, D, AY, D, NOB, NOB, 1.f); STEP_END
    S_RW(7, 0, 1) S_FFN_IN(8, 0, 2) S_FFN_OUT(9, 0, 2) S_PLE_PROJ(10, 0) S_RW(11, 0, 2) S_PLE_GATE(12, 0) S_RW(13, 0, 3)
    STEP_BEGIN(14) RUN_GEMM(pg8::EP_KVF, AY, D, Wb + E_WKVF, NKVFP, D, (bfu*)(ws + WS_K), D, (bfu*)(ws + WS_V), NOB, 1.f); STEP_END
    S_FFN_IN(15, 1, 1)
    STEP_BEGIN(16) { for (int bh = bx; bh < BATCH * 16; bh += G) cumsum_bh(ldsp, LOGF, CL, bh); } STEP_END
    S_FFN_OUT(17, 1, 1) S_RW(18, 1, 0)
    STEP_BEGIN(19) RUN_GEMM(pg8::EP_QG, AY, D, Wb + E_WQG, 2 * D, D, (bfu*)(ws + WS_Q), D, (bfu*)(ws + WS_G), NOB, attn_body::C2); STEP_END
    STEP_BEGIN(20) {
        const attn_body::AttnTensors AT{(const attn_body::bf16*)(ws + WS_Q), (const attn_body::bf16*)(ws + WS_K), (const attn_body::bf16*)(ws + WS_V), (attn_body::bf16*)(ws + WS_Q), (const attn_body::bf16*)(ws + WS_G), CL};
        const attn_body::StaticOrder S(G, bx);
        attn_body::attn_phase<attn_body::StaticOrder>((char*)lds, AT, S);
    } STEP_END
    STEP_BEGIN(21) RUN_GEMM(pg8::EP_PLAIN, (const bfu*)(ws + WS_Q), D, Wb + E_WFO, D, D, AY, D, NOB, NOB, 1.f); STEP_END
    S_RW(22, 1, 1) S_FFN_IN(23, 1, 2) S_FFN_OUT(24, 1, 2) S_PLE_PROJ(25, 1) S_RW(26, 1, 2) S_PLE_GATE(27, 1) S_RW(28, 1, 3)
}

#ifndef MK_MULTI
#define MK_MULTI 0
#endif
extern "C" void kernel_launch(void* const* d_in, const int* in_sizes, int n_in, void* d_out, int out_size, void* d_ws, size_t ws_size, hipStream_t stream) {
    static int grid = 0;
    if (grid == 0) {
        if (n_in != 25 || out_size != T * D || ws_size < WS_END) { fprintf(stderr, "kernel_launch: unexpected shapes (n_in %d out %d ws %zu)\n", n_in, out_size, ws_size); grid = -1; return; }
        int dev = 0, cus = 0, per_cu = 0;
        (void)hipGetDevice(&dev); (void)hipDeviceGetAttribute(&cus, hipDeviceAttributeMultiprocessorCount, dev);
        if (hipFuncSetAttribute((const void*)yoco_fwd, hipFuncAttributeMaxDynamicSharedMemorySize, LDS_BYTES) != hipSuccess) { fprintf(stderr, "kernel_launch: hipFuncSetAttribute failed\n"); grid = -1; return; }
        if (hipOccupancyMaxActiveBlocksPerMultiprocessor(&per_cu, (const void*)yoco_fwd, NWAVES * 64, LDS_BYTES) != hipSuccess || per_cu < 1) per_cu = 1;
        (void)hipGetLastError();
        if (cus <= 0) cus = 256;
        grid = cus * per_cu;
    }
    if (grid < 0) return;
    Args a{};
    for (int i = 0; i < 25; ++i) a.in[i] = (const float*)d_in[i];
    a.out = (float*)d_out; a.ws = (unsigned char*)d_ws;
#if MK_MULTI
    int lo = 0;
    for (int s = 1; s <= NSTEP; ++s) if (s == NSTEP || sync_before(s)) { a.st_lo = lo; a.st_hi = s; hipLaunchKernelGGL(yoco_fwd, dim3(grid), dim3(NWAVES * 64), LDS_BYTES, stream, a); lo = s; }
#else
#ifndef ST_CUT
#define ST_CUT NSTEP
#endif
    a.st_lo = 0; a.st_hi = ST_CUT;
    void* kargs[] = {&a};
    const hipError_t e = hipLaunchCooperativeKernel((const void*)yoco_fwd, dim3(grid), dim3(NWAVES * 64), kargs, LDS_BYTES, stream);
    if (e != hipSuccess) fprintf(stderr, "kernel_launch: cooperative launch failed: %s (grid %d)\n", hipGetErrorString(e), grid);
#endif
}
```

```cpp
#include <hip/hip_runtime.h>
#include <hip/hip_cooperative_groups.h>
#include <hip/hip_bf16.h>
#include <cstdio>
#include <cstdint>
#include <cmath>
namespace cg = cooperative_groups;
namespace pg8 {
#define PG8_LAS __attribute__((address_space(3)))
typedef unsigned short bf16_t;
typedef short bf16x8 __attribute__((ext_vector_type(8)));
typedef float f32x4 __attribute__((ext_vector_type(4)));
typedef unsigned u32x4 __attribute__((ext_vector_type(4)));
constexpr int BM = 256, BK = 64, HALF = 128, HTB = HALF * BK * 2  , STAGE_BYTES = 8 * HTB, NXCD = 8, WGM = 8;

__host__ __device__ __forceinline__ int lds_byte(int r, int c) { const int st = (r >> 4) * 2 + (c >> 5), rr = r & 15, cc = c & 31, ob = rr * 64 + cc * 2; return st * 1024 + (ob ^ (((ob >> 9) & 1) << 5)); }
__host__ __device__ __forceinline__ void stage_rc(int b, int& R, int& C) { const int st = b / 1024, sb = b % 1024, swz = sb ^ (((sb >> 9) & 1) << 5); R = (st >> 1) * 16 + swz / 64; C = (st & 1) * 32 + (swz % 64) / 2; }
__host__ __device__ __forceinline__ int perm32(int rho) { const int n = rho >> 4, i = rho & 15; return 8 * (i >> 2) + 4 * n + (i & 3); }

struct Unit { int pm, pn; };
struct Gemm { const bf16_t* A; const bf16_t* Bt; int M, N, K, lda; };

struct StaticOrder {
    int nM, nN, nwg, G, c;
    __host__ __device__ void init(int M, int N, int G_, int c_) { nM = M / BM; nN = N / BM; nwg = nM * nN; G = G_; c = c_; }
    __host__ __device__ bool next(int i, Unit& u) const {
        const long L = (long)i * G + c; if (L >= nwg) return false;
        int wgid = (int)L; { const int q = nwg / NXCD, r = nwg % NXCD, xcd = wgid % NXCD, off = wgid / NXCD; wgid = (xcd < r ? xcd * (q + 1) : r * (q + 1) + (xcd - r) * q) + off; }
        const int nig = WGM * nN, gid = wgid / nig, fm = gid * WGM, gsz = (nM - fm) < WGM ? (nM - fm) : WGM;
        u.pm = fm + ((wgid % nig) % gsz); u.pn = (wgid % nig) / gsz; return true;
    }
    __device__ __forceinline__ void a_ready(const Unit&) const {}
    __device__ __forceinline__ void done(const Unit&) const {}
};

typedef float f32x2cv __attribute__((ext_vector_type(2))); typedef __bf16 bf16x2cv __attribute__((ext_vector_type(2)));
__device__ __forceinline__ unsigned cvt_pk_bf16_asm(float lo, float hi) { unsigned r; asm volatile("v_cvt_pk_bf16_f32 %0, %1, %2" : "=v"(r) : "v"(lo), "v"(hi)); return r; }
__device__ __forceinline__ unsigned cvt_pk_bf16(float lo, float hi) { const f32x2cv v = {lo, hi}; const bf16x2cv b = __builtin_convertvector(v, bf16x2cv); return __builtin_bit_cast(unsigned, b); }
enum { EP_PLAIN = 0, EP_SWIGLU = 1, EP_KVF = 2, EP_QG = 3, EP_PLEGATE = 4 };
__device__ __forceinline__ float fsigmoid(float x) { return __builtin_amdgcn_rcpf(1.0f + __builtin_amdgcn_exp2f(-1.4426950408889634f * x)); }
__device__ __forceinline__ float bflo(unsigned w) { return __uint_as_float(w << 16); }
__device__ __forceinline__ float bfhi(unsigned w) { return __uint_as_float(w & 0xffff0000u); }
template <int MODE, int LDC> struct Epi {
    static constexpr bool PERM = true, AFTER_DRAIN = false;
    bf16_t* O; bf16_t* O2; const bf16_t* aux; float* lf; const float* bfp; float scale0; static constexpr int ldc = LDC;
    __device__ __forceinline__ void operator()(const f32x4 (&acc)[2][2][4][2], const Unit& u, int wr, int wc, int fr, int fq) const {
        asm volatile("s_nop 15\n\ts_nop 15" ::: "memory");
        const int row0 = u.pm * BM + wr * 64 + fr;
        if constexpr (MODE == EP_SWIGLU) {
            const int col0 = u.pn * HALF + wc * 32 + 8 * fq;
#pragma unroll
            for (int ai = 0; ai < 2; ++ai)
#pragma unroll
                for (int m = 0; m < 4; ++m) { bf16_t* rowp = O + (size_t)(row0 + ai * HALF + m * 16) * ldc + col0;
                    const f32x4 g0 = acc[ai][0][m][0], g1 = acc[ai][0][m][1], u0 = acc[ai][1][m][0], u1 = acc[ai][1][m][1]; f32x4 v0, v1;
#pragma unroll
                    for (int j = 0; j < 4; ++j) { v0[j] = g0[j] * fsigmoid(g0[j]) * u0[j]; v1[j] = g1[j] * fsigmoid(g1[j]) * u1[j]; }
                    u32x4 w; w.x = cvt_pk_bf16_asm(v0[0], v0[1]); w.y = cvt_pk_bf16_asm(v0[2], v0[3]); w.z = cvt_pk_bf16_asm(v1[0], v1[1]); w.w = cvt_pk_bf16_asm(v1[2], v1[3]);
                    *(u32x4*)rowp = w; }
        } else {
            bf16_t* base = O; int colt = u.pn * BM; int kind = 0; float sc = 1.f;
            if constexpr (MODE == EP_KVF) { if (u.pn >= 8) kind = 2; else if (u.pn >= 4) { base = O2; colt -= 1024; } }
            if constexpr (MODE == EP_QG) { if (u.pn >= 4) { base = O2; colt -= 1024; kind = 1; } else sc = scale0; }
            if (MODE == EP_KVF && kind == 2) {
                if (wc == 0 && fq < 2) {
#pragma unroll
                    for (int ai = 0; ai < 2; ++ai)
#pragma unroll
                        for (int m = 0; m < 4; ++m) { float* lp = lf + (size_t)(row0 + ai * HALF + m * 16) * 16 + 8 * fq;
#pragma unroll
                            for (int n = 0; n < 2; ++n) { const f32x4 a = acc[ai][0][m][n]; f32x4 o;
#pragma unroll
                                for (int j = 0; j < 4; ++j) { const float x = a[j] + bfp[8 * fq + 4 * n + j]; o[j] = fminf(x, 0.f) - __logf(1.0f + __expf(-fabsf(x))); }
                                *(f32x4*)(lp + 4 * n) = o; } }
                }
                return;
            }
            const int col0 = colt + wc * 32 + 8 * fq;
#pragma unroll
            for (int ai = 0; ai < 2; ++ai)
#pragma unroll
                for (int m = 0; m < 4; ++m) { const size_t roff = (size_t)(row0 + ai * HALF + m * 16) * ldc + col0;
#pragma unroll
                    for (int bj = 0; bj < 2; ++bj) { f32x4 v0 = acc[ai][bj][m][0], v1 = acc[ai][bj][m][1];
                        if (MODE == EP_QG && kind == 1) {
#pragma unroll
                            for (int j = 0; j < 4; ++j) { v0[j] = fsigmoid(v0[j]); v1[j] = fsigmoid(v1[j]); } }
                        else if (MODE == EP_QG) { v0 = v0 * sc; v1 = v1 * sc; }
                        if constexpr (MODE == EP_PLEGATE) { const u32x4 pq = *(const u32x4*)(aux + roff + bj * HALF);
                            v0[0] = fsigmoid(v0[0]) * bflo(pq.x); v0[1] = fsigmoid(v0[1]) * bfhi(pq.x); v0[2] = fsigmoid(v0[2]) * bflo(pq.y); v0[3] = fsigmoid(v0[3]) * bfhi(pq.y);
                            v1[0] = fsigmoid(v1[0]) * bflo(pq.z); v1[1] = fsigmoid(v1[1]) * bfhi(pq.z); v1[2] = fsigmoid(v1[2]) * bflo(pq.w); v1[3] = fsigmoid(v1[3]) * bfhi(pq.w); }
                        u32x4 w; w.x = cvt_pk_bf16_asm(v0[0], v0[1]); w.y = cvt_pk_bf16_asm(v0[2], v0[3]); w.z = cvt_pk_bf16_asm(v1[0], v1[1]); w.w = cvt_pk_bf16_asm(v1[2], v1[3]);
                        *(u32x4*)(base + roff + bj * HALF) = w; } }
        }
    }
};

template <class Epi, class Sched, bool ALIGN_EPI, bool SP2, int KC, int LDA>
__device__ __forceinline__ void gemm_phase(PG8_LAS unsigned char* lds, const Gemm g, const Sched& S, const Epi& E) {
    int tid_o = threadIdx.x; asm volatile("" : "+v"(tid_o)); const int tid = tid_o, wid = __builtin_amdgcn_readfirstlane(tid >> 6), lane = tid & 63, wr = wid >> 2, wc = wid & 3, fr = lane & 15, fq = lane >> 4;
    constexpr int K = KC, nt = K / BK;
    unsigned voffA[2], voffB[2];
#pragma unroll
    for (int i = 0; i < 2; ++i) { int R, C; stage_rc(tid * 16 + i * 8192, R, C); const int Rb = Epi::PERM ? ((R & ~31) + perm32(R & 31)) : R;
        voffA[i] = (unsigned)(R * LDA + C) * 2u; voffB[i] = (unsigned)(Rb * K + C) * 2u; }
    const size_t kstep = (size_t)(BK * 2);
    const size_t hstep = (size_t)HALF * K * 2;
    const size_t tstep = 2 * hstep; const size_t hstepA = (size_t)HALF * LDA * 2, tstepA = 2 * hstepA;
    const unsigned ldsw = (unsigned)wid * 1024u;
    const int aoff = lds_byte(wr * 64 + fr, fq * 8), boff = lds_byte(wc * 32 + fr, fq * 8);
#define PG8_SA(b, h) (((b) * 2 + (h)) * HTB)
#define PG8_SB(b, h) ((4 + (b) * 2 + (h)) * HTB)
#define PG8_STAGE(bufoff, gbase, voff) do { _Pragma("unroll") for (int _i = 0; _i < 2; ++_i) \
        __builtin_amdgcn_global_load_lds((const unsigned*)((const char*)(gbase) + (voff)[_i]), (PG8_LAS unsigned*)(lds + (bufoff) + ldsw + _i * 8192), 16, 0, 0); } while (0)
#define PG8_LDA(dst, b, h) do { _Pragma("unroll") for (int m = 0; m < 4; ++m) _Pragma("unroll") for (int k = 0; k < 2; ++k) dst[m][k] = *(const PG8_LAS bf16x8*)(lds + PG8_SA(b, h) + aoff + m * 2048 + k * 1024); } while (0)
#define PG8_LDB(dst, b, h) do { _Pragma("unroll") for (int n = 0; n < 2; ++n) _Pragma("unroll") for (int k = 0; k < 2; ++k) dst[n][k] = *(const PG8_LAS bf16x8*)(lds + PG8_SB(b, h) + boff + n * 2048 + k * 1024); } while (0)
#define PG8_MMA(ai, bj, At, Bt) do { __builtin_amdgcn_s_setprio(1); _Pragma("unroll") for (int m = 0; m < 4; ++m) _Pragma("unroll") for (int n = 0; n < 2; ++n) _Pragma("unroll") for (int k = 0; k < 2; ++k) \
        acc[ai][bj][m][n] = __builtin_amdgcn_mfma_f32_16x16x32_bf16(Bt[n][k], At[m][k], acc[ai][bj][m][n], 0, 0, 0); __builtin_amdgcn_s_setprio(0); } while (0)
#define PG8_WAIT_V(n) asm volatile("s_waitcnt vmcnt(" #n ")" ::: "memory")
#define PG8_WAIT_L(n) asm volatile("s_waitcnt lgkmcnt(" #n ")" ::: "memory")
#define PG8_BAR __builtin_amdgcn_s_barrier()
#define PG8_SCHED __builtin_amdgcn_sched_barrier(0)
    Unit cur, nxt; int ui = 0;
    if (!S.next(0, cur)) return;
    f32x4 acc[2][2][4][2];
#pragma unroll
    for (int a = 0; a < 2; ++a)
#pragma unroll
        for (int b = 0; b < 2; ++b)
#pragma unroll
            for (int m = 0; m < 4; ++m)
#pragma unroll
                for (int n = 0; n < 2; ++n) acc[a][b][m][n] = (f32x4){0.f, 0.f, 0.f, 0.f};
    bf16x8 At[4][2], B0[2][2], B1[2][2];
    const char* cA = (const char*)g.A + (size_t)cur.pm * tstepA; const char* cB = (const char*)g.Bt + (size_t)cur.pn * tstep;
    S.a_ready(cur);
    if constexpr (SP2) {
        PG8_STAGE(PG8_SB(0, 0), cB, voffB); PG8_STAGE(PG8_SB(0, 1), cB + hstep, voffB); PG8_STAGE(PG8_SA(0, 0), cA, voffA); PG8_STAGE(PG8_SA(0, 1), cA + hstepA, voffA);
        if (wr == 1) PG8_BAR;
        PG8_WAIT_V(2); PG8_BAR;
        PG8_STAGE(PG8_SB(1, 0), cB + kstep, voffB); PG8_STAGE(PG8_SA(1, 0), cA + kstep, voffA); PG8_STAGE(PG8_SB(1, 1), cB + hstep + kstep, voffB);
        PG8_WAIT_V(6); PG8_BAR;
    } else {
        PG8_STAGE(PG8_SB(0, 0), cB, voffB); PG8_STAGE(PG8_SA(0, 0), cA, voffA); PG8_STAGE(PG8_SB(0, 1), cB + hstep, voffB); PG8_STAGE(PG8_SA(0, 1), cA + hstepA, voffA);
        if (wr == 1) PG8_BAR;
        PG8_WAIT_V(4); PG8_BAR;
        PG8_STAGE(PG8_SB(1, 0), cB + kstep, voffB); PG8_STAGE(PG8_SA(1, 0), cA + kstep, voffA); PG8_STAGE(PG8_SB(1, 1), cB + hstep + kstep, voffB);
        PG8_WAIT_V(6); PG8_BAR;
    }
    for (;;) {
        const bool has_next = S.next(ui + 1, nxt);
        const char* nA = has_next ? (const char*)g.A + (size_t)nxt.pm * tstepA : cA; const char* nB = has_next ? (const char*)g.Bt + (size_t)nxt.pn * tstep : cB;
        for (int t = 0; t < nt; t += 2) {
            const bool last = (t == nt - 2);
            const char* a1 = cA + (size_t)(t + 1) * kstep;
            const char* a2 = last ? nA : cA + (size_t)(t + 2) * kstep; const char* b2 = last ? nB : cB + (size_t)(t + 2) * kstep;
            const char* a3 = a2 + kstep; const char* b3 = b2 + kstep;
            if (last && has_next) S.a_ready(nxt);
            if constexpr (SP2) {
            PG8_LDB(B0, 0, 0); PG8_LDB(B1, 0, 1); PG8_SCHED; PG8_LDA(At, 0, 0); PG8_STAGE(PG8_SA(1, 1), a1 + hstepA, voffA);
            PG8_WAIT_V(8); PG8_WAIT_L(0); PG8_BAR; PG8_MMA(0, 0, At, B0); PG8_MMA(0, 1, At, B1); PG8_BAR; PG8_SCHED;
            PG8_LDA(At, 0, 1); PG8_STAGE(PG8_SB(0, 0), b2, voffB); PG8_STAGE(PG8_SB(0, 1), b2 + hstep, voffB); PG8_STAGE(PG8_SA(0, 0), a2, voffA);
            PG8_WAIT_V(8); PG8_WAIT_L(0); PG8_BAR; PG8_MMA(1, 0, At, B0); PG8_MMA(1, 1, At, B1); PG8_BAR; PG8_SCHED;
            PG8_LDB(B0, 1, 0); PG8_LDB(B1, 1, 1); PG8_SCHED; PG8_LDA(At, 1, 0); PG8_STAGE(PG8_SA(0, 1), a2 + hstepA, voffA);
            PG8_WAIT_V(8); PG8_WAIT_L(0); PG8_BAR; PG8_MMA(0, 0, At, B0); PG8_MMA(0, 1, At, B1); PG8_BAR; PG8_SCHED;
            PG8_LDA(At, 1, 1); PG8_STAGE(PG8_SB(1, 0), b3, voffB); PG8_STAGE(PG8_SB(1, 1), b3 + hstep, voffB); PG8_STAGE(PG8_SA(1, 0), a3, voffA);
            PG8_WAIT_V(8); PG8_WAIT_L(0); PG8_BAR; PG8_MMA(1, 0, At, B0); PG8_MMA(1, 1, At, B1); PG8_BAR; PG8_SCHED;
            } else {
            PG8_LDB(B0, 0, 0); PG8_SCHED; PG8_LDA(At, 0, 0); PG8_STAGE(PG8_SA(1, 1), a1 + hstepA, voffA);
            PG8_WAIT_L(8); PG8_BAR; PG8_WAIT_L(0); PG8_MMA(0, 0, At, B0); PG8_BAR; PG8_SCHED;
            PG8_LDB(B1, 0, 1); PG8_STAGE(PG8_SB(0, 0), b2, voffB);
            PG8_BAR; PG8_WAIT_L(0); PG8_MMA(0, 1, At, B1); PG8_BAR;
            PG8_LDA(At, 0, 1); PG8_STAGE(PG8_SA(0, 0), a2, voffA);
            PG8_BAR; PG8_WAIT_L(0); PG8_MMA(1, 0, At, B0); PG8_BAR; PG8_SCHED;
            PG8_STAGE(PG8_SB(0, 1), b2 + hstep, voffB);
            PG8_WAIT_V(6); PG8_BAR; PG8_MMA(1, 1, At, B1); PG8_BAR;
            PG8_LDB(B0, 1, 0); PG8_SCHED; PG8_LDA(At, 1, 0); PG8_STAGE(PG8_SA(0, 1), a2 + hstepA, voffA);
            PG8_WAIT_L(8); PG8_BAR; PG8_WAIT_L(0); PG8_MMA(0, 0, At, B0); PG8_BAR; PG8_SCHED;
            PG8_LDB(B1, 1, 1); PG8_STAGE(PG8_SB(1, 0), b3, voffB);
            PG8_BAR; PG8_WAIT_L(0); PG8_MMA(0, 1, At, B1); PG8_BAR;
            PG8_LDA(At, 1, 1); PG8_STAGE(PG8_SA(1, 0), a3, voffA);
            PG8_BAR; PG8_WAIT_L(0); PG8_MMA(1, 0, At, B0); PG8_BAR; PG8_SCHED;
            PG8_STAGE(PG8_SB(1, 1), b3 + hstep, voffB);
            PG8_WAIT_V(6); PG8_BAR; PG8_MMA(1, 1, At, B1); PG8_BAR;
            }
        }
        if constexpr (ALIGN_EPI) { if (wr == 0) PG8_BAR; }
        if constexpr (!Epi::AFTER_DRAIN) { E(acc, cur, wr, wc, fr, fq); S.done(cur); }
        if (!has_next) break;
#pragma unroll
        for (int a = 0; a < 2; ++a)
#pragma unroll
            for (int b = 0; b < 2; ++b)
#pragma unroll
                for (int m = 0; m < 4; ++m)
#pragma unroll
                    for (int n = 0; n < 2; ++n) acc[a][b][m][n] = (f32x4){0.f, 0.f, 0.f, 0.f};
        cur = nxt; cA = nA; cB = nB; ++ui;
        if constexpr (ALIGN_EPI) { if (wr == 1) PG8_BAR; }
    }
    PG8_WAIT_V(0);
    if constexpr (!ALIGN_EPI) { if (wr == 0) PG8_BAR; }
    PG8_BAR;
    if constexpr (Epi::AFTER_DRAIN) { E.fused(acc, cur, wr, wc, fr, fq, lds, wid, lane); S.done(cur); }
#undef PG8_SA
#undef PG8_SB
#undef PG8_STAGE
#undef PG8_LDA
#undef PG8_LDB
#undef PG8_MMA
#undef PG8_WAIT_V
#undef PG8_WAIT_L
#undef PG8_BAR
#undef PG8_SCHED
}
}
#include <hip/hip_bf16.h>
#include <cmath>
namespace attn_body {
using bf16=__hip_bfloat16;
using bf16x8=__attribute__((ext_vector_type(8)))short;
using s16x4=__attribute__((ext_vector_type(4)))short;
using f32x16=__attribute__((ext_vector_type(16)))float;
using u32x4=__attribute__((ext_vector_type(4)))unsigned;
constexpr int BATCH=8,NHEAD=16,SEQ=4096,D=64,DM=NHEAD*D;
constexpr int NW=8,QBLK=32,QB=QBLK*NW,KVBLK=64,NQB=SEQ/QB;
constexpr int ATTN_PITCH=DM, ATTN_UNIT_ROWS=QB;
__device__ __forceinline__ int crow(int r,int hi){return (r&3)+8*(r>>2)+4*hi;}
#define SBAR() __builtin_amdgcn_sched_barrier(0)
__device__ __forceinline__ void cmask(f32x16&p0,f32x16&p1,int jb,int qrel,int hi){
  const float NEG=-INFINITY; int kb=64*jb+4*hi;
  #pragma unroll
  for(int r=0;r<16;++r){int kv=kb+(r&3)+8*(r>>2); if(kv>qrel)p0[r]=NEG; if(kv+32>qrel)p1[r]=NEG;}
}

constexpr int NSLOT=3, SLOTB=8192;
constexpr int LDS_K=0, LDS_V=NSLOT*SLOTB, LDS_WS=2*NSLOT*SLOTB, LDS_OST=LDS_WS+NW*64*4, LDS_CB=LDS_OST+NW*4096, LDS_BYTES=LDS_CB+SEQ*4;
constexpr float C2=0.125f*1.4426950408889634f;
__device__ __forceinline__ void glds16(const void*gsrc,unsigned lds_dst){unsigned keep;
  asm volatile("s_mov_b32 %0, m0\n\ts_mov_b32 m0, %2\n\ts_nop 0\n\tglobal_load_lds_dwordx4 %1, off\n\ts_mov_b32 m0, %0":"=&s"(keep):"v"(gsrc),"s"(lds_dst):"memory");}
__device__ __forceinline__ float max3f(float a,float b,float c){float r;asm("v_max3_f32 %0, %1, %2, %3":"=v"(r):"v"(a),"v"(b),"v"(c));return r;}
__device__ __forceinline__ float max2f(float a,float b){float r;asm("v_max_f32_e32 %0, %1, %2":"=v"(r):"v"(a),"v"(b));return r;}
__device__ __forceinline__ float fadd_s(float a,float b){float r;asm("v_add_f32_e32 %0, %1, %2":"=v"(r):"v"(a),"v"(b));return r;}
__device__ __forceinline__ float fsub_s(float a,float b){float r;asm("v_sub_f32_e32 %0, %1, %2":"=v"(r):"v"(a),"v"(b));return r;}
typedef float f32x2_t __attribute__((ext_vector_type(2))); typedef __bf16 bf16x2_t __attribute__((ext_vector_type(2)));
__device__ __forceinline__ unsigned cvtpk_s(float lo,float hi){f32x2_t v={lo,hi};bf16x2_t b=__builtin_convertvector(v,bf16x2_t);return __builtin_bit_cast(unsigned,b);}
#define WAIT_BAR(N) asm volatile("s_waitcnt vmcnt(" #N ") lgkmcnt(0)\n\ts_barrier":::"memory")

__device__ __forceinline__ void qkt(f32x16&p0,f32x16&p1,const char*Kslot,const bf16x8*qr,const f32x16&negm,int r32,int hi){
  const char*kb=Kslot+hi*1024+r32*16;
  #pragma unroll
  for(int d0=0;d0<4;++d0){
    const bf16x8 b0=*reinterpret_cast<const bf16x8*>(kb+d0*2048);
    const bf16x8 b1=*reinterpret_cast<const bf16x8*>(kb+d0*2048+512);
    if(d0==0){p0=__builtin_amdgcn_mfma_f32_32x32x16_bf16(b0,qr[0],negm,0,0,0);p1=__builtin_amdgcn_mfma_f32_32x32x16_bf16(b1,qr[0],negm,0,0,0);}
    else{p0=__builtin_amdgcn_mfma_f32_32x32x16_bf16(b0,qr[d0],p0,0,0,0);p1=__builtin_amdgcn_mfma_f32_32x32x16_bf16(b1,qr[d0],p1,0,0,0);}}
}
typedef __attribute__((address_space(3))) const char* lds_cptr;
typedef short v4i16_t __attribute__((ext_vector_type(4)));
__device__ __forceinline__ void kload8(bf16x8*kf,lds_cptr kp){
  kf[0]=*(const __attribute__((address_space(3))) bf16x8*)(kp);      kf[1]=*(const __attribute__((address_space(3))) bf16x8*)(kp+512);
  kf[2]=*(const __attribute__((address_space(3))) bf16x8*)(kp+2048); kf[3]=*(const __attribute__((address_space(3))) bf16x8*)(kp+2560);
  kf[4]=*(const __attribute__((address_space(3))) bf16x8*)(kp+4096); kf[5]=*(const __attribute__((address_space(3))) bf16x8*)(kp+4608);
  kf[6]=*(const __attribute__((address_space(3))) bf16x8*)(kp+6144); kf[7]=*(const __attribute__((address_space(3))) bf16x8*)(kp+6656);
}
__device__ __forceinline__ void kload2(bf16x8*kf,lds_cptr kp,int j){ kf[2*j]=*(const __attribute__((address_space(3))) bf16x8*)(kp+j*2048); kf[2*j+1]=*(const __attribute__((address_space(3))) bf16x8*)(kp+j*2048+512); }
__device__ __forceinline__ s16x4 vtr(lds_cptr p){ return __builtin_bit_cast(s16x4,__builtin_amdgcn_ds_read_tr16_b64_v4i16((__attribute__((address_space(3))) v4i16_t*)p)); }
__device__ __forceinline__ float rowmax(const f32x16&p0,const f32x16&p1){
  float a=max3f(p0[0],p0[1],p1[0]),b=max3f(p0[2],p0[3],p1[1]);a=max3f(a,p1[2],p1[3]);
  #pragma unroll
  for(int r=4;r<16;r+=4){a=max3f(a,p0[r],p0[r+1]);b=max3f(b,p0[r+2],p0[r+3]);a=max3f(a,p1[r],p1[r+1]);b=max3f(b,p1[r+2],p1[r+3]);}
  const float m=max2f(a,b);
  auto rr=__builtin_amdgcn_permlane32_swap(__float_as_uint(m),__float_as_uint(m),false,false);
  return max2f(__uint_as_float(rr[0]),__uint_as_float(rr[1]));
}
__device__ __forceinline__ void pv(f32x16*o,int vb,bf16x8 pa0,bf16x8 pa1,bf16x8 pa2,bf16x8 pa3){
  #pragma unroll
  for(int d0=0;d0<2;++d0){s16x4 lo[4],hi[4];
    #pragma unroll
    for(int ks=0;ks<4;++ks){
      asm volatile("ds_read_b64_tr_b16 %0,%1 offset:%c2":"=&v"(lo[ks]):"v"(vb),"i"(d0*4096+ks*1024):"memory");
      asm volatile("ds_read_b64_tr_b16 %0,%1 offset:%c2":"=&v"(hi[ks]):"v"(vb),"i"(d0*4096+ks*1024+512):"memory");}
    asm volatile("s_waitcnt lgkmcnt(0)":::"memory");SBAR();
    #define PK(k) (bf16x8){lo[k][0],lo[k][1],lo[k][2],lo[k][3],hi[k][0],hi[k][1],hi[k][2],hi[k][3]}
    o[d0]=__builtin_amdgcn_mfma_f32_32x32x16_bf16(pa0,PK(0),o[d0],0,0,0);
    o[d0]=__builtin_amdgcn_mfma_f32_32x32x16_bf16(pa1,PK(1),o[d0],0,0,0);
    o[d0]=__builtin_amdgcn_mfma_f32_32x32x16_bf16(pa2,PK(2),o[d0],0,0,0);
    o[d0]=__builtin_amdgcn_mfma_f32_32x32x16_bf16(pa3,PK(3),o[d0],0,0,0);
    #undef PK
  }
}

#ifndef ATTN_STORE16
#define ATTN_STORE16(p,v) (*(u32x4*)(p)=(v))
#endif
template<int THRL> __device__ __forceinline__ void attn_unit(int b,int h,int qb,const bf16*Q,const bf16*__restrict__ K,const bf16*__restrict__ V,bf16*O,const bf16*__restrict__ Gt,const float*__restrict__ CL,char*shm){
  int tid_o=threadIdx.x; asm volatile("":"+v"(tid_o)); const int tid=tid_o,lane=tid&63,r32=lane&31,hi=lane>>5; const int wid=__builtin_amdgcn_readfirstlane(tid>>6);
  const long rowbase=(long)b*SEQ; const int q0=qb*QB;
  const float*cbh=CL+((long)b*NHEAD+h)*SEQ;
  { typedef float f4_t __attribute__((ext_vector_type(4))); __attribute__((address_space(3))) f4_t*cl4=(__attribute__((address_space(3))) f4_t*)((lds_cptr)shm+LDS_CB);
    for(int i=tid;i<(q0+QB)/4;i+=NW*64)cl4[i]=*(const f4_t*)(cbh+4*i); }
  const float cq=cbh[q0+wid*QBLK+(lane&31)];
  const bf16*Qw=Q+(rowbase+q0+wid*QBLK)*DM+h*D;
  const bf16*Kh=K+rowbase*DM+h*D,*Vh=V+rowbase*DM+h*D;
  const unsigned lds0=(unsigned)(uintptr_t)shm;
  float*wsf=(float*)(shm+LDS_WS)+wid*64;
  const bf16*ksrc=Kh+(long)lane*DM+wid*8;
  const bf16*vsrc=Vh+(long)(16*(wid&3)+(lane>>2))*DM+(wid>>2)*32+(lane&3)*8;
  const unsigned kdst=lds0+LDS_K+wid*1024, vdst=lds0+LDS_V+wid*1024;
  #define DMA_K(t,slot) glds16(ksrc+(long)(t)*KVBLK*DM,(unsigned)__builtin_amdgcn_readfirstlane(kdst+(slot)))
  #define DMA_V(t,slot) glds16(vsrc+(long)(t)*KVBLK*DM,(unsigned)__builtin_amdgcn_readfirstlane(vdst+(slot)))
  const int vb0=(int)(lds0+LDS_V)+((lane>>4)&1)*32+(lane&3)*8+(4*hi+((lane&15)>>2))*64;
  const char*Kbase=shm+LDS_K; bf16x8 kf[8];
  const lds_cptr shm3=(lds_cptr)shm; const lds_cptr kp0=shm3+LDS_K+hi*1024+r32*16; const lds_cptr vp0=shm3+LDS_V+((lane>>4)&1)*32+(lane&3)*8+(4*hi+((lane&15)>>2))*64;
  const int NT=(q0+QB)/KVBLK;
  DMA_K(0,0);DMA_V(0,0);DMA_K(1,SLOTB);
  bf16x8 qr[4];
  #pragma unroll
  for(int d0=0;d0<4;++d0)qr[d0]=*reinterpret_cast<const bf16x8*>(&Qw[(long)r32*DM+d0*16+hi*8]);
  float mhat=0.f,l_reg=0.f;f32x16 o[2];o[0]=f32x16{};o[1]=f32x16{};f32x16 negm;
  #pragma unroll
  for(int r=0;r<16;++r)negm[r]=cq;
  asm volatile("":"+v"(negm));
  typedef float cf4_t __attribute__((ext_vector_type(4))); const __attribute__((address_space(3))) cf4_t*clds=(const __attribute__((address_space(3))) cf4_t*)((lds_cptr)shm+LDS_CB)+hi;
  #define CBIAS(P0,P1,t) do{ const __attribute__((address_space(3))) cf4_t*cp_=clds+16*(t); _Pragma("unroll") for(int j_=0;j_<4;++j_){ const cf4_t a_=cp_[2*j_], b_=cp_[8+2*j_]; \
      P0[4*j_]-=a_[0];P0[4*j_+1]-=a_[1];P0[4*j_+2]-=a_[2];P0[4*j_+3]-=a_[3]; P1[4*j_]-=b_[0];P1[4*j_+1]-=b_[1];P1[4*j_+2]-=b_[2];P1[4*j_+3]-=b_[3]; } }while(0)
  const int qrel=wid*QBLK+r32;
  #define CMASK(P0,P1,t) do{int jb_=(t)-(NT-4); if(jb_>=0)cmask(P0,P1,jb_,qrel,hi);}while(0)
  bool resc=false;
  #define START(P0,P1) do{ const float rm=rowmax(P0,P1); resc=false; \
    { const float dl=rm; mhat=fadd_s(mhat,dl); \
      _Pragma("unroll") for(int r=0;r<16;++r){P0[r]=fsub_s(P0[r],dl);P1[r]=fsub_s(P1[r],dl);} \
      _Pragma("unroll") for(int r=0;r<16;++r)negm[r]=cq-mhat; asm volatile("":"+v"(negm)); } \
    _Pragma("unroll") for(int r=0;r<16;++r)P0[r]=__builtin_amdgcn_exp2f(P0[r]); }while(0)
  #define RESC() do{ if(resc){ asm volatile("s_waitcnt lgkmcnt(0)":::"memory"); \
      _Pragma("unroll") for(int d_=0;d_<2;++d_) _Pragma("unroll") for(int r=0;r<16;++r)o[d_][r]*=wsf[crow(r,hi)]; } }while(0)
  f32x16 pA0,pA1,pB0,pB1;
  int sl_prev=0,sl_cur=0,sl_next=SLOTB;
  #define ROT() do{sl_prev=sl_cur;sl_cur=sl_next;sl_next=(sl_next==(NSLOT-1)*SLOTB)?0:sl_next+SLOTB;}while(0)
  DMA_K(2,2*SLOTB);
  WAIT_BAR(3);
  qkt(pA0,pA1,Kbase,qr,negm,r32,hi);asm volatile("s_nop 15\n\ts_nop 7":"+v"(pA0),"+v"(pA1));CMASK(pA0,pA1,0);CBIAS(pA0,pA1,0);
  START(pA0,pA1);
  _Pragma("unroll") for(int r=0;r<16;++r)pA1[r]=__builtin_amdgcn_exp2f(pA1[r]);
  WAIT_BAR(0);
  DMA_K(3,0);DMA_V(1,SLOTB);
  ROT();
  kload8(kf,kp0+sl_cur);
  WAIT_BAR(2);
  s16x4 vlo[8],vhi[8]; u32x4 pw0,pw1,pw2,pw3;
  #define PKW(P,B) cvtpk_s(P[B],P[B+1])
  #define PAF(k) __builtin_bit_cast(bf16x8,pw##k)
  #define VFR(i) (bf16x8){vlo[i][0],vlo[i][1],vlo[i][2],vlo[i][3],vhi[i][0],vhi[i][1],vhi[i][2],vhi[i][3]}
  #define PIN(x) asm volatile("":"+v"(x))
  #define MX3(a,b,c) __builtin_fmaxf(__builtin_fmaxf((a),(b)),(c))
  #define GAPA(MF,A0,A1,A2,A3,W0,W1,PW) do{ MF; sacc+=A0; sacc+=A1; sacc+=A2; sacc+=A3; PIN(sacc); W0; W1; PIN(PW); SBAR(); }while(0)
  #define EX(v) __builtin_amdgcn_exp2f(v)
  #define GAPB(MF,X,B) do{ MF; X[B]=EX(X[B]); X[B+1]=EX(X[B+1]); X[B+2]=EX(X[B+2]); X[B+3]=EX(X[B+3]); PIN(X); SBAR(); }while(0)
  #define VRD(i) do{ vlo[i]=vtr(vp_+(((i)>>2)*4096+((i)&3)*1024)); vhi[i]=vtr(vp_+(((i)>>2)*4096+((i)&3)*1024+512)); }while(0)
  #define KRD(G,j) do{ if(G){ kload2(kf,kp0+sl_next,j); SBAR(); } }while(0)
  #define STEP(C0,C1,P0,P1,t,GK,GV,GL) do{ SBAR(); \
    const lds_cptr vp_=vp0+sl_prev; \
    VRD(0); SBAR(); float sacc=(P0[0]+P0[1]); \
    GAPA(C0=__builtin_amdgcn_mfma_f32_32x32x16_bf16(kf[0],qr[0],negm,0,0,0), P0[2],P0[3],P0[4],P0[5],     pw0[0]=PKW(P0,0), pw0[1]=PKW(P0,2), pw0); \
    VRD(4); SBAR(); GAPA(C1=__builtin_amdgcn_mfma_f32_32x32x16_bf16(kf[1],qr[0],negm,0,0,0), P0[6],P0[7],P0[8],P0[9],     pw0[2]=PKW(P0,4), pw0[3]=PKW(P0,6), pw0); \
    VRD(1); SBAR(); GAPA(C0=__builtin_amdgcn_mfma_f32_32x32x16_bf16(kf[2],qr[1],C0,0,0,0),   P0[10],P0[11],P0[12],P0[13], pw1[0]=PKW(P0,8), pw1[1]=PKW(P0,10), pw1); \
    VRD(5); SBAR(); GAPA(C1=__builtin_amdgcn_mfma_f32_32x32x16_bf16(kf[3],qr[1],C1,0,0,0),   P0[14],P0[15],P1[0],P1[1],   pw1[2]=PKW(P0,12),pw1[3]=PKW(P0,14), pw1); \
    VRD(2); SBAR(); GAPA(C0=__builtin_amdgcn_mfma_f32_32x32x16_bf16(kf[4],qr[2],C0,0,0,0),   P1[2],P1[3],P1[4],P1[5],     pw2[0]=PKW(P1,0), pw2[1]=PKW(P1,2), pw2); \
    VRD(6); SBAR(); GAPA(C1=__builtin_amdgcn_mfma_f32_32x32x16_bf16(kf[5],qr[2],C1,0,0,0),   P1[6],P1[7],P1[8],P1[9],     pw2[2]=PKW(P1,4), pw2[3]=PKW(P1,6), pw2); \
    VRD(3); SBAR(); GAPA(C0=__builtin_amdgcn_mfma_f32_32x32x16_bf16(kf[6],qr[3],C0,0,0,0),   P1[10],P1[11],P1[12],P1[13], pw3[0]=PKW(P1,8), pw3[1]=PKW(P1,10), pw3); \
    VRD(7); SBAR(); GAPA(C1=__builtin_amdgcn_mfma_f32_32x32x16_bf16(kf[7],qr[3],C1,0,0,0),   P1[14],P1[15],0.f,0.f,       pw3[2]=PKW(P1,12),pw3[3]=PKW(P1,14), pw3); \
    l_reg+=sacc; \
    if(GK){DMA_K((t)+3,sl_cur);} if(GV){DMA_V((t)+1,sl_next);} \
    CMASK(C0,C1,t); CBIAS(C0,C1,t); \
    { float a=MX3(C0[0],C0[1],C1[0]),b=MX3(C0[2],C0[3],C1[1]); a=MX3(a,C1[2],C1[3]); \
      _Pragma("unroll") for(int r=4;r<16;r+=4){a=MX3(a,C0[r],C0[r+1]);b=MX3(b,C0[r+2],C0[r+3]);a=MX3(a,C1[r],C1[r+1]);b=MX3(b,C1[r+2],C1[r+3]);} \
      float rm=__builtin_fmaxf(a,b); { auto rr=__builtin_amdgcn_permlane32_swap(__float_as_uint(rm),__float_as_uint(rm),false,false); rm=__builtin_fmaxf(__uint_as_float(rr[0]),__uint_as_float(rr[1])); } \
      resc=false; \
      if(__builtin_expect(__any(rm>(float)THRL),0)){ const float dl=__builtin_fmaxf(rm,0.f); mhat+=dl; \
        _Pragma("unroll") for(int r=0;r<16;++r){C0[r]-=dl;C1[r]-=dl;} \
        _Pragma("unroll") for(int r=0;r<16;++r)negm[r]=cq-mhat; asm volatile("":"+v"(negm)); \
        const float f=__builtin_amdgcn_exp2f(-dl); l_reg*=f; if(hi==0)wsf[r32]=f; resc=true; } } \
    SBAR(); \
    GAPB(o[0]=__builtin_amdgcn_mfma_f32_32x32x16_bf16(PAF(0),VFR(0),o[0],0,0,0), C0,0); \
    GAPB(o[1]=__builtin_amdgcn_mfma_f32_32x32x16_bf16(PAF(0),VFR(4),o[1],0,0,0), C0,4); \
    KRD(GL,0); GAPB(o[0]=__builtin_amdgcn_mfma_f32_32x32x16_bf16(PAF(1),VFR(1),o[0],0,0,0), C0,8); \
    KRD(GL,1); GAPB(o[1]=__builtin_amdgcn_mfma_f32_32x32x16_bf16(PAF(1),VFR(5),o[1],0,0,0), C0,12); \
    KRD(GL,2); GAPB(o[0]=__builtin_amdgcn_mfma_f32_32x32x16_bf16(PAF(2),VFR(2),o[0],0,0,0), C1,0); \
    KRD(GL,3); GAPB(o[1]=__builtin_amdgcn_mfma_f32_32x32x16_bf16(PAF(2),VFR(6),o[1],0,0,0), C1,4); \
    GAPB(o[0]=__builtin_amdgcn_mfma_f32_32x32x16_bf16(PAF(3),VFR(3),o[0],0,0,0), C1,8); \
    GAPB(o[1]=__builtin_amdgcn_mfma_f32_32x32x16_bf16(PAF(3),VFR(7),o[1],0,0,0), C1,12); \
    }while(0)
  int t=1;
  #undef CMASK
  #define CMASK(P0,P1,t) do{}while(0)
  for(;t+5<NT;t+=2){
    STEP(pB0,pB1,pA0,pA1,t,true,true,true);     WAIT_BAR(2); RESC(); ROT();
    STEP(pA0,pA1,pB0,pB1,t+1,true,true,true);   WAIT_BAR(2); RESC(); ROT();
  }
  #undef CMASK
  #define CMASK(P0,P1,t) do{int jb_=(t)-(NT-4); if(jb_>=0)cmask(P0,P1,jb_,qrel,hi);}while(0)
  #define ENDW(tt) do{ if((tt)+3<NT){WAIT_BAR(2);} else if((tt)+2<NT){WAIT_BAR(1);} else {WAIT_BAR(0);} }while(0)
  for(;t+1<NT;t+=2){
    STEP(pB0,pB1,pA0,pA1,t,(t+3<NT),(t+1<NT),(t+1<NT));       ENDW(t);   RESC(); ROT();
    STEP(pA0,pA1,pB0,pB1,t+1,(t+4<NT),(t+2<NT),(t+2<NT));     ENDW(t+1); RESC(); ROT();
  }
  STEP(pB0,pB1,pA0,pA1,NT-1,false,false,false); RESC();
  { float sacc=pB0[0]+pB0[1]; _Pragma("unroll") for(int r=2;r<16;++r)sacc+=pB0[r]; _Pragma("unroll") for(int r=0;r<16;++r)sacc+=pB1[r]; l_reg+=sacc;
    pw0=(u32x4){PKW(pB0,0),PKW(pB0,2),PKW(pB0,4),PKW(pB0,6)};pw1=(u32x4){PKW(pB0,8),PKW(pB0,10),PKW(pB0,12),PKW(pB0,14)};pw2=(u32x4){PKW(pB1,0),PKW(pB1,2),PKW(pB1,4),PKW(pB1,6)};pw3=(u32x4){PKW(pB1,8),PKW(pB1,10),PKW(pB1,12),PKW(pB1,14)};
    SBAR(); pv(o,vb0+sl_cur,PAF(0),PAF(1),PAF(2),PAF(3)); }
  #undef PKW
  #undef PAF
  #undef VFR
  #undef PIN
  #undef MX3
  #undef GAPA
  #undef GAPB
  #undef EX
  #undef VRD
  #undef KRD
  #undef STEP
  #undef ENDW
  {auto rr=__builtin_amdgcn_permlane32_swap(__float_as_uint(l_reg),__float_as_uint(l_reg),false,false);l_reg=__uint_as_float(rr[0])+__uint_as_float(rr[1]);}
  if(hi==0)wsf[32+r32]=l_reg;asm volatile("s_waitcnt lgkmcnt(0)":::"memory");
  float rli[16];
  #pragma unroll
  for(int r=0;r<16;++r)rli[r]=__builtin_amdgcn_rcpf(wsf[32+crow(r,hi)]);
  bf16*Ow=O+(rowbase+q0+wid*QBLK)*DM+h*D;
  { bf16*stg=(bf16*)(shm+LDS_OST)+wid*2048;
    #pragma unroll
    for(int r=0;r<16;++r){const int orow=crow(r,hi);
      #pragma unroll
      for(int d0=0;d0<2;++d0)stg[orow*64+d0*32+r32]=__float2bfloat16(o[d0][r]*rli[r]);}
    asm volatile("s_waitcnt lgkmcnt(0)":::"memory");
    #pragma unroll
    for(int i=0;i<4;++i){const bf16*Gw=Gt+(rowbase+q0+wid*QBLK)*DM+h*D; const int row=i*8+(lane>>3),ch=lane&7; const u32x4 v=*(const u32x4*)(stg+row*64+ch*8); const u32x4 gq=*(const u32x4*)(Gw+(long)row*DM+ch*8); u32x4 w;
      #pragma unroll
      for(int e=0;e<4;++e){ const float a0=__uint_as_float(v[e]<<16)*__uint_as_float(gq[e]<<16), a1=__uint_as_float(v[e]&0xffff0000u)*__uint_as_float(gq[e]&0xffff0000u); w[e]=cvtpk_s(a0,a1); }
      ATTN_STORE16(Ow+(long)row*DM+ch*8,w);} }
  asm volatile("s_waitcnt lgkmcnt(0)\n\ts_barrier":::"memory");
  #undef CBIAS
  #undef DMA_K
  #undef DMA_V
  #undef CMASK
  #undef START
  #undef RESC
  #undef ROT
}
constexpr int ATTN_LDS_BYTES=LDS_BYTES;
struct AttnTensors { const bf16* Q; const bf16* K; const bf16* V; bf16* O; const bf16* G; const float* CL; };
struct AttnUnit { int bh; int qb; };
struct StaticOrder {
  int vcu, G;
  __device__ __forceinline__ explicit StaticOrder(int grid,int block):vcu((grid%8==0)?(block%8)*(grid/8)+block/8:block),G(grid){}
  __device__ __forceinline__ bool next(int i,AttnUnit&u)const{
    if(G==256){ if(i>=8)return false; const int j=2*(i>>1)+(vcu&1); u.bh=vcu>>1; u.qb=(i&1)?15-j:j; return true; }
    const int idx=i*G+vcu; if(idx>=BATCH*NHEAD*NQB)return false; u.bh=idx/NQB; u.qb=NQB-1-idx%NQB; return true; }
  __device__ __forceinline__ void a_ready(const AttnUnit&)const{}
  __device__ __forceinline__ void done(const AttnUnit&)const{}
};
template<class Sched,int THRL=8> __device__ __forceinline__ void attn_phase(char*lds,const AttnTensors&T,const Sched&S){
  AttnUnit u;
  for(int i=0;S.next(i,u);++i){ S.a_ready(u); attn_unit<THRL>(u.bh/NHEAD,u.bh%NHEAD,u.qb,T.Q,T.K,T.V,T.O,T.G,T.CL,lds); S.done(u); }
}
#undef SBAR
#undef WAIT_BAR
}
#define GAS __attribute__((address_space(1)))
#define LAS __attribute__((address_space(3)))
typedef unsigned short bfu;
typedef unsigned v4u __attribute__((ext_vector_type(4)));
typedef unsigned v2u __attribute__((ext_vector_type(2)));
typedef float f32x4 __attribute__((ext_vector_type(4)));
typedef short bf16x8 __attribute__((ext_vector_type(8)));
#define LDS_WAIT() asm volatile("s_waitcnt lgkmcnt(0)" ::: "memory")
constexpr int NWAVES = 8;
constexpr int BATCH = 8, SEQ = 4096, D = 1024, FF = 2816, T = BATCH * SEQ, PLE = 256, NKVF = 2064, NKVFP = 2304;
constexpr float EPS = 1e-6f, LOG2E = 1.4426950408889634f;
constexpr size_t MiB = 1u << 20;
constexpr size_t E_W1IN = 0, N_WIN = (size_t)2 * FF * D, N_WOUT = (size_t)D * FF;
constexpr size_t E_W1OUT = E_W1IN + 2 * N_WIN, E_W2IN = E_W1OUT + 2 * N_WOUT, E_W2OUT = E_W2IN + 2 * N_WIN, E_WHIN = E_W2OUT + 2 * N_WOUT;
constexpr size_t E_WHOUT = E_WHIN + (size_t)4 * D * D, E_WKVF = E_WHOUT + (size_t)D * D, E_WQG = E_WKVF + (size_t)NKVFP * D, E_WFO = E_WQG + (size_t)2 * D * D;
constexpr size_t E_WPG = E_WFO + (size_t)D * D, E_WPP = E_WPG + (size_t)2 * D * D, E_WEND = E_WPP + (size_t)2 * D * PLE;
static_assert(E_WEND * 2 <= 92 * MiB, "weights fit");
constexpr size_t WS_P = 92 * MiB, WS_LOGF = 124 * MiB, WS_C = 126 * MiB, WS_AY = 128 * MiB, WS_BIG = 192 * MiB, WS_PROJ = 448 * MiB, WS_END = 512 * MiB;
constexpr size_t WS_V = WS_BIG + 192 * MiB, WS_K = WS_PROJ, WS_Q = WS_BIG, WS_G = WS_BIG + 64 * MiB;
constexpr int LDS_BYTES = 147456;

__device__ __forceinline__ float wave_sum(float v) {
#pragma unroll
    for (int o = 1; o < 64; o <<= 1) v += __shfl_xor(v, o);
    return v;
}
__device__ __forceinline__ unsigned pk2(float lo, float hi) { return pg8::cvt_pk_bf16(lo, hi); }
__device__ __forceinline__ float bf2f(unsigned short u) { return __uint_as_float((unsigned)u << 16); }
__device__ __forceinline__ unsigned short f2b(float f) { return (unsigned short)(pk2(f, 0.f) & 0xffffu); }

__device__ __forceinline__ void conv_item(const float* W, int K, int N, bfu* WT, const float* gain, int gmask, int sw, LAS float* scr, int item, int lane) {
    const int nblk = (N + 31) / 32, kb = item / nblk, nb = item % nblk, k0 = 64 * kb, n0 = 32 * nb;
    const int nn = n0 + (lane & 31); const bool nok = nn < N;
#pragma unroll 8
    for (int i = 0; i < 32; ++i) { const int kk = 2 * i + (lane >> 5); float w = nok ? W[(size_t)(k0 + kk) * N + nn] : 0.f; if (gain) w *= gain[(k0 + kk) & gmask]; scr[kk * 33 + (lane & 31)] = w; }
    LDS_WAIT(); asm volatile("" ::: "memory");
    int drow0 = n0; if (sw) { const int j0 = (n0 < FF) ? n0 : n0 - FF; drow0 = 256 * (j0 >> 7) + (j0 & 127) + ((n0 < FF) ? 0 : 128); }
    const int c = lane & 7;
#pragma unroll
    for (int j = 0; j < 4; ++j) { const int n = (lane >> 3) + 8 * j; const LAS float* s = scr + (8 * c) * 33 + n;
        v4u o; o.x = pk2(s[0 * 33], s[1 * 33]); o.y = pk2(s[2 * 33], s[3 * 33]); o.z = pk2(s[4 * 33], s[5 * 33]); o.w = pk2(s[6 * 33], s[7 * 33]);
        *(v4u*)(WT + (size_t)(drow0 + n) * K + k0 + 8 * c) = o; }
    LDS_WAIT(); asm volatile("" ::: "memory");
}
__device__ __forceinline__ void rms_row_to_bf16(const float* xrow, bfu* orow, int lane) {
    const f32x4* xr = (const f32x4*)xrow + lane;
    f32x4 v[4]; float s = 0.f;
#pragma unroll
    for (int j = 0; j < 4; ++j) { v[j] = xr[64 * j]; s += (v[j].x * v[j].x + v[j].y * v[j].y) + (v[j].z * v[j].z + v[j].w * v[j].w); }
    const float r = __builtin_amdgcn_rsqf(wave_sum(s) * (1.f / D) + EPS);
    v2u* o8 = (v2u*)orow + lane;
#pragma unroll
    for (int j = 0; j < 4; ++j) { v2u w; w.x = pk2(v[j].x * r, v[j].y * r); w.y = pk2(v[j].z * r, v[j].w * r); o8[64 * j] = w; }
}
__device__ __forceinline__ void rw_phase(const float* hin, float* hout, const bfu* Y, bfu* A, const float* gain, float scale, int gw, int ngw, int lane) {
    f32x4 g[4];
#pragma unroll
    for (int j = 0; j < 4; ++j) g[j] = *((const f32x4*)gain + lane + 64 * j);
    for (int m = gw; m < T; m += ngw) {
        const f32x4* hr = (const f32x4*)(hin + (size_t)m * D) + lane; const v2u* yr = (const v2u*)(Y + (size_t)m * D) + lane;
        f32x4 v[4], y[4]; float s = 0.f;
#pragma unroll
        for (int j = 0; j < 4; ++j) { v[j] = hr[64 * j]; const v2u w = yr[64 * j]; y[j] = (f32x4){pg8::bflo(w.x), pg8::bfhi(w.x), pg8::bflo(w.y), pg8::bfhi(w.y)};
            s += (y[j].x * y[j].x + y[j].y * y[j].y) + (y[j].z * y[j].z + y[j].w * y[j].w); }
        const float ry = __builtin_amdgcn_rsqf(wave_sum(s) * (1.f / D) + EPS) * scale; float s2 = 0.f;
#pragma unroll
        for (int j = 0; j < 4; ++j) { v[j] = v[j] + y[j] * ry * g[j]; s2 += (v[j].x * v[j].x + v[j].y * v[j].y) + (v[j].z * v[j].z + v[j].w * v[j].w); }
        const float r2 = __builtin_amdgcn_rsqf(wave_sum(s2) * (1.f / D) + EPS);
        f32x4* ho = (f32x4*)(hout + (size_t)m * D) + lane; v2u* ao = (v2u*)(A + (size_t)m * D) + lane;
#pragma unroll
        for (int j = 0; j < 4; ++j) { ho[64 * j] = v[j]; v2u w; w.x = pk2(v[j].x * r2, v[j].y * r2); w.y = pk2(v[j].z * r2, v[j].w * r2); ao[64 * j] = w; }
    }
}

constexpr int HG_QH = 0, HG_QT = 17408, HG_KT = 34816, HG_KHT = 52224, HG_VT = 70656, HG_PP = 89088, HG_ST = 98304, HG_TOT = 133120, HG_DV = 135168, HG_END = 135680;
constexpr int RS = 136, RS2 = 72, OFS = 132;
static_assert(HG_END <= LDS_BYTES, "hgrn lds");
__device__ __forceinline__ f32x4 mfma16(bf16x8 a, bf16x8 b, f32x4 c) { return __builtin_amdgcn_mfma_f32_16x16x32_bf16(a, b, c, 0, 0, 0); }
constexpr int HSEG = 4, HCH = SEQ / 64 / HSEG;
template <bool OUT>
__device__ __forceinline__ void hgrn_scan(LAS unsigned char* lds, bfu* QZVG, const float* lbl, int bh, int seg, float* Ebuf, float* Lbuf) {
    int tid_o = threadIdx.x; asm volatile("" : "+v"(tid_o)); const int tid = tid_o, lane = tid & 63, wid = __builtin_amdgcn_readfirstlane(tid >> 6), col = tid & 127, rg = tid >> 7, fr = lane & 15, fq = lane >> 4;
    const int b = bh >> 3, h = bh & 7;
    LAS bfu* QH = (LAS bfu*)(lds + HG_QH); LAS bfu* QT = (LAS bfu*)(lds + HG_QT); LAS bfu* KT = (LAS bfu*)(lds + HG_KT); LAS bfu* KHT = (LAS bfu*)(lds + HG_KHT);
    LAS bfu* VT = (LAS bfu*)(lds + HG_VT); LAS bfu* PP = (LAS bfu*)(lds + HG_PP); LAS bfu* ST = (LAS bfu*)(lds + HG_ST);
    LAS float* TOT = (LAS float*)(lds + HG_TOT); LAS float* DV = (LAS float*)(lds + HG_DV); LAS float* OF = (LAS float*)(lds + HG_QT);
    const float l0 = lbl[h * 128 + col], l1 = lbl[1024 + h * 128 + col];
    const float lb = 1.f / (1.f + __expf(l1 - l0)), omlb = 1.f - lb;
    bfu* base = QZVG + ((size_t)b * SEQ + (size_t)seg * HCH * 64) * 4096 + h * 128;
    const bfu* pq = base + (size_t)(16 * rg) * 4096 + col; const bfu* pz = pq + 1024; const bfu* pv = pq + 2048;
    const int erow = tid >> 3, eseg = tid & 7;
    const bfu* pg = base + 3072 + (size_t)erow * 4096 + 16 * eseg; bfu* po = base + (size_t)erow * 4096 + 16 * eseg;
    f32x4 Sacc[8];
#pragma unroll
    for (int i = 0; i < 8; ++i) Sacc[i] = (f32x4){0.f, 0.f, 0.f, 0.f};
    float Lacc = 0.f;
    if constexpr (OUT) {
        for (int j = 0; j < seg; ++j) {
            const float* Ej = Ebuf + ((size_t)(bh * HSEG + j) * 64 * 64) * 4 + (size_t)(wid * 8) * 64 * 4; const float* Lj = Lbuf + (size_t)(bh * HSEG + j) * 128;
#pragma unroll
            for (int kb = 0; kb < 8; ++kb) { const f32x4 e = *(const f32x4*)(Ej + ((size_t)kb * 64 + lane) * 4); const f32x4 l4 = *(const f32x4*)(Lj + 16 * kb + 4 * fq);
                f32x4 s = Sacc[kb]; s[0] = s[0] * __expf(l4[0]) + e[0]; s[1] = s[1] * __expf(l4[1]) + e[1]; s[2] = s[2] * __expf(l4[2]) + e[2]; s[3] = s[3] * __expf(l4[3]) + e[3]; Sacc[kb] = s; }
        }
#pragma unroll
        for (int kb = 0; kb < 8; ++kb) *(LAS v2u*)(ST + (16 * wid + fr) * RS + 16 * kb + 4 * fq) = (v2u){pk2(Sacc[kb][0], Sacc[kb][1]), pk2(Sacc[kb][2], Sacc[kb][3])};
    }
    unsigned short zr[16], qr[16], vr[16]; v4u gr0 = (v4u){0u, 0u, 0u, 0u}, gr1 = gr0;
#define HG_LOAD() do { _Pragma("unroll") for (int j = 0; j < 16; ++j) { zr[j] = pz[(size_t)j * 4096]; vr[j] = pv[(size_t)j * 4096]; if (OUT) qr[j] = pq[(size_t)j * 4096]; else qr[j] = 0; } \
        if (OUT) { gr0 = *(const v4u*)pg; gr1 = *(const v4u*)(pg + 8); } pz += (size_t)64 * 4096; pq += (size_t)64 * 4096; pv += (size_t)64 * 4096; pg += (size_t)64 * 4096; } while (0)
    HG_LOAD();
    for (int c = 0; c < HCH; ++c) {
        float kk[16], cum[16], qf[16]; unsigned short vv[16]; const v4u g0 = gr0, g1 = gr1;
        float run = 0.f;
#pragma unroll
        for (int j = 0; j < 16; ++j) { const float z = bf2f(zr[j]); const float k = omlb * __builtin_amdgcn_rcpf(1.f + __expf(z)); run += __logf(1.f - k); cum[j] = run; kk[j] = k; qf[j] = bf2f(qr[j]); vv[j] = vr[j]; }
        TOT[rg * 128 + col] = run;
        if (c + 1 < HCH) HG_LOAD();
        LDS_WAIT(); __builtin_amdgcn_s_barrier(); asm volatile("" ::: "memory");
        const float t0 = TOT[col], t1 = TOT[128 + col], t2 = TOT[256 + col], t3 = TOT[384 + col];
        const float pre = (rg > 0 ? t0 : 0.f) + (rg > 1 ? t1 : 0.f) + (rg > 2 ? t2 : 0.f), tot = (t0 + t1) + (t2 + t3), mid = t0 + t1;
        Lacc += tot;
        unsigned khp[8], vvp[8];
#pragma unroll
        for (int j = 0; j < 16; ++j) { const float cj = pre + cum[j]; const int r = 16 * rg + j;
            if constexpr (OUT) { QH[r * RS + col] = f2b(qf[j] * __expf(cj)); QT[r * RS + col] = f2b(qf[j] * __expf(cj - mid)); KT[r * RS + col] = f2b(kk[j] * __expf(mid - cj)); }
            const unsigned short kh = f2b(kk[j] * __expf(tot - cj));
            if (j & 1) { khp[j >> 1] |= (unsigned)kh << 16; vvp[j >> 1] |= (unsigned)vv[j] << 16; } else { khp[j >> 1] = kh; vvp[j >> 1] = vv[j]; } }
        *(LAS v4u*)(KHT + col * RS2 + 16 * rg) = (v4u){khp[0], khp[1], khp[2], khp[3]}; *(LAS v4u*)(KHT + col * RS2 + 16 * rg + 8) = (v4u){khp[4], khp[5], khp[6], khp[7]};
        *(LAS v4u*)(VT + col * RS2 + 16 * rg) = (v4u){vvp[0], vvp[1], vvp[2], vvp[3]}; *(LAS v4u*)(VT + col * RS2 + 16 * rg + 8) = (v4u){vvp[4], vvp[5], vvp[6], vvp[7]};
        if (rg == 0) DV[col] = __expf(tot);
        LDS_WAIT(); __builtin_amdgcn_s_barrier(); asm volatile("" ::: "memory");
        if constexpr (OUT) {
            const int tb = wid >> 1;
#pragma unroll
            for (int ss = 0; ss < 2; ++ss) { const int sb = 2 * (wid & 1) + ss; f32x4 sc = (f32x4){0.f, 0.f, 0.f, 0.f};
                if (sb <= tb) {
#pragma unroll
                    for (int ks = 0; ks < 4; ++ks) { const bf16x8 a = *(const LAS bf16x8*)(QT + (16 * tb + fr) * RS + 32 * ks + 8 * fq), bq = *(const LAS bf16x8*)(KT + (16 * sb + fr) * RS + 32 * ks + 8 * fq); sc = mfma16(a, bq, sc); } }
#pragma unroll
                for (int i = 0; i < 4; ++i) { const int t = 16 * tb + 4 * fq + i, s = 16 * sb + fr; PP[t * RS2 + s] = f2b((sb <= tb && s <= t) ? sc[i] : 0.f); } }
            LDS_WAIT(); __builtin_amdgcn_s_barrier(); asm volatile("" ::: "memory");
        }
        {   bf16x8 vtf[2];
#pragma unroll
            for (int ks = 0; ks < 2; ++ks) vtf[ks] = *(const LAS bf16x8*)(VT + (16 * wid + fr) * RS2 + 32 * ks + 8 * fq);
            if constexpr (OUT) { bf16x8 stf[4];
#pragma unroll
                for (int ks = 0; ks < 4; ++ks) stf[ks] = *(const LAS bf16x8*)(ST + (16 * wid + fr) * RS + 32 * ks + 8 * fq);
#pragma unroll
                for (int tb = 0; tb < 4; ++tb) { f32x4 o = (f32x4){0.f, 0.f, 0.f, 0.f};
#pragma unroll
                    for (int ks = 0; ks < 4; ++ks) o = mfma16(*(const LAS bf16x8*)(QH + (16 * tb + fr) * RS + 32 * ks + 8 * fq), stf[ks], o);
#pragma unroll
                    for (int ks = 0; ks < 2; ++ks) o = mfma16(*(const LAS bf16x8*)(PP + (16 * tb + fr) * RS2 + 32 * ks + 8 * fq), vtf[ks], o);
#pragma unroll
                    for (int i = 0; i < 4; ++i) OF[(16 * tb + 4 * fq + i) * OFS + 16 * wid + fr] = o[i]; } }
#pragma unroll
            for (int kb = 0; kb < 8; ++kb) { const f32x4 d4 = *(const LAS f32x4*)(DV + 16 * kb + 4 * fq); f32x4 s = Sacc[kb] * d4;
#pragma unroll
                for (int ks = 0; ks < 2; ++ks) s = mfma16(*(const LAS bf16x8*)(KHT + (16 * kb + fr) * RS2 + 32 * ks + 8 * fq), vtf[ks], s);
                Sacc[kb] = s; if constexpr (OUT) *(LAS v2u*)(ST + (16 * wid + fr) * RS + 16 * kb + 4 * fq) = (v2u){pk2(s[0], s[1]), pk2(s[2], s[3])}; }
        }
        if constexpr (OUT) {
            LDS_WAIT(); __builtin_amdgcn_s_barrier(); asm volatile("" ::: "memory");
            f32x4 o4[4]; float ss = 0.f;
#pragma unroll
            for (int j = 0; j < 4; ++j) { o4[j] = *(const LAS f32x4*)(OF + erow * OFS + 16 * eseg + 4 * j); ss += (o4[j].x * o4[j].x + o4[j].y * o4[j].y) + (o4[j].z * o4[j].z + o4[j].w * o4[j].w); }
            ss += __shfl_xor(ss, 1); ss += __shfl_xor(ss, 2); ss += __shfl_xor(ss, 4);
            const float rs = __builtin_amdgcn_rsqf(ss * (1.f / 128.f) + EPS);
            unsigned w[8];
#pragma unroll
            for (int j = 0; j < 4; ++j) { const unsigned ga = (j < 2) ? g0[2 * j] : g1[2 * (j - 2)], gb = (j < 2) ? g0[2 * j + 1] : g1[2 * (j - 2) + 1];
                const float a0 = pg8::bflo(ga), a1 = pg8::bfhi(ga), a2 = pg8::bflo(gb), a3 = pg8::bfhi(gb);
                w[2 * j] = pk2(o4[j].x * rs * a0 * pg8::fsigmoid(a0), o4[j].y * rs * a1 * pg8::fsigmoid(a1)); w[2 * j + 1] = pk2(o4[j].z * rs * a2 * pg8::fsigmoid(a2), o4[j].w * rs * a3 * pg8::fsigmoid(a3)); }
            *(v4u*)po = (v4u){w[0], w[1], w[2], w[3]}; *(v4u*)(po + 8) = (v4u){w[4], w[5], w[6], w[7]}; po += (size_t)64 * 4096;
        }
    }
#undef HG_LOAD
    if constexpr (!OUT) {
        float* Es = Ebuf + ((size_t)(bh * HSEG + seg) * 64 * 64) * 4 + (size_t)(wid * 8) * 64 * 4;
#pragma unroll
        for (int kb = 0; kb < 8; ++kb) *(f32x4*)(Es + ((size_t)kb * 64 + lane) * 4) = Sacc[kb];
        if (rg == 0) Lbuf[(size_t)(bh * HSEG + seg) * 128 + col] = Lacc;
    }
    LDS_WAIT(); __builtin_amdgcn_s_barrier(); asm volatile("" ::: "memory");
}

__device__ __forceinline__ void cumsum_bh(LAS unsigned char* lds, const float* LOGF, float* C, int bh) {
    const int tid = threadIdx.x, lane = tid & 63, wid = tid >> 6, b = bh >> 4, h = bh & 15;
    LAS float* wsum = (LAS float*)lds;
    const float* src = LOGF + ((size_t)b * SEQ + 8 * tid) * 16 + h;
    float v[8]; float run = 0.f;
#pragma unroll
    for (int j = 0; j < 8; ++j) { run += src[j * 16]; v[j] = run; }
    float inc = run;
#pragma unroll
    for (int o = 1; o < 64; o <<= 1) { const float t = __shfl_up(inc, o); if (lane >= o) inc += t; }
    if (lane == 63) wsum[wid] = inc;
    LDS_WAIT(); __builtin_amdgcn_s_barrier(); asm volatile("" ::: "memory");
    float off = inc - run;
    for (int w = 0; w < wid; ++w) off += wsum[w];
    float* dst = C + (size_t)bh * SEQ + 8 * tid;
    *(f32x4*)dst = (f32x4){(off + v[0]) * LOG2E, (off + v[1]) * LOG2E, (off + v[2]) * LOG2E, (off + v[3]) * LOG2E};
    *(f32x4*)(dst + 4) = (f32x4){(off + v[4]) * LOG2E, (off + v[5]) * LOG2E, (off + v[6]) * LOG2E, (off + v[7]) * LOG2E};
    LDS_WAIT(); __builtin_amdgcn_s_barrier(); asm volatile("" ::: "memory");
}

struct Args { const float* in[25]; float* out; unsigned char* ws; int st_lo, st_hi; };
enum { ST_PRO, ST_F1I0, ST_F1O0, ST_RW00, ST_HIN, ST_HS1, ST_HS2, ST_HOUT, ST_RW01, ST_F2I0, ST_F2O0, ST_PP0, ST_RW02, ST_PG0, ST_RW03, ST_KVF, ST_F1I1, ST_CUM, ST_F1O1, ST_RW10, ST_QG, ST_ATT, ST_FOUT, ST_RW11, ST_F2I1, ST_F2O1, ST_PP1, ST_RW12, ST_PG1, ST_RW13, NSTEP };
__host__ __device__ constexpr bool sync_before(int s) { return !(s == ST_PRO || s == ST_PP0 || s == ST_F1I1 || s == ST_F1O1 || s == ST_PP1); }
enum { K_PRO = 0, K_FFN_IN, K_FFN_OUT, K_RW, K_HGRN_IN, K_HGRN, K_HGRN_OUT, K_PLE_PROJ, K_PLE_GATE, K_KVF, K_CUMSUM, K_QG, K_ATTN, K_FOX_OUT };

__global__ void __launch_bounds__(NWAVES * 64, 2) yoco_fwd(Args args) {
    extern __shared__ __attribute__((aligned(16))) unsigned char lds[];
    cg::grid_group grid = cg::this_grid();
    LAS unsigned char* ldsp = (LAS unsigned char*)lds;
    const int st_lo = args.st_lo, st_hi = args.st_hi;
#define STEP_BEGIN(k) if (st_lo <= (k) && (k) < st_hi) { if ((k) > st_lo && sync_before(k)) { asm volatile("s_waitcnt vmcnt(0) lgkmcnt(0)" ::: "memory"); grid.sync(); __builtin_amdgcn_fence(__ATOMIC_ACQUIRE, "agent"); asm volatile("s_waitcnt vmcnt(0)" ::: "memory"); } \
        const __attribute__((address_space(4))) Args* ap = (const __attribute__((address_space(4))) Args*)__builtin_amdgcn_kernarg_segment_ptr(); asm volatile("" : "+s"(ap)); \
        int tid_k = threadIdx.x; asm volatile("" : "+v"(tid_k)); const int tid = tid_k, lane = tid & 63, wave = __builtin_amdgcn_readfirstlane(tid >> 6); \
        const int G = gridDim.x, bx = blockIdx.x; unsigned char* ws = ap->ws; bfu* Wb = (bfu*)ws; bfu* PB = (bfu*)(ws + WS_P); float* LOGF = (float*)(ws + WS_LOGF); float* CL = (float*)(ws + WS_C); \
        bfu* AY = (bfu*)(ws + WS_AY); bfu* BIG = (bfu*)(ws + WS_BIG); bfu* PROJ = (bfu*)(ws + WS_PROJ); const int gw = bx * NWAVES + wave, ngw = G * NWAVES; \
        (void)tid; (void)lane; (void)Wb; (void)PB; (void)LOGF; (void)CL; (void)AY; (void)BIG; (void)PROJ; (void)gw; (void)ngw;
#define STEP_END }
#define RUN_GEMM(MODE, A_, LDA_, Bt_, N_, K_, O_, LDC_, O2_, AUX_, SC_) do { const pg8::Gemm g{A_, Bt_, T, N_, K_, LDA_}; pg8::StaticOrder S; S.init(T, N_, G, bx); \
        const pg8::Epi<MODE, LDC_> E{O_, O2_, AUX_, LOGF, ap->in[18], SC_}; pg8::gemm_phase<pg8::Epi<MODE, LDC_>, pg8::StaticOrder, true, true, K_, LDA_>(ldsp, g, S, E); } while (0)
#define NOB ((bfu*)nullptr)
#define S_FFN_IN(k, L, w)  STEP_BEGIN(k) RUN_GEMM(pg8::EP_SWIGLU, AY, D, Wb + ((w) == 1 ? E_W1IN : E_W2IN) + (L) * N_WIN, 2 * FF, D, BIG, FF, NOB, NOB, 1.f); STEP_END
#define S_FFN_OUT(k, L, w) STEP_BEGIN(k) RUN_GEMM(pg8::EP_PLAIN, BIG, FF, Wb + ((w) == 1 ? E_W1OUT : E_W2OUT) + (L) * N_WOUT, D, FF, AY, D, NOB, NOB, 1.f); STEP_END
#define S_PLE_PROJ(k, L)   STEP_BEGIN(k) RUN_GEMM(pg8::EP_PLAIN, PB + (size_t)(L) * T * PLE, PLE, Wb + E_WPP + (size_t)(L) * PLE * D, D, PLE, PROJ, D, NOB, NOB, 1.f); STEP_END
#define S_PLE_GATE(k, L)   STEP_BEGIN(k) RUN_GEMM(pg8::EP_PLEGATE, AY, D, Wb + E_WPG + (size_t)(L) * D * D, D, D, BIG, D, NOB, PROJ, 1.f); STEP_END
#define S_RW(k, L, w)      STEP_BEGIN(k) { const float* hin = ((L) == 0 && (w) == 0) ? ap->in[0] : ap->out; const bfu* Y = ((w) == 3) ? BIG : AY; \
        const float* gain = ((w) == 0 ? ap->in[5] : (w) == 1 ? ap->in[7] : (w) == 2 ? ap->in[11] : ap->in[24]) + (L) * D; \
        rw_phase(hin, ap->out, Y, AY, gain, ((w) == 0 || (w) == 2) ? 0.5f : 1.0f, gw, ngw, lane); } STEP_END

    STEP_BEGIN(ST_PRO) {
        LAS float* scr = (LAS float*)(ldsp + wave * 16384);
        for (int it = gw;; it += ngw) {
            int r = it;
#define CONV(src, K_, N_, dst, gain, gmask, sw) { constexpr int NI = ((K_) / 64) * (((N_) + 31) / 32); if (r < NI) { conv_item(src, K_, N_, dst, gain, gmask, sw, scr, r, lane); continue; } r -= NI; }
            CONV(ap->in[3], D, 2 * FF, Wb + E_W1IN, ap->in[2], 1023, 1)
            CONV(ap->in[3] + N_WIN, D, 2 * FF, Wb + E_W1IN + N_WIN, ap->in[2] + D, 1023, 1)
            CONV(ap->in[9], D, 2 * FF, Wb + E_W2IN, ap->in[8], 1023, 1)
            CONV(ap->in[9] + N_WIN, D, 2 * FF, Wb + E_W2IN + N_WIN, ap->in[8] + D, 1023, 1)
            CONV(ap->in[4], FF, D, Wb + E_W1OUT, (const float*)nullptr, 0, 0)
            CONV(ap->in[4] + N_WOUT, FF, D, Wb + E_W1OUT + N_WOUT, (const float*)nullptr, 0, 0)
            CONV(ap->in[10], FF, D, Wb + E_W2OUT, (const float*)nullptr, 0, 0)
            CONV(ap->in[10] + N_WOUT, FF, D, Wb + E_W2OUT + N_WOUT, (const float*)nullptr, 0, 0)
            CONV(ap->in[12], D, 4 * D, Wb + E_WHIN, ap->in[6], 1023, 0)
            CONV(ap->in[15], D, D, Wb + E_WHOUT, ap->in[14], 127, 0)
            CONV(ap->in[17], D, NKVF, Wb + E_WKVF, ap->in[16], 1023, 0)
            CONV(ap->in[19], D, 2 * D, Wb + E_WQG, ap->in[6] + D, 1023, 0)
            CONV(ap->in[20], D, D, Wb + E_WFO, (const float*)nullptr, 0, 0)
            CONV(ap->in[22], D, D, Wb + E_WPG, ap->in[21], 1023, 0)
            CONV(ap->in[22] + (size_t)D * D, D, D, Wb + E_WPG + (size_t)D * D, ap->in[21] + D, 1023, 0)
            CONV(ap->in[23], PLE, D, Wb + E_WPP, (const float*)nullptr, 0, 0)
            CONV(ap->in[23] + (size_t)PLE * D, PLE, D, Wb + E_WPP + (size_t)PLE * D, (const float*)nullptr, 0, 0)
#undef CONV
            break;
        }
        {   const float* p = ap->in[1]; const size_t n8 = (size_t)2 * T * PLE / 8;
            for (size_t i = (size_t)bx * 512 + tid; i < n8; i += (size_t)G * 512) { const f32x4 a = *((const f32x4*)p + 2 * i), c = *((const f32x4*)p + 2 * i + 1);
                *((v4u*)PB + i) = (v4u){pk2(a.x, a.y), pk2(a.z, a.w), pk2(c.x, c.y), pk2(c.z, c.w)}; } }
        const float* x = ap->in[0];
        for (int m = gw; m < T; m += ngw) rms_row_to_bf16(x + (size_t)m * D, AY + (size_t)m * D, lane);
    } STEP_END
    S_FFN_IN(ST_F1I0, 0, 1) S_FFN_OUT(ST_F1O0, 0, 1) S_RW(ST_RW00, 0, 0)
    STEP_BEGIN(ST_HIN) RUN_GEMM(pg8::EP_PLAIN, AY, D, Wb + E_WHIN, 4 * D, D, BIG, 4 * D, NOB, NOB, 1.f); STEP_END
    STEP_BEGIN(ST_HS1) { const float* lbl = ap->in[13]; float* Eb = (float*)AY; float* Lb = (float*)(ws + WS_AY + 32 * MiB);
        for (int it = bx; it < BATCH * 8 * HSEG; it += G) if ((it & 3) != 3) hgrn_scan<false>(ldsp, BIG, lbl, it >> 2, it & 3, Eb, Lb); } STEP_END
    STEP_BEGIN(ST_HS2) { const float* lbl = ap->in[13]; float* Eb = (float*)AY; float* Lb = (float*)(ws + WS_AY + 32 * MiB);
        for (int it = bx; it < BATCH * 8 * HSEG; it += G) hgrn_scan<true>(ldsp, BIG, lbl, it >> 2, it & 3, Eb, Lb); } STEP_END
    STEP_BEGIN(ST_HOUT) RUN_GEMM(pg8::EP_PLAIN, BIG, 4 * D, Wb + E_WHOUT, D, D, AY, D, NOB, NOB, 1.f); STEP_END
    S_RW(ST_RW01, 0, 1) S_FFN_IN(ST_F2I0, 0, 2) S_FFN_OUT(ST_F2O0, 0, 2) S_PLE_PROJ(ST_PP0, 0) S_RW(ST_RW02, 0, 2) S_PLE_GATE(ST_PG0, 0) S_RW(ST_RW03, 0, 3)
    STEP_BEGIN(ST_KVF) RUN_GEMM(pg8::EP_KVF, AY, D, Wb + E_WKVF, NKVFP, D, (bfu*)(ws + WS_K), D, (bfu*)(ws + WS_V), NOB, 1.f); STEP_END
    S_FFN_IN(ST_F1I1, 1, 1)
    STEP_BEGIN(ST_CUM) { for (int bh = bx; bh < BATCH * 16; bh += G) cumsum_bh(ldsp, LOGF, CL, bh); } STEP_END
    S_FFN_OUT(ST_F1O1, 1, 1) S_RW(ST_RW10, 1, 0)
    STEP_BEGIN(ST_QG) RUN_GEMM(pg8::EP_QG, AY, D, Wb + E_WQG, 2 * D, D, (bfu*)(ws + WS_Q), D, (bfu*)(ws + WS_G), NOB, attn_body::C2); STEP_END
    STEP_BEGIN(ST_ATT) {
        const attn_body::AttnTensors AT{(const attn_body::bf16*)(ws + WS_Q), (const attn_body::bf16*)(ws + WS_K), (const attn_body::bf16*)(ws + WS_V), (attn_body::bf16*)(ws + WS_Q), (const attn_body::bf16*)(ws + WS_G), CL};
        const attn_body::StaticOrder S(G, bx);
        attn_body::attn_phase<attn_body::StaticOrder>((char*)lds, AT, S);
    } STEP_END
    STEP_BEGIN(ST_FOUT) RUN_GEMM(pg8::EP_PLAIN, (const bfu*)(ws + WS_Q), D, Wb + E_WFO, D, D, AY, D, NOB, NOB, 1.f); STEP_END
    S_RW(ST_RW11, 1, 1) S_FFN_IN(ST_F2I1, 1, 2) S_FFN_OUT(ST_F2O1, 1, 2) S_PLE_PROJ(ST_PP1, 1) S_RW(ST_RW12, 1, 2) S_PLE_GATE(ST_PG1, 1) S_RW(ST_RW13, 1, 3)
}

#ifndef MK_MULTI
#define MK_MULTI 0
#endif
extern "C" void kernel_launch(void* const* d_in, const int* in_sizes, int n_in, void* d_out, int out_size, void* d_ws, size_t ws_size, hipStream_t stream) {
    static int grid = 0;
    if (grid == 0) {
        if (n_in != 25 || out_size != T * D || ws_size < WS_END) { fprintf(stderr, "kernel_launch: unexpected shapes (n_in %d out %d ws %zu)\n", n_in, out_size, ws_size); grid = -1; return; }
        int dev = 0, cus = 0, per_cu = 0;
        (void)hipGetDevice(&dev); (void)hipDeviceGetAttribute(&cus, hipDeviceAttributeMultiprocessorCount, dev);
        if (hipFuncSetAttribute((const void*)yoco_fwd, hipFuncAttributeMaxDynamicSharedMemorySize, LDS_BYTES) != hipSuccess) { fprintf(stderr, "kernel_launch: hipFuncSetAttribute failed\n"); grid = -1; return; }
        if (hipOccupancyMaxActiveBlocksPerMultiprocessor(&per_cu, (const void*)yoco_fwd, NWAVES * 64, LDS_BYTES) != hipSuccess || per_cu < 1) per_cu = 1;
        (void)hipGetLastError();
        if (cus <= 0) cus = 256;
        grid = cus * per_cu;
    }
    if (grid < 0) return;
    Args a{};
    for (int i = 0; i < 25; ++i) a.in[i] = (const float*)d_in[i];
    a.out = (float*)d_out; a.ws = (unsigned char*)d_ws;
#if MK_MULTI
    int lo = 0;
    for (int s = 1; s <= NSTEP; ++s) if (s == NSTEP || sync_before(s)) { a.st_lo = lo; a.st_hi = s; hipLaunchKernelGGL(yoco_fwd, dim3(grid), dim3(NWAVES * 64), LDS_BYTES, stream, a); lo = s; }
#else
#ifndef ST_CUT
#define ST_CUT NSTEP
#endif
    a.st_lo = 0; a.st_hi = ST_CUT;
    void* kargs[] = {&a};
    const hipError_t e = hipLaunchCooperativeKernel((const void*)yoco_fwd, dim3(grid), dim3(NWAVES * 64), kargs, LDS_BYTES, stream);
    if (e != hipSuccess) fprintf(stderr, "kernel_launch: cooperative launch failed: %s (grid %d)\n", hipGetErrorString(e), grid);
#endif
}
```

```cpp
#include <hip/hip_runtime.h>
#include <hip/hip_cooperative_groups.h>
#include <hip/hip_bf16.h>
#include <cstdio>
#include <cstdint>
#include <cmath>
namespace cg = cooperative_groups;
__device__ __forceinline__ int tid_from(int wave_s) { unsigned l; asm volatile("v_mbcnt_lo_u32_b32 %0, -1, 0\n\tv_mbcnt_hi_u32_b32 %0, -1, %0" : "=v"(l)); return wave_s * 64 + (int)l; }
namespace pg8 {
#define PG8_LAS __attribute__((address_space(3)))
typedef unsigned short bf16_t;
typedef short bf16x8 __attribute__((ext_vector_type(8)));
typedef float f32x4 __attribute__((ext_vector_type(4)));
typedef unsigned u32x4 __attribute__((ext_vector_type(4)));
constexpr int BM = 256, BK = 64, HALF = 128, HTB = HALF * BK * 2  , STAGE_BYTES = 8 * HTB, NXCD = 8, WGM = 8;

__host__ __device__ __forceinline__ int lds_byte(int r, int c) { const int st = (r >> 4) * 2 + (c >> 5), rr = r & 15, cc = c & 31, ob = rr * 64 + cc * 2; return st * 1024 + (ob ^ (((ob >> 9) & 1) << 5)); }
__host__ __device__ __forceinline__ void stage_rc(int b, int& R, int& C) { const int st = b / 1024, sb = b % 1024, swz = sb ^ (((sb >> 9) & 1) << 5); R = (st >> 1) * 16 + swz / 64; C = (st & 1) * 32 + (swz % 64) / 2; }
__host__ __device__ __forceinline__ int perm32(int rho) { const int n = rho >> 4, i = rho & 15; return 8 * (i >> 2) + 4 * n + (i & 3); }

struct Unit { int pm, pn; };
struct Gemm { const bf16_t* A; const bf16_t* Bt; int M, N, K, lda; };

struct StaticOrder {
    int nM, nN, nwg, G, c;
    __host__ __device__ void init(int M, int N, int G_, int c_) { nM = M / BM; nN = N / BM; nwg = nM * nN; G = G_; c = c_; }
    __host__ __device__ bool next(int i, Unit& u) const {
        const long L = (long)i * G + c; if (L >= nwg) return false;
        int wgid = (int)L; { const int q = nwg / NXCD, r = nwg % NXCD, xcd = wgid % NXCD, off = wgid / NXCD; wgid = (xcd < r ? xcd * (q + 1) : r * (q + 1) + (xcd - r) * q) + off; }
        const int nig = WGM * nN, gid = wgid / nig, fm = gid * WGM, gsz = (nM - fm) < WGM ? (nM - fm) : WGM;
        u.pm = fm + ((wgid % nig) % gsz); u.pn = (wgid % nig) / gsz; return true;
    }
    __device__ __forceinline__ void a_ready(const Unit&) const {}
    __device__ __forceinline__ void done(const Unit&) const {}
};

typedef float f32x2cv __attribute__((ext_vector_type(2))); typedef __bf16 bf16x2cv __attribute__((ext_vector_type(2)));
__device__ __forceinline__ unsigned cvt_pk_bf16_asm(float lo, float hi) { unsigned r; asm volatile("v_cvt_pk_bf16_f32 %0, %1, %2" : "=v"(r) : "v"(lo), "v"(hi)); return r; }
__device__ __forceinline__ unsigned cvt_pk_bf16(float lo, float hi) { const f32x2cv v = {lo, hi}; const bf16x2cv b = __builtin_convertvector(v, bf16x2cv); return __builtin_bit_cast(unsigned, b); }
enum { EP_PLAIN = 0, EP_SWIGLU = 1, EP_KVF = 2, EP_QG = 3, EP_PLEGATE = 4 };
__device__ __forceinline__ float fsigmoid(float x) { return __builtin_amdgcn_rcpf(1.0f + __builtin_amdgcn_exp2f(-1.4426950408889634f * x)); }
__device__ __forceinline__ float bflo(unsigned w) { return __uint_as_float(w << 16); }
__device__ __forceinline__ float bfhi(unsigned w) { return __uint_as_float(w & 0xffff0000u); }
template <int MODE, int LDC> struct Epi {
    static constexpr bool PERM = true, AFTER_DRAIN = false;
    bf16_t* O; bf16_t* O2; const bf16_t* aux; float* lf; const float* bfp; float scale0; static constexpr int ldc = LDC;
    __device__ __forceinline__ void operator()(const f32x4 (&acc)[2][2][4][2], const Unit& u, int wr, int wc, int fr, int fq) const {
        asm volatile("s_nop 15\n\ts_nop 15" ::: "memory");
        const int row0 = u.pm * BM + wr * 64 + fr;
        if constexpr (MODE == EP_SWIGLU) {
            const int col0 = u.pn * HALF + wc * 32 + 8 * fq;
#pragma unroll
            for (int ai = 0; ai < 2; ++ai)
#pragma unroll
                for (int m = 0; m < 4; ++m) { bf16_t* rowp = O + (size_t)(row0 + ai * HALF + m * 16) * ldc + col0;
                    const f32x4 g0 = acc[ai][0][m][0], g1 = acc[ai][0][m][1], u0 = acc[ai][1][m][0], u1 = acc[ai][1][m][1]; f32x4 v0, v1;
#pragma unroll
                    for (int j = 0; j < 4; ++j) { v0[j] = g0[j] * fsigmoid(g0[j]) * u0[j]; v1[j] = g1[j] * fsigmoid(g1[j]) * u1[j]; }
                    u32x4 w; w.x = cvt_pk_bf16_asm(v0[0], v0[1]); w.y = cvt_pk_bf16_asm(v0[2], v0[3]); w.z = cvt_pk_bf16_asm(v1[0], v1[1]); w.w = cvt_pk_bf16_asm(v1[2], v1[3]);
                    *(u32x4*)rowp = w; }
        } else {
            bf16_t* base = O; int colt = u.pn * BM; int kind = 0; float sc = 1.f;
            if constexpr (MODE == EP_KVF) { if (u.pn >= 8) kind = 2; else if (u.pn >= 4) { base = O2; colt -= 1024; } }
            if constexpr (MODE == EP_QG) { if (u.pn >= 4) { base = O2; colt -= 1024; kind = 1; } else sc = scale0; }
            if (MODE == EP_KVF && kind == 2) {
                if (wc == 0 && fq < 2) {
#pragma unroll
                    for (int ai = 0; ai < 2; ++ai)
#pragma unroll
                        for (int m = 0; m < 4; ++m) { float* lp = lf + (size_t)(row0 + ai * HALF + m * 16) * 16 + 8 * fq;
#pragma unroll
                            for (int n = 0; n < 2; ++n) { const f32x4 a = acc[ai][0][m][n]; f32x4 o;
#pragma unroll
                                for (int j = 0; j < 4; ++j) { const float x = a[j] + bfp[8 * fq + 4 * n + j]; o[j] = fminf(x, 0.f) - __logf(1.0f + __expf(-fabsf(x))); }
                                *(f32x4*)(lp + 4 * n) = o; } }
                }
                return;
            }
            const int col0 = colt + wc * 32 + 8 * fq;
#pragma unroll
            for (int ai = 0; ai < 2; ++ai)
#pragma unroll
                for (int m = 0; m < 4; ++m) { const size_t roff = (size_t)(row0 + ai * HALF + m * 16) * ldc + col0;
#pragma unroll
                    for (int bj = 0; bj < 2; ++bj) { f32x4 v0 = acc[ai][bj][m][0], v1 = acc[ai][bj][m][1];
                        if (MODE == EP_QG && kind == 1) {
#pragma unroll
                            for (int j = 0; j < 4; ++j) { v0[j] = fsigmoid(v0[j]); v1[j] = fsigmoid(v1[j]); } }
                        else if (MODE == EP_QG) { v0 = v0 * sc; v1 = v1 * sc; }
                        if constexpr (MODE == EP_PLEGATE) { const u32x4 pq = *(const u32x4*)(aux + roff + bj * HALF);
                            v0[0] = fsigmoid(v0[0]) * bflo(pq.x); v0[1] = fsigmoid(v0[1]) * bfhi(pq.x); v0[2] = fsigmoid(v0[2]) * bflo(pq.y); v0[3] = fsigmoid(v0[3]) * bfhi(pq.y);
                            v1[0] = fsigmoid(v1[0]) * bflo(pq.z); v1[1] = fsigmoid(v1[1]) * bfhi(pq.z); v1[2] = fsigmoid(v1[2]) * bflo(pq.w); v1[3] = fsigmoid(v1[3]) * bfhi(pq.w); }
                        u32x4 w; w.x = cvt_pk_bf16_asm(v0[0], v0[1]); w.y = cvt_pk_bf16_asm(v0[2], v0[3]); w.z = cvt_pk_bf16_asm(v1[0], v1[1]); w.w = cvt_pk_bf16_asm(v1[2], v1[3]);
                        *(u32x4*)(base + roff + bj * HALF) = w; } }
        }
    }
};

template <class Epi, class Sched, bool ALIGN_EPI, bool SP2, int KC, int LDA>
__device__ __forceinline__ void gemm_phase(PG8_LAS unsigned char* lds, const Gemm g, const Sched& S, const Epi& E, int wave_s) {
    int tid_o = tid_from(wave_s); asm volatile("" : "+v"(tid_o)); const int tid = tid_o, wid = __builtin_amdgcn_readfirstlane(tid >> 6), lane = tid & 63, wr = wid >> 2, wc = wid & 3, fr = lane & 15, fq = lane >> 4;
    constexpr int K = KC, nt = K / BK;
    unsigned voffA[2], voffB[2];
#pragma unroll
    for (int i = 0; i < 2; ++i) { int R, C; stage_rc(tid * 16 + i * 8192, R, C); const int Rb = Epi::PERM ? ((R & ~31) + perm32(R & 31)) : R;
        voffA[i] = (unsigned)(R * LDA + C) * 2u; voffB[i] = (unsigned)(Rb * K + C) * 2u; }
    const size_t kstep = (size_t)(BK * 2);
    const size_t hstep = (size_t)HALF * K * 2;
    const size_t tstep = 2 * hstep; const size_t hstepA = (size_t)HALF * LDA * 2, tstepA = 2 * hstepA;
    const unsigned ldsw = (unsigned)wid * 1024u;
    const int aoff = lds_byte(wr * 64 + fr, fq * 8), boff = lds_byte(wc * 32 + fr, fq * 8);
#define PG8_SA(b, h) (((b) * 2 + (h)) * HTB)
#define PG8_SB(b, h) ((4 + (b) * 2 + (h)) * HTB)
#define PG8_STAGE(bufoff, gbase, voff) do { _Pragma("unroll") for (int _i = 0; _i < 2; ++_i) \
        __builtin_amdgcn_global_load_lds((const unsigned*)((const char*)(gbase) + (voff)[_i]), (PG8_LAS unsigned*)(lds + (bufoff) + ldsw + _i * 8192), 16, 0, 0); } while (0)
#define PG8_LDA(dst, b, h) do { _Pragma("unroll") for (int m = 0; m < 4; ++m) _Pragma("unroll") for (int k = 0; k < 2; ++k) dst[m][k] = *(const PG8_LAS bf16x8*)(lds + PG8_SA(b, h) + aoff + m * 2048 + k * 1024); } while (0)
#define PG8_LDB(dst, b, h) do { _Pragma("unroll") for (int n = 0; n < 2; ++n) _Pragma("unroll") for (int k = 0; k < 2; ++k) dst[n][k] = *(const PG8_LAS bf16x8*)(lds + PG8_SB(b, h) + boff + n * 2048 + k * 1024); } while (0)
#define PG8_MMA(ai, bj, At, Bt) do { __builtin_amdgcn_s_setprio(1); _Pragma("unroll") for (int m = 0; m < 4; ++m) _Pragma("unroll") for (int n = 0; n < 2; ++n) _Pragma("unroll") for (int k = 0; k < 2; ++k) \
        acc[ai][bj][m][n] = __builtin_amdgcn_mfma_f32_16x16x32_bf16(Bt[n][k], At[m][k], acc[ai][bj][m][n], 0, 0, 0); __builtin_amdgcn_s_setprio(0); } while (0)
#define PG8_WAIT_V(n) asm volatile("s_waitcnt vmcnt(" #n ")" ::: "memory")
#define PG8_WAIT_L(n) asm volatile("s_waitcnt lgkmcnt(" #n ")" ::: "memory")
#define PG8_BAR __builtin_amdgcn_s_barrier()
#define PG8_SCHED __builtin_amdgcn_sched_barrier(0)
    Unit cur, nxt; int ui = 0;
    if (!S.next(0, cur)) return;
    f32x4 acc[2][2][4][2];
#pragma unroll
    for (int a = 0; a < 2; ++a)
#pragma unroll
        for (int b = 0; b < 2; ++b)
#pragma unroll
            for (int m = 0; m < 4; ++m)
#pragma unroll
                for (int n = 0; n < 2; ++n) acc[a][b][m][n] = (f32x4){0.f, 0.f, 0.f, 0.f};
    bf16x8 At[4][2], B0[2][2], B1[2][2];
    const char* cA = (const char*)g.A + (size_t)cur.pm * tstepA; const char* cB = (const char*)g.Bt + (size_t)cur.pn * tstep;
    S.a_ready(cur);
    if constexpr (SP2) {
        PG8_STAGE(PG8_SB(0, 0), cB, voffB); PG8_STAGE(PG8_SB(0, 1), cB + hstep, voffB); PG8_STAGE(PG8_SA(0, 0), cA, voffA); PG8_STAGE(PG8_SA(0, 1), cA + hstepA, voffA);
        if (wr == 1) PG8_BAR;
        PG8_WAIT_V(2); PG8_BAR;
        PG8_STAGE(PG8_SB(1, 0), cB + kstep, voffB); PG8_STAGE(PG8_SA(1, 0), cA + kstep, voffA); PG8_STAGE(PG8_SB(1, 1), cB + hstep + kstep, voffB);
        PG8_WAIT_V(6); PG8_BAR;
    } else {
        PG8_STAGE(PG8_SB(0, 0), cB, voffB); PG8_STAGE(PG8_SA(0, 0), cA, voffA); PG8_STAGE(PG8_SB(0, 1), cB + hstep, voffB); PG8_STAGE(PG8_SA(0, 1), cA + hstepA, voffA);
        if (wr == 1) PG8_BAR;
        PG8_WAIT_V(4); PG8_BAR;
        PG8_STAGE(PG8_SB(1, 0), cB + kstep, voffB); PG8_STAGE(PG8_SA(1, 0), cA + kstep, voffA); PG8_STAGE(PG8_SB(1, 1), cB + hstep + kstep, voffB);
        PG8_WAIT_V(6); PG8_BAR;
    }
    for (;;) {
        const bool has_next = S.next(ui + 1, nxt);
        const char* nA = has_next ? (const char*)g.A + (size_t)nxt.pm * tstepA : cA; const char* nB = has_next ? (const char*)g.Bt + (size_t)nxt.pn * tstep : cB;
        for (int t = 0; t < nt; t += 2) {
            const bool last = (t == nt - 2);
            const char* a1 = cA + (size_t)(t + 1) * kstep;
            const char* a2 = last ? nA : cA + (size_t)(t + 2) * kstep; const char* b2 = last ? nB : cB + (size_t)(t + 2) * kstep;
            const char* a3 = a2 + kstep; const char* b3 = b2 + kstep;
            if (last && has_next) S.a_ready(nxt);
            if constexpr (SP2) {
            PG8_LDB(B0, 0, 0); PG8_LDB(B1, 0, 1); PG8_SCHED; PG8_LDA(At, 0, 0); PG8_STAGE(PG8_SA(1, 1), a1 + hstepA, voffA);
            PG8_WAIT_V(8); PG8_WAIT_L(0); PG8_BAR; PG8_MMA(0, 0, At, B0); PG8_MMA(0, 1, At, B1); PG8_BAR; PG8_SCHED;
            PG8_LDA(At, 0, 1); PG8_STAGE(PG8_SB(0, 0), b2, voffB); PG8_STAGE(PG8_SB(0, 1), b2 + hstep, voffB); PG8_STAGE(PG8_SA(0, 0), a2, voffA);
            PG8_WAIT_V(8); PG8_WAIT_L(0); PG8_BAR; PG8_MMA(1, 0, At, B0); PG8_MMA(1, 1, At, B1); PG8_BAR; PG8_SCHED;
            PG8_LDB(B0, 1, 0); PG8_LDB(B1, 1, 1); PG8_SCHED; PG8_LDA(At, 1, 0); PG8_STAGE(PG8_SA(0, 1), a2 + hstepA, voffA);
            PG8_WAIT_V(8); PG8_WAIT_L(0); PG8_BAR; PG8_MMA(0, 0, At, B0); PG8_MMA(0, 1, At, B1); PG8_BAR; PG8_SCHED;
            PG8_LDA(At, 1, 1); PG8_STAGE(PG8_SB(1, 0), b3, voffB); PG8_STAGE(PG8_SB(1, 1), b3 + hstep, voffB); PG8_STAGE(PG8_SA(1, 0), a3, voffA);
            PG8_WAIT_V(8); PG8_WAIT_L(0); PG8_BAR; PG8_MMA(1, 0, At, B0); PG8_MMA(1, 1, At, B1); PG8_BAR; PG8_SCHED;
            } else {
            PG8_LDB(B0, 0, 0); PG8_SCHED; PG8_LDA(At, 0, 0); PG8_STAGE(PG8_SA(1, 1), a1 + hstepA, voffA);
            PG8_WAIT_L(8); PG8_BAR; PG8_WAIT_L(0); PG8_MMA(0, 0, At, B0); PG8_BAR; PG8_SCHED;
            PG8_LDB(B1, 0, 1); PG8_STAGE(PG8_SB(0, 0), b2, voffB);
            PG8_BAR; PG8_WAIT_L(0); PG8_MMA(0, 1, At, B1); PG8_BAR;
            PG8_LDA(At, 0, 1); PG8_STAGE(PG8_SA(0, 0), a2, voffA);
            PG8_BAR; PG8_WAIT_L(0); PG8_MMA(1, 0, At, B0); PG8_BAR; PG8_SCHED;
            PG8_STAGE(PG8_SB(0, 1), b2 + hstep, voffB);
            PG8_WAIT_V(6); PG8_BAR; PG8_MMA(1, 1, At, B1); PG8_BAR;
            PG8_LDB(B0, 1, 0); PG8_SCHED; PG8_LDA(At, 1, 0); PG8_STAGE(PG8_SA(0, 1), a2 + hstepA, voffA);
            PG8_WAIT_L(8); PG8_BAR; PG8_WAIT_L(0); PG8_MMA(0, 0, At, B0); PG8_BAR; PG8_SCHED;
            PG8_LDB(B1, 1, 1); PG8_STAGE(PG8_SB(1, 0), b3, voffB);
            PG8_BAR; PG8_WAIT_L(0); PG8_MMA(0, 1, At, B1); PG8_BAR;
            PG8_LDA(At, 1, 1); PG8_STAGE(PG8_SA(1, 0), a3, voffA);
            PG8_BAR; PG8_WAIT_L(0); PG8_MMA(1, 0, At, B0); PG8_BAR; PG8_SCHED;
            PG8_STAGE(PG8_SB(1, 1), b3 + hstep, voffB);
            PG8_WAIT_V(6); PG8_BAR; PG8_MMA(1, 1, At, B1); PG8_BAR;
            }
        }
        if constexpr (ALIGN_EPI) { if (wr == 0) PG8_BAR; }
        if constexpr (!Epi::AFTER_DRAIN) { E(acc, cur, wr, wc, fr, fq); S.done(cur); }
        if (!has_next) break;
#pragma unroll
        for (int a = 0; a < 2; ++a)
#pragma unroll
            for (int b = 0; b < 2; ++b)
#pragma unroll
                for (int m = 0; m < 4; ++m)
#pragma unroll
                    for (int n = 0; n < 2; ++n) acc[a][b][m][n] = (f32x4){0.f, 0.f, 0.f, 0.f};
        cur = nxt; cA = nA; cB = nB; ++ui;
        if constexpr (ALIGN_EPI) { if (wr == 1) PG8_BAR; }
    }
    PG8_WAIT_V(0);
    if constexpr (!ALIGN_EPI) { if (wr == 0) PG8_BAR; }
    PG8_BAR;
    if constexpr (Epi::AFTER_DRAIN) { E.fused(acc, cur, wr, wc, fr, fq, lds, wid, lane); S.done(cur); }
#undef PG8_SA
#undef PG8_SB
#undef PG8_STAGE
#undef PG8_LDA
#undef PG8_LDB
#undef PG8_MMA
#undef PG8_WAIT_V
#undef PG8_WAIT_L
#undef PG8_BAR
#undef PG8_SCHED
}
}
#include <hip/hip_bf16.h>
#include <cmath>
namespace attn_body {
using bf16=__hip_bfloat16;
using bf16x8=__attribute__((ext_vector_type(8)))short;
using s16x4=__attribute__((ext_vector_type(4)))short;
using f32x16=__attribute__((ext_vector_type(16)))float;
using u32x4=__attribute__((ext_vector_type(4)))unsigned;
constexpr int BATCH=8,NHEAD=16,SEQ=4096,D=64,DM=NHEAD*D;
constexpr int NW=8,QBLK=32,QB=QBLK*NW,KVBLK=64,NQB=SEQ/QB;
constexpr int ATTN_PITCH=DM, ATTN_UNIT_ROWS=QB;
__device__ __forceinline__ int crow(int r,int hi){return (r&3)+8*(r>>2)+4*hi;}
#define SBAR() __builtin_amdgcn_sched_barrier(0)
__device__ __forceinline__ void cmask(f32x16&p0,f32x16&p1,int jb,int qrel,int hi){
  const float NEG=-INFINITY; int kb=64*jb+4*hi;
  #pragma unroll
  for(int r=0;r<16;++r){int kv=kb+(r&3)+8*(r>>2); if(kv>qrel)p0[r]=NEG; if(kv+32>qrel)p1[r]=NEG;}
}

constexpr int NSLOT=3, SLOTB=8192;
constexpr int LDS_K=0, LDS_V=NSLOT*SLOTB, LDS_WS=2*NSLOT*SLOTB, LDS_OST=LDS_WS+NW*64*4, LDS_CB=LDS_OST+NW*4096, LDS_BYTES=LDS_CB+SEQ*4;
constexpr float C2=0.125f*1.4426950408889634f;
__device__ __forceinline__ void glds16(const void*gsrc,unsigned lds_dst){unsigned keep;
  asm volatile("s_mov_b32 %0, m0\n\ts_mov_b32 m0, %2\n\ts_nop 0\n\tglobal_load_lds_dwordx4 %1, off\n\ts_mov_b32 m0, %0":"=&s"(keep):"v"(gsrc),"s"(lds_dst):"memory");}
__device__ __forceinline__ float max3f(float a,float b,float c){float r;asm("v_max3_f32 %0, %1, %2, %3":"=v"(r):"v"(a),"v"(b),"v"(c));return r;}
__device__ __forceinline__ float max2f(float a,float b){float r;asm("v_max_f32_e32 %0, %1, %2":"=v"(r):"v"(a),"v"(b));return r;}
__device__ __forceinline__ float fadd_s(float a,float b){float r;asm("v_add_f32_e32 %0, %1, %2":"=v"(r):"v"(a),"v"(b));return r;}
__device__ __forceinline__ float fsub_s(float a,float b){float r;asm("v_sub_f32_e32 %0, %1, %2":"=v"(r):"v"(a),"v"(b));return r;}
typedef float f32x2_t __attribute__((ext_vector_type(2))); typedef __bf16 bf16x2_t __attribute__((ext_vector_type(2)));
__device__ __forceinline__ unsigned cvtpk_s(float lo,float hi){f32x2_t v={lo,hi};bf16x2_t b=__builtin_convertvector(v,bf16x2_t);return __builtin_bit_cast(unsigned,b);}
#define WAIT_BAR(N) asm volatile("s_waitcnt vmcnt(" #N ") lgkmcnt(0)\n\ts_barrier":::"memory")

__device__ __forceinline__ void qkt(f32x16&p0,f32x16&p1,const char*Kslot,const bf16x8*qr,const f32x16&negm,int r32,int hi){
  const char*kb=Kslot+hi*1024+r32*16;
  #pragma unroll
  for(int d0=0;d0<4;++d0){
    const bf16x8 b0=*reinterpret_cast<const bf16x8*>(kb+d0*2048);
    const bf16x8 b1=*reinterpret_cast<const bf16x8*>(kb+d0*2048+512);
    if(d0==0){p0=__builtin_amdgcn_mfma_f32_32x32x16_bf16(b0,qr[0],negm,0,0,0);p1=__builtin_amdgcn_mfma_f32_32x32x16_bf16(b1,qr[0],negm,0,0,0);}
    else{p0=__builtin_amdgcn_mfma_f32_32x32x16_bf16(b0,qr[d0],p0,0,0,0);p1=__builtin_amdgcn_mfma_f32_32x32x16_bf16(b1,qr[d0],p1,0,0,0);}}
}
typedef __attribute__((address_space(3))) const char* lds_cptr;
typedef short v4i16_t __attribute__((ext_vector_type(4)));
__device__ __forceinline__ void kload8(bf16x8*kf,lds_cptr kp){
  kf[0]=*(const __attribute__((address_space(3))) bf16x8*)(kp);      kf[1]=*(const __attribute__((address_space(3))) bf16x8*)(kp+512);
  kf[2]=*(const __attribute__((address_space(3))) bf16x8*)(kp+2048); kf[3]=*(const __attribute__((address_space(3))) bf16x8*)(kp+2560);
  kf[4]=*(const __attribute__((address_space(3))) bf16x8*)(kp+4096); kf[5]=*(const __attribute__((address_space(3))) bf16x8*)(kp+4608);
  kf[6]=*(const __attribute__((address_space(3))) bf16x8*)(kp+6144); kf[7]=*(const __attribute__((address_space(3))) bf16x8*)(kp+6656);
}
__device__ __forceinline__ void kload2(bf16x8*kf,lds_cptr kp,int j){ kf[2*j]=*(const __attribute__((address_space(3))) bf16x8*)(kp+j*2048); kf[2*j+1]=*(const __attribute__((address_space(3))) bf16x8*)(kp+j*2048+512); }
__device__ __forceinline__ s16x4 vtr(lds_cptr p){ return __builtin_bit_cast(s16x4,__builtin_amdgcn_ds_read_tr16_b64_v4i16((__attribute__((address_space(3))) v4i16_t*)p)); }
__device__ __forceinline__ float rowmax(const f32x16&p0,const f32x16&p1){
  float a=max3f(p0[0],p0[1],p1[0]),b=max3f(p0[2],p0[3],p1[1]);a=max3f(a,p1[2],p1[3]);
  #pragma unroll
  for(int r=4;r<16;r+=4){a=max3f(a,p0[r],p0[r+1]);b=max3f(b,p0[r+2],p0[r+3]);a=max3f(a,p1[r],p1[r+1]);b=max3f(b,p1[r+2],p1[r+3]);}
  const float m=max2f(a,b);
  auto rr=__builtin_amdgcn_permlane32_swap(__float_as_uint(m),__float_as_uint(m),false,false);
  return max2f(__uint_as_float(rr[0]),__uint_as_float(rr[1]));
}
__device__ __forceinline__ void pv(f32x16*o,int vb,bf16x8 pa0,bf16x8 pa1,bf16x8 pa2,bf16x8 pa3){
  #pragma unroll
  for(int d0=0;d0<2;++d0){s16x4 lo[4],hi[4];
    #pragma unroll
    for(int ks=0;ks<4;++ks){
      asm volatile("ds_read_b64_tr_b16 %0,%1 offset:%c2":"=&v"(lo[ks]):"v"(vb),"i"(d0*4096+ks*1024):"memory");
      asm volatile("ds_read_b64_tr_b16 %0,%1 offset:%c2":"=&v"(hi[ks]):"v"(vb),"i"(d0*4096+ks*1024+512):"memory");}
    asm volatile("s_waitcnt lgkmcnt(0)":::"memory");SBAR();
    #define PK(k) (bf16x8){lo[k][0],lo[k][1],lo[k][2],lo[k][3],hi[k][0],hi[k][1],hi[k][2],hi[k][3]}
    o[d0]=__builtin_amdgcn_mfma_f32_32x32x16_bf16(pa0,PK(0),o[d0],0,0,0);
    o[d0]=__builtin_amdgcn_mfma_f32_32x32x16_bf16(pa1,PK(1),o[d0],0,0,0);
    o[d0]=__builtin_amdgcn_mfma_f32_32x32x16_bf16(pa2,PK(2),o[d0],0,0,0);
    o[d0]=__builtin_amdgcn_mfma_f32_32x32x16_bf16(pa3,PK(3),o[d0],0,0,0);
    #undef PK
  }
}

#ifndef ATTN_STORE16
#define ATTN_STORE16(p,v) (*(u32x4*)(p)=(v))
#endif
template<int THRL> __device__ __forceinline__ void attn_unit(int b,int h,int qb,const bf16*Q,const bf16*__restrict__ K,const bf16*__restrict__ V,bf16*O,const bf16*__restrict__ Gt,const float*__restrict__ CL,char*shm,int wave_s){
  int tid_o=tid_from(wave_s); asm volatile("":"+v"(tid_o)); const int tid=tid_o,lane=tid&63,r32=lane&31,hi=lane>>5; const int wid=__builtin_amdgcn_readfirstlane(tid>>6);
  const long rowbase=(long)b*SEQ; const int q0=qb*QB;
  const float*cbh=CL+((long)b*NHEAD+h)*SEQ;
  { typedef float f4_t __attribute__((ext_vector_type(4))); __attribute__((address_space(3))) f4_t*cl4=(__attribute__((address_space(3))) f4_t*)((lds_cptr)shm+LDS_CB);
    for(int i=tid;i<(q0+QB)/4;i+=NW*64)cl4[i]=*(const f4_t*)(cbh+4*i); }
  const float cq=cbh[q0+wid*QBLK+(lane&31)];
  const bf16*Qw=Q+(rowbase+q0+wid*QBLK)*DM+h*D;
  const bf16*Kh=K+rowbase*DM+h*D,*Vh=V+rowbase*DM+h*D;
  const unsigned lds0=(unsigned)(uintptr_t)shm;
  float*wsf=(float*)(shm+LDS_WS)+wid*64;
  const bf16*ksrc=Kh+(long)lane*DM+wid*8;
  const bf16*vsrc=Vh+(long)(16*(wid&3)+(lane>>2))*DM+(wid>>2)*32+(lane&3)*8;
  const unsigned kdst=lds0+LDS_K+wid*1024, vdst=lds0+LDS_V+wid*1024;
  #define DMA_K(t,slot) glds16(ksrc+(long)(t)*KVBLK*DM,(unsigned)__builtin_amdgcn_readfirstlane(kdst+(slot)))
  #define DMA_V(t,slot) glds16(vsrc+(long)(t)*KVBLK*DM,(unsigned)__builtin_amdgcn_readfirstlane(vdst+(slot)))
  const int vb0=(int)(lds0+LDS_V)+((lane>>4)&1)*32+(lane&3)*8+(4*hi+((lane&15)>>2))*64;
  const char*Kbase=shm+LDS_K; bf16x8 kf[8];
  const lds_cptr shm3=(lds_cptr)shm; const lds_cptr kp0=shm3+LDS_K+hi*1024+r32*16; const lds_cptr vp0=shm3+LDS_V+((lane>>4)&1)*32+(lane&3)*8+(4*hi+((lane&15)>>2))*64;
  const int NT=(q0+QB)/KVBLK;
  DMA_K(0,0);DMA_V(0,0);DMA_K(1,SLOTB);
  bf16x8 qr[4];
  #pragma unroll
  for(int d0=0;d0<4;++d0)qr[d0]=*reinterpret_cast<const bf16x8*>(&Qw[(long)r32*DM+d0*16+hi*8]);
  float mhat=0.f,l_reg=0.f;f32x16 o[2];o[0]=f32x16{};o[1]=f32x16{};f32x16 negm;
  #pragma unroll
  for(int r=0;r<16;++r)negm[r]=cq;
  asm volatile("":"+v"(negm));
  typedef float cf4_t __attribute__((ext_vector_type(4))); const __attribute__((address_space(3))) cf4_t*clds=(const __attribute__((address_space(3))) cf4_t*)((lds_cptr)shm+LDS_CB)+hi;
  #define CBIAS(P0,P1,t) do{ const __attribute__((address_space(3))) cf4_t*cp_=clds+16*(t); _Pragma("unroll") for(int j_=0;j_<4;++j_){ const cf4_t a_=cp_[2*j_], b_=cp_[8+2*j_]; \
      P0[4*j_]-=a_[0];P0[4*j_+1]-=a_[1];P0[4*j_+2]-=a_[2];P0[4*j_+3]-=a_[3]; P1[4*j_]-=b_[0];P1[4*j_+1]-=b_[1];P1[4*j_+2]-=b_[2];P1[4*j_+3]-=b_[3]; } }while(0)
  const int qrel=wid*QBLK+r32;
  #define CMASK(P0,P1,t) do{int jb_=(t)-(NT-4); if(jb_>=0)cmask(P0,P1,jb_,qrel,hi);}while(0)
  bool resc=false;
  #define START(P0,P1) do{ const float rm=rowmax(P0,P1); resc=false; \
    { const float dl=rm; mhat=fadd_s(mhat,dl); \
      _Pragma("unroll") for(int r=0;r<16;++r){P0[r]=fsub_s(P0[r],dl);P1[r]=fsub_s(P1[r],dl);} \
      _Pragma("unroll") for(int r=0;r<16;++r)negm[r]=cq-mhat; asm volatile("":"+v"(negm)); } \
    _Pragma("unroll") for(int r=0;r<16;++r)P0[r]=__builtin_amdgcn_exp2f(P0[r]); }while(0)
  #define RESC() do{ if(resc){ asm volatile("s_waitcnt lgkmcnt(0)":::"memory"); \
      _Pragma("unroll") for(int d_=0;d_<2;++d_) _Pragma("unroll") for(int r=0;r<16;++r)o[d_][r]*=wsf[crow(r,hi)]; } }while(0)
  f32x16 pA0,pA1,pB0,pB1;
  int sl_prev=0,sl_cur=0,sl_next=SLOTB;
  #define ROT() do{sl_prev=sl_cur;sl_cur=sl_next;sl_next=(sl_next==(NSLOT-1)*SLOTB)?0:sl_next+SLOTB;}while(0)
  DMA_K(2,2*SLOTB);
  WAIT_BAR(3);
  qkt(pA0,pA1,Kbase,qr,negm,r32,hi);asm volatile("s_nop 15\n\ts_nop 7":"+v"(pA0),"+v"(pA1));CMASK(pA0,pA1,0);CBIAS(pA0,pA1,0);
  START(pA0,pA1);
  _Pragma("unroll") for(int r=0;r<16;++r)pA1[r]=__builtin_amdgcn_exp2f(pA1[r]);
  WAIT_BAR(0);
  DMA_K(3,0);DMA_V(1,SLOTB);
  ROT();
  kload8(kf,kp0+sl_cur);
  WAIT_BAR(2);
  s16x4 vlo[8],vhi[8]; u32x4 pw0,pw1,pw2,pw3;
  #define PKW(P,B) cvtpk_s(P[B],P[B+1])
  #define PAF(k) __builtin_bit_cast(bf16x8,pw##k)
  #define VFR(i) (bf16x8){vlo[i][0],vlo[i][1],vlo[i][2],vlo[i][3],vhi[i][0],vhi[i][1],vhi[i][2],vhi[i][3]}
  #define PIN(x) asm volatile("":"+v"(x))
  #define MX3(a,b,c) __builtin_fmaxf(__builtin_fmaxf((a),(b)),(c))
  #define GAPA(MF,A0,A1,A2,A3,W0,W1,PW) do{ MF; sacc+=A0; sacc+=A1; sacc+=A2; sacc+=A3; PIN(sacc); W0; W1; PIN(PW); SBAR(); }while(0)
  #define EX(v) __builtin_amdgcn_exp2f(v)
  #define GAPB(MF,X,B) do{ MF; X[B]=EX(X[B]); X[B+1]=EX(X[B+1]); X[B+2]=EX(X[B+2]); X[B+3]=EX(X[B+3]); PIN(X); SBAR(); }while(0)
  #define VRD(i) do{ vlo[i]=vtr(vp_+(((i)>>2)*4096+((i)&3)*1024)); vhi[i]=vtr(vp_+(((i)>>2)*4096+((i)&3)*1024+512)); }while(0)
  #define KRD(G,j) do{ if(G){ kload2(kf,kp0+sl_next,j); SBAR(); } }while(0)
  #define STEP(C0,C1,P0,P1,t,GK,GV,GL) do{ SBAR(); \
    const lds_cptr vp_=vp0+sl_prev; \
    VRD(0); SBAR(); float sacc=(P0[0]+P0[1]); \
    GAPA(C0=__builtin_amdgcn_mfma_f32_32x32x16_bf16(kf[0],qr[0],negm,0,0,0), P0[2],P0[3],P0[4],P0[5],     pw0[0]=PKW(P0,0), pw0[1]=PKW(P0,2), pw0); \
    VRD(4); SBAR(); GAPA(C1=__builtin_amdgcn_mfma_f32_32x32x16_bf16(kf[1],qr[0],negm,0,0,0), P0[6],P0[7],P0[8],P0[9],     pw0[2]=PKW(P0,4), pw0[3]=PKW(P0,6), pw0); \
    VRD(1); SBAR(); GAPA(C0=__builtin_amdgcn_mfma_f32_32x32x16_bf16(kf[2],qr[1],C0,0,0,0),   P0[10],P0[11],P0[12],P0[13], pw1[0]=PKW(P0,8), pw1[1]=PKW(P0,10), pw1); \
    VRD(5); SBAR(); GAPA(C1=__builtin_amdgcn_mfma_f32_32x32x16_bf16(kf[3],qr[1],C1,0,0,0),   P0[14],P0[15],P1[0],P1[1],   pw1[2]=PKW(P0,12),pw1[3]=PKW(P0,14), pw1); \
    VRD(2); SBAR(); GAPA(C0=__builtin_amdgcn_mfma_f32_32x32x16_bf16(kf[4],qr[2],C0,0,0,0),   P1[2],P1[3],P1[4],P1[5],     pw2[0]=PKW(P1,0), pw2[1]=PKW(P1,2), pw2); \
    VRD(6); SBAR(); GAPA(C1=__builtin_amdgcn_mfma_f32_32x32x16_bf16(kf[5],qr[2],C1,0,0,0),   P1[6],P1[7],P1[8],P1[9],     pw2[2]=PKW(P1,4), pw2[3]=PKW(P1,6), pw2); \
    VRD(3); SBAR(); GAPA(C0=__builtin_amdgcn_mfma_f32_32x32x16_bf16(kf[6],qr[3],C0,0,0,0),   P1[10],P1[11],P1[12],P1[13], pw3[0]=PKW(P1,8), pw3[1]=PKW(P1,10), pw3); \
    VRD(7); SBAR(); GAPA(C1=__builtin_amdgcn_mfma_f32_32x32x16_bf16(kf[7],qr[3],C1,0,0,0),   P1[14],P1[15],0.f,0.f,       pw3[2]=PKW(P1,12),pw3[3]=PKW(P1,14), pw3); \
    l_reg+=sacc; \
    if(GK){DMA_K((t)+3,sl_cur);} if(GV){DMA_V((t)+1,sl_next);} \
    CMASK(C0,C1,t); CBIAS(C0,C1,t); \
    { float a=MX3(C0[0],C0[1],C1[0]),b=MX3(C0[2],C0[3],C1[1]); a=MX3(a,C1[2],C1[3]); \
      _Pragma("unroll") for(int r=4;r<16;r+=4){a=MX3(a,C0[r],C0[r+1]);b=MX3(b,C0[r+2],C0[r+3]);a=MX3(a,C1[r],C1[r+1]);b=MX3(b,C1[r+2],C1[r+3]);} \
      float rm=__builtin_fmaxf(a,b); { auto rr=__builtin_amdgcn_permlane32_swap(__float_as_uint(rm),__float_as_uint(rm),false,false); rm=__builtin_fmaxf(__uint_as_float(rr[0]),__uint_as_float(rr[1])); } \
      resc=false; \
      if(__builtin_expect(__any(rm>(float)THRL),0)){ const float dl=__builtin_fmaxf(rm,0.f); mhat+=dl; \
        _Pragma("unroll") for(int r=0;r<16;++r){C0[r]-=dl;C1[r]-=dl;} \
        _Pragma("unroll") for(int r=0;r<16;++r)negm[r]=cq-mhat; asm volatile("":"+v"(negm)); \
        const float f=__builtin_amdgcn_exp2f(-dl); l_reg*=f; if(hi==0)wsf[r32]=f; resc=true; } } \
    SBAR(); \
    GAPB(o[0]=__builtin_amdgcn_mfma_f32_32x32x16_bf16(PAF(0),VFR(0),o[0],0,0,0), C0,0); \
    GAPB(o[1]=__builtin_amdgcn_mfma_f32_32x32x16_bf16(PAF(0),VFR(4),o[1],0,0,0), C0,4); \
    KRD(GL,0); GAPB(o[0]=__builtin_amdgcn_mfma_f32_32x32x16_bf16(PAF(1),VFR(1),o[0],0,0,0), C0,8); \
    KRD(GL,1); GAPB(o[1]=__builtin_amdgcn_mfma_f32_32x32x16_bf16(PAF(1),VFR(5),o[1],0,0,0), C0,12); \
    KRD(GL,2); GAPB(o[0]=__builtin_amdgcn_mfma_f32_32x32x16_bf16(PAF(2),VFR(2),o[0],0,0,0), C1,0); \
    KRD(GL,3); GAPB(o[1]=__builtin_amdgcn_mfma_f32_32x32x16_bf16(PAF(2),VFR(6),o[1],0,0,0), C1,4); \
    GAPB(o[0]=__builtin_amdgcn_mfma_f32_32x32x16_bf16(PAF(3),VFR(3),o[0],0,0,0), C1,8); \
    GAPB(o[1]=__builtin_amdgcn_mfma_f32_32x32x16_bf16(PAF(3),VFR(7),o[1],0,0,0), C1,12); \
    }while(0)
  int t=1;
  #undef CMASK
  #define CMASK(P0,P1,t) do{}while(0)
  for(;t+5<NT;t+=2){
    STEP(pB0,pB1,pA0,pA1,t,true,true,true);     WAIT_BAR(2); RESC(); ROT();
    STEP(pA0,pA1,pB0,pB1,t+1,true,true,true);   WAIT_BAR(2); RESC(); ROT();
  }
  #undef CMASK
  #define CMASK(P0,P1,t) do{int jb_=(t)-(NT-4); if(jb_>=0)cmask(P0,P1,jb_,qrel,hi);}while(0)
  #define ENDW(tt) do{ if((tt)+3<NT){WAIT_BAR(2);} else if((tt)+2<NT){WAIT_BAR(1);} else {WAIT_BAR(0);} }while(0)
  for(;t+1<NT;t+=2){
    STEP(pB0,pB1,pA0,pA1,t,(t+3<NT),(t+1<NT),(t+1<NT));       ENDW(t);   RESC(); ROT();
    STEP(pA0,pA1,pB0,pB1,t+1,(t+4<NT),(t+2<NT),(t+2<NT));     ENDW(t+1); RESC(); ROT();
  }
  STEP(pB0,pB1,pA0,pA1,NT-1,false,false,false); RESC();
  { float sacc=pB0[0]+pB0[1]; _Pragma("unroll") for(int r=2;r<16;++r)sacc+=pB0[r]; _Pragma("unroll") for(int r=0;r<16;++r)sacc+=pB1[r]; l_reg+=sacc;
    pw0=(u32x4){PKW(pB0,0),PKW(pB0,2),PKW(pB0,4),PKW(pB0,6)};pw1=(u32x4){PKW(pB0,8),PKW(pB0,10),PKW(pB0,12),PKW(pB0,14)};pw2=(u32x4){PKW(pB1,0),PKW(pB1,2),PKW(pB1,4),PKW(pB1,6)};pw3=(u32x4){PKW(pB1,8),PKW(pB1,10),PKW(pB1,12),PKW(pB1,14)};
    SBAR(); pv(o,vb0+sl_cur,PAF(0),PAF(1),PAF(2),PAF(3)); }
  #undef PKW
  #undef PAF
  #undef VFR
  #undef PIN
  #undef MX3
  #undef GAPA
  #undef GAPB
  #undef EX
  #undef VRD
  #undef KRD
  #undef STEP
  #undef ENDW
  {auto rr=__builtin_amdgcn_permlane32_swap(__float_as_uint(l_reg),__float_as_uint(l_reg),false,false);l_reg=__uint_as_float(rr[0])+__uint_as_float(rr[1]);}
  if(hi==0)wsf[32+r32]=l_reg;asm volatile("s_waitcnt lgkmcnt(0)":::"memory");
  float rli[16];
  #pragma unroll
  for(int r=0;r<16;++r)rli[r]=__builtin_amdgcn_rcpf(wsf[32+crow(r,hi)]);
  bf16*Ow=O+(rowbase+q0+wid*QBLK)*DM+h*D;
  { bf16*stg=(bf16*)(shm+LDS_OST)+wid*2048;
    #pragma unroll
    for(int r=0;r<16;++r){const int orow=crow(r,hi);
      #pragma unroll
      for(int d0=0;d0<2;++d0)stg[orow*64+d0*32+r32]=__float2bfloat16(o[d0][r]*rli[r]);}
    asm volatile("s_waitcnt lgkmcnt(0)":::"memory");
    #pragma unroll
    for(int i=0;i<4;++i){const bf16*Gw=Gt+(rowbase+q0+wid*QBLK)*DM+h*D; const int row=i*8+(lane>>3),ch=lane&7; const u32x4 v=*(const u32x4*)(stg+row*64+ch*8); const u32x4 gq=*(const u32x4*)(Gw+(long)row*DM+ch*8); u32x4 w;
      #pragma unroll
      for(int e=0;e<4;++e){ const float a0=__uint_as_float(v[e]<<16)*__uint_as_float(gq[e]<<16), a1=__uint_as_float(v[e]&0xffff0000u)*__uint_as_float(gq[e]&0xffff0000u); w[e]=cvtpk_s(a0,a1); }
      ATTN_STORE16(Ow+(long)row*DM+ch*8,w);} }
  asm volatile("s_waitcnt lgkmcnt(0)\n\ts_barrier":::"memory");
  #undef CBIAS
  #undef DMA_K
  #undef DMA_V
  #undef CMASK
  #undef START
  #undef RESC
  #undef ROT
}
constexpr int ATTN_LDS_BYTES=LDS_BYTES;
struct AttnTensors { const bf16* Q; const bf16* K; const bf16* V; bf16* O; const bf16* G; const float* CL; };
struct AttnUnit { int bh; int qb; };
struct StaticOrder {
  int vcu, G;
  __device__ __forceinline__ explicit StaticOrder(int grid,int block):vcu((grid%8==0)?(block%8)*(grid/8)+block/8:block),G(grid){}
  __device__ __forceinline__ bool next(int i,AttnUnit&u)const{
    if(G==256){ if(i>=8)return false; const int j=2*(i>>1)+(vcu&1); u.bh=vcu>>1; u.qb=(i&1)?15-j:j; return true; }
    const int idx=i*G+vcu; if(idx>=BATCH*NHEAD*NQB)return false; u.bh=idx/NQB; u.qb=NQB-1-idx%NQB; return true; }
  __device__ __forceinline__ void a_ready(const AttnUnit&)const{}
  __device__ __forceinline__ void done(const AttnUnit&)const{}
};
template<class Sched,int THRL=8> __device__ __forceinline__ void attn_phase(char*lds,const AttnTensors&T,const Sched&S,int wave_s){
  AttnUnit u;
  for(int i=0;S.next(i,u);++i){ S.a_ready(u); attn_unit<THRL>(u.bh/NHEAD,u.bh%NHEAD,u.qb,T.Q,T.K,T.V,T.O,T.G,T.CL,lds,wave_s); S.done(u); }
}
#undef SBAR
#undef WAIT_BAR
}
#define GAS __attribute__((address_space(1)))
#define LAS __attribute__((address_space(3)))
typedef unsigned short bfu;
typedef unsigned v4u __attribute__((ext_vector_type(4)));
typedef unsigned v2u __attribute__((ext_vector_type(2)));
typedef float f32x4 __attribute__((ext_vector_type(4)));
typedef short bf16x8 __attribute__((ext_vector_type(8)));
#define LDS_WAIT() asm volatile("s_waitcnt lgkmcnt(0)" ::: "memory")
constexpr int NWAVES = 8;
constexpr int BATCH = 8, SEQ = 4096, D = 1024, FF = 2816, T = BATCH * SEQ, PLE = 256, NKVF = 2064, NKVFP = 2304;
constexpr float EPS = 1e-6f, LOG2E = 1.4426950408889634f;
constexpr size_t MiB = 1u << 20;
constexpr size_t E_W1IN = 0, N_WIN = (size_t)2 * FF * D, N_WOUT = (size_t)D * FF;
constexpr size_t E_W1OUT = E_W1IN + 2 * N_WIN, E_W2IN = E_W1OUT + 2 * N_WOUT, E_W2OUT = E_W2IN + 2 * N_WIN, E_WHIN = E_W2OUT + 2 * N_WOUT;
constexpr size_t E_WHOUT = E_WHIN + (size_t)4 * D * D, E_WKVF = E_WHOUT + (size_t)D * D, E_WQG = E_WKVF + (size_t)NKVFP * D, E_WFO = E_WQG + (size_t)2 * D * D;
constexpr size_t E_WPG = E_WFO + (size_t)D * D, E_WPP = E_WPG + (size_t)2 * D * D, E_WEND = E_WPP + (size_t)2 * D * PLE;
static_assert(E_WEND * 2 <= 92 * MiB, "weights fit");
constexpr size_t WS_P = 92 * MiB, WS_LOGF = 124 * MiB, WS_C = 126 * MiB, WS_AY = 128 * MiB, WS_BIG = 192 * MiB, WS_PROJ = 448 * MiB, WS_END = 512 * MiB;
constexpr size_t WS_V = WS_BIG + 192 * MiB, WS_K = WS_PROJ, WS_Q = WS_BIG, WS_G = WS_BIG + 64 * MiB;
constexpr int LDS_BYTES = 147456;

__device__ __forceinline__ float wave_sum(float v) {
#pragma unroll
    for (int o = 1; o < 64; o <<= 1) v += __shfl_xor(v, o);
    return v;
}
__device__ __forceinline__ unsigned pk2(float lo, float hi) { return pg8::cvt_pk_bf16(lo, hi); }
__device__ __forceinline__ float bf2f(unsigned short u) { return __uint_as_float((unsigned)u << 16); }
__device__ __forceinline__ unsigned short f2b(float f) { return (unsigned short)(pk2(f, 0.f) & 0xffffu); }

__device__ __forceinline__ void conv_item(const float* W, int K, int N, bfu* WT, const float* gain, int gmask, int sw, LAS float* scr, int item, int lane) {
    const int nblk = (N + 31) / 32, kb = item / nblk, nb = item % nblk, k0 = 64 * kb, n0 = 32 * nb;
    const int nn = n0 + (lane & 31); const bool nok = nn < N;
#pragma unroll 8
    for (int i = 0; i < 32; ++i) { const int kk = 2 * i + (lane >> 5); float w = nok ? W[(size_t)(k0 + kk) * N + nn] : 0.f; if (gain) w *= gain[(k0 + kk) & gmask]; scr[kk * 33 + (lane & 31)] = w; }
    LDS_WAIT(); asm volatile("" ::: "memory");
    int drow0 = n0; if (sw) { const int j0 = (n0 < FF) ? n0 : n0 - FF; drow0 = 256 * (j0 >> 7) + (j0 & 127) + ((n0 < FF) ? 0 : 128); }
    const int c = lane & 7;
#pragma unroll
    for (int j = 0; j < 4; ++j) { const int n = (lane >> 3) + 8 * j; const LAS float* s = scr + (8 * c) * 33 + n;
        v4u o; o.x = pk2(s[0 * 33], s[1 * 33]); o.y = pk2(s[2 * 33], s[3 * 33]); o.z = pk2(s[4 * 33], s[5 * 33]); o.w = pk2(s[6 * 33], s[7 * 33]);
        *(v4u*)(WT + (size_t)(drow0 + n) * K + k0 + 8 * c) = o; }
    LDS_WAIT(); asm volatile("" ::: "memory");
}
__device__ __forceinline__ void rms_row_to_bf16(const float* xrow, bfu* orow, int lane) {
    const f32x4* xr = (const f32x4*)xrow + lane;
    f32x4 v[4]; float s = 0.f;
#pragma unroll
    for (int j = 0; j < 4; ++j) { v[j] = xr[64 * j]; s += (v[j].x * v[j].x + v[j].y * v[j].y) + (v[j].z * v[j].z + v[j].w * v[j].w); }
    const float r = __builtin_amdgcn_rsqf(wave_sum(s) * (1.f / D) + EPS);
    v2u* o8 = (v2u*)orow + lane;
#pragma unroll
    for (int j = 0; j < 4; ++j) { v2u w; w.x = pk2(v[j].x * r, v[j].y * r); w.y = pk2(v[j].z * r, v[j].w * r); o8[64 * j] = w; }
}
__device__ __forceinline__ void rw_phase(const float* hin, float* hout, const bfu* Y, bfu* A, const float* gain, float scale, int gw, int ngw, int lane) {
    f32x4 g[4];
#pragma unroll
    for (int j = 0; j < 4; ++j) g[j] = *((const f32x4*)gain + lane + 64 * j);
    for (int m = gw; m < T; m += ngw) {
        const f32x4* hr = (const f32x4*)(hin + (size_t)m * D) + lane; const v2u* yr = (const v2u*)(Y + (size_t)m * D) + lane;
        f32x4 v[4], y[4]; float s = 0.f;
#pragma unroll
        for (int j = 0; j < 4; ++j) { v[j] = hr[64 * j]; const v2u w = yr[64 * j]; y[j] = (f32x4){pg8::bflo(w.x), pg8::bfhi(w.x), pg8::bflo(w.y), pg8::bfhi(w.y)};
            s += (y[j].x * y[j].x + y[j].y * y[j].y) + (y[j].z * y[j].z + y[j].w * y[j].w); }
        const float ry = __builtin_amdgcn_rsqf(wave_sum(s) * (1.f / D) + EPS) * scale; float s2 = 0.f;
#pragma unroll
        for (int j = 0; j < 4; ++j) { v[j] = v[j] + y[j] * ry * g[j]; s2 += (v[j].x * v[j].x + v[j].y * v[j].y) + (v[j].z * v[j].z + v[j].w * v[j].w); }
        const float r2 = __builtin_amdgcn_rsqf(wave_sum(s2) * (1.f / D) + EPS);
        f32x4* ho = (f32x4*)(hout + (size_t)m * D) + lane; v2u* ao = (v2u*)(A + (size_t)m * D) + lane;
#pragma unroll
        for (int j = 0; j < 4; ++j) { ho[64 * j] = v[j]; v2u w; w.x = pk2(v[j].x * r2, v[j].y * r2); w.y = pk2(v[j].z * r2, v[j].w * r2); ao[64 * j] = w; }
    }
}

constexpr int HG_QH = 0, HG_QT = 17408, HG_KT = 34816, HG_KHT = 52224, HG_VT = 70656, HG_PP = 89088, HG_ST = 98304, HG_TOT = 133120, HG_DV = 135168, HG_END = 135680;
constexpr int RS = 136, RS2 = 72, OFS = 132;
static_assert(HG_END <= LDS_BYTES, "hgrn lds");
__device__ __forceinline__ f32x4 mfma16(bf16x8 a, bf16x8 b, f32x4 c) { return __builtin_amdgcn_mfma_f32_16x16x32_bf16(a, b, c, 0, 0, 0); }
constexpr int HSEG = 4, HCH = SEQ / 64 / HSEG;
template <bool OUT>
__device__ __forceinline__ void hgrn_scan(LAS unsigned char* lds, bfu* QZVG, const float* lbl, int bh, int seg, float* Ebuf, float* Lbuf, int wave_s) {
    int tid_o = tid_from(wave_s); asm volatile("" : "+v"(tid_o)); const int tid = tid_o, lane = tid & 63, wid = __builtin_amdgcn_readfirstlane(tid >> 6), col = tid & 127, rg = tid >> 7, fr = lane & 15, fq = lane >> 4;
    const int b = bh >> 3, h = bh & 7;
    LAS bfu* QH = (LAS bfu*)(lds + HG_QH); LAS bfu* QT = (LAS bfu*)(lds + HG_QT); LAS bfu* KT = (LAS bfu*)(lds + HG_KT); LAS bfu* KHT = (LAS bfu*)(lds + HG_KHT);
    LAS bfu* VT = (LAS bfu*)(lds + HG_VT); LAS bfu* PP = (LAS bfu*)(lds + HG_PP); LAS bfu* ST = (LAS bfu*)(lds + HG_ST);
    LAS float* TOT = (LAS float*)(lds + HG_TOT); LAS float* DV = (LAS float*)(lds + HG_DV); LAS float* OF = (LAS float*)(lds + HG_QT);
    const float l0 = lbl[h * 128 + col], l1 = lbl[1024 + h * 128 + col];
    const float lb = 1.f / (1.f + __expf(l1 - l0)), omlb = 1.f - lb;
    bfu* base = QZVG + ((size_t)b * SEQ + (size_t)seg * HCH * 64) * 4096 + h * 128;
    const bfu* pq = base + (size_t)(16 * rg) * 4096 + col; const bfu* pz = pq + 1024; const bfu* pv = pq + 2048;
    const int erow = tid >> 3, eseg = tid & 7;
    const bfu* pg = base + 3072 + (size_t)erow * 4096 + 16 * eseg; bfu* po = base + (size_t)erow * 4096 + 16 * eseg;
    f32x4 Sacc[8];
#pragma unroll
    for (int i = 0; i < 8; ++i) Sacc[i] = (f32x4){0.f, 0.f, 0.f, 0.f};
    float Lacc = 0.f;
    if constexpr (OUT) {
        for (int j = 0; j < seg; ++j) {
            const float* Ej = Ebuf + ((size_t)(bh * HSEG + j) * 64 * 64) * 4 + (size_t)(wid * 8) * 64 * 4; const float* Lj = Lbuf + (size_t)(bh * HSEG + j) * 128;
#pragma unroll
            for (int kb = 0; kb < 8; ++kb) { const f32x4 e = *(const f32x4*)(Ej + ((size_t)kb * 64 + lane) * 4); const f32x4 l4 = *(const f32x4*)(Lj + 16 * kb + 4 * fq);
                f32x4 s = Sacc[kb]; s[0] = s[0] * __expf(l4[0]) + e[0]; s[1] = s[1] * __expf(l4[1]) + e[1]; s[2] = s[2] * __expf(l4[2]) + e[2]; s[3] = s[3] * __expf(l4[3]) + e[3]; Sacc[kb] = s; }
        }
#pragma unroll
        for (int kb = 0; kb < 8; ++kb) *(LAS v2u*)(ST + (16 * wid + fr) * RS + 16 * kb + 4 * fq) = (v2u){pk2(Sacc[kb][0], Sacc[kb][1]), pk2(Sacc[kb][2], Sacc[kb][3])};
    }
    unsigned short zr[16], qr[16], vr[16]; v4u gr0 = (v4u){0u, 0u, 0u, 0u}, gr1 = gr0;
#define HG_LOAD() do { _Pragma("unroll") for (int j = 0; j < 16; ++j) { zr[j] = pz[(size_t)j * 4096]; vr[j] = pv[(size_t)j * 4096]; if (OUT) qr[j] = pq[(size_t)j * 4096]; else qr[j] = 0; } \
        if (OUT) { gr0 = *(const v4u*)pg; gr1 = *(const v4u*)(pg + 8); } pz += (size_t)64 * 4096; pq += (size_t)64 * 4096; pv += (size_t)64 * 4096; pg += (size_t)64 * 4096; } while (0)
    HG_LOAD();
    for (int c = 0; c < HCH; ++c) {
        float kk[16], cum[16], qf[16]; unsigned short vv[16]; const v4u g0 = gr0, g1 = gr1;
        float run = 0.f;
#pragma unroll
        for (int j = 0; j < 16; ++j) { const float z = bf2f(zr[j]); const float k = omlb * __builtin_amdgcn_rcpf(1.f + __expf(z)); run += __logf(1.f - k); cum[j] = run; kk[j] = k; qf[j] = bf2f(qr[j]); vv[j] = vr[j]; }
        TOT[rg * 128 + col] = run;
        if (c + 1 < HCH) HG_LOAD();
        LDS_WAIT(); __builtin_amdgcn_s_barrier(); asm volatile("" ::: "memory");
        const float t0 = TOT[col], t1 = TOT[128 + col], t2 = TOT[256 + col], t3 = TOT[384 + col];
        const float pre = (rg > 0 ? t0 : 0.f) + (rg > 1 ? t1 : 0.f) + (rg > 2 ? t2 : 0.f), tot = (t0 + t1) + (t2 + t3), mid = t0 + t1;
        Lacc += tot;
        unsigned khp[8], vvp[8];
#pragma unroll
        for (int j = 0; j < 16; ++j) { const float cj = pre + cum[j]; const int r = 16 * rg + j;
            if constexpr (OUT) { QH[r * RS + col] = f2b(qf[j] * __expf(cj)); QT[r * RS + col] = f2b(qf[j] * __expf(cj - mid)); KT[r * RS + col] = f2b(kk[j] * __expf(mid - cj)); }
            const unsigned short kh = f2b(kk[j] * __expf(tot - cj));
            if (j & 1) { khp[j >> 1] |= (unsigned)kh << 16; vvp[j >> 1] |= (unsigned)vv[j] << 16; } else { khp[j >> 1] = kh; vvp[j >> 1] = vv[j]; } }
        *(LAS v4u*)(KHT + col * RS2 + 16 * rg) = (v4u){khp[0], khp[1], khp[2], khp[3]}; *(LAS v4u*)(KHT + col * RS2 + 16 * rg + 8) = (v4u){khp[4], khp[5], khp[6], khp[7]};
        *(LAS v4u*)(VT + col * RS2 + 16 * rg) = (v4u){vvp[0], vvp[1], vvp[2], vvp[3]}; *(LAS v4u*)(VT + col * RS2 + 16 * rg + 8) = (v4u){vvp[4], vvp[5], vvp[6], vvp[7]};
        if (rg == 0) DV[col] = __expf(tot);
        LDS_WAIT(); __builtin_amdgcn_s_barrier(); asm volatile("" ::: "memory");
        if constexpr (OUT) {
            const int tb = wid >> 1;
#pragma unroll
            for (int ss = 0; ss < 2; ++ss) { const int sb = 2 * (wid & 1) + ss; f32x4 sc = (f32x4){0.f, 0.f, 0.f, 0.f};
                if (sb <= tb) {
#pragma unroll
                    for (int ks = 0; ks < 4; ++ks) { const bf16x8 a = *(const LAS bf16x8*)(QT + (16 * tb + fr) * RS + 32 * ks + 8 * fq), bq = *(const LAS bf16x8*)(KT + (16 * sb + fr) * RS + 32 * ks + 8 * fq); sc = mfma16(a, bq, sc); } }
#pragma unroll
                for (int i = 0; i < 4; ++i) { const int t = 16 * tb + 4 * fq + i, s = 16 * sb + fr; PP[t * RS2 + s] = f2b((sb <= tb && s <= t) ? sc[i] : 0.f); } }
            LDS_WAIT(); __builtin_amdgcn_s_barrier(); asm volatile("" ::: "memory");
        }
        {   bf16x8 vtf[2];
#pragma unroll
            for (int ks = 0; ks < 2; ++ks) vtf[ks] = *(const LAS bf16x8*)(VT + (16 * wid + fr) * RS2 + 32 * ks + 8 * fq);
            if constexpr (OUT) { bf16x8 stf[4];
#pragma unroll
                for (int ks = 0; ks < 4; ++ks) stf[ks] = *(const LAS bf16x8*)(ST + (16 * wid + fr) * RS + 32 * ks + 8 * fq);
#pragma unroll
                for (int tb = 0; tb < 4; ++tb) { f32x4 o = (f32x4){0.f, 0.f, 0.f, 0.f};
#pragma unroll
                    for (int ks = 0; ks < 4; ++ks) o = mfma16(*(const LAS bf16x8*)(QH + (16 * tb + fr) * RS + 32 * ks + 8 * fq), stf[ks], o);
#pragma unroll
                    for (int ks = 0; ks < 2; ++ks) o = mfma16(*(const LAS bf16x8*)(PP + (16 * tb + fr) * RS2 + 32 * ks + 8 * fq), vtf[ks], o);
#pragma unroll
                    for (int i = 0; i < 4; ++i) OF[(16 * tb + 4 * fq + i) * OFS + 16 * wid + fr] = o[i]; } }
#pragma unroll
            for (int kb = 0; kb < 8; ++kb) { const f32x4 d4 = *(const LAS f32x4*)(DV + 16 * kb + 4 * fq); f32x4 s = Sacc[kb] * d4;
#pragma unroll
                for (int ks = 0; ks < 2; ++ks) s = mfma16(*(const LAS bf16x8*)(KHT + (16 * kb + fr) * RS2 + 32 * ks + 8 * fq), vtf[ks], s);
                Sacc[kb] = s; if constexpr (OUT) *(LAS v2u*)(ST + (16 * wid + fr) * RS + 16 * kb + 4 * fq) = (v2u){pk2(s[0], s[1]), pk2(s[2], s[3])}; }
        }
        if constexpr (OUT) {
            LDS_WAIT(); __builtin_amdgcn_s_barrier(); asm volatile("" ::: "memory");
            f32x4 o4[4]; float ss = 0.f;
#pragma unroll
            for (int j = 0; j < 4; ++j) { o4[j] = *(const LAS f32x4*)(OF + erow * OFS + 16 * eseg + 4 * j); ss += (o4[j].x * o4[j].x + o4[j].y * o4[j].y) + (o4[j].z * o4[j].z + o4[j].w * o4[j].w); }
            ss += __shfl_xor(ss, 1); ss += __shfl_xor(ss, 2); ss += __shfl_xor(ss, 4);
            const float rs = __builtin_amdgcn_rsqf(ss * (1.f / 128.f) + EPS);
            unsigned w[8];
#pragma unroll
            for (int j = 0; j < 4; ++j) { const unsigned ga = (j < 2) ? g0[2 * j] : g1[2 * (j - 2)], gb = (j < 2) ? g0[2 * j + 1] : g1[2 * (j - 2) + 1];
                const float a0 = pg8::bflo(ga), a1 = pg8::bfhi(ga), a2 = pg8::bflo(gb), a3 = pg8::bfhi(gb);
                w[2 * j] = pk2(o4[j].x * rs * a0 * pg8::fsigmoid(a0), o4[j].y * rs * a1 * pg8::fsigmoid(a1)); w[2 * j + 1] = pk2(o4[j].z * rs * a2 * pg8::fsigmoid(a2), o4[j].w * rs * a3 * pg8::fsigmoid(a3)); }
            *(v4u*)po = (v4u){w[0], w[1], w[2], w[3]}; *(v4u*)(po + 8) = (v4u){w[4], w[5], w[6], w[7]}; po += (size_t)64 * 4096;
        }
    }
#undef HG_LOAD
    if constexpr (!OUT) {
        float* Es = Ebuf + ((size_t)(bh * HSEG + seg) * 64 * 64) * 4 + (size_t)(wid * 8) * 64 * 4;
#pragma unroll
        for (int kb = 0; kb < 8; ++kb) *(f32x4*)(Es + ((size_t)kb * 64 + lane) * 4) = Sacc[kb];
        if (rg == 0) Lbuf[(size_t)(bh * HSEG + seg) * 128 + col] = Lacc;
    }
    LDS_WAIT(); __builtin_amdgcn_s_barrier(); asm volatile("" ::: "memory");
}

__device__ __forceinline__ void cumsum_bh(LAS unsigned char* lds, const float* LOGF, float* C, int bh, int wave_s) {
    const int tid = tid_from(wave_s), lane = tid & 63, wid = tid >> 6, b = bh >> 4, h = bh & 15;
    LAS float* wsum = (LAS float*)lds;
    const float* src = LOGF + ((size_t)b * SEQ + 8 * tid) * 16 + h;
    float v[8]; float run = 0.f;
#pragma unroll
    for (int j = 0; j < 8; ++j) { run += src[j * 16]; v[j] = run; }
    float inc = run;
#pragma unroll
    for (int o = 1; o < 64; o <<= 1) { const float t = __shfl_up(inc, o); if (lane >= o) inc += t; }
    if (lane == 63) wsum[wid] = inc;
    LDS_WAIT(); __builtin_amdgcn_s_barrier(); asm volatile("" ::: "memory");
    float off = inc - run;
    for (int w = 0; w < wid; ++w) off += wsum[w];
    float* dst = C + (size_t)bh * SEQ + 8 * tid;
    *(f32x4*)dst = (f32x4){(off + v[0]) * LOG2E, (off + v[1]) * LOG2E, (off + v[2]) * LOG2E, (off + v[3]) * LOG2E};
    *(f32x4*)(dst + 4) = (f32x4){(off + v[4]) * LOG2E, (off + v[5]) * LOG2E, (off + v[6]) * LOG2E, (off + v[7]) * LOG2E};
    LDS_WAIT(); __builtin_amdgcn_s_barrier(); asm volatile("" ::: "memory");
}

#define RLX_AGENT __ATOMIC_RELAXED, __HIP_MEMORY_SCOPE_AGENT
#define XB_TMO      128
#define XB_XCNT(j)  (256  + 64 * (j))
#define XB_XSUB(j)  (1280 + 64 * (j))
#define XB_XGEN(j)  (2304 + 64 * (j))
#define XB_TOP      3328
#define XB_TOPGEN   3392
#define XCD_BAR_WORDS 3456
#define XB_SPIN_CAP (1u << 18)

__device__ __forceinline__ unsigned xb_ld(unsigned* p)              { return __hip_atomic_load(p, __ATOMIC_RELAXED, __HIP_MEMORY_SCOPE_AGENT); }
__device__ __forceinline__ unsigned xb_add(unsigned* p, unsigned v) { return __hip_atomic_fetch_add(p, v, __ATOMIC_RELAXED, __HIP_MEMORY_SCOPE_AGENT); }
__device__ __forceinline__ unsigned xb_xcc_id() { return (unsigned)__builtin_amdgcn_s_getreg((3 << 11) | 20) & 0xFu; }
#define XB_SPIN(cond, bar) do { unsigned _sp = 0; while (cond) { __builtin_amdgcn_s_sleep(1); \
    if ((++_sp & 255u) == 0u) { if (xb_ld(&(bar)[XB_TMO])) break; if (_sp > XB_SPIN_CAP) { atomicAdd(&(bar)[XB_TMO], 1u); break; } } } } while (0)

struct XcdBarrier {
    unsigned* bar; unsigned x;
    volatile LAS unsigned* st;
};

__device__ __forceinline__ XcdBarrier xcd_barrier_post(unsigned* bar, volatile LAS unsigned* st, bool is_t0) {
    XcdBarrier b; b.bar = bar; b.x = xb_xcc_id(); b.st = st;
    if (is_t0) (void)xb_add(&bar[XB_XCNT(b.x)], 1u);
    return b;
}
__device__ __forceinline__ void xcd_barrier_complete(unsigned* bar, unsigned x, unsigned& nloc, unsigned& nx) {
    const unsigned G = gridDim.x * gridDim.y * gridDim.z;
    unsigned sum, cnt, mine, sp = 0u;
    for (;;) {
        sum = 0u; cnt = 0u; mine = 0u;
#pragma unroll
        for (unsigned j = 0; j < 16; ++j) { const unsigned c = xb_ld(&bar[XB_XCNT(j)]); sum += c; cnt += (c > 0u) ? 1u : 0u; mine = (j == x) ? c : mine; }
        if (sum == G) break;
        __builtin_amdgcn_s_sleep(1);
        if ((++sp & 255u) == 0u) { if (xb_ld(&bar[XB_TMO])) break; if (sp > XB_SPIN_CAP) { atomicAdd(&bar[XB_TMO], 1u); break; } }
    }
    nloc = mine > 0u ? mine : 1u; nx = cnt > 0u ? cnt : 1u;
}

__device__ __forceinline__ void xcd_barrier(const XcdBarrier& b, bool is_t0) {
    asm volatile("s_waitcnt vmcnt(0)" ::: "memory");
    __syncthreads();
    if (is_t0) {
        unsigned* bar = b.bar;
        __builtin_amdgcn_s_waitcnt(0);
        unsigned nloc = b.st[0], nx = b.st[1];
        if (nloc == 0u) { xcd_barrier_complete(bar, b.x, nloc, nx); b.st[0] = nloc; b.st[1] = nx; }
        const unsigned old = xb_add(&bar[XB_XSUB(b.x)], 1u);
        const unsigned gen = old / nloc;
        if (old + 1u == (gen + 1u) * nloc) {
            __builtin_amdgcn_fence(__ATOMIC_RELEASE, "agent");
            asm volatile("s_waitcnt vmcnt(0)" ::: "memory");
            const unsigned og = xb_add(&bar[XB_TOP], 1u);
            const unsigned tg = og / nx;
            if (og + 1u == (tg + 1u) * nx) xb_add(&bar[XB_TOPGEN], 1u);
            else XB_SPIN(xb_ld(&bar[XB_TOPGEN]) == tg, bar);
            __builtin_amdgcn_fence(__ATOMIC_ACQUIRE, "agent");
            xb_add(&bar[XB_XGEN(b.x)], 1u);
            asm volatile("s_waitcnt vmcnt(0)" ::: "memory");
        } else {
            XB_SPIN(xb_ld(&bar[XB_XGEN(b.x)]) == gen, bar);
            __builtin_amdgcn_fence(__ATOMIC_ACQUIRE, "agent");
            asm volatile("s_waitcnt vmcnt(0)" ::: "memory");
        }
    }
    __syncthreads();
}

constexpr size_t WS_CTL = E_WEND * 2, CTL_BYTES = 16384; static_assert(WS_CTL % 256 == 0 && WS_CTL + CTL_BYTES <= WS_P && XCD_BAR_WORDS * 4 <= CTL_BYTES, "ctl");
constexpr int LDS_BARST = LDS_BYTES - 64;
struct Args { const float* in[25]; float* out; unsigned char* ws; int st_lo, st_hi; };
enum { ST_PRO, ST_F1I0, ST_F1O0, ST_RW00, ST_HIN, ST_HS1, ST_HS2, ST_HOUT, ST_RW01, ST_F2I0, ST_F2O0, ST_PP0, ST_RW02, ST_PG0, ST_RW03, ST_KVF, ST_F1I1, ST_CUM, ST_F1O1, ST_RW10, ST_QG, ST_ATT, ST_FOUT, ST_RW11, ST_F2I1, ST_F2O1, ST_PP1, ST_RW12, ST_PG1, ST_RW13, NSTEP };
__host__ __device__ constexpr bool sync_before(int s) { return !(s == ST_PRO || s == ST_PP0 || s == ST_F1I1 || s == ST_F1O1 || s == ST_PP1); }
enum { K_PRO = 0, K_FFN_IN, K_FFN_OUT, K_RW, K_HGRN_IN, K_HGRN, K_HGRN_OUT, K_PLE_PROJ, K_PLE_GATE, K_KVF, K_CUMSUM, K_QG, K_ATTN, K_FOX_OUT };

__global__ void __launch_bounds__(NWAVES * 64, 2) yoco_fwd(Args args) {
    extern __shared__ __attribute__((aligned(16))) unsigned char lds[];
    cg::grid_group grid = cg::this_grid();
    LAS unsigned char* ldsp = (LAS unsigned char*)lds;
    const int st_lo = args.st_lo, st_hi = args.st_hi;
    const int wave_s = __builtin_amdgcn_readfirstlane((int)(threadIdx.x >> 6));
    if (tid_from(wave_s) < 2) ((volatile LAS unsigned*)(ldsp + LDS_BARST))[tid_from(wave_s)] = 0u;
    __syncthreads();
    (void)xcd_barrier_post((unsigned*)(args.ws + WS_CTL), (volatile LAS unsigned*)(ldsp + LDS_BARST), tid_from(wave_s) == 0);
#define STEP_BEGIN(k) if (st_lo <= (k) && (k) < st_hi) { if ((k) > st_lo && sync_before(k)) { if ((k) == ST_F1I0) { asm volatile("s_waitcnt vmcnt(0) lgkmcnt(0)" ::: "memory"); grid.sync(); __builtin_amdgcn_fence(__ATOMIC_ACQUIRE, "agent"); asm volatile("s_waitcnt vmcnt(0)" ::: "memory"); } \
          else { XcdBarrier xb_; xb_.bar = (unsigned*)(((const __attribute__((address_space(4))) Args*)__builtin_amdgcn_kernarg_segment_ptr())->ws + WS_CTL); xb_.x = xb_xcc_id(); xb_.st = (volatile LAS unsigned*)(ldsp + LDS_BARST); xcd_barrier(xb_, tid_from(wave_s) == 0); } } \
        const __attribute__((address_space(4))) Args* ap = (const __attribute__((address_space(4))) Args*)__builtin_amdgcn_kernarg_segment_ptr(); asm volatile("" : "+s"(ap)); \
        int tid_k = tid_from(wave_s); asm volatile("" : "+v"(tid_k)); const int tid = tid_k, lane = tid & 63, wave = __builtin_amdgcn_readfirstlane(tid >> 6); \
        const int G = gridDim.x, bx = blockIdx.x; unsigned char* ws = ap->ws; bfu* Wb = (bfu*)ws; bfu* PB = (bfu*)(ws + WS_P); float* LOGF = (float*)(ws + WS_LOGF); float* CL = (float*)(ws + WS_C); \
        bfu* AY = (bfu*)(ws + WS_AY); bfu* BIG = (bfu*)(ws + WS_BIG); bfu* PROJ = (bfu*)(ws + WS_PROJ); const int gw = bx * NWAVES + wave, ngw = G * NWAVES; \
        (void)tid; (void)lane; (void)Wb; (void)PB; (void)LOGF; (void)CL; (void)AY; (void)BIG; (void)PROJ; (void)gw; (void)ngw;
#define STEP_END }
#define RUN_GEMM(MODE, A_, LDA_, Bt_, N_, K_, O_, LDC_, O2_, AUX_, SC_) do { const pg8::Gemm g{A_, Bt_, T, N_, K_, LDA_}; pg8::StaticOrder S; S.init(T, N_, G, bx); \
        const pg8::Epi<MODE, LDC_> E{O_, O2_, AUX_, LOGF, ap->in[18], SC_}; pg8::gemm_phase<pg8::Epi<MODE, LDC_>, pg8::StaticOrder, true, true, K_, LDA_>(ldsp, g, S, E, wave_s); } while (0)
#define NOB ((bfu*)nullptr)
#define S_FFN_IN(k, L, w)  STEP_BEGIN(k) RUN_GEMM(pg8::EP_SWIGLU, AY, D, Wb + ((w) == 1 ? E_W1IN : E_W2IN) + (L) * N_WIN, 2 * FF, D, BIG, FF, NOB, NOB, 1.f); STEP_END
#define S_FFN_OUT(k, L, w) STEP_BEGIN(k) RUN_GEMM(pg8::EP_PLAIN, BIG, FF, Wb + ((w) == 1 ? E_W1OUT : E_W2OUT) + (L) * N_WOUT, D, FF, AY, D, NOB, NOB, 1.f); STEP_END
#define S_PLE_PROJ(k, L)   STEP_BEGIN(k) RUN_GEMM(pg8::EP_PLAIN, PB + (size_t)(L) * T * PLE, PLE, Wb + E_WPP + (size_t)(L) * PLE * D, D, PLE, PROJ, D, NOB, NOB, 1.f); STEP_END
#define S_PLE_GATE(k, L)   STEP_BEGIN(k) RUN_GEMM(pg8::EP_PLEGATE, AY, D, Wb + E_WPG + (size_t)(L) * D * D, D, D, BIG, D, NOB, PROJ, 1.f); STEP_END
#define S_RW(k, L, w)      STEP_BEGIN(k) { const float* hin = ((L) == 0 && (w) == 0) ? ap->in[0] : ap->out; const bfu* Y = ((w) == 3) ? BIG : AY; \
        const float* gain = ((w) == 0 ? ap->in[5] : (w) == 1 ? ap->in[7] : (w) == 2 ? ap->in[11] : ap->in[24]) + (L) * D; \
        rw_phase(hin, ap->out, Y, AY, gain, ((w) == 0 || (w) == 2) ? 0.5f : 1.0f, gw, ngw, lane); } STEP_END

    STEP_BEGIN(ST_PRO) {
        LAS float* scr = (LAS float*)(ldsp + wave * 16384);
        for (int it = gw;; it += ngw) {
            int r = it;
#define CONV(src, K_, N_, dst, gain, gmask, sw) { constexpr int NI = ((K_) / 64) * (((N_) + 31) / 32); if (r < NI) { conv_item(src, K_, N_, dst, gain, gmask, sw, scr, r, lane); continue; } r -= NI; }
            CONV(ap->in[3], D, 2 * FF, Wb + E_W1IN, ap->in[2], 1023, 1)
            CONV(ap->in[3] + N_WIN, D, 2 * FF, Wb + E_W1IN + N_WIN, ap->in[2] + D, 1023, 1)
            CONV(ap->in[9], D, 2 * FF, Wb + E_W2IN, ap->in[8], 1023, 1)
            CONV(ap->in[9] + N_WIN, D, 2 * FF, Wb + E_W2IN + N_WIN, ap->in[8] + D, 1023, 1)
            CONV(ap->in[4], FF, D, Wb + E_W1OUT, (const float*)nullptr, 0, 0)
            CONV(ap->in[4] + N_WOUT, FF, D, Wb + E_W1OUT + N_WOUT, (const float*)nullptr, 0, 0)
            CONV(ap->in[10], FF, D, Wb + E_W2OUT, (const float*)nullptr, 0, 0)
            CONV(ap->in[10] + N_WOUT, FF, D, Wb + E_W2OUT + N_WOUT, (const float*)nullptr, 0, 0)
            CONV(ap->in[12], D, 4 * D, Wb + E_WHIN, ap->in[6], 1023, 0)
            CONV(ap->in[15], D, D, Wb + E_WHOUT, ap->in[14], 127, 0)
            CONV(ap->in[17], D, NKVF, Wb + E_WKVF, ap->in[16], 1023, 0)
            CONV(ap->in[19], D, 2 * D, Wb + E_WQG, ap->in[6] + D, 1023, 0)
            CONV(ap->in[20], D, D, Wb + E_WFO, (const float*)nullptr, 0, 0)
            CONV(ap->in[22], D, D, Wb + E_WPG, ap->in[21], 1023, 0)
            CONV(ap->in[22] + (size_t)D * D, D, D, Wb + E_WPG + (size_t)D * D, ap->in[21] + D, 1023, 0)
            CONV(ap->in[23], PLE, D, Wb + E_WPP, (const float*)nullptr, 0, 0)
            CONV(ap->in[23] + (size_t)PLE * D, PLE, D, Wb + E_WPP + (size_t)PLE * D, (const float*)nullptr, 0, 0)
#undef CONV
            break;
        }
        {   const float* p = ap->in[1]; const size_t n8 = (size_t)2 * T * PLE / 8;
            for (size_t i = (size_t)bx * 512 + tid; i < n8; i += (size_t)G * 512) { const f32x4 a = *((const f32x4*)p + 2 * i), c = *((const f32x4*)p + 2 * i + 1);
                *((v4u*)PB + i) = (v4u){pk2(a.x, a.y), pk2(a.z, a.w), pk2(c.x, c.y), pk2(c.z, c.w)}; } }
        const float* x = ap->in[0];
        for (int m = gw; m < T; m += ngw) rms_row_to_bf16(x + (size_t)m * D, AY + (size_t)m * D, lane);
    } STEP_END
    S_FFN_IN(ST_F1I0, 0, 1) S_FFN_OUT(ST_F1O0, 0, 1) S_RW(ST_RW00, 0, 0)
    STEP_BEGIN(ST_HIN) RUN_GEMM(pg8::EP_PLAIN, AY, D, Wb + E_WHIN, 4 * D, D, BIG, 4 * D, NOB, NOB, 1.f); STEP_END
    STEP_BEGIN(ST_HS1) { const float* lbl = ap->in[13]; float* Eb = (float*)AY; float* Lb = (float*)(ws + WS_AY + 32 * MiB);
        for (int it = bx; it < BATCH * 8 * HSEG; it += G) if ((it & 3) != 3) hgrn_scan<false>(ldsp, BIG, lbl, it >> 2, it & 3, Eb, Lb, wave_s); } STEP_END
    STEP_BEGIN(ST_HS2) { const float* lbl = ap->in[13]; float* Eb = (float*)AY; float* Lb = (float*)(ws + WS_AY + 32 * MiB);
        for (int it = bx; it < BATCH * 8 * HSEG; it += G) hgrn_scan<true>(ldsp, BIG, lbl, it >> 2, it & 3, Eb, Lb, wave_s); } STEP_END
    STEP_BEGIN(ST_HOUT) RUN_GEMM(pg8::EP_PLAIN, BIG, 4 * D, Wb + E_WHOUT, D, D, AY, D, NOB, NOB, 1.f); STEP_END
    S_RW(ST_RW01, 0, 1) S_FFN_IN(ST_F2I0, 0, 2) S_FFN_OUT(ST_F2O0, 0, 2) S_PLE_PROJ(ST_PP0, 0) S_RW(ST_RW02, 0, 2) S_PLE_GATE(ST_PG0, 0) S_RW(ST_RW03, 0, 3)
    STEP_BEGIN(ST_KVF) RUN_GEMM(pg8::EP_KVF, AY, D, Wb + E_WKVF, NKVFP, D, (bfu*)(ws + WS_K), D, (bfu*)(ws + WS_V), NOB, 1.f); STEP_END
    S_FFN_IN(ST_F1I1, 1, 1)
    STEP_BEGIN(ST_CUM) { for (int bh = bx; bh < BATCH * 16; bh += G) cumsum_bh(ldsp, LOGF, CL, bh, wave_s); } STEP_END
    S_FFN_OUT(ST_F1O1, 1, 1) S_RW(ST_RW10, 1, 0)
    STEP_BEGIN(ST_QG) RUN_GEMM(pg8::EP_QG, AY, D, Wb + E_WQG, 2 * D, D, (bfu*)(ws + WS_Q), D, (bfu*)(ws + WS_G), NOB, attn_body::C2); STEP_END
    STEP_BEGIN(ST_ATT) {
        const attn_body::AttnTensors AT{(const attn_body::bf16*)(ws + WS_Q), (const attn_body::bf16*)(ws + WS_K), (const attn_body::bf16*)(ws + WS_V), (attn_body::bf16*)(ws + WS_Q), (const attn_body::bf16*)(ws + WS_G), CL};
        const attn_body::StaticOrder S(G, bx);
        attn_body::attn_phase<attn_body::StaticOrder>((char*)lds, AT, S, wave_s);
    } STEP_END
    STEP_BEGIN(ST_FOUT) RUN_GEMM(pg8::EP_PLAIN, (const bfu*)(ws + WS_Q), D, Wb + E_WFO, D, D, AY, D, NOB, NOB, 1.f); STEP_END
    S_RW(ST_RW11, 1, 1) S_FFN_IN(ST_F2I1, 1, 2) S_FFN_OUT(ST_F2O1, 1, 2) S_PLE_PROJ(ST_PP1, 1) S_RW(ST_RW12, 1, 2) S_PLE_GATE(ST_PG1, 1) S_RW(ST_RW13, 1, 3)
}

#ifndef MK_MULTI
#define MK_MULTI 0
#endif
extern "C" void kernel_launch(void* const* d_in, const int* in_sizes, int n_in, void* d_out, int out_size, void* d_ws, size_t ws_size, hipStream_t stream) {
    static int grid = 0;
    if (grid == 0) {
        if (n_in != 25 || out_size != T * D || ws_size < WS_END) { fprintf(stderr, "kernel_launch: unexpected shapes (n_in %d out %d ws %zu)\n", n_in, out_size, ws_size); grid = -1; return; }
        int dev = 0, cus = 0, per_cu = 0;
        (void)hipGetDevice(&dev); (void)hipDeviceGetAttribute(&cus, hipDeviceAttributeMultiprocessorCount, dev);
        if (hipFuncSetAttribute((const void*)yoco_fwd, hipFuncAttributeMaxDynamicSharedMemorySize, LDS_BYTES) != hipSuccess) { fprintf(stderr, "kernel_launch: hipFuncSetAttribute failed\n"); grid = -1; return; }
        if (hipOccupancyMaxActiveBlocksPerMultiprocessor(&per_cu, (const void*)yoco_fwd, NWAVES * 64, LDS_BYTES) != hipSuccess || per_cu < 1) per_cu = 1;
        (void)hipGetLastError();
        if (cus <= 0) cus = 256;
        grid = cus * per_cu;
    }
    if (grid < 0) return;
    if (hipMemsetAsync((char*)d_ws + WS_CTL, 0, CTL_BYTES, stream) != hipSuccess) { fprintf(stderr, "kernel_launch: memset failed\n"); return; }
    Args a{};
    for (int i = 0; i < 25; ++i) a.in[i] = (const float*)d_in[i];
    a.out = (float*)d_out; a.ws = (unsigned char*)d_ws;
#if MK_MULTI
    int lo = 0;
    for (int s = 1; s <= NSTEP; ++s) if (s == NSTEP || sync_before(s)) { a.st_lo = lo; a.st_hi = s; hipLaunchKernelGGL(yoco_fwd, dim3(grid), dim3(NWAVES * 64), LDS_BYTES, stream, a); lo = s; }
#else
#ifndef ST_CUT
#define ST_CUT NSTEP
#endif
    a.st_lo = 0; a.st_hi = ST_CUT;
    void* kargs[] = {&a};
    const hipError_t e = hipLaunchCooperativeKernel((const void*)yoco_fwd, dim3(grid), dim3(NWAVES * 64), kargs, LDS_BYTES, stream);
    if (e != hipSuccess) fprintf(stderr, "kernel_launch: cooperative launch failed: %s (grid %d)\n", hipGetErrorString(e), grid);
#endif
}
```

```cpp
#include <hip/hip_runtime.h>
#include <hip/hip_cooperative_groups.h>
#include <hip/hip_bf16.h>
#include <cstdio>
#include <cstdint>
#include <cmath>
namespace cg = cooperative_groups;
__device__ __forceinline__ int tid_from(int wave_s) { unsigned l; asm volatile("v_mbcnt_lo_u32_b32 %0, -1, 0\n\tv_mbcnt_hi_u32_b32 %0, -1, %0" : "=v"(l)); return wave_s * 64 + (int)l; }
namespace pg8 {
#define PG8_LAS __attribute__((address_space(3)))
typedef unsigned short bf16_t;
typedef short bf16x8 __attribute__((ext_vector_type(8)));
typedef float f32x4 __attribute__((ext_vector_type(4)));
typedef unsigned u32x4 __attribute__((ext_vector_type(4)));
constexpr int BM = 256, BK = 64, HALF = 128, HTB = HALF * BK * 2  , STAGE_BYTES = 8 * HTB, NXCD = 8, WGM = 8;

__host__ __device__ __forceinline__ int lds_byte(int r, int c) { const int st = (r >> 4) * 2 + (c >> 5), rr = r & 15, cc = c & 31, ob = rr * 64 + cc * 2; return st * 1024 + (ob ^ (((ob >> 9) & 1) << 5)); }
__host__ __device__ __forceinline__ void stage_rc(int b, int& R, int& C) { const int st = b / 1024, sb = b % 1024, swz = sb ^ (((sb >> 9) & 1) << 5); R = (st >> 1) * 16 + swz / 64; C = (st & 1) * 32 + (swz % 64) / 2; }
__host__ __device__ __forceinline__ int perm32(int rho) { const int n = rho >> 4, i = rho & 15; return 8 * (i >> 2) + 4 * n + (i & 3); }

struct Unit { int pm, pn; };
struct Gemm { const bf16_t* A; const bf16_t* Bt; int M, N, K, lda; };

struct StaticOrder {
    int nM, nN, nwg, G, c;
    __host__ __device__ void init(int M, int N, int G_, int c_) { nM = M / BM; nN = N / BM; nwg = nM * nN; G = G_; c = c_; }
    __host__ __device__ bool next(int i, Unit& u) const {
        const long L = (long)i * G + c; if (L >= nwg) return false;
        int wgid = (int)L; { const int q = nwg / NXCD, r = nwg % NXCD, xcd = wgid % NXCD, off = wgid / NXCD; wgid = (xcd < r ? xcd * (q + 1) : r * (q + 1) + (xcd - r) * q) + off; }
        const int nig = WGM * nN, gid = wgid / nig, fm = gid * WGM, gsz = (nM - fm) < WGM ? (nM - fm) : WGM;
        u.pm = fm + ((wgid % nig) % gsz); u.pn = (wgid % nig) / gsz; return true;
    }
    __device__ __forceinline__ void a_ready(const Unit&) const {}
    __device__ __forceinline__ void done(const Unit&) const {}
};

typedef float f32x2cv __attribute__((ext_vector_type(2))); typedef __bf16 bf16x2cv __attribute__((ext_vector_type(2)));
__device__ __forceinline__ unsigned cvt_pk_bf16_asm(float lo, float hi) { unsigned r; asm volatile("v_cvt_pk_bf16_f32 %0, %1, %2" : "=v"(r) : "v"(lo), "v"(hi)); return r; }
__device__ __forceinline__ unsigned cvt_pk_bf16(float lo, float hi) { const f32x2cv v = {lo, hi}; const bf16x2cv b = __builtin_convertvector(v, bf16x2cv); return __builtin_bit_cast(unsigned, b); }
enum { EP_PLAIN = 0, EP_SWIGLU = 1, EP_KVF = 2, EP_QG = 3, EP_PLEGATE = 4 };
__device__ __forceinline__ float fsigmoid(float x) { return __builtin_amdgcn_rcpf(1.0f + __builtin_amdgcn_exp2f(-1.4426950408889634f * x)); }
__device__ __forceinline__ float bflo(unsigned w) { return __uint_as_float(w << 16); }
__device__ __forceinline__ float bfhi(unsigned w) { return __uint_as_float(w & 0xffff0000u); }
template <int MODE, int LDC> struct Epi {
    static constexpr bool PERM = true, AFTER_DRAIN = false;
    bf16_t* O; bf16_t* O2; const bf16_t* aux; float* lf; const float* bfp; float scale0; static constexpr int ldc = LDC;
    __device__ __forceinline__ void operator()(const f32x4 (&acc)[2][2][4][2], const Unit& u, int wr, int wc, int fr, int fq) const {
        asm volatile("s_nop 15\n\ts_nop 15" ::: "memory");
        const int row0 = u.pm * BM + wr * 64 + fr;
        if constexpr (MODE == EP_SWIGLU) {
            const int col0 = u.pn * HALF + wc * 32 + 8 * fq;
#pragma unroll
            for (int ai = 0; ai < 2; ++ai)
#pragma unroll
                for (int m = 0; m < 4; ++m) { bf16_t* rowp = O + (size_t)(row0 + ai * HALF + m * 16) * ldc + col0;
                    const f32x4 g0 = acc[ai][0][m][0], g1 = acc[ai][0][m][1], u0 = acc[ai][1][m][0], u1 = acc[ai][1][m][1]; f32x4 v0, v1;
#pragma unroll
                    for (int j = 0; j < 4; ++j) { v0[j] = g0[j] * fsigmoid(g0[j]) * u0[j]; v1[j] = g1[j] * fsigmoid(g1[j]) * u1[j]; }
                    u32x4 w; w.x = cvt_pk_bf16_asm(v0[0], v0[1]); w.y = cvt_pk_bf16_asm(v0[2], v0[3]); w.z = cvt_pk_bf16_asm(v1[0], v1[1]); w.w = cvt_pk_bf16_asm(v1[2], v1[3]);
                    *(u32x4*)rowp = w; }
        } else {
            bf16_t* base = O; int colt = u.pn * BM; int kind = 0; float sc = 1.f;
            if constexpr (MODE == EP_KVF) { if (u.pn >= 8) kind = 2; else if (u.pn >= 4) { base = O2; colt -= 1024; } }
            if constexpr (MODE == EP_QG) { if (u.pn >= 4) { base = O2; colt -= 1024; kind = 1; } else sc = scale0; }
            if (MODE == EP_KVF && kind == 2) {
                if (wc == 0 && fq < 2) {
#pragma unroll
                    for (int ai = 0; ai < 2; ++ai)
#pragma unroll
                        for (int m = 0; m < 4; ++m) { float* lp = lf + (size_t)(row0 + ai * HALF + m * 16) * 16 + 8 * fq;
#pragma unroll
                            for (int n = 0; n < 2; ++n) { const f32x4 a = acc[ai][0][m][n]; f32x4 o;
#pragma unroll
                                for (int j = 0; j < 4; ++j) { const float x = a[j] + bfp[8 * fq + 4 * n + j]; o[j] = fminf(x, 0.f) - __logf(1.0f + __expf(-fabsf(x))); }
                                *(f32x4*)(lp + 4 * n) = o; } }
                }
                return;
            }
            const int col0 = colt + wc * 32 + 8 * fq;
#pragma unroll
            for (int ai = 0; ai < 2; ++ai)
#pragma unroll
                for (int m = 0; m < 4; ++m) { const size_t roff = (size_t)(row0 + ai * HALF + m * 16) * ldc + col0;
#pragma unroll
                    for (int bj = 0; bj < 2; ++bj) { f32x4 v0 = acc[ai][bj][m][0], v1 = acc[ai][bj][m][1];
                        if (MODE == EP_QG && kind == 1) {
#pragma unroll
                            for (int j = 0; j < 4; ++j) { v0[j] = fsigmoid(v0[j]); v1[j] = fsigmoid(v1[j]); } }
                        else if (MODE == EP_QG) { v0 = v0 * sc; v1 = v1 * sc; }
                        if constexpr (MODE == EP_PLEGATE) { const u32x4 pq = *(const u32x4*)(aux + roff + bj * HALF);
                            v0[0] = fsigmoid(v0[0]) * bflo(pq.x); v0[1] = fsigmoid(v0[1]) * bfhi(pq.x); v0[2] = fsigmoid(v0[2]) * bflo(pq.y); v0[3] = fsigmoid(v0[3]) * bfhi(pq.y);
                            v1[0] = fsigmoid(v1[0]) * bflo(pq.z); v1[1] = fsigmoid(v1[1]) * bfhi(pq.z); v1[2] = fsigmoid(v1[2]) * bflo(pq.w); v1[3] = fsigmoid(v1[3]) * bfhi(pq.w); }
                        u32x4 w; w.x = cvt_pk_bf16_asm(v0[0], v0[1]); w.y = cvt_pk_bf16_asm(v0[2], v0[3]); w.z = cvt_pk_bf16_asm(v1[0], v1[1]); w.w = cvt_pk_bf16_asm(v1[2], v1[3]);
                        *(u32x4*)(base + roff + bj * HALF) = w; } }
        }
    }
};

template <class Epi, class Sched, bool ALIGN_EPI, bool SP2, int KC, int LDA>
__device__ __forceinline__ void gemm_phase(PG8_LAS unsigned char* lds, const Gemm g, const Sched& S, const Epi& E, int wave_s) {
    int tid_o = tid_from(wave_s); asm volatile("" : "+v"(tid_o)); const int tid = tid_o, wid = __builtin_amdgcn_readfirstlane(tid >> 6), lane = tid & 63, wr = wid >> 2, wc = wid & 3, fr = lane & 15, fq = lane >> 4;
    constexpr int K = KC, nt = K / BK;
    unsigned voffA[2], voffB[2];
#pragma unroll
    for (int i = 0; i < 2; ++i) { int R, C; stage_rc(tid * 16 + i * 8192, R, C); const int Rb = Epi::PERM ? ((R & ~31) + perm32(R & 31)) : R;
        voffA[i] = (unsigned)(R * LDA + C) * 2u; voffB[i] = (unsigned)(Rb * K + C) * 2u; }
    const size_t kstep = (size_t)(BK * 2);
    const size_t hstep = (size_t)HALF * K * 2;
    const size_t tstep = 2 * hstep; const size_t hstepA = (size_t)HALF * LDA * 2, tstepA = 2 * hstepA;
    const unsigned ldsw = (unsigned)wid * 1024u;
    const int aoff = lds_byte(wr * 64 + fr, fq * 8), boff = lds_byte(wc * 32 + fr, fq * 8);
#define PG8_SA(b, h) (((b) * 2 + (h)) * HTB)
#define PG8_SB(b, h) ((4 + (b) * 2 + (h)) * HTB)
#define PG8_STAGE(bufoff, gbase, voff) do { _Pragma("unroll") for (int _i = 0; _i < 2; ++_i) \
        __builtin_amdgcn_global_load_lds((const unsigned*)((const char*)(gbase) + (voff)[_i]), (PG8_LAS unsigned*)(lds + (bufoff) + ldsw + _i * 8192), 16, 0, 0); } while (0)
#define PG8_LDA(dst, b, h) do { _Pragma("unroll") for (int m = 0; m < 4; ++m) _Pragma("unroll") for (int k = 0; k < 2; ++k) dst[m][k] = *(const PG8_LAS bf16x8*)(lds + PG8_SA(b, h) + aoff + m * 2048 + k * 1024); } while (0)
#define PG8_LDB(dst, b, h) do { _Pragma("unroll") for (int n = 0; n < 2; ++n) _Pragma("unroll") for (int k = 0; k < 2; ++k) dst[n][k] = *(const PG8_LAS bf16x8*)(lds + PG8_SB(b, h) + boff + n * 2048 + k * 1024); } while (0)
#define PG8_MMA(ai, bj, At, Bt) do { __builtin_amdgcn_s_setprio(1); _Pragma("unroll") for (int m = 0; m < 4; ++m) _Pragma("unroll") for (int n = 0; n < 2; ++n) _Pragma("unroll") for (int k = 0; k < 2; ++k) \
        acc[ai][bj][m][n] = __builtin_amdgcn_mfma_f32_16x16x32_bf16(Bt[n][k], At[m][k], acc[ai][bj][m][n], 0, 0, 0); __builtin_amdgcn_s_setprio(0); } while (0)
#define PG8_WAIT_V(n) asm volatile("s_waitcnt vmcnt(" #n ")" ::: "memory")
#define PG8_WAIT_L(n) asm volatile("s_waitcnt lgkmcnt(" #n ")" ::: "memory")
#define PG8_BAR __builtin_amdgcn_s_barrier()
#define PG8_SCHED __builtin_amdgcn_sched_barrier(0)
    Unit cur, nxt; int ui = 0;
    if (!S.next(0, cur)) return;
    f32x4 acc[2][2][4][2];
#pragma unroll
    for (int a = 0; a < 2; ++a)
#pragma unroll
        for (int b = 0; b < 2; ++b)
#pragma unroll
            for (int m = 0; m < 4; ++m)
#pragma unroll
                for (int n = 0; n < 2; ++n) acc[a][b][m][n] = (f32x4){0.f, 0.f, 0.f, 0.f};
    bf16x8 At[4][2], B0[2][2], B1[2][2];
    const char* cA = (const char*)g.A + (size_t)cur.pm * tstepA; const char* cB = (const char*)g.Bt + (size_t)cur.pn * tstep;
    S.a_ready(cur);
    if constexpr (SP2) {
        PG8_STAGE(PG8_SB(0, 0), cB, voffB); PG8_STAGE(PG8_SB(0, 1), cB + hstep, voffB); PG8_STAGE(PG8_SA(0, 0), cA, voffA); PG8_STAGE(PG8_SA(0, 1), cA + hstepA, voffA);
        if (wr == 1) PG8_BAR;
        PG8_WAIT_V(2); PG8_BAR;
        PG8_STAGE(PG8_SB(1, 0), cB + kstep, voffB); PG8_STAGE(PG8_SA(1, 0), cA + kstep, voffA); PG8_STAGE(PG8_SB(1, 1), cB + hstep + kstep, voffB);
        PG8_WAIT_V(6); PG8_BAR;
    } else {
        PG8_STAGE(PG8_SB(0, 0), cB, voffB); PG8_STAGE(PG8_SA(0, 0), cA, voffA); PG8_STAGE(PG8_SB(0, 1), cB + hstep, voffB); PG8_STAGE(PG8_SA(0, 1), cA + hstepA, voffA);
        if (wr == 1) PG8_BAR;
        PG8_WAIT_V(4); PG8_BAR;
        PG8_STAGE(PG8_SB(1, 0), cB + kstep, voffB); PG8_STAGE(PG8_SA(1, 0), cA + kstep, voffA); PG8_STAGE(PG8_SB(1, 1), cB + hstep + kstep, voffB);
        PG8_WAIT_V(6); PG8_BAR;
    }
    for (;;) {
        const bool has_next = S.next(ui + 1, nxt);
        const char* nA = has_next ? (const char*)g.A + (size_t)nxt.pm * tstepA : cA; const char* nB = has_next ? (const char*)g.Bt + (size_t)nxt.pn * tstep : cB;
        for (int t = 0; t < nt; t += 2) {
            const bool last = (t == nt - 2);
            const char* a1 = cA + (size_t)(t + 1) * kstep;
            const char* a2 = last ? nA : cA + (size_t)(t + 2) * kstep; const char* b2 = last ? nB : cB + (size_t)(t + 2) * kstep;
            const char* a3 = a2 + kstep; const char* b3 = b2 + kstep;
            if (last && has_next) S.a_ready(nxt);
            if constexpr (SP2) {
            PG8_LDB(B0, 0, 0); PG8_LDB(B1, 0, 1); PG8_SCHED; PG8_LDA(At, 0, 0); PG8_STAGE(PG8_SA(1, 1), a1 + hstepA, voffA);
            PG8_WAIT_V(8); PG8_WAIT_L(0); PG8_BAR; PG8_MMA(0, 0, At, B0); PG8_MMA(0, 1, At, B1); PG8_BAR; PG8_SCHED;
            PG8_LDA(At, 0, 1); PG8_STAGE(PG8_SB(0, 0), b2, voffB); PG8_STAGE(PG8_SB(0, 1), b2 + hstep, voffB); PG8_STAGE(PG8_SA(0, 0), a2, voffA);
            PG8_WAIT_V(8); PG8_WAIT_L(0); PG8_BAR; PG8_MMA(1, 0, At, B0); PG8_MMA(1, 1, At, B1); PG8_BAR; PG8_SCHED;
            PG8_LDB(B0, 1, 0); PG8_LDB(B1, 1, 1); PG8_SCHED; PG8_LDA(At, 1, 0); PG8_STAGE(PG8_SA(0, 1), a2 + hstepA, voffA);
            PG8_WAIT_V(8); PG8_WAIT_L(0); PG8_BAR; PG8_MMA(0, 0, At, B0); PG8_MMA(0, 1, At, B1); PG8_BAR; PG8_SCHED;
            PG8_LDA(At, 1, 1); PG8_STAGE(PG8_SB(1, 0), b3, voffB); PG8_STAGE(PG8_SB(1, 1), b3 + hstep, voffB); PG8_STAGE(PG8_SA(1, 0), a3, voffA);
            PG8_WAIT_V(8); PG8_WAIT_L(0); PG8_BAR; PG8_MMA(1, 0, At, B0); PG8_MMA(1, 1, At, B1); PG8_BAR; PG8_SCHED;
            } else {
            PG8_LDB(B0, 0, 0); PG8_SCHED; PG8_LDA(At, 0, 0); PG8_STAGE(PG8_SA(1, 1), a1 + hstepA, voffA);
            PG8_WAIT_L(8); PG8_BAR; PG8_WAIT_L(0); PG8_MMA(0, 0, At, B0); PG8_BAR; PG8_SCHED;
            PG8_LDB(B1, 0, 1); PG8_STAGE(PG8_SB(0, 0), b2, voffB);
            PG8_BAR; PG8_WAIT_L(0); PG8_MMA(0, 1, At, B1); PG8_BAR;
            PG8_LDA(At, 0, 1); PG8_STAGE(PG8_SA(0, 0), a2, voffA);
            PG8_BAR; PG8_WAIT_L(0); PG8_MMA(1, 0, At, B0); PG8_BAR; PG8_SCHED;
            PG8_STAGE(PG8_SB(0, 1), b2 + hstep, voffB);
            PG8_WAIT_V(6); PG8_BAR; PG8_MMA(1, 1, At, B1); PG8_BAR;
            PG8_LDB(B0, 1, 0); PG8_SCHED; PG8_LDA(At, 1, 0); PG8_STAGE(PG8_SA(0, 1), a2 + hstepA, voffA);
            PG8_WAIT_L(8); PG8_BAR; PG8_WAIT_L(0); PG8_MMA(0, 0, At, B0); PG8_BAR; PG8_SCHED;
            PG8_LDB(B1, 1, 1); PG8_STAGE(PG8_SB(1, 0), b3, voffB);
            PG8_BAR; PG8_WAIT_L(0); PG8_MMA(0, 1, At, B1); PG8_BAR;
            PG8_LDA(At, 1, 1); PG8_STAGE(PG8_SA(1, 0), a3, voffA);
            PG8_BAR; PG8_WAIT_L(0); PG8_MMA(1, 0, At, B0); PG8_BAR; PG8_SCHED;
            PG8_STAGE(PG8_SB(1, 1), b3 + hstep, voffB);
            PG8_WAIT_V(6); PG8_BAR; PG8_MMA(1, 1, At, B1); PG8_BAR;
            }
        }
        if constexpr (ALIGN_EPI) { if (wr == 0) PG8_BAR; }
        if constexpr (!Epi::AFTER_DRAIN) { E(acc, cur, wr, wc, fr, fq); S.done(cur); }
        if (!has_next) break;
#pragma unroll
        for (int a = 0; a < 2; ++a)
#pragma unroll
            for (int b = 0; b < 2; ++b)
#pragma unroll
                for (int m = 0; m < 4; ++m)
#pragma unroll
                    for (int n = 0; n < 2; ++n) acc[a][b][m][n] = (f32x4){0.f, 0.f, 0.f, 0.f};
        cur = nxt; cA = nA; cB = nB; ++ui;
        if constexpr (ALIGN_EPI) { if (wr == 1) PG8_BAR; }
    }
    PG8_WAIT_V(0);
    if constexpr (!ALIGN_EPI) { if (wr == 0) PG8_BAR; }
    PG8_BAR;
    if constexpr (Epi::AFTER_DRAIN) { E.fused(acc, cur, wr, wc, fr, fq, lds, wid, lane); S.done(cur); }
#undef PG8_SA
#undef PG8_SB
#undef PG8_STAGE
#undef PG8_LDA
#undef PG8_LDB
#undef PG8_MMA
#undef PG8_WAIT_V
#undef PG8_WAIT_L
#undef PG8_BAR
#undef PG8_SCHED
}
}
#include <hip/hip_bf16.h>
#include <cmath>
namespace attn_body {
using bf16=__hip_bfloat16;
using bf16x8=__attribute__((ext_vector_type(8)))short;
using s16x4=__attribute__((ext_vector_type(4)))short;
using f32x16=__attribute__((ext_vector_type(16)))float;
using u32x4=__attribute__((ext_vector_type(4)))unsigned;
constexpr int BATCH=8,NHEAD=16,SEQ=4096,D=64,DM=NHEAD*D;
constexpr int NW=8,QBLK=32,QB=QBLK*NW,KVBLK=64,NQB=SEQ/QB;
constexpr int ATTN_PITCH=DM, ATTN_UNIT_ROWS=QB;
__device__ __forceinline__ int crow(int r,int hi){return (r&3)+8*(r>>2)+4*hi;}
#define SBAR() __builtin_amdgcn_sched_barrier(0)
__device__ __forceinline__ void cmask(f32x16&p0,f32x16&p1,int jb,int qrel,int hi){
  const float NEG=-INFINITY; int kb=64*jb+4*hi;
  #pragma unroll
  for(int r=0;r<16;++r){int kv=kb+(r&3)+8*(r>>2); if(kv>qrel)p0[r]=NEG; if(kv+32>qrel)p1[r]=NEG;}
}

constexpr int NSLOT=3, SLOTB=8192;
constexpr int LDS_K=0, LDS_V=NSLOT*SLOTB, LDS_WS=2*NSLOT*SLOTB, LDS_OST=LDS_WS+NW*64*4, LDS_CB=LDS_OST+NW*4096, LDS_BYTES=LDS_CB+SEQ*4;
constexpr float C2=0.125f*1.4426950408889634f;
__device__ __forceinline__ void glds16(const void*gsrc,unsigned lds_dst){unsigned keep;
  asm volatile("s_mov_b32 %0, m0\n\ts_mov_b32 m0, %2\n\ts_nop 0\n\tglobal_load_lds_dwordx4 %1, off\n\ts_mov_b32 m0, %0":"=&s"(keep):"v"(gsrc),"s"(lds_dst):"memory");}
__device__ __forceinline__ float max3f(float a,float b,float c){float r;asm("v_max3_f32 %0, %1, %2, %3":"=v"(r):"v"(a),"v"(b),"v"(c));return r;}
__device__ __forceinline__ float max2f(float a,float b){float r;asm("v_max_f32_e32 %0, %1, %2":"=v"(r):"v"(a),"v"(b));return r;}
__device__ __forceinline__ float fadd_s(float a,float b){float r;asm("v_add_f32_e32 %0, %1, %2":"=v"(r):"v"(a),"v"(b));return r;}
__device__ __forceinline__ float fsub_s(float a,float b){float r;asm("v_sub_f32_e32 %0, %1, %2":"=v"(r):"v"(a),"v"(b));return r;}
typedef float f32x2_t __attribute__((ext_vector_type(2))); typedef __bf16 bf16x2_t __attribute__((ext_vector_type(2)));
__device__ __forceinline__ unsigned cvtpk_s(float lo,float hi){f32x2_t v={lo,hi};bf16x2_t b=__builtin_convertvector(v,bf16x2_t);return __builtin_bit_cast(unsigned,b);}
#define WAIT_BAR(N) asm volatile("s_waitcnt vmcnt(" #N ") lgkmcnt(0)\n\ts_barrier":::"memory")

__device__ __forceinline__ void qkt(f32x16&p0,f32x16&p1,const char*Kslot,const bf16x8*qr,const f32x16&negm,int r32,int hi){
  const char*kb=Kslot+hi*1024+r32*16;
  #pragma unroll
  for(int d0=0;d0<4;++d0){
    const bf16x8 b0=*reinterpret_cast<const bf16x8*>(kb+d0*2048);
    const bf16x8 b1=*reinterpret_cast<const bf16x8*>(kb+d0*2048+512);
    if(d0==0){p0=__builtin_amdgcn_mfma_f32_32x32x16_bf16(b0,qr[0],negm,0,0,0);p1=__builtin_amdgcn_mfma_f32_32x32x16_bf16(b1,qr[0],negm,0,0,0);}
    else{p0=__builtin_amdgcn_mfma_f32_32x32x16_bf16(b0,qr[d0],p0,0,0,0);p1=__builtin_amdgcn_mfma_f32_32x32x16_bf16(b1,qr[d0],p1,0,0,0);}}
}
typedef __attribute__((address_space(3))) const char* lds_cptr;
typedef short v4i16_t __attribute__((ext_vector_type(4)));
__device__ __forceinline__ void kload8(bf16x8*kf,lds_cptr kp){
  kf[0]=*(const __attribute__((address_space(3))) bf16x8*)(kp);      kf[1]=*(const __attribute__((address_space(3))) bf16x8*)(kp+512);
  kf[2]=*(const __attribute__((address_space(3))) bf16x8*)(kp+2048); kf[3]=*(const __attribute__((address_space(3))) bf16x8*)(kp+2560);
  kf[4]=*(const __attribute__((address_space(3))) bf16x8*)(kp+4096); kf[5]=*(const __attribute__((address_space(3))) bf16x8*)(kp+4608);
  kf[6]=*(const __attribute__((address_space(3))) bf16x8*)(kp+6144); kf[7]=*(const __attribute__((address_space(3))) bf16x8*)(kp+6656);
}
__device__ __forceinline__ void kload2(bf16x8*kf,lds_cptr kp,int j){ kf[2*j]=*(const __attribute__((address_space(3))) bf16x8*)(kp+j*2048); kf[2*j+1]=*(const __attribute__((address_space(3))) bf16x8*)(kp+j*2048+512); }
__device__ __forceinline__ s16x4 vtr(lds_cptr p){ return __builtin_bit_cast(s16x4,__builtin_amdgcn_ds_read_tr16_b64_v4i16((__attribute__((address_space(3))) v4i16_t*)p)); }
__device__ __forceinline__ float rowmax(const f32x16&p0,const f32x16&p1){
  float a=max3f(p0[0],p0[1],p1[0]),b=max3f(p0[2],p0[3],p1[1]);a=max3f(a,p1[2],p1[3]);
  #pragma unroll
  for(int r=4;r<16;r+=4){a=max3f(a,p0[r],p0[r+1]);b=max3f(b,p0[r+2],p0[r+3]);a=max3f(a,p1[r],p1[r+1]);b=max3f(b,p1[r+2],p1[r+3]);}
  const float m=max2f(a,b);
  auto rr=__builtin_amdgcn_permlane32_swap(__float_as_uint(m),__float_as_uint(m),false,false);
  return max2f(__uint_as_float(rr[0]),__uint_as_float(rr[1]));
}
__device__ __forceinline__ void pv(f32x16*o,int vb,bf16x8 pa0,bf16x8 pa1,bf16x8 pa2,bf16x8 pa3){
  #pragma unroll
  for(int d0=0;d0<2;++d0){s16x4 lo[4],hi[4];
    #pragma unroll
    for(int ks=0;ks<4;++ks){
      asm volatile("ds_read_b64_tr_b16 %0,%1 offset:%c2":"=&v"(lo[ks]):"v"(vb),"i"(d0*4096+ks*1024):"memory");
      asm volatile("ds_read_b64_tr_b16 %0,%1 offset:%c2":"=&v"(hi[ks]):"v"(vb),"i"(d0*4096+ks*1024+512):"memory");}
    asm volatile("s_waitcnt lgkmcnt(0)":::"memory");SBAR();
    #define PK(k) (bf16x8){lo[k][0],lo[k][1],lo[k][2],lo[k][3],hi[k][0],hi[k][1],hi[k][2],hi[k][3]}
    o[d0]=__builtin_amdgcn_mfma_f32_32x32x16_bf16(pa0,PK(0),o[d0],0,0,0);
    o[d0]=__builtin_amdgcn_mfma_f32_32x32x16_bf16(pa1,PK(1),o[d0],0,0,0);
    o[d0]=__builtin_amdgcn_mfma_f32_32x32x16_bf16(pa2,PK(2),o[d0],0,0,0);
    o[d0]=__builtin_amdgcn_mfma_f32_32x32x16_bf16(pa3,PK(3),o[d0],0,0,0);
    #undef PK
  }
}

#ifndef ATTN_STORE16
#define ATTN_STORE16(p,v) (*(u32x4*)(p)=(v))
#endif
template<int THRL> __device__ __forceinline__ void attn_unit(int b,int h,int qb,const bf16*Q,const bf16*__restrict__ K,const bf16*__restrict__ V,bf16*O,const bf16*__restrict__ Gt,const float*__restrict__ CL,char*shm,int wave_s){
  int tid_o=tid_from(wave_s); asm volatile("":"+v"(tid_o)); const int tid=tid_o,lane=tid&63,r32=lane&31,hi=lane>>5; const int wid=__builtin_amdgcn_readfirstlane(tid>>6);
  const long rowbase=(long)b*SEQ; const int q0=qb*QB;
  const float*cbh=CL+((long)b*NHEAD+h)*SEQ;
  { typedef float f4_t __attribute__((ext_vector_type(4))); __attribute__((address_space(3))) f4_t*cl4=(__attribute__((address_space(3))) f4_t*)((lds_cptr)shm+LDS_CB);
    for(int i=tid;i<(q0+QB)/4;i+=NW*64)cl4[i]=*(const f4_t*)(cbh+4*i); }
  const float cq=cbh[q0+wid*QBLK+(lane&31)];
  const bf16*Qw=Q+(rowbase+q0+wid*QBLK)*DM+h*D;
  const bf16*Kh=K+rowbase*DM+h*D,*Vh=V+rowbase*DM+h*D;
  const unsigned lds0=(unsigned)(uintptr_t)shm;
  float*wsf=(float*)(shm+LDS_WS)+wid*64;
  const bf16*ksrc=Kh+(long)lane*DM+wid*8;
  const bf16*vsrc=Vh+(long)(16*(wid&3)+(lane>>2))*DM+(wid>>2)*32+(lane&3)*8;
  const unsigned kdst=lds0+LDS_K+wid*1024, vdst=lds0+LDS_V+wid*1024;
  #define DMA_K(t,slot) glds16(ksrc+(long)(t)*KVBLK*DM,(unsigned)__builtin_amdgcn_readfirstlane(kdst+(slot)))
  #define DMA_V(t,slot) glds16(vsrc+(long)(t)*KVBLK*DM,(unsigned)__builtin_amdgcn_readfirstlane(vdst+(slot)))
  const int vb0=(int)(lds0+LDS_V)+((lane>>4)&1)*32+(lane&3)*8+(4*hi+((lane&15)>>2))*64;
  const char*Kbase=shm+LDS_K; bf16x8 kf[8];
  const lds_cptr shm3=(lds_cptr)shm; const lds_cptr kp0=shm3+LDS_K+hi*1024+r32*16; const lds_cptr vp0=shm3+LDS_V+((lane>>4)&1)*32+(lane&3)*8+(4*hi+((lane&15)>>2))*64;
  const int NT=(q0+QB)/KVBLK;
  DMA_K(0,0);DMA_V(0,0);DMA_K(1,SLOTB);
  bf16x8 qr[4];
  #pragma unroll
  for(int d0=0;d0<4;++d0)qr[d0]=*reinterpret_cast<const bf16x8*>(&Qw[(long)r32*DM+d0*16+hi*8]);
  float mhat=0.f,l_reg=0.f;f32x16 o[2];o[0]=f32x16{};o[1]=f32x16{};f32x16 negm;
  #pragma unroll
  for(int r=0;r<16;++r)negm[r]=cq;
  asm volatile("":"+v"(negm));
  typedef float cf4_t __attribute__((ext_vector_type(4))); const __attribute__((address_space(3))) cf4_t*clds=(const __attribute__((address_space(3))) cf4_t*)((lds_cptr)shm+LDS_CB)+hi;
  #define CBIAS(P0,P1,t) do{ const __attribute__((address_space(3))) cf4_t*cp_=clds+16*(t); _Pragma("unroll") for(int j_=0;j_<4;++j_){ const cf4_t a_=cp_[2*j_], b_=cp_[8+2*j_]; \
      P0[4*j_]-=a_[0];P0[4*j_+1]-=a_[1];P0[4*j_+2]-=a_[2];P0[4*j_+3]-=a_[3]; P1[4*j_]-=b_[0];P1[4*j_+1]-=b_[1];P1[4*j_+2]-=b_[2];P1[4*j_+3]-=b_[3]; } }while(0)
  const int qrel=wid*QBLK+r32;
  #define CMASK(P0,P1,t) do{int jb_=(t)-(NT-4); if(jb_>=0)cmask(P0,P1,jb_,qrel,hi);}while(0)
  bool resc=false;
  #define START(P0,P1) do{ const float rm=rowmax(P0,P1); resc=false; \
    { const float dl=rm; mhat=fadd_s(mhat,dl); \
      _Pragma("unroll") for(int r=0;r<16;++r){P0[r]=fsub_s(P0[r],dl);P1[r]=fsub_s(P1[r],dl);} \
      _Pragma("unroll") for(int r=0;r<16;++r)negm[r]=cq-mhat; asm volatile("":"+v"(negm)); } \
    _Pragma("unroll") for(int r=0;r<16;++r)P0[r]=__builtin_amdgcn_exp2f(P0[r]); }while(0)
  #define RESC() do{ if(resc){ asm volatile("s_waitcnt lgkmcnt(0)":::"memory"); \
      _Pragma("unroll") for(int d_=0;d_<2;++d_) _Pragma("unroll") for(int r=0;r<16;++r)o[d_][r]*=wsf[crow(r,hi)]; } }while(0)
  f32x16 pA0,pA1,pB0,pB1;
  int sl_prev=0,sl_cur=0,sl_next=SLOTB;
  #define ROT() do{sl_prev=sl_cur;sl_cur=sl_next;sl_next=(sl_next==(NSLOT-1)*SLOTB)?0:sl_next+SLOTB;}while(0)
  DMA_K(2,2*SLOTB);
  WAIT_BAR(3);
  qkt(pA0,pA1,Kbase,qr,negm,r32,hi);asm volatile("s_nop 15\n\ts_nop 7":"+v"(pA0),"+v"(pA1));CMASK(pA0,pA1,0);CBIAS(pA0,pA1,0);
  START(pA0,pA1);
  _Pragma("unroll") for(int r=0;r<16;++r)pA1[r]=__builtin_amdgcn_exp2f(pA1[r]);
  WAIT_BAR(0);
  DMA_K(3,0);DMA_V(1,SLOTB);
  ROT();
  kload8(kf,kp0+sl_cur);
  WAIT_BAR(2);
  s16x4 vlo[8],vhi[8]; u32x4 pw0,pw1,pw2,pw3;
  #define PKW(P,B) cvtpk_s(P[B],P[B+1])
  #define PAF(k) __builtin_bit_cast(bf16x8,pw##k)
  #define VFR(i) (bf16x8){vlo[i][0],vlo[i][1],vlo[i][2],vlo[i][3],vhi[i][0],vhi[i][1],vhi[i][2],vhi[i][3]}
  #define PIN(x) asm volatile("":"+v"(x))
  #define MX3(a,b,c) __builtin_fmaxf(__builtin_fmaxf((a),(b)),(c))
  #define GAPA(MF,A0,A1,A2,A3,W0,W1,PW) do{ MF; sacc+=A0; sacc+=A1; sacc+=A2; sacc+=A3; PIN(sacc); W0; W1; PIN(PW); SBAR(); }while(0)
  #define EX(v) __builtin_amdgcn_exp2f(v)
  #define GAPB(MF,X,B) do{ MF; X[B]=EX(X[B]); X[B+1]=EX(X[B+1]); X[B+2]=EX(X[B+2]); X[B+3]=EX(X[B+3]); PIN(X); SBAR(); }while(0)
  #define VRD(i) do{ vlo[i]=vtr(vp_+(((i)>>2)*4096+((i)&3)*1024)); vhi[i]=vtr(vp_+(((i)>>2)*4096+((i)&3)*1024+512)); }while(0)
  #define KRD(G,j) do{ if(G){ kload2(kf,kp0+sl_next,j); SBAR(); } }while(0)
  #define STEP(C0,C1,P0,P1,t,GK,GV,GL) do{ SBAR(); \
    const lds_cptr vp_=vp0+sl_prev; \
    VRD(0); SBAR(); float sacc=(P0[0]+P0[1]); \
    GAPA(C0=__builtin_amdgcn_mfma_f32_32x32x16_bf16(kf[0],qr[0],negm,0,0,0), P0[2],P0[3],P0[4],P0[5],     pw0[0]=PKW(P0,0), pw0[1]=PKW(P0,2), pw0); \
    VRD(4); SBAR(); GAPA(C1=__builtin_amdgcn_mfma_f32_32x32x16_bf16(kf[1],qr[0],negm,0,0,0), P0[6],P0[7],P0[8],P0[9],     pw0[2]=PKW(P0,4), pw0[3]=PKW(P0,6), pw0); \
    VRD(1); SBAR(); GAPA(C0=__builtin_amdgcn_mfma_f32_32x32x16_bf16(kf[2],qr[1],C0,0,0,0),   P0[10],P0[11],P0[12],P0[13], pw1[0]=PKW(P0,8), pw1[1]=PKW(P0,10), pw1); \
    VRD(5); SBAR(); GAPA(C1=__builtin_amdgcn_mfma_f32_32x32x16_bf16(kf[3],qr[1],C1,0,0,0),   P0[14],P0[15],P1[0],P1[1],   pw1[2]=PKW(P0,12),pw1[3]=PKW(P0,14), pw1); \
    VRD(2); SBAR(); GAPA(C0=__builtin_amdgcn_mfma_f32_32x32x16_bf16(kf[4],qr[2],C0,0,0,0),   P1[2],P1[3],P1[4],P1[5],     pw2[0]=PKW(P1,0), pw2[1]=PKW(P1,2), pw2); \
    VRD(6); SBAR(); GAPA(C1=__builtin_amdgcn_mfma_f32_32x32x16_bf16(kf[5],qr[2],C1,0,0,0),   P1[6],P1[7],P1[8],P1[9],     pw2[2]=PKW(P1,4), pw2[3]=PKW(P1,6), pw2); \
    VRD(3); SBAR(); GAPA(C0=__builtin_amdgcn_mfma_f32_32x32x16_bf16(kf[6],qr[3],C0,0,0,0),   P1[10],P1[11],P1[12],P1[13], pw3[0]=PKW(P1,8), pw3[1]=PKW(P1,10), pw3); \
    VRD(7); SBAR(); GAPA(C1=__builtin_amdgcn_mfma_f32_32x32x16_bf16(kf[7],qr[3],C1,0,0,0),   P1[14],P1[15],0.f,0.f,       pw3[2]=PKW(P1,12),pw3[3]=PKW(P1,14), pw3); \
    l_reg+=sacc; \
    if(GK){DMA_K((t)+3,sl_cur);} if(GV){DMA_V((t)+1,sl_next);} \
    CMASK(C0,C1,t); CBIAS(C0,C1,t); \
    { float a=MX3(C0[0],C0[1],C1[0]),b=MX3(C0[2],C0[3],C1[1]); a=MX3(a,C1[2],C1[3]); \
      _Pragma("unroll") for(int r=4;r<16;r+=4){a=MX3(a,C0[r],C0[r+1]);b=MX3(b,C0[r+2],C0[r+3]);a=MX3(a,C1[r],C1[r+1]);b=MX3(b,C1[r+2],C1[r+3]);} \
      float rm=__builtin_fmaxf(a,b); { auto rr=__builtin_amdgcn_permlane32_swap(__float_as_uint(rm),__float_as_uint(rm),false,false); rm=__builtin_fmaxf(__uint_as_float(rr[0]),__uint_as_float(rr[1])); } \
      resc=false; \
      if(__builtin_expect(__any(rm>(float)THRL),0)){ const float dl=__builtin_fmaxf(rm,0.f); mhat+=dl; \
        _Pragma("unroll") for(int r=0;r<16;++r){C0[r]-=dl;C1[r]-=dl;} \
        _Pragma("unroll") for(int r=0;r<16;++r)negm[r]=cq-mhat; asm volatile("":"+v"(negm)); \
        const float f=__builtin_amdgcn_exp2f(-dl); l_reg*=f; if(hi==0)wsf[r32]=f; resc=true; } } \
    SBAR(); \
    GAPB(o[0]=__builtin_amdgcn_mfma_f32_32x32x16_bf16(PAF(0),VFR(0),o[0],0,0,0), C0,0); \
    GAPB(o[1]=__builtin_amdgcn_mfma_f32_32x32x16_bf16(PAF(0),VFR(4),o[1],0,0,0), C0,4); \
    KRD(GL,0); GAPB(o[0]=__builtin_amdgcn_mfma_f32_32x32x16_bf16(PAF(1),VFR(1),o[0],0,0,0), C0,8); \
    KRD(GL,1); GAPB(o[1]=__builtin_amdgcn_mfma_f32_32x32x16_bf16(PAF(1),VFR(5),o[1],0,0,0), C0,12); \
    KRD(GL,2); GAPB(o[0]=__builtin_amdgcn_mfma_f32_32x32x16_bf16(PAF(2),VFR(2),o[0],0,0,0), C1,0); \
    KRD(GL,3); GAPB(o[1]=__builtin_amdgcn_mfma_f32_32x32x16_bf16(PAF(2),VFR(6),o[1],0,0,0), C1,4); \
    GAPB(o[0]=__builtin_amdgcn_mfma_f32_32x32x16_bf16(PAF(3),VFR(3),o[0],0,0,0), C1,8); \
    GAPB(o[1]=__builtin_amdgcn_mfma_f32_32x32x16_bf16(PAF(3),VFR(7),o[1],0,0,0), C1,12); \
    }while(0)
  int t=1;
  #undef CMASK
  #define CMASK(P0,P1,t) do{}while(0)
  for(;t+5<NT;t+=2){
    STEP(pB0,pB1,pA0,pA1,t,true,true,true);     WAIT_BAR(2); RESC(); ROT();
    STEP(pA0,pA1,pB0,pB1,t+1,true,true,true);   WAIT_BAR(2); RESC(); ROT();
  }
  #undef CMASK
  #define CMASK(P0,P1,t) do{int jb_=(t)-(NT-4); if(jb_>=0)cmask(P0,P1,jb_,qrel,hi);}while(0)
  #define ENDW(tt) do{ if((tt)+3<NT){WAIT_BAR(2);} else if((tt)+2<NT){WAIT_BAR(1);} else {WAIT_BAR(0);} }while(0)
  for(;t+1<NT;t+=2){
    STEP(pB0,pB1,pA0,pA1,t,(t+3<NT),(t+1<NT),(t+1<NT));       ENDW(t);   RESC(); ROT();
    STEP(pA0,pA1,pB0,pB1,t+1,(t+4<NT),(t+2<NT),(t+2<NT));     ENDW(t+1); RESC(); ROT();
  }
  STEP(pB0,pB1,pA0,pA1,NT-1,false,false,false); RESC();
  { float sacc=pB0[0]+pB0[1]; _Pragma("unroll") for(int r=2;r<16;++r)sacc+=pB0[r]; _Pragma("unroll") for(int r=0;r<16;++r)sacc+=pB1[r]; l_reg+=sacc;
    pw0=(u32x4){PKW(pB0,0),PKW(pB0,2),PKW(pB0,4),PKW(pB0,6)};pw1=(u32x4){PKW(pB0,8),PKW(pB0,10),PKW(pB0,12),PKW(pB0,14)};pw2=(u32x4){PKW(pB1,0),PKW(pB1,2),PKW(pB1,4),PKW(pB1,6)};pw3=(u32x4){PKW(pB1,8),PKW(pB1,10),PKW(pB1,12),PKW(pB1,14)};
    SBAR(); pv(o,vb0+sl_cur,PAF(0),PAF(1),PAF(2),PAF(3)); }
  #undef PKW
  #undef PAF
  #undef VFR
  #undef PIN
  #undef MX3
  #undef GAPA
  #undef GAPB
  #undef EX
  #undef VRD
  #undef KRD
  #undef STEP
  #undef ENDW
  {auto rr=__builtin_amdgcn_permlane32_swap(__float_as_uint(l_reg),__float_as_uint(l_reg),false,false);l_reg=__uint_as_float(rr[0])+__uint_as_float(rr[1]);}
  if(hi==0)wsf[32+r32]=l_reg;asm volatile("s_waitcnt lgkmcnt(0)":::"memory");
  float rli[16];
  #pragma unroll
  for(int r=0;r<16;++r)rli[r]=__builtin_amdgcn_rcpf(wsf[32+crow(r,hi)]);
  bf16*Ow=O+(rowbase+q0+wid*QBLK)*DM+h*D;
  { bf16*stg=(bf16*)(shm+LDS_OST)+wid*2048;
    #pragma unroll
    for(int r=0;r<16;++r){const int orow=crow(r,hi);
      #pragma unroll
      for(int d0=0;d0<2;++d0)stg[orow*64+d0*32+r32]=__float2bfloat16(o[d0][r]*rli[r]);}
    asm volatile("s_waitcnt lgkmcnt(0)":::"memory");
    #pragma unroll
    for(int i=0;i<4;++i){const bf16*Gw=Gt+(rowbase+q0+wid*QBLK)*DM+h*D; const int row=i*8+(lane>>3),ch=lane&7; const u32x4 v=*(const u32x4*)(stg+row*64+ch*8); const u32x4 gq=*(const u32x4*)(Gw+(long)row*DM+ch*8); u32x4 w;
      #pragma unroll
      for(int e=0;e<4;++e){ const float a0=__uint_as_float(v[e]<<16)*__uint_as_float(gq[e]<<16), a1=__uint_as_float(v[e]&0xffff0000u)*__uint_as_float(gq[e]&0xffff0000u); w[e]=cvtpk_s(a0,a1); }
      ATTN_STORE16(Ow+(long)row*DM+ch*8,w);} }
  asm volatile("s_waitcnt lgkmcnt(0)\n\ts_barrier":::"memory");
  #undef CBIAS
  #undef DMA_K
  #undef DMA_V
  #undef CMASK
  #undef START
  #undef RESC
  #undef ROT
}
constexpr int ATTN_LDS_BYTES=LDS_BYTES;
struct AttnTensors { const bf16* Q; const bf16* K; const bf16* V; bf16* O; const bf16* G; const float* CL; };
struct AttnUnit { int bh; int qb; };
struct StaticOrder {
  int vcu, G;
  __device__ __forceinline__ explicit StaticOrder(int grid,int block):vcu((grid%8==0)?(block%8)*(grid/8)+block/8:block),G(grid){}
  __device__ __forceinline__ bool next(int i,AttnUnit&u)const{
    if(G==256){ if(i>=8)return false; const int j=2*(i>>1)+(vcu&1); u.bh=vcu>>1; u.qb=(i&1)?15-j:j; return true; }
    const int idx=i*G+vcu; if(idx>=BATCH*NHEAD*NQB)return false; u.bh=idx/NQB; u.qb=NQB-1-idx%NQB; return true; }
  __device__ __forceinline__ void a_ready(const AttnUnit&)const{}
  __device__ __forceinline__ void done(const AttnUnit&)const{}
};
template<class Sched,int THRL=8> __device__ __forceinline__ void attn_phase(char*lds,const AttnTensors&T,const Sched&S,int wave_s){
  AttnUnit u;
  for(int i=0;S.next(i,u);++i){ S.a_ready(u); attn_unit<THRL>(u.bh/NHEAD,u.bh%NHEAD,u.qb,T.Q,T.K,T.V,T.O,T.G,T.CL,lds,wave_s); S.done(u); }
}
#undef SBAR
#undef WAIT_BAR
}
#define GAS __attribute__((address_space(1)))
#define LAS __attribute__((address_space(3)))
typedef unsigned short bfu;
typedef unsigned v4u __attribute__((ext_vector_type(4)));
typedef unsigned v2u __attribute__((ext_vector_type(2)));
typedef float f32x4 __attribute__((ext_vector_type(4)));
typedef short bf16x8 __attribute__((ext_vector_type(8)));
#define LDS_WAIT() asm volatile("s_waitcnt lgkmcnt(0)" ::: "memory")
constexpr int NWAVES = 8;
constexpr int BATCH = 8, SEQ = 4096, D = 1024, FF = 2816, T = BATCH * SEQ, PLE = 256, NKVF = 2064, NKVFP = 2304;
constexpr float EPS = 1e-6f, LOG2E = 1.4426950408889634f;
constexpr size_t MiB = 1u << 20;
constexpr size_t E_W1IN = 0, N_WIN = (size_t)2 * FF * D, N_WOUT = (size_t)D * FF;
constexpr size_t E_W1OUT = E_W1IN + 2 * N_WIN, E_W2IN = E_W1OUT + 2 * N_WOUT, E_W2OUT = E_W2IN + 2 * N_WIN, E_WHIN = E_W2OUT + 2 * N_WOUT;
constexpr size_t E_WHOUT = E_WHIN + (size_t)4 * D * D, E_WKVF = E_WHOUT + (size_t)D * D, E_WQG = E_WKVF + (size_t)NKVFP * D, E_WFO = E_WQG + (size_t)2 * D * D;
constexpr size_t E_WPG = E_WFO + (size_t)D * D, E_WPP = E_WPG + (size_t)2 * D * D, E_WEND = E_WPP + (size_t)2 * D * PLE;
static_assert(E_WEND * 2 <= 92 * MiB, "weights fit");
constexpr size_t WS_P = 92 * MiB, WS_LOGF = 124 * MiB, WS_C = 126 * MiB, WS_AY = 128 * MiB, WS_BIG = 192 * MiB, WS_PROJ = 448 * MiB, WS_END = 512 * MiB;
constexpr size_t WS_V = WS_BIG + 192 * MiB, WS_K = WS_PROJ, WS_Q = WS_BIG, WS_G = WS_BIG + 64 * MiB;
constexpr int LDS_BYTES = 147456;

__device__ __forceinline__ float wave_sum(float v) {
#pragma unroll
    for (int o = 1; o < 64; o <<= 1) v += __shfl_xor(v, o);
    return v;
}
__device__ __forceinline__ unsigned pk2(float lo, float hi) { return pg8::cvt_pk_bf16(lo, hi); }
__device__ __forceinline__ float bf2f(unsigned short u) { return __uint_as_float((unsigned)u << 16); }
__device__ __forceinline__ unsigned short f2b(float f) { return (unsigned short)(pk2(f, 0.f) & 0xffffu); }

__device__ __forceinline__ void conv_item(const float* W, int K, int N, bfu* WT, const float* gain, int gmask, int sw, LAS float* scr, int item, int lane) {
    const int nblk = (N + 31) / 32, kb = item / nblk, nb = item % nblk, k0 = 64 * kb, n0 = 32 * nb;
    const int nn = n0 + (lane & 31); const bool nok = nn < N;
    const int c = lane & 7;
    f32x4 ga = (f32x4){1.f, 1.f, 1.f, 1.f}, gb = ga;
    if (gain) { ga = *(const f32x4*)(gain + ((k0 + 8 * c) & gmask)); gb = *(const f32x4*)(gain + ((k0 + 8 * c) & gmask) + 4); }
    float wv[32];
#pragma unroll
    for (int i = 0; i < 32; ++i) { const int kk = 2 * i + (lane >> 5); wv[i] = nok ? W[(size_t)(k0 + kk) * N + nn] : 0.f; }
#pragma unroll
    for (int i = 0; i < 32; ++i) { const int kk = 2 * i + (lane >> 5); scr[kk * 33 + (lane & 31)] = wv[i]; }
    LDS_WAIT(); asm volatile("" ::: "memory");
    int drow0 = n0; if (sw) { const int j0 = (n0 < FF) ? n0 : n0 - FF; drow0 = 256 * (j0 >> 7) + (j0 & 127) + ((n0 < FF) ? 0 : 128); }
#pragma unroll
    for (int j = 0; j < 4; ++j) { const int n = (lane >> 3) + 8 * j; const LAS float* s = scr + (8 * c) * 33 + n;
        v4u o; o.x = pk2(s[0 * 33] * ga[0], s[1 * 33] * ga[1]); o.y = pk2(s[2 * 33] * ga[2], s[3 * 33] * ga[3]); o.z = pk2(s[4 * 33] * gb[0], s[5 * 33] * gb[1]); o.w = pk2(s[6 * 33] * gb[2], s[7 * 33] * gb[3]);
        *(v4u*)(WT + (size_t)(drow0 + n) * K + k0 + 8 * c) = o; }
    LDS_WAIT(); asm volatile("" ::: "memory");
}
__device__ __forceinline__ void rms_row_to_bf16(const float* xrow, bfu* orow, int lane) {
    const f32x4* xr = (const f32x4*)xrow + lane;
    f32x4 v[4]; float s = 0.f;
#pragma unroll
    for (int j = 0; j < 4; ++j) { v[j] = xr[64 * j]; s += (v[j].x * v[j].x + v[j].y * v[j].y) + (v[j].z * v[j].z + v[j].w * v[j].w); }
    const float r = __builtin_amdgcn_rsqf(wave_sum(s) * (1.f / D) + EPS);
    v2u* o8 = (v2u*)orow + lane;
#pragma unroll
    for (int j = 0; j < 4; ++j) { v2u w; w.x = pk2(v[j].x * r, v[j].y * r); w.y = pk2(v[j].z * r, v[j].w * r); o8[64 * j] = w; }
}
__device__ __forceinline__ void rw_phase(const float* hin, float* hout, const bfu* Y, bfu* A, const float* gain, float scale, int gw, int ngw, int lane) {
    f32x4 g[4];
#pragma unroll
    for (int j = 0; j < 4; ++j) g[j] = *((const f32x4*)gain + lane + 64 * j);
    for (int m0 = gw; m0 < T; m0 += 2 * ngw) {
        f32x4 v[2][4], y[2][4]; float s[2] = {0.f, 0.f}; const int m1 = m0 + ngw; const bool two = m1 < T;
#pragma unroll
        for (int r = 0; r < 2; ++r) { const int m = (r == 0 || two) ? (r == 0 ? m0 : m1) : m0;
            const f32x4* hr = (const f32x4*)(hin + (size_t)m * D) + lane; const v2u* yr = (const v2u*)(Y + (size_t)m * D) + lane;
#pragma unroll
            for (int j = 0; j < 4; ++j) { v[r][j] = hr[64 * j]; const v2u w = yr[64 * j]; y[r][j] = (f32x4){pg8::bflo(w.x), pg8::bfhi(w.x), pg8::bflo(w.y), pg8::bfhi(w.y)}; } }
#pragma unroll
        for (int r = 0; r < 2; ++r)
#pragma unroll
            for (int j = 0; j < 4; ++j) s[r] += (y[r][j].x * y[r][j].x + y[r][j].y * y[r][j].y) + (y[r][j].z * y[r][j].z + y[r][j].w * y[r][j].w);
        float s2[2] = {0.f, 0.f};
#pragma unroll
        for (int r = 0; r < 2; ++r) { const float ry = __builtin_amdgcn_rsqf(wave_sum(s[r]) * (1.f / D) + EPS) * scale;
#pragma unroll
            for (int j = 0; j < 4; ++j) { v[r][j] = v[r][j] + y[r][j] * ry * g[j]; s2[r] += (v[r][j].x * v[r][j].x + v[r][j].y * v[r][j].y) + (v[r][j].z * v[r][j].z + v[r][j].w * v[r][j].w); } }
#pragma unroll
        for (int r = 0; r < 2; ++r) { if (r == 1 && !two) break; const int m = r == 0 ? m0 : m1;
            const float r2 = __builtin_amdgcn_rsqf(wave_sum(s2[r]) * (1.f / D) + EPS);
            f32x4* ho = (f32x4*)(hout + (size_t)m * D) + lane; v2u* ao = (v2u*)(A + (size_t)m * D) + lane;
#pragma unroll
            for (int j = 0; j < 4; ++j) { ho[64 * j] = v[r][j]; v2u w; w.x = pk2(v[r][j].x * r2, v[r][j].y * r2); w.y = pk2(v[r][j].z * r2, v[r][j].w * r2); ao[64 * j] = w; } }
    }
}

constexpr int HG_QH = 0, HG_QT = 17408, HG_KT = 34816, HG_KHT = 52224, HG_VT = 70656, HG_PP = 89088, HG_ST = 98304, HG_TOT = 133120, HG_DV = 135168, HG_END = 135680;
constexpr int RS = 136, RS2 = 72, OFS = 132;
static_assert(HG_END <= LDS_BYTES, "hgrn lds");
__device__ __forceinline__ f32x4 mfma16(bf16x8 a, bf16x8 b, f32x4 c) { return __builtin_amdgcn_mfma_f32_16x16x32_bf16(a, b, c, 0, 0, 0); }
constexpr int HSEG = 4, HCH = SEQ / 64 / HSEG;
template <bool OUT>
__device__ __forceinline__ void hgrn_scan(LAS unsigned char* lds, bfu* QZVG, const float* lbl, int bh, int seg, float* Ebuf, float* Lbuf, int wave_s) {
    int tid_o = tid_from(wave_s); asm volatile("" : "+v"(tid_o)); const int tid = tid_o, lane = tid & 63, wid = __builtin_amdgcn_readfirstlane(tid >> 6), col = tid & 127, rg = tid >> 7, fr = lane & 15, fq = lane >> 4;
    const int b = bh >> 3, h = bh & 7;
    LAS bfu* QH = (LAS bfu*)(lds + HG_QH); LAS bfu* QT = (LAS bfu*)(lds + HG_QT); LAS bfu* KT = (LAS bfu*)(lds + HG_KT); LAS bfu* KHT = (LAS bfu*)(lds + HG_KHT);
    LAS bfu* VT = (LAS bfu*)(lds + HG_VT); LAS bfu* PP = (LAS bfu*)(lds + HG_PP); LAS bfu* ST = (LAS bfu*)(lds + HG_ST);
    LAS float* TOT = (LAS float*)(lds + HG_TOT); LAS float* DV = (LAS float*)(lds + HG_DV); LAS float* OF = (LAS float*)(lds + HG_QT);
    const float l0 = lbl[h * 128 + col], l1 = lbl[1024 + h * 128 + col];
    const float lb = 1.f / (1.f + __expf(l1 - l0)), omlb = 1.f - lb;
    bfu* base = QZVG + ((size_t)b * SEQ + (size_t)seg * HCH * 64) * 4096 + h * 128;
    const bfu* pq = base + (size_t)(16 * rg) * 4096 + col; const bfu* pz = pq + 1024; const bfu* pv = pq + 2048;
    const int erow = tid >> 3, eseg = tid & 7;
    const bfu* pg = base + 3072 + (size_t)erow * 4096 + 16 * eseg; bfu* po = base + (size_t)erow * 4096 + 16 * eseg;
    f32x4 Sacc[8];
#pragma unroll
    for (int i = 0; i < 8; ++i) Sacc[i] = (f32x4){0.f, 0.f, 0.f, 0.f};
    float Lacc = 0.f;
    if constexpr (OUT) {
        for (int j = 0; j < seg; ++j) {
            const float* Ej = Ebuf + ((size_t)(bh * HSEG + j) * 64 * 64) * 4 + (size_t)(wid * 8) * 64 * 4; const float* Lj = Lbuf + (size_t)(bh * HSEG + j) * 128;
#pragma unroll
            for (int kb = 0; kb < 8; ++kb) { const f32x4 e = *(const f32x4*)(Ej + ((size_t)kb * 64 + lane) * 4); const f32x4 l4 = *(const f32x4*)(Lj + 16 * kb + 4 * fq);
                f32x4 s = Sacc[kb]; s[0] = s[0] * __expf(l4[0]) + e[0]; s[1] = s[1] * __expf(l4[1]) + e[1]; s[2] = s[2] * __expf(l4[2]) + e[2]; s[3] = s[3] * __expf(l4[3]) + e[3]; Sacc[kb] = s; }
        }
#pragma unroll
        for (int kb = 0; kb < 8; ++kb) *(LAS v2u*)(ST + (16 * wid + fr) * RS + 16 * kb + 4 * fq) = (v2u){pk2(Sacc[kb][0], Sacc[kb][1]), pk2(Sacc[kb][2], Sacc[kb][3])};
    }
    unsigned short zr[16], qr[16], vr[16]; v4u gr0 = (v4u){0u, 0u, 0u, 0u}, gr1 = gr0;
#define HG_LOAD() do { _Pragma("unroll") for (int j = 0; j < 16; ++j) { zr[j] = pz[(size_t)j * 4096]; vr[j] = pv[(size_t)j * 4096]; if (OUT) qr[j] = pq[(size_t)j * 4096]; else qr[j] = 0; } \
        if (OUT) { gr0 = *(const v4u*)pg; gr1 = *(const v4u*)(pg + 8); } pz += (size_t)64 * 4096; pq += (size_t)64 * 4096; pv += (size_t)64 * 4096; pg += (size_t)64 * 4096; } while (0)
    HG_LOAD();
    for (int c = 0; c < HCH; ++c) {
        float kk[16], cum[16], qf[16]; unsigned short vv[16]; const v4u g0 = gr0, g1 = gr1;
        float run = 0.f;
#pragma unroll
        for (int j = 0; j < 16; ++j) { const float z = bf2f(zr[j]); const float k = omlb * __builtin_amdgcn_rcpf(1.f + __expf(z)); run += __logf(1.f - k); cum[j] = run; kk[j] = k; qf[j] = bf2f(qr[j]); vv[j] = vr[j]; }
        TOT[rg * 128 + col] = run;
        if (c + 1 < HCH) HG_LOAD();
        LDS_WAIT(); __builtin_amdgcn_s_barrier(); asm volatile("" ::: "memory");
        const float t0 = TOT[col], t1 = TOT[128 + col], t2 = TOT[256 + col], t3 = TOT[384 + col];
        const float pre = (rg > 0 ? t0 : 0.f) + (rg > 1 ? t1 : 0.f) + (rg > 2 ? t2 : 0.f), tot = (t0 + t1) + (t2 + t3), mid = t0 + t1;
        Lacc += tot;
        unsigned khp[8], vvp[8];
#pragma unroll
        for (int j = 0; j < 16; ++j) { const float cj = pre + cum[j]; const int r = 16 * rg + j;
            if constexpr (OUT) { QH[r * RS + col] = f2b(qf[j] * __expf(cj)); QT[r * RS + col] = f2b(qf[j] * __expf(cj - mid)); KT[r * RS + col] = f2b(kk[j] * __expf(mid - cj)); }
            const unsigned short kh = f2b(kk[j] * __expf(tot - cj));
            if (j & 1) { khp[j >> 1] |= (unsigned)kh << 16; vvp[j >> 1] |= (unsigned)vv[j] << 16; } else { khp[j >> 1] = kh; vvp[j >> 1] = vv[j]; } }
        *(LAS v4u*)(KHT + col * RS2 + 16 * rg) = (v4u){khp[0], khp[1], khp[2], khp[3]}; *(LAS v4u*)(KHT + col * RS2 + 16 * rg + 8) = (v4u){khp[4], khp[5], khp[6], khp[7]};
        *(LAS v4u*)(VT + col * RS2 + 16 * rg) = (v4u){vvp[0], vvp[1], vvp[2], vvp[3]}; *(LAS v4u*)(VT + col * RS2 + 16 * rg + 8) = (v4u){vvp[4], vvp[5], vvp[6], vvp[7]};
        if (rg == 0) DV[col] = __expf(tot);
        LDS_WAIT(); __builtin_amdgcn_s_barrier(); asm volatile("" ::: "memory");
        if constexpr (OUT) {
            const int tb = wid >> 1;
#pragma unroll
            for (int ss = 0; ss < 2; ++ss) { const int sb = 2 * (wid & 1) + ss; f32x4 sc = (f32x4){0.f, 0.f, 0.f, 0.f};
                if (sb <= tb) {
#pragma unroll
                    for (int ks = 0; ks < 4; ++ks) { const bf16x8 a = *(const LAS bf16x8*)(QT + (16 * tb + fr) * RS + 32 * ks + 8 * fq), bq = *(const LAS bf16x8*)(KT + (16 * sb + fr) * RS + 32 * ks + 8 * fq); sc = mfma16(a, bq, sc); } }
#pragma unroll
                for (int i = 0; i < 4; ++i) { const int t = 16 * tb + 4 * fq + i, s = 16 * sb + fr; PP[t * RS2 + s] = f2b((sb <= tb && s <= t) ? sc[i] : 0.f); } }
            LDS_WAIT(); __builtin_amdgcn_s_barrier(); asm volatile("" ::: "memory");
        }
        {   bf16x8 vtf[2];
#pragma unroll
            for (int ks = 0; ks < 2; ++ks) vtf[ks] = *(const LAS bf16x8*)(VT + (16 * wid + fr) * RS2 + 32 * ks + 8 * fq);
            if constexpr (OUT) { bf16x8 stf[4];
#pragma unroll
                for (int ks = 0; ks < 4; ++ks) stf[ks] = *(const LAS bf16x8*)(ST + (16 * wid + fr) * RS + 32 * ks + 8 * fq);
#pragma unroll
                for (int tb = 0; tb < 4; ++tb) { f32x4 o = (f32x4){0.f, 0.f, 0.f, 0.f};
#pragma unroll
                    for (int ks = 0; ks < 4; ++ks) o = mfma16(*(const LAS bf16x8*)(QH + (16 * tb + fr) * RS + 32 * ks + 8 * fq), stf[ks], o);
#pragma unroll
                    for (int ks = 0; ks < 2; ++ks) o = mfma16(*(const LAS bf16x8*)(PP + (16 * tb + fr) * RS2 + 32 * ks + 8 * fq), vtf[ks], o);
#pragma unroll
                    for (int i = 0; i < 4; ++i) OF[(16 * tb + 4 * fq + i) * OFS + 16 * wid + fr] = o[i]; } }
#pragma unroll
            for (int kb = 0; kb < 8; ++kb) { const f32x4 d4 = *(const LAS f32x4*)(DV + 16 * kb + 4 * fq); f32x4 s = Sacc[kb] * d4;
#pragma unroll
                for (int ks = 0; ks < 2; ++ks) s = mfma16(*(const LAS bf16x8*)(KHT + (16 * kb + fr) * RS2 + 32 * ks + 8 * fq), vtf[ks], s);
                Sacc[kb] = s; if constexpr (OUT) *(LAS v2u*)(ST + (16 * wid + fr) * RS + 16 * kb + 4 * fq) = (v2u){pk2(s[0], s[1]), pk2(s[2], s[3])}; }
        }
        if constexpr (OUT) {
            LDS_WAIT(); __builtin_amdgcn_s_barrier(); asm volatile("" ::: "memory");
            f32x4 o4[4]; float ss = 0.f;
#pragma unroll
            for (int j = 0; j < 4; ++j) { o4[j] = *(const LAS f32x4*)(OF + erow * OFS + 16 * eseg + 4 * j); ss += (o4[j].x * o4[j].x + o4[j].y * o4[j].y) + (o4[j].z * o4[j].z + o4[j].w * o4[j].w); }
            ss += __shfl_xor(ss, 1); ss += __shfl_xor(ss, 2); ss += __shfl_xor(ss, 4);
            const float rs = __builtin_amdgcn_rsqf(ss * (1.f / 128.f) + EPS);
            unsigned w[8];
#pragma unroll
            for (int j = 0; j < 4; ++j) { const unsigned ga = (j < 2) ? g0[2 * j] : g1[2 * (j - 2)], gb = (j < 2) ? g0[2 * j + 1] : g1[2 * (j - 2) + 1];
                const float a0 = pg8::bflo(ga), a1 = pg8::bfhi(ga), a2 = pg8::bflo(gb), a3 = pg8::bfhi(gb);
                w[2 * j] = pk2(o4[j].x * rs * a0 * pg8::fsigmoid(a0), o4[j].y * rs * a1 * pg8::fsigmoid(a1)); w[2 * j + 1] = pk2(o4[j].z * rs * a2 * pg8::fsigmoid(a2), o4[j].w * rs * a3 * pg8::fsigmoid(a3)); }
            *(v4u*)po = (v4u){w[0], w[1], w[2], w[3]}; *(v4u*)(po + 8) = (v4u){w[4], w[5], w[6], w[7]}; po += (size_t)64 * 4096;
        }
    }
#undef HG_LOAD
    if constexpr (!OUT) {
        float* Es = Ebuf + ((size_t)(bh * HSEG + seg) * 64 * 64) * 4 + (size_t)(wid * 8) * 64 * 4;
#pragma unroll
        for (int kb = 0; kb < 8; ++kb) *(f32x4*)(Es + ((size_t)kb * 64 + lane) * 4) = Sacc[kb];
        if (rg == 0) Lbuf[(size_t)(bh * HSEG + seg) * 128 + col] = Lacc;
    }
    LDS_WAIT(); __builtin_amdgcn_s_barrier(); asm volatile("" ::: "memory");
}

__device__ __forceinline__ void cumsum_bh(LAS unsigned char* lds, const float* LOGF, float* C, int bh, int wave_s) {
    const int tid = tid_from(wave_s), lane = tid & 63, wid = tid >> 6, b = bh >> 4, h = bh & 15;
    LAS float* wsum = (LAS float*)lds;
    const float* src = LOGF + ((size_t)b * SEQ + 8 * tid) * 16 + h;
    float v[8]; float run = 0.f;
#pragma unroll
    for (int j = 0; j < 8; ++j) { run += src[j * 16]; v[j] = run; }
    float inc = run;
#pragma unroll
    for (int o = 1; o < 64; o <<= 1) { const float t = __shfl_up(inc, o); if (lane >= o) inc += t; }
    if (lane == 63) wsum[wid] = inc;
    LDS_WAIT(); __builtin_amdgcn_s_barrier(); asm volatile("" ::: "memory");
    float off = inc - run;
    for (int w = 0; w < wid; ++w) off += wsum[w];
    float* dst = C + (size_t)bh * SEQ + 8 * tid;
    *(f32x4*)dst = (f32x4){(off + v[0]) * LOG2E, (off + v[1]) * LOG2E, (off + v[2]) * LOG2E, (off + v[3]) * LOG2E};
    *(f32x4*)(dst + 4) = (f32x4){(off + v[4]) * LOG2E, (off + v[5]) * LOG2E, (off + v[6]) * LOG2E, (off + v[7]) * LOG2E};
    LDS_WAIT(); __builtin_amdgcn_s_barrier(); asm volatile("" ::: "memory");
}

#define RLX_AGENT __ATOMIC_RELAXED, __HIP_MEMORY_SCOPE_AGENT
#define XB_TMO      128
#define XB_XCNT(j)  (256  + 64 * (j))
#define XB_XSUB(j)  (1280 + 64 * (j))
#define XB_XGEN(j)  (2304 + 64 * (j))
#define XB_TOP      3328
#define XB_TOPGEN   3392
#define XCD_BAR_WORDS 3456
#define XB_SPIN_CAP (1u << 18)

__device__ __forceinline__ unsigned xb_ld(unsigned* p)              { return __hip_atomic_load(p, __ATOMIC_RELAXED, __HIP_MEMORY_SCOPE_AGENT); }
__device__ __forceinline__ unsigned xb_add(unsigned* p, unsigned v) { return __hip_atomic_fetch_add(p, v, __ATOMIC_RELAXED, __HIP_MEMORY_SCOPE_AGENT); }
__device__ __forceinline__ unsigned xb_xcc_id() { return (unsigned)__builtin_amdgcn_s_getreg((3 << 11) | 20) & 0xFu; }
#define XB_SPIN(cond, bar) do { unsigned _sp = 0; while (cond) { __builtin_amdgcn_s_sleep(1); \
    if ((++_sp & 255u) == 0u) { if (xb_ld(&(bar)[XB_TMO])) break; if (_sp > XB_SPIN_CAP) { atomicAdd(&(bar)[XB_TMO], 1u); break; } } } } while (0)

struct XcdBarrier {
    unsigned* bar; unsigned x;
    volatile LAS unsigned* st;
};

__device__ __forceinline__ XcdBarrier xcd_barrier_post(unsigned* bar, volatile LAS unsigned* st, bool is_t0) {
    XcdBarrier b; b.bar = bar; b.x = xb_xcc_id(); b.st = st;
    if (is_t0) (void)xb_add(&bar[XB_XCNT(b.x)], 1u);
    return b;
}
__device__ __forceinline__ void xcd_barrier_complete(unsigned* bar, unsigned x, unsigned& nloc, unsigned& nx) {
    const unsigned G = gridDim.x * gridDim.y * gridDim.z;
    unsigned sum, cnt, mine, sp = 0u;
    for (;;) {
        sum = 0u; cnt = 0u; mine = 0u;
#pragma unroll
        for (unsigned j = 0; j < 16; ++j) { const unsigned c = xb_ld(&bar[XB_XCNT(j)]); sum += c; cnt += (c > 0u) ? 1u : 0u; mine = (j == x) ? c : mine; }
        if (sum == G) break;
        __builtin_amdgcn_s_sleep(1);
        if ((++sp & 255u) == 0u) { if (xb_ld(&bar[XB_TMO])) break; if (sp > XB_SPIN_CAP) { atomicAdd(&bar[XB_TMO], 1u); break; } }
    }
    nloc = mine > 0u ? mine : 1u; nx = cnt > 0u ? cnt : 1u;
}

__device__ __forceinline__ void xcd_barrier(const XcdBarrier& b, bool is_t0) {
    asm volatile("s_waitcnt vmcnt(0)" ::: "memory");
    __syncthreads();
    if (is_t0) {
        unsigned* bar = b.bar;
        __builtin_amdgcn_s_waitcnt(0);
        unsigned nloc = b.st[0], nx = b.st[1];
        if (nloc == 0u) { xcd_barrier_complete(bar, b.x, nloc, nx); b.st[0] = nloc; b.st[1] = nx; }
        const unsigned old = xb_add(&bar[XB_XSUB(b.x)], 1u);
        const unsigned gen = old / nloc;
        if (old + 1u == (gen + 1u) * nloc) {
            __builtin_amdgcn_fence(__ATOMIC_RELEASE, "agent");
            asm volatile("s_waitcnt vmcnt(0)" ::: "memory");
            const unsigned og = xb_add(&bar[XB_TOP], 1u);
            const unsigned tg = og / nx;
            if (og + 1u == (tg + 1u) * nx) xb_add(&bar[XB_TOPGEN], 1u);
            else XB_SPIN(xb_ld(&bar[XB_TOPGEN]) == tg, bar);
            __builtin_amdgcn_fence(__ATOMIC_ACQUIRE, "agent");
            xb_add(&bar[XB_XGEN(b.x)], 1u);
            asm volatile("s_waitcnt vmcnt(0)" ::: "memory");
        } else {
            XB_SPIN(xb_ld(&bar[XB_XGEN(b.x)]) == gen, bar);
            __builtin_amdgcn_fence(__ATOMIC_ACQUIRE, "agent");
            asm volatile("s_waitcnt vmcnt(0)" ::: "memory");
        }
    }
    __syncthreads();
}

constexpr size_t WS_CTL = E_WEND * 2, CTL_BYTES = 16384; static_assert(WS_CTL % 256 == 0 && WS_CTL + CTL_BYTES <= WS_P && XCD_BAR_WORDS * 4 <= CTL_BYTES, "ctl");
constexpr int LDS_BARST = LDS_BYTES - 64;
struct Args { const float* in[25]; float* out; unsigned char* ws; int st_lo, st_hi; };
enum { ST_PRO, ST_F1I0, ST_F1O0, ST_RW00, ST_HIN, ST_HS1, ST_HS2, ST_HOUT, ST_RW01, ST_F2I0, ST_F2O0, ST_PP0, ST_RW02, ST_PG0, ST_RW03, ST_KVF, ST_F1I1, ST_CUM, ST_F1O1, ST_RW10, ST_QG, ST_ATT, ST_FOUT, ST_RW11, ST_F2I1, ST_F2O1, ST_PP1, ST_RW12, ST_PG1, ST_RW13, NSTEP };
__host__ __device__ constexpr bool sync_before(int s) { return !(s == ST_PRO || s == ST_PP0 || s == ST_F1I1 || s == ST_F1O1 || s == ST_PP1); }
enum { K_PRO = 0, K_FFN_IN, K_FFN_OUT, K_RW, K_HGRN_IN, K_HGRN, K_HGRN_OUT, K_PLE_PROJ, K_PLE_GATE, K_KVF, K_CUMSUM, K_QG, K_ATTN, K_FOX_OUT };

__global__ void __launch_bounds__(NWAVES * 64, 2) yoco_fwd(Args args) {
    extern __shared__ __attribute__((aligned(16))) unsigned char lds[];
    cg::grid_group grid = cg::this_grid();
    LAS unsigned char* ldsp = (LAS unsigned char*)lds;
    const int st_lo = args.st_lo, st_hi = args.st_hi;
    const int wave_s = __builtin_amdgcn_readfirstlane((int)(threadIdx.x >> 6));
    if (tid_from(wave_s) < 2) ((volatile LAS unsigned*)(ldsp + LDS_BARST))[tid_from(wave_s)] = 0u;
    __syncthreads();
    (void)xcd_barrier_post((unsigned*)(args.ws + WS_CTL), (volatile LAS unsigned*)(ldsp + LDS_BARST), tid_from(wave_s) == 0);
#define STEP_BEGIN(k) if (st_lo <= (k) && (k) < st_hi) { if ((k) > st_lo && sync_before(k)) { if ((k) == ST_F1I0) { asm volatile("s_waitcnt vmcnt(0) lgkmcnt(0)" ::: "memory"); grid.sync(); __builtin_amdgcn_fence(__ATOMIC_ACQUIRE, "agent"); asm volatile("s_waitcnt vmcnt(0)" ::: "memory"); } \
          else { XcdBarrier xb_; xb_.bar = (unsigned*)(((const __attribute__((address_space(4))) Args*)__builtin_amdgcn_kernarg_segment_ptr())->ws + WS_CTL); xb_.x = xb_xcc_id(); xb_.st = (volatile LAS unsigned*)(ldsp + LDS_BARST); xcd_barrier(xb_, tid_from(wave_s) == 0); } } \
        const __attribute__((address_space(4))) Args* ap = (const __attribute__((address_space(4))) Args*)__builtin_amdgcn_kernarg_segment_ptr(); asm volatile("" : "+s"(ap)); \
        int tid_k = tid_from(wave_s); asm volatile("" : "+v"(tid_k)); const int tid = tid_k, lane = tid & 63, wave = __builtin_amdgcn_readfirstlane(tid >> 6); \
        const int G = gridDim.x, bx = blockIdx.x; unsigned char* ws = ap->ws; bfu* Wb = (bfu*)ws; bfu* PB = (bfu*)(ws + WS_P); float* LOGF = (float*)(ws + WS_LOGF); float* CL = (float*)(ws + WS_C); \
        bfu* AY = (bfu*)(ws + WS_AY); bfu* BIG = (bfu*)(ws + WS_BIG); bfu* PROJ = (bfu*)(ws + WS_PROJ); const int gw = bx * NWAVES + wave, ngw = G * NWAVES; \
        (void)tid; (void)lane; (void)Wb; (void)PB; (void)LOGF; (void)CL; (void)AY; (void)BIG; (void)PROJ; (void)gw; (void)ngw;
#define STEP_END }
#define RUN_GEMM(MODE, A_, LDA_, Bt_, N_, K_, O_, LDC_, O2_, AUX_, SC_) do { const pg8::Gemm g{A_, Bt_, T, N_, K_, LDA_}; pg8::StaticOrder S; S.init(T, N_, G, bx); \
        const pg8::Epi<MODE, LDC_> E{O_, O2_, AUX_, LOGF, ap->in[18], SC_}; pg8::gemm_phase<pg8::Epi<MODE, LDC_>, pg8::StaticOrder, true, true, K_, LDA_>(ldsp, g, S, E, wave_s); } while (0)
#define NOB ((bfu*)nullptr)
#define S_FFN_IN(k, L, w)  STEP_BEGIN(k) RUN_GEMM(pg8::EP_SWIGLU, AY, D, Wb + ((w) == 1 ? E_W1IN : E_W2IN) + (L) * N_WIN, 2 * FF, D, BIG, FF, NOB, NOB, 1.f); STEP_END
#define S_FFN_OUT(k, L, w) STEP_BEGIN(k) RUN_GEMM(pg8::EP_PLAIN, BIG, FF, Wb + ((w) == 1 ? E_W1OUT : E_W2OUT) + (L) * N_WOUT, D, FF, AY, D, NOB, NOB, 1.f); STEP_END
#define S_PLE_PROJ(k, L)   STEP_BEGIN(k) RUN_GEMM(pg8::EP_PLAIN, PB + (size_t)(L) * T * PLE, PLE, Wb + E_WPP + (size_t)(L) * PLE * D, D, PLE, PROJ, D, NOB, NOB, 1.f); STEP_END
#define S_PLE_GATE(k, L)   STEP_BEGIN(k) RUN_GEMM(pg8::EP_PLEGATE, AY, D, Wb + E_WPG + (size_t)(L) * D * D, D, D, BIG, D, NOB, PROJ, 1.f); STEP_END
#define S_RW(k, L, w)      STEP_BEGIN(k) { const float* hin = ((L) == 0 && (w) == 0) ? ap->in[0] : ap->out; const bfu* Y = ((w) == 3) ? BIG : AY; \
        const float* gain = ((w) == 0 ? ap->in[5] : (w) == 1 ? ap->in[7] : (w) == 2 ? ap->in[11] : ap->in[24]) + (L) * D; \
        rw_phase(hin, ap->out, Y, AY, gain, ((w) == 0 || (w) == 2) ? 0.5f : 1.0f, gw, ngw, lane); } STEP_END

    STEP_BEGIN(ST_PRO) {
        LAS float* scr = (LAS float*)(ldsp + wave * 16384);
        for (int it = gw;; it += ngw) {
            int r = it;
#define CONV(src, K_, N_, dst, gain, gmask, sw) { constexpr int NI = ((K_) / 64) * (((N_) + 31) / 32); if (r < NI) { conv_item(src, K_, N_, dst, gain, gmask, sw, scr, r, lane); continue; } r -= NI; }
            CONV(ap->in[3], D, 2 * FF, Wb + E_W1IN, ap->in[2], 1023, 1)
            CONV(ap->in[3] + N_WIN, D, 2 * FF, Wb + E_W1IN + N_WIN, ap->in[2] + D, 1023, 1)
            CONV(ap->in[9], D, 2 * FF, Wb + E_W2IN, ap->in[8], 1023, 1)
            CONV(ap->in[9] + N_WIN, D, 2 * FF, Wb + E_W2IN + N_WIN, ap->in[8] + D, 1023, 1)
            CONV(ap->in[4], FF, D, Wb + E_W1OUT, (const float*)nullptr, 0, 0)
            CONV(ap->in[4] + N_WOUT, FF, D, Wb + E_W1OUT + N_WOUT, (const float*)nullptr, 0, 0)
            CONV(ap->in[10], FF, D, Wb + E_W2OUT, (const float*)nullptr, 0, 0)
            CONV(ap->in[10] + N_WOUT, FF, D, Wb + E_W2OUT + N_WOUT, (const float*)nullptr, 0, 0)
            CONV(ap->in[12], D, 4 * D, Wb + E_WHIN, ap->in[6], 1023, 0)
            CONV(ap->in[15], D, D, Wb + E_WHOUT, ap->in[14], 127, 0)
            CONV(ap->in[17], D, NKVF, Wb + E_WKVF, ap->in[16], 1023, 0)
            CONV(ap->in[19], D, 2 * D, Wb + E_WQG, ap->in[6] + D, 1023, 0)
            CONV(ap->in[20], D, D, Wb + E_WFO, (const float*)nullptr, 0, 0)
            CONV(ap->in[22], D, D, Wb + E_WPG, ap->in[21], 1023, 0)
            CONV(ap->in[22] + (size_t)D * D, D, D, Wb + E_WPG + (size_t)D * D, ap->in[21] + D, 1023, 0)
            CONV(ap->in[23], PLE, D, Wb + E_WPP, (const float*)nullptr, 0, 0)
            CONV(ap->in[23] + (size_t)PLE * D, PLE, D, Wb + E_WPP + (size_t)PLE * D, (const float*)nullptr, 0, 0)
#undef CONV
            break;
        }
        {   const float* p = ap->in[1]; const size_t n8 = (size_t)2 * T * PLE / 8;
            for (size_t i = (size_t)bx * 512 + tid; i < n8; i += (size_t)G * 512) { const f32x4 a = *((const f32x4*)p + 2 * i), c = *((const f32x4*)p + 2 * i + 1);
                *((v4u*)PB + i) = (v4u){pk2(a.x, a.y), pk2(a.z, a.w), pk2(c.x, c.y), pk2(c.z, c.w)}; } }
        const float* x = ap->in[0];
        for (int m = gw; m < T; m += 2 * ngw) { rms_row_to_bf16(x + (size_t)m * D, AY + (size_t)m * D, lane); if (m + ngw < T) rms_row_to_bf16(x + (size_t)(m + ngw) * D, AY + (size_t)(m + ngw) * D, lane); }
    } STEP_END
    S_FFN_IN(ST_F1I0, 0, 1) S_FFN_OUT(ST_F1O0, 0, 1) S_RW(ST_RW00, 0, 0)
    STEP_BEGIN(ST_HIN) RUN_GEMM(pg8::EP_PLAIN, AY, D, Wb + E_WHIN, 4 * D, D, BIG, 4 * D, NOB, NOB, 1.f); STEP_END
    STEP_BEGIN(ST_HS1) { const float* lbl = ap->in[13]; float* Eb = (float*)AY; float* Lb = (float*)(ws + WS_AY + 32 * MiB);
        for (int it = bx; it < BATCH * 8 * HSEG; it += G) if ((it & 3) != 3) hgrn_scan<false>(ldsp, BIG, lbl, it >> 2, it & 3, Eb, Lb, wave_s); } STEP_END
    STEP_BEGIN(ST_HS2) { const float* lbl = ap->in[13]; float* Eb = (float*)AY; float* Lb = (float*)(ws + WS_AY + 32 * MiB);
        for (int it = bx; it < BATCH * 8 * HSEG; it += G) hgrn_scan<true>(ldsp, BIG, lbl, it >> 2, it & 3, Eb, Lb, wave_s); } STEP_END
    STEP_BEGIN(ST_HOUT) RUN_GEMM(pg8::EP_PLAIN, BIG, 4 * D, Wb + E_WHOUT, D, D, AY, D, NOB, NOB, 1.f); STEP_END
    S_RW(ST_RW01, 0, 1) S_FFN_IN(ST_F2I0, 0, 2) S_FFN_OUT(ST_F2O0, 0, 2) S_PLE_PROJ(ST_PP0, 0) S_RW(ST_RW02, 0, 2) S_PLE_GATE(ST_PG0, 0) S_RW(ST_RW03, 0, 3)
    STEP_BEGIN(ST_KVF) RUN_GEMM(pg8::EP_KVF, AY, D, Wb + E_WKVF, NKVFP, D, (bfu*)(ws + WS_K), D, (bfu*)(ws + WS_V), NOB, 1.f); STEP_END
    S_FFN_IN(ST_F1I1, 1, 1)
    STEP_BEGIN(ST_CUM) { for (int bh = bx; bh < BATCH * 16; bh += G) cumsum_bh(ldsp, LOGF, CL, bh, wave_s); } STEP_END
    S_FFN_OUT(ST_F1O1, 1, 1) S_RW(ST_RW10, 1, 0)
    STEP_BEGIN(ST_QG) RUN_GEMM(pg8::EP_QG, AY, D, Wb + E_WQG, 2 * D, D, (bfu*)(ws + WS_Q), D, (bfu*)(ws + WS_G), NOB, attn_body::C2); STEP_END
    STEP_BEGIN(ST_ATT) {
        const attn_body::AttnTensors AT{(const attn_body::bf16*)(ws + WS_Q), (const attn_body::bf16*)(ws + WS_K), (const attn_body::bf16*)(ws + WS_V), (attn_body::bf16*)(ws + WS_Q), (const attn_body::bf16*)(ws + WS_G), CL};
        const attn_body::StaticOrder S(G, bx);
        attn_body::attn_phase<attn_body::StaticOrder>((char*)lds, AT, S, wave_s);
    } STEP_END
    STEP_BEGIN(ST_FOUT) RUN_GEMM(pg8::EP_PLAIN, (const bfu*)(ws + WS_Q), D, Wb + E_WFO, D, D, AY, D, NOB, NOB, 1.f); STEP_END
    S_RW(ST_RW11, 1, 1) S_FFN_IN(ST_F2I1, 1, 2) S_FFN_OUT(ST_F2O1, 1, 2) S_PLE_PROJ(ST_PP1, 1) S_RW(ST_RW12, 1, 2) S_PLE_GATE(ST_PG1, 1) S_RW(ST_RW13, 1, 3)
}

#ifndef MK_MULTI
#define MK_MULTI 0
#endif
extern "C" void kernel_launch(void* const* d_in, const int* in_sizes, int n_in, void* d_out, int out_size, void* d_ws, size_t ws_size, hipStream_t stream) {
    static int grid = 0;
    if (grid == 0) {
        if (n_in != 25 || out_size != T * D || ws_size < WS_END) { fprintf(stderr, "kernel_launch: unexpected shapes (n_in %d out %d ws %zu)\n", n_in, out_size, ws_size); grid = -1; return; }
        int dev = 0, cus = 0, per_cu = 0;
        (void)hipGetDevice(&dev); (void)hipDeviceGetAttribute(&cus, hipDeviceAttributeMultiprocessorCount, dev);
        if (hipFuncSetAttribute((const void*)yoco_fwd, hipFuncAttributeMaxDynamicSharedMemorySize, LDS_BYTES) != hipSuccess) { fprintf(stderr, "kernel_launch: hipFuncSetAttribute failed\n"); grid = -1; return; }
        if (hipOccupancyMaxActiveBlocksPerMultiprocessor(&per_cu, (const void*)yoco_fwd, NWAVES * 64, LDS_BYTES) != hipSuccess || per_cu < 1) per_cu = 1;
        (void)hipGetLastError();
        if (cus <= 0) cus = 256;
        grid = cus * per_cu;
    }
    if (grid < 0) return;
    if (hipMemsetAsync((char*)d_ws + WS_CTL, 0, CTL_BYTES, stream) != hipSuccess) { fprintf(stderr, "kernel_launch: memset failed\n"); return; }
    Args a{};
    for (int i = 0; i < 25; ++i) a.in[i] = (const float*)d_in[i];
    a.out = (float*)d_out; a.ws = (unsigned char*)d_ws;
#if MK_MULTI
    int lo = 0;
    for (int s = 1; s <= NSTEP; ++s) if (s == NSTEP || sync_before(s)) { a.st_lo = lo; a.st_hi = s; hipLaunchKernelGGL(yoco_fwd, dim3(grid), dim3(NWAVES * 64), LDS_BYTES, stream, a); lo = s; }
#else
#ifndef ST_CUT
#define ST_CUT NSTEP
#endif
    a.st_lo = 0; a.st_hi = ST_CUT;
    void* kargs[] = {&a};
    const hipError_t e = hipLaunchCooperativeKernel((const void*)yoco_fwd, dim3(grid), dim3(NWAVES * 64), kargs, LDS_BYTES, stream);
    if (e != hipSuccess) fprintf(stderr, "kernel_launch: cooperative launch failed: %s (grid %d)\n", hipGetErrorString(e), grid);
#endif
}
```

```cpp
#include <hip/hip_runtime.h>
#include <hip/hip_cooperative_groups.h>
#include <hip/hip_bf16.h>
#include <cstdio>
#include <cstdint>
#include <cmath>
namespace cg = cooperative_groups;
__device__ __forceinline__ int tid_from(int wave_s) { unsigned l; asm volatile("v_mbcnt_lo_u32_b32 %0, -1, 0\n\tv_mbcnt_hi_u32_b32 %0, -1, %0" : "=v"(l)); return wave_s * 64 + (int)l; }
namespace pg8 {
#define PG8_LAS __attribute__((address_space(3)))
typedef unsigned short bf16_t;
typedef short bf16x8 __attribute__((ext_vector_type(8)));
typedef float f32x4 __attribute__((ext_vector_type(4)));
typedef unsigned u32x4 __attribute__((ext_vector_type(4)));
constexpr int BM = 256, BK = 64, HALF = 128, HTB = HALF * BK * 2  , STAGE_BYTES = 8 * HTB, NXCD = 8, WGM = 8;

__host__ __device__ __forceinline__ int lds_byte(int r, int c) { const int st = (r >> 4) * 2 + (c >> 5), rr = r & 15, cc = c & 31, ob = rr * 64 + cc * 2; return st * 1024 + (ob ^ (((ob >> 9) & 1) << 5)); }
__host__ __device__ __forceinline__ void stage_rc(int b, int& R, int& C) { const int st = b / 1024, sb = b % 1024, swz = sb ^ (((sb >> 9) & 1) << 5); R = (st >> 1) * 16 + swz / 64; C = (st & 1) * 32 + (swz % 64) / 2; }
__host__ __device__ __forceinline__ int perm32(int rho) { const int n = rho >> 4, i = rho & 15; return 8 * (i >> 2) + 4 * n + (i & 3); }

struct Unit { int pm, pn; };
struct Gemm { const bf16_t* A; const bf16_t* Bt; int M, N, K, lda; };

struct StaticOrder {
    int nM, nN, nwg, G, c;
    __host__ __device__ void init(int M, int N, int G_, int c_) { nM = M / BM; nN = N / BM; nwg = nM * nN; G = G_; c = c_; }
    __host__ __device__ bool next(int i, Unit& u) const {
        const long L = (long)i * G + c; if (L >= nwg) return false;
        int wgid = (int)L; { const int q = nwg / NXCD, r = nwg % NXCD, xcd = wgid % NXCD, off = wgid / NXCD; wgid = (xcd < r ? xcd * (q + 1) : r * (q + 1) + (xcd - r) * q) + off; }
        const int nig = WGM * nN, gid = wgid / nig, fm = gid * WGM, gsz = (nM - fm) < WGM ? (nM - fm) : WGM;
        u.pm = fm + ((wgid % nig) % gsz); u.pn = (wgid % nig) / gsz; return true;
    }
    __device__ __forceinline__ void a_ready(const Unit&) const {}
    __device__ __forceinline__ void done(const Unit&) const {}
};

typedef float f32x2cv __attribute__((ext_vector_type(2))); typedef __bf16 bf16x2cv __attribute__((ext_vector_type(2)));
__device__ __forceinline__ unsigned cvt_pk_bf16_asm(float lo, float hi) { unsigned r; asm volatile("v_cvt_pk_bf16_f32 %0, %1, %2" : "=v"(r) : "v"(lo), "v"(hi)); return r; }
__device__ __forceinline__ unsigned cvt_pk_bf16(float lo, float hi) { const f32x2cv v = {lo, hi}; const bf16x2cv b = __builtin_convertvector(v, bf16x2cv); return __builtin_bit_cast(unsigned, b); }
enum { EP_PLAIN = 0, EP_SWIGLU = 1, EP_KVF = 2, EP_QG = 3, EP_PLEGATE = 4 };
__device__ __forceinline__ float fsigmoid(float x) { return __builtin_amdgcn_rcpf(1.0f + __builtin_amdgcn_exp2f(-1.4426950408889634f * x)); }
__device__ __forceinline__ float bflo(unsigned w) { return __uint_as_float(w << 16); }
__device__ __forceinline__ float bfhi(unsigned w) { return __uint_as_float(w & 0xffff0000u); }
template <int MODE, int LDC> struct Epi {
    static constexpr bool PERM = true, AFTER_DRAIN = false;
    bf16_t* O; bf16_t* O2; const bf16_t* aux; float* lf; const float* bfp; float scale0; static constexpr int ldc = LDC;
    __device__ __forceinline__ void operator()(const f32x4 (&acc)[2][2][4][2], const Unit& u, int wr, int wc, int fr, int fq) const {
        asm volatile("s_nop 15\n\ts_nop 15" ::: "memory");
        const int row0 = u.pm * BM + wr * 64 + fr;
        if constexpr (MODE == EP_SWIGLU) {
            const int col0 = u.pn * HALF + wc * 32 + 8 * fq;
#pragma unroll
            for (int ai = 0; ai < 2; ++ai)
#pragma unroll
                for (int m = 0; m < 4; ++m) { bf16_t* rowp = O + (size_t)(row0 + ai * HALF + m * 16) * ldc + col0;
                    const f32x4 g0 = acc[ai][0][m][0], g1 = acc[ai][0][m][1], u0 = acc[ai][1][m][0], u1 = acc[ai][1][m][1]; f32x4 v0, v1;
#pragma unroll
                    for (int j = 0; j < 4; ++j) { v0[j] = g0[j] * fsigmoid(g0[j]) * u0[j]; v1[j] = g1[j] * fsigmoid(g1[j]) * u1[j]; }
                    u32x4 w; w.x = cvt_pk_bf16_asm(v0[0], v0[1]); w.y = cvt_pk_bf16_asm(v0[2], v0[3]); w.z = cvt_pk_bf16_asm(v1[0], v1[1]); w.w = cvt_pk_bf16_asm(v1[2], v1[3]);
                    *(u32x4*)rowp = w; }
        } else {
            bf16_t* base = O; int colt = u.pn * BM; int kind = 0; float sc = 1.f;
            if constexpr (MODE == EP_KVF) { if (u.pn >= 8) kind = 2; else if (u.pn >= 4) { base = O2; colt -= 1024; } }
            if constexpr (MODE == EP_QG) { if (u.pn >= 4) { base = O2; colt -= 1024; kind = 1; } else sc = scale0; }
            if (MODE == EP_KVF && kind == 2) {
                if (wc == 0 && fq < 2) {
#pragma unroll
                    for (int ai = 0; ai < 2; ++ai)
#pragma unroll
                        for (int m = 0; m < 4; ++m) { float* lp = lf + (size_t)(row0 + ai * HALF + m * 16) * 16 + 8 * fq;
#pragma unroll
                            for (int n = 0; n < 2; ++n) { const f32x4 a = acc[ai][0][m][n]; f32x4 o;
#pragma unroll
                                for (int j = 0; j < 4; ++j) { const float x = a[j] + bfp[8 * fq + 4 * n + j]; o[j] = fminf(x, 0.f) - __logf(1.0f + __expf(-fabsf(x))); }
                                *(f32x4*)(lp + 4 * n) = o; } }
                }
                return;
            }
            const int col0 = colt + wc * 32 + 8 * fq;
#pragma unroll
            for (int ai = 0; ai < 2; ++ai)
#pragma unroll
                for (int m = 0; m < 4; ++m) { const size_t roff = (size_t)(row0 + ai * HALF + m * 16) * ldc + col0;
#pragma unroll
                    for (int bj = 0; bj < 2; ++bj) { f32x4 v0 = acc[ai][bj][m][0], v1 = acc[ai][bj][m][1];
                        if (MODE == EP_QG && kind == 1) {
#pragma unroll
                            for (int j = 0; j < 4; ++j) { v0[j] = fsigmoid(v0[j]); v1[j] = fsigmoid(v1[j]); } }
                        else if (MODE == EP_QG) { v0 = v0 * sc; v1 = v1 * sc; }
                        if constexpr (MODE == EP_PLEGATE) { const u32x4 pq = *(const u32x4*)(aux + roff + bj * HALF);
                            v0[0] = fsigmoid(v0[0]) * bflo(pq.x); v0[1] = fsigmoid(v0[1]) * bfhi(pq.x); v0[2] = fsigmoid(v0[2]) * bflo(pq.y); v0[3] = fsigmoid(v0[3]) * bfhi(pq.y);
                            v1[0] = fsigmoid(v1[0]) * bflo(pq.z); v1[1] = fsigmoid(v1[1]) * bfhi(pq.z); v1[2] = fsigmoid(v1[2]) * bflo(pq.w); v1[3] = fsigmoid(v1[3]) * bfhi(pq.w); }
                        u32x4 w; w.x = cvt_pk_bf16_asm(v0[0], v0[1]); w.y = cvt_pk_bf16_asm(v0[2], v0[3]); w.z = cvt_pk_bf16_asm(v1[0], v1[1]); w.w = cvt_pk_bf16_asm(v1[2], v1[3]);
                        *(u32x4*)(base + roff + bj * HALF) = w; } }
        }
    }
};

template <class Epi, class Sched, bool ALIGN_EPI, bool SP2, int KC, int LDA>
__device__ __forceinline__ void gemm_phase(PG8_LAS unsigned char* lds, const Gemm g, const Sched& S, const Epi& E, int wave_s) {
    int tid_o = tid_from(wave_s); asm volatile("" : "+v"(tid_o)); const int tid = tid_o, wid = __builtin_amdgcn_readfirstlane(tid >> 6), lane = tid & 63, wr = wid >> 2, wc = wid & 3, fr = lane & 15, fq = lane >> 4;
    constexpr int K = KC, nt = K / BK;
    unsigned voffA[2], voffB[2];
#pragma unroll
    for (int i = 0; i < 2; ++i) { int R, C; stage_rc(tid * 16 + i * 8192, R, C); const int Rb = Epi::PERM ? ((R & ~31) + perm32(R & 31)) : R;
        voffA[i] = (unsigned)(R * LDA + C) * 2u; voffB[i] = (unsigned)(Rb * K + C) * 2u; }
    const size_t kstep = (size_t)(BK * 2);
    const size_t hstep = (size_t)HALF * K * 2;
    const size_t tstep = 2 * hstep; const size_t hstepA = (size_t)HALF * LDA * 2, tstepA = 2 * hstepA;
    const unsigned ldsw = (unsigned)wid * 1024u;
    const int aoff = lds_byte(wr * 64 + fr, fq * 8), boff = lds_byte(wc * 32 + fr, fq * 8);
#define PG8_SA(b, h) (((b) * 2 + (h)) * HTB)
#define PG8_SB(b, h) ((4 + (b) * 2 + (h)) * HTB)
#define PG8_STAGE(bufoff, gbase, voff) do { _Pragma("unroll") for (int _i = 0; _i < 2; ++_i) \
        __builtin_amdgcn_global_load_lds((const unsigned*)((const char*)(gbase) + (voff)[_i]), (PG8_LAS unsigned*)(lds + (bufoff) + ldsw + _i * 8192), 16, 0, 0); } while (0)
#define PG8_LDA(dst, b, h) do { _Pragma("unroll") for (int m = 0; m < 4; ++m) _Pragma("unroll") for (int k = 0; k < 2; ++k) dst[m][k] = *(const PG8_LAS bf16x8*)(lds + PG8_SA(b, h) + aoff + m * 2048 + k * 1024); } while (0)
#define PG8_LDB(dst, b, h) do { _Pragma("unroll") for (int n = 0; n < 2; ++n) _Pragma("unroll") for (int k = 0; k < 2; ++k) dst[n][k] = *(const PG8_LAS bf16x8*)(lds + PG8_SB(b, h) + boff + n * 2048 + k * 1024); } while (0)
#define PG8_MMA(ai, bj, At, Bt) do { __builtin_amdgcn_s_setprio(1); _Pragma("unroll") for (int m = 0; m < 4; ++m) _Pragma("unroll") for (int n = 0; n < 2; ++n) _Pragma("unroll") for (int k = 0; k < 2; ++k) \
        acc[ai][bj][m][n] = __builtin_amdgcn_mfma_f32_16x16x32_bf16(Bt[n][k], At[m][k], acc[ai][bj][m][n], 0, 0, 0); __builtin_amdgcn_s_setprio(0); } while (0)
#define PG8_WAIT_V(n) asm volatile("s_waitcnt vmcnt(" #n ")" ::: "memory")
#define PG8_WAIT_L(n) asm volatile("s_waitcnt lgkmcnt(" #n ")" ::: "memory")
#define PG8_BAR __builtin_amdgcn_s_barrier()
#define PG8_SCHED __builtin_amdgcn_sched_barrier(0)
    Unit cur, nxt; int ui = 0;
    if (!S.next(0, cur)) return;
    f32x4 acc[2][2][4][2];
#pragma unroll
    for (int a = 0; a < 2; ++a)
#pragma unroll
        for (int b = 0; b < 2; ++b)
#pragma unroll
            for (int m = 0; m < 4; ++m)
#pragma unroll
                for (int n = 0; n < 2; ++n) acc[a][b][m][n] = (f32x4){0.f, 0.f, 0.f, 0.f};
    bf16x8 At[4][2], B0[2][2], B1[2][2];
    const char* cA = (const char*)g.A + (size_t)cur.pm * tstepA; const char* cB = (const char*)g.Bt + (size_t)cur.pn * tstep;
    S.a_ready(cur);
    if constexpr (SP2) {
        PG8_STAGE(PG8_SB(0, 0), cB, voffB); PG8_STAGE(PG8_SB(0, 1), cB + hstep, voffB); PG8_STAGE(PG8_SA(0, 0), cA, voffA); PG8_STAGE(PG8_SA(0, 1), cA + hstepA, voffA);
        if (wr == 1) PG8_BAR;
        PG8_WAIT_V(2); PG8_BAR;
        PG8_STAGE(PG8_SB(1, 0), cB + kstep, voffB); PG8_STAGE(PG8_SA(1, 0), cA + kstep, voffA); PG8_STAGE(PG8_SB(1, 1), cB + hstep + kstep, voffB);
        PG8_WAIT_V(6); PG8_BAR;
    } else {
        PG8_STAGE(PG8_SB(0, 0), cB, voffB); PG8_STAGE(PG8_SA(0, 0), cA, voffA); PG8_STAGE(PG8_SB(0, 1), cB + hstep, voffB); PG8_STAGE(PG8_SA(0, 1), cA + hstepA, voffA);
        if (wr == 1) PG8_BAR;
        PG8_WAIT_V(4); PG8_BAR;
        PG8_STAGE(PG8_SB(1, 0), cB + kstep, voffB); PG8_STAGE(PG8_SA(1, 0), cA + kstep, voffA); PG8_STAGE(PG8_SB(1, 1), cB + hstep + kstep, voffB);
        PG8_WAIT_V(6); PG8_BAR;
    }
    for (;;) {
        const bool has_next = S.next(ui + 1, nxt);
        const char* nA = has_next ? (const char*)g.A + (size_t)nxt.pm * tstepA : cA; const char* nB = has_next ? (const char*)g.Bt + (size_t)nxt.pn * tstep : cB;
        for (int t = 0; t < nt; t += 2) {
            const bool last = (t == nt - 2);
            const char* a1 = cA + (size_t)(t + 1) * kstep;
            const char* a2 = last ? nA : cA + (size_t)(t + 2) * kstep; const char* b2 = last ? nB : cB + (size_t)(t + 2) * kstep;
            const char* a3 = a2 + kstep; const char* b3 = b2 + kstep;
            if (last && has_next) S.a_ready(nxt);
            if constexpr (SP2) {
            PG8_LDB(B0, 0, 0); PG8_LDB(B1, 0, 1); PG8_SCHED; PG8_LDA(At, 0, 0); PG8_STAGE(PG8_SA(1, 1), a1 + hstepA, voffA);
            PG8_WAIT_V(8); PG8_WAIT_L(0); PG8_BAR; PG8_MMA(0, 0, At, B0); PG8_MMA(0, 1, At, B1); PG8_BAR; PG8_SCHED;
            PG8_LDA(At, 0, 1); PG8_STAGE(PG8_SB(0, 0), b2, voffB); PG8_STAGE(PG8_SB(0, 1), b2 + hstep, voffB); PG8_STAGE(PG8_SA(0, 0), a2, voffA);
            PG8_WAIT_V(8); PG8_WAIT_L(0); PG8_BAR; PG8_MMA(1, 0, At, B0); PG8_MMA(1, 1, At, B1); PG8_BAR; PG8_SCHED;
            PG8_LDB(B0, 1, 0); PG8_LDB(B1, 1, 1); PG8_SCHED; PG8_LDA(At, 1, 0); PG8_STAGE(PG8_SA(0, 1), a2 + hstepA, voffA);
            PG8_WAIT_V(8); PG8_WAIT_L(0); PG8_BAR; PG8_MMA(0, 0, At, B0); PG8_MMA(0, 1, At, B1); PG8_BAR; PG8_SCHED;
            PG8_LDA(At, 1, 1); PG8_STAGE(PG8_SB(1, 0), b3, voffB); PG8_STAGE(PG8_SB(1, 1), b3 + hstep, voffB); PG8_STAGE(PG8_SA(1, 0), a3, voffA);
            PG8_WAIT_V(8); PG8_WAIT_L(0); PG8_BAR; PG8_MMA(1, 0, At, B0); PG8_MMA(1, 1, At, B1); PG8_BAR; PG8_SCHED;
            } else {
            PG8_LDB(B0, 0, 0); PG8_SCHED; PG8_LDA(At, 0, 0); PG8_STAGE(PG8_SA(1, 1), a1 + hstepA, voffA);
            PG8_WAIT_L(8); PG8_BAR; PG8_WAIT_L(0); PG8_MMA(0, 0, At, B0); PG8_BAR; PG8_SCHED;
            PG8_LDB(B1, 0, 1); PG8_STAGE(PG8_SB(0, 0), b2, voffB);
            PG8_BAR; PG8_WAIT_L(0); PG8_MMA(0, 1, At, B1); PG8_BAR;
            PG8_LDA(At, 0, 1); PG8_STAGE(PG8_SA(0, 0), a2, voffA);
            PG8_BAR; PG8_WAIT_L(0); PG8_MMA(1, 0, At, B0); PG8_BAR; PG8_SCHED;
            PG8_STAGE(PG8_SB(0, 1), b2 + hstep, voffB);
            PG8_WAIT_V(6); PG8_BAR; PG8_MMA(1, 1, At, B1); PG8_BAR;
            PG8_LDB(B0, 1, 0); PG8_SCHED; PG8_LDA(At, 1, 0); PG8_STAGE(PG8_SA(0, 1), a2 + hstepA, voffA);
            PG8_WAIT_L(8); PG8_BAR; PG8_WAIT_L(0); PG8_MMA(0, 0, At, B0); PG8_BAR; PG8_SCHED;
            PG8_LDB(B1, 1, 1); PG8_STAGE(PG8_SB(1, 0), b3, voffB);
            PG8_BAR; PG8_WAIT_L(0); PG8_MMA(0, 1, At, B1); PG8_BAR;
            PG8_LDA(At, 1, 1); PG8_STAGE(PG8_SA(1, 0), a3, voffA);
            PG8_BAR; PG8_WAIT_L(0); PG8_MMA(1, 0, At, B0); PG8_BAR; PG8_SCHED;
            PG8_STAGE(PG8_SB(1, 1), b3 + hstep, voffB);
            PG8_WAIT_V(6); PG8_BAR; PG8_MMA(1, 1, At, B1); PG8_BAR;
            }
        }
        if constexpr (ALIGN_EPI) { if (wr == 0) PG8_BAR; }
        if constexpr (!Epi::AFTER_DRAIN) { E(acc, cur, wr, wc, fr, fq); S.done(cur); }
        if (!has_next) break;
#pragma unroll
        for (int a = 0; a < 2; ++a)
#pragma unroll
            for (int b = 0; b < 2; ++b)
#pragma unroll
                for (int m = 0; m < 4; ++m)
#pragma unroll
                    for (int n = 0; n < 2; ++n) acc[a][b][m][n] = (f32x4){0.f, 0.f, 0.f, 0.f};
        cur = nxt; cA = nA; cB = nB; ++ui;
        if constexpr (ALIGN_EPI) { if (wr == 1) PG8_BAR; }
    }
    PG8_WAIT_V(0);
    if constexpr (!ALIGN_EPI) { if (wr == 0) PG8_BAR; }
    PG8_BAR;
    if constexpr (Epi::AFTER_DRAIN) { E.fused(acc, cur, wr, wc, fr, fq, lds, wid, lane); S.done(cur); }
#undef PG8_SA
#undef PG8_SB
#undef PG8_STAGE
#undef PG8_LDA
#undef PG8_LDB
#undef PG8_MMA
#undef PG8_WAIT_V
#undef PG8_WAIT_L
#undef PG8_BAR
#undef PG8_SCHED
}
}
#include <hip/hip_bf16.h>
#include <cmath>
namespace attn_body {
using bf16=__hip_bfloat16;
using bf16x8=__attribute__((ext_vector_type(8)))short;
using s16x4=__attribute__((ext_vector_type(4)))short;
using f32x16=__attribute__((ext_vector_type(16)))float;
using u32x4=__attribute__((ext_vector_type(4)))unsigned;
constexpr int BATCH=8,NHEAD=16,SEQ=4096,D=64,DM=NHEAD*D;
constexpr int NW=8,QBLK=32,QB=QBLK*NW,KVBLK=64,NQB=SEQ/QB;
constexpr int ATTN_PITCH=DM, ATTN_UNIT_ROWS=QB;
__device__ __forceinline__ int crow(int r,int hi){return (r&3)+8*(r>>2)+4*hi;}
#define SBAR() __builtin_amdgcn_sched_barrier(0)
__device__ __forceinline__ void cmask(f32x16&p0,f32x16&p1,int jb,int qrel,int hi){
  const float NEG=-INFINITY; int kb=64*jb+4*hi;
  #pragma unroll
  for(int r=0;r<16;++r){int kv=kb+(r&3)+8*(r>>2); if(kv>qrel)p0[r]=NEG; if(kv+32>qrel)p1[r]=NEG;}
}

constexpr int NSLOT=3, SLOTB=8192;
constexpr int LDS_K=0, LDS_V=NSLOT*SLOTB, LDS_WS=2*NSLOT*SLOTB, LDS_OST=LDS_WS+NW*64*4, LDS_CB=LDS_OST+NW*4096, LDS_BYTES=LDS_CB+SEQ*4;
constexpr float C2=0.125f*1.4426950408889634f;
__device__ __forceinline__ void glds16(const void*gsrc,unsigned lds_dst){unsigned keep;
  asm volatile("s_mov_b32 %0, m0\n\ts_mov_b32 m0, %2\n\ts_nop 0\n\tglobal_load_lds_dwordx4 %1, off\n\ts_mov_b32 m0, %0":"=&s"(keep):"v"(gsrc),"s"(lds_dst):"memory");}
__device__ __forceinline__ float max3f(float a,float b,float c){float r;asm("v_max3_f32 %0, %1, %2, %3":"=v"(r):"v"(a),"v"(b),"v"(c));return r;}
__device__ __forceinline__ float max2f(float a,float b){float r;asm("v_max_f32_e32 %0, %1, %2":"=v"(r):"v"(a),"v"(b));return r;}
__device__ __forceinline__ float fadd_s(float a,float b){float r;asm("v_add_f32_e32 %0, %1, %2":"=v"(r):"v"(a),"v"(b));return r;}
__device__ __forceinline__ float fsub_s(float a,float b){float r;asm("v_sub_f32_e32 %0, %1, %2":"=v"(r):"v"(a),"v"(b));return r;}
typedef float f32x2_t __attribute__((ext_vector_type(2))); typedef __bf16 bf16x2_t __attribute__((ext_vector_type(2)));
__device__ __forceinline__ unsigned cvtpk_s(float lo,float hi){f32x2_t v={lo,hi};bf16x2_t b=__builtin_convertvector(v,bf16x2_t);return __builtin_bit_cast(unsigned,b);}
#define WAIT_BAR(N) asm volatile("s_waitcnt vmcnt(" #N ") lgkmcnt(0)\n\ts_barrier":::"memory")

__device__ __forceinline__ void qkt(f32x16&p0,f32x16&p1,const char*Kslot,const bf16x8*qr,const f32x16&negm,int r32,int hi){
  const char*kb=Kslot+hi*1024+r32*16;
  #pragma unroll
  for(int d0=0;d0<4;++d0){
    const bf16x8 b0=*reinterpret_cast<const bf16x8*>(kb+d0*2048);
    const bf16x8 b1=*reinterpret_cast<const bf16x8*>(kb+d0*2048+512);
    if(d0==0){p0=__builtin_amdgcn_mfma_f32_32x32x16_bf16(b0,qr[0],negm,0,0,0);p1=__builtin_amdgcn_mfma_f32_32x32x16_bf16(b1,qr[0],negm,0,0,0);}
    else{p0=__builtin_amdgcn_mfma_f32_32x32x16_bf16(b0,qr[d0],p0,0,0,0);p1=__builtin_amdgcn_mfma_f32_32x32x16_bf16(b1,qr[d0],p1,0,0,0);}}
}
typedef __attribute__((address_space(3))) const char* lds_cptr;
typedef short v4i16_t __attribute__((ext_vector_type(4)));
__device__ __forceinline__ void kload8(bf16x8*kf,lds_cptr kp){
  kf[0]=*(const __attribute__((address_space(3))) bf16x8*)(kp);      kf[1]=*(const __attribute__((address_space(3))) bf16x8*)(kp+512);
  kf[2]=*(const __attribute__((address_space(3))) bf16x8*)(kp+2048); kf[3]=*(const __attribute__((address_space(3))) bf16x8*)(kp+2560);
  kf[4]=*(const __attribute__((address_space(3))) bf16x8*)(kp+4096); kf[5]=*(const __attribute__((address_space(3))) bf16x8*)(kp+4608);
  kf[6]=*(const __attribute__((address_space(3))) bf16x8*)(kp+6144); kf[7]=*(const __attribute__((address_space(3))) bf16x8*)(kp+6656);
}
__device__ __forceinline__ void kload2(bf16x8*kf,lds_cptr kp,int j){ kf[2*j]=*(const __attribute__((address_space(3))) bf16x8*)(kp+j*2048); kf[2*j+1]=*(const __attribute__((address_space(3))) bf16x8*)(kp+j*2048+512); }
__device__ __forceinline__ s16x4 vtr(lds_cptr p){ return __builtin_bit_cast(s16x4,__builtin_amdgcn_ds_read_tr16_b64_v4i16((__attribute__((address_space(3))) v4i16_t*)p)); }
__device__ __forceinline__ float rowmax(const f32x16&p0,const f32x16&p1){
  float a=max3f(p0[0],p0[1],p1[0]),b=max3f(p0[2],p0[3],p1[1]);a=max3f(a,p1[2],p1[3]);
  #pragma unroll
  for(int r=4;r<16;r+=4){a=max3f(a,p0[r],p0[r+1]);b=max3f(b,p0[r+2],p0[r+3]);a=max3f(a,p1[r],p1[r+1]);b=max3f(b,p1[r+2],p1[r+3]);}
  const float m=max2f(a,b);
  auto rr=__builtin_amdgcn_permlane32_swap(__float_as_uint(m),__float_as_uint(m),false,false);
  return max2f(__uint_as_float(rr[0]),__uint_as_float(rr[1]));
}
__device__ __forceinline__ void pv(f32x16*o,int vb,bf16x8 pa0,bf16x8 pa1,bf16x8 pa2,bf16x8 pa3){
  #pragma unroll
  for(int d0=0;d0<2;++d0){s16x4 lo[4],hi[4];
    #pragma unroll
    for(int ks=0;ks<4;++ks){
      asm volatile("ds_read_b64_tr_b16 %0,%1 offset:%c2":"=&v"(lo[ks]):"v"(vb),"i"(d0*4096+ks*1024):"memory");
      asm volatile("ds_read_b64_tr_b16 %0,%1 offset:%c2":"=&v"(hi[ks]):"v"(vb),"i"(d0*4096+ks*1024+512):"memory");}
    asm volatile("s_waitcnt lgkmcnt(0)":::"memory");SBAR();
    #define PK(k) (bf16x8){lo[k][0],lo[k][1],lo[k][2],lo[k][3],hi[k][0],hi[k][1],hi[k][2],hi[k][3]}
    o[d0]=__builtin_amdgcn_mfma_f32_32x32x16_bf16(pa0,PK(0),o[d0],0,0,0);
    o[d0]=__builtin_amdgcn_mfma_f32_32x32x16_bf16(pa1,PK(1),o[d0],0,0,0);
    o[d0]=__builtin_amdgcn_mfma_f32_32x32x16_bf16(pa2,PK(2),o[d0],0,0,0);
    o[d0]=__builtin_amdgcn_mfma_f32_32x32x16_bf16(pa3,PK(3),o[d0],0,0,0);
    #undef PK
  }
}

#ifndef ATTN_STORE16
#define ATTN_STORE16(p,v) (*(u32x4*)(p)=(v))
#endif
template<int THRL> __device__ __forceinline__ void attn_unit(int b,int h,int qb,const bf16*Q,const bf16*__restrict__ K,const bf16*__restrict__ V,bf16*O,const bf16*__restrict__ Gt,const float*__restrict__ CL,char*shm,int wave_s){
  int tid_o=tid_from(wave_s); asm volatile("":"+v"(tid_o)); const int tid=tid_o,lane=tid&63,r32=lane&31,hi=lane>>5; const int wid=__builtin_amdgcn_readfirstlane(tid>>6);
  const long rowbase=(long)b*SEQ; const int q0=qb*QB;
  const float*cbh=CL+((long)b*NHEAD+h)*SEQ;
  typedef float f4_t __attribute__((ext_vector_type(4))); f4_t creg0=f4_t{},creg1=f4_t{}; const int n4c=(q0+QB)/4;
  if(tid<n4c)creg0=*(const f4_t*)(cbh+4*tid); if(tid+NW*64<n4c)creg1=*(const f4_t*)(cbh+4*(tid+NW*64));
  const float cq=cbh[q0+wid*QBLK+(lane&31)];
  const bf16*Qw=Q+(rowbase+q0+wid*QBLK)*DM+h*D;
  const bf16*Kh=K+rowbase*DM+h*D,*Vh=V+rowbase*DM+h*D;
  const unsigned lds0=(unsigned)(uintptr_t)shm;
  float*wsf=(float*)(shm+LDS_WS)+wid*64;
  const bf16*ksrc=Kh+(long)lane*DM+wid*8;
  const bf16*vsrc=Vh+(long)(16*(wid&3)+(lane>>2))*DM+(wid>>2)*32+(lane&3)*8;
  const unsigned kdst=lds0+LDS_K+wid*1024, vdst=lds0+LDS_V+wid*1024;
  #define DMA_K(t,slot) glds16(ksrc+(long)(t)*KVBLK*DM,(unsigned)__builtin_amdgcn_readfirstlane(kdst+(slot)))
  #define DMA_V(t,slot) glds16(vsrc+(long)(t)*KVBLK*DM,(unsigned)__builtin_amdgcn_readfirstlane(vdst+(slot)))
  const int vb0=(int)(lds0+LDS_V)+((lane>>4)&1)*32+(lane&3)*8+(4*hi+((lane&15)>>2))*64;
  const char*Kbase=shm+LDS_K; bf16x8 kf[8];
  const lds_cptr shm3=(lds_cptr)shm; const lds_cptr kp0=shm3+LDS_K+hi*1024+r32*16; const lds_cptr vp0=shm3+LDS_V+((lane>>4)&1)*32+(lane&3)*8+(4*hi+((lane&15)>>2))*64;
  const int NT=(q0+QB)/KVBLK;
  DMA_K(0,0);DMA_V(0,0);DMA_K(1,SLOTB);
  bf16x8 qr[4];
  #pragma unroll
  for(int d0=0;d0<4;++d0)qr[d0]=*reinterpret_cast<const bf16x8*>(&Qw[(long)r32*DM+d0*16+hi*8]);
  float mhat=0.f,l_reg=0.f;f32x16 o[2];o[0]=f32x16{};o[1]=f32x16{};f32x16 negm;
  #pragma unroll
  for(int r=0;r<16;++r)negm[r]=cq;
  asm volatile("":"+v"(negm));
  typedef float cf4_t __attribute__((ext_vector_type(4))); const __attribute__((address_space(3))) cf4_t*clds=(const __attribute__((address_space(3))) cf4_t*)((lds_cptr)shm+LDS_CB)+hi;
  #define CBIAS(P0,P1,t) do{ const __attribute__((address_space(3))) cf4_t*cp_=clds+16*(t); _Pragma("unroll") for(int j_=0;j_<4;++j_){ const cf4_t a_=cp_[2*j_], b_=cp_[8+2*j_]; \
      P0[4*j_]-=a_[0];P0[4*j_+1]-=a_[1];P0[4*j_+2]-=a_[2];P0[4*j_+3]-=a_[3]; P1[4*j_]-=b_[0];P1[4*j_+1]-=b_[1];P1[4*j_+2]-=b_[2];P1[4*j_+3]-=b_[3]; } }while(0)
  const int qrel=wid*QBLK+r32;
  #define CMASK(P0,P1,t) do{int jb_=(t)-(NT-4); if(jb_>=0)cmask(P0,P1,jb_,qrel,hi);}while(0)
  bool resc=false;
  #define START(P0,P1) do{ const float rm=rowmax(P0,P1); resc=false; \
    { const float c63_=((const __attribute__((address_space(3))) float*)((lds_cptr)shm+LDS_CB))[63]; const float dl=rm-(cq-c63_);     \
      mhat=fadd_s(mhat,dl); \
      _Pragma("unroll") for(int r=0;r<16;++r){P0[r]=fsub_s(P0[r],dl);P1[r]=fsub_s(P1[r],dl);} \
      _Pragma("unroll") for(int r=0;r<16;++r)negm[r]=cq-mhat; asm volatile("":"+v"(negm)); } \
    _Pragma("unroll") for(int r=0;r<16;++r)P0[r]=__builtin_amdgcn_exp2f(P0[r]); }while(0)
  #define RESC() do{ if(resc){ asm volatile("s_waitcnt lgkmcnt(0)":::"memory"); \
      _Pragma("unroll") for(int d_=0;d_<2;++d_) _Pragma("unroll") for(int r=0;r<16;++r)o[d_][r]*=wsf[crow(r,hi)]; } }while(0)
  f32x16 pA0,pA1,pB0,pB1;
  int sl_prev=0,sl_cur=0,sl_next=SLOTB;
  #define ROT() do{sl_prev=sl_cur;sl_cur=sl_next;sl_next=(sl_next==(NSLOT-1)*SLOTB)?0:sl_next+SLOTB;}while(0)
  { __attribute__((address_space(3))) f4_t*cl4=(__attribute__((address_space(3))) f4_t*)((lds_cptr)shm+LDS_CB); if(tid<n4c)cl4[tid]=creg0; if(tid+NW*64<n4c)cl4[tid+NW*64]=creg1; }
  DMA_K(2,2*SLOTB);
  WAIT_BAR(3);
  qkt(pA0,pA1,Kbase,qr,negm,r32,hi);asm volatile("s_nop 15\n\ts_nop 7":"+v"(pA0),"+v"(pA1));CMASK(pA0,pA1,0);CBIAS(pA0,pA1,0);
  START(pA0,pA1);
  _Pragma("unroll") for(int r=0;r<16;++r)pA1[r]=__builtin_amdgcn_exp2f(pA1[r]);
  WAIT_BAR(0);
  DMA_K(3,0);DMA_V(1,SLOTB);
  ROT();
  kload8(kf,kp0+sl_cur);
  WAIT_BAR(2);
  s16x4 vlo[8],vhi[8]; u32x4 pw0,pw1,pw2,pw3;
  #define PKW(P,B) cvtpk_s(P[B],P[B+1])
  #define PAF(k) __builtin_bit_cast(bf16x8,pw##k)
  #define VFR(i) (bf16x8){vlo[i][0],vlo[i][1],vlo[i][2],vlo[i][3],vhi[i][0],vhi[i][1],vhi[i][2],vhi[i][3]}
  #define PIN(x) asm volatile("":"+v"(x))
  #define MX3(a,b,c) __builtin_fmaxf(__builtin_fmaxf((a),(b)),(c))
  #define GAPA(MF,A0,A1,A2,A3,W0,W1,PW) do{ MF; sacc+=A0; sacc+=A1; sacc+=A2; sacc+=A3; PIN(sacc); W0; W1; PIN(PW); SBAR(); }while(0)
  #define EX(v) __builtin_amdgcn_exp2f(v)
  #define GAPB(MF,X,B) do{ MF; X[B]=EX(X[B]); X[B+1]=EX(X[B+1]); X[B+2]=EX(X[B+2]); X[B+3]=EX(X[B+3]); PIN(X); SBAR(); }while(0)
  #define VRD(i) do{ vlo[i]=vtr(vp_+(((i)>>2)*4096+((i)&3)*1024)); vhi[i]=vtr(vp_+(((i)>>2)*4096+((i)&3)*1024+512)); }while(0)
  #define KRD(G,j) do{ if(G){ kload2(kf,kp0+sl_next,j); SBAR(); } }while(0)
  #define STEP(C0,C1,P0,P1,t,GK,GV,GL) do{ SBAR(); \
    const lds_cptr vp_=vp0+sl_prev; \
    VRD(0); SBAR(); float sacc=(P0[0]+P0[1]); \
    GAPA(C0=__builtin_amdgcn_mfma_f32_32x32x16_bf16(kf[0],qr[0],negm,0,0,0), P0[2],P0[3],P0[4],P0[5],     pw0[0]=PKW(P0,0), pw0[1]=PKW(P0,2), pw0); \
    VRD(4); SBAR(); GAPA(C1=__builtin_amdgcn_mfma_f32_32x32x16_bf16(kf[1],qr[0],negm,0,0,0), P0[6],P0[7],P0[8],P0[9],     pw0[2]=PKW(P0,4), pw0[3]=PKW(P0,6), pw0); \
    VRD(1); SBAR(); GAPA(C0=__builtin_amdgcn_mfma_f32_32x32x16_bf16(kf[2],qr[1],C0,0,0,0),   P0[10],P0[11],P0[12],P0[13], pw1[0]=PKW(P0,8), pw1[1]=PKW(P0,10), pw1); \
    VRD(5); SBAR(); GAPA(C1=__builtin_amdgcn_mfma_f32_32x32x16_bf16(kf[3],qr[1],C1,0,0,0),   P0[14],P0[15],P1[0],P1[1],   pw1[2]=PKW(P0,12),pw1[3]=PKW(P0,14), pw1); \
    VRD(2); SBAR(); GAPA(C0=__builtin_amdgcn_mfma_f32_32x32x16_bf16(kf[4],qr[2],C0,0,0,0),   P1[2],P1[3],P1[4],P1[5],     pw2[0]=PKW(P1,0), pw2[1]=PKW(P1,2), pw2); \
    VRD(6); SBAR(); GAPA(C1=__builtin_amdgcn_mfma_f32_32x32x16_bf16(kf[5],qr[2],C1,0,0,0),   P1[6],P1[7],P1[8],P1[9],     pw2[2]=PKW(P1,4), pw2[3]=PKW(P1,6), pw2); \
    VRD(3); SBAR(); GAPA(C0=__builtin_amdgcn_mfma_f32_32x32x16_bf16(kf[6],qr[3],C0,0,0,0),   P1[10],P1[11],P1[12],P1[13], pw3[0]=PKW(P1,8), pw3[1]=PKW(P1,10), pw3); \
    VRD(7); SBAR(); GAPA(C1=__builtin_amdgcn_mfma_f32_32x32x16_bf16(kf[7],qr[3],C1,0,0,0),   P1[14],P1[15],0.f,0.f,       pw3[2]=PKW(P1,12),pw3[3]=PKW(P1,14), pw3); \
    l_reg+=sacc; \
    if(GK){DMA_K((t)+3,sl_cur);} if(GV){DMA_V((t)+1,sl_next);} \
    CMASK(C0,C1,t); CBIAS(C0,C1,t); \
    { float a=MX3(C0[0],C0[1],C1[0]),b=MX3(C0[2],C0[3],C1[1]); a=MX3(a,C1[2],C1[3]); \
      _Pragma("unroll") for(int r=4;r<16;r+=4){a=MX3(a,C0[r],C0[r+1]);b=MX3(b,C0[r+2],C0[r+3]);a=MX3(a,C1[r],C1[r+1]);b=MX3(b,C1[r+2],C1[r+3]);} \
      float rm=__builtin_fmaxf(a,b); { auto rr=__builtin_amdgcn_permlane32_swap(__float_as_uint(rm),__float_as_uint(rm),false,false); rm=__builtin_fmaxf(__uint_as_float(rr[0]),__uint_as_float(rr[1])); } \
      resc=false; \
      if(__builtin_expect(__any(rm>(float)THRL),0)){ const float dl=__builtin_fmaxf(rm,0.f); mhat+=dl; \
        _Pragma("unroll") for(int r=0;r<16;++r){C0[r]-=dl;C1[r]-=dl;} \
        _Pragma("unroll") for(int r=0;r<16;++r)negm[r]=cq-mhat; asm volatile("":"+v"(negm)); \
        const float f=__builtin_amdgcn_exp2f(-dl); l_reg*=f; if(hi==0)wsf[r32]=f; resc=true; } } \
    SBAR(); \
    GAPB(o[0]=__builtin_amdgcn_mfma_f32_32x32x16_bf16(PAF(0),VFR(0),o[0],0,0,0), C0,0); \
    GAPB(o[1]=__builtin_amdgcn_mfma_f32_32x32x16_bf16(PAF(0),VFR(4),o[1],0,0,0), C0,4); \
    KRD(GL,0); GAPB(o[0]=__builtin_amdgcn_mfma_f32_32x32x16_bf16(PAF(1),VFR(1),o[0],0,0,0), C0,8); \
    KRD(GL,1); GAPB(o[1]=__builtin_amdgcn_mfma_f32_32x32x16_bf16(PAF(1),VFR(5),o[1],0,0,0), C0,12); \
    KRD(GL,2); GAPB(o[0]=__builtin_amdgcn_mfma_f32_32x32x16_bf16(PAF(2),VFR(2),o[0],0,0,0), C1,0); \
    KRD(GL,3); GAPB(o[1]=__builtin_amdgcn_mfma_f32_32x32x16_bf16(PAF(2),VFR(6),o[1],0,0,0), C1,4); \
    GAPB(o[0]=__builtin_amdgcn_mfma_f32_32x32x16_bf16(PAF(3),VFR(3),o[0],0,0,0), C1,8); \
    GAPB(o[1]=__builtin_amdgcn_mfma_f32_32x32x16_bf16(PAF(3),VFR(7),o[1],0,0,0), C1,12); \
    }while(0)
  int t=1;
  #undef CMASK
  #define CMASK(P0,P1,t) do{}while(0)
  for(;t+5<NT;t+=2){
    STEP(pB0,pB1,pA0,pA1,t,true,true,true);     WAIT_BAR(2); RESC(); ROT();
    STEP(pA0,pA1,pB0,pB1,t+1,true,true,true);   WAIT_BAR(2); RESC(); ROT();
  }
  #undef CMASK
  #define CMASK(P0,P1,t) do{int jb_=(t)-(NT-4); if(jb_>=0)cmask(P0,P1,jb_,qrel,hi);}while(0)
  #define ENDW(tt) do{ if((tt)+3<NT){WAIT_BAR(2);} else if((tt)+2<NT){WAIT_BAR(1);} else {WAIT_BAR(0);} }while(0)
  for(;t+1<NT;t+=2){
    STEP(pB0,pB1,pA0,pA1,t,(t+3<NT),(t+1<NT),(t+1<NT));       ENDW(t);   RESC(); ROT();
    STEP(pA0,pA1,pB0,pB1,t+1,(t+4<NT),(t+2<NT),(t+2<NT));     ENDW(t+1); RESC(); ROT();
  }
  STEP(pB0,pB1,pA0,pA1,NT-1,false,false,false); RESC();
  { float sacc=pB0[0]+pB0[1]; _Pragma("unroll") for(int r=2;r<16;++r)sacc+=pB0[r]; _Pragma("unroll") for(int r=0;r<16;++r)sacc+=pB1[r]; l_reg+=sacc;
    pw0=(u32x4){PKW(pB0,0),PKW(pB0,2),PKW(pB0,4),PKW(pB0,6)};pw1=(u32x4){PKW(pB0,8),PKW(pB0,10),PKW(pB0,12),PKW(pB0,14)};pw2=(u32x4){PKW(pB1,0),PKW(pB1,2),PKW(pB1,4),PKW(pB1,6)};pw3=(u32x4){PKW(pB1,8),PKW(pB1,10),PKW(pB1,12),PKW(pB1,14)};
    SBAR(); pv(o,vb0+sl_cur,PAF(0),PAF(1),PAF(2),PAF(3)); }
  #undef PKW
  #undef PAF
  #undef VFR
  #undef PIN
  #undef MX3
  #undef GAPA
  #undef GAPB
  #undef EX
  #undef VRD
  #undef KRD
  #undef STEP
  #undef ENDW
  {auto rr=__builtin_amdgcn_permlane32_swap(__float_as_uint(l_reg),__float_as_uint(l_reg),false,false);l_reg=__uint_as_float(rr[0])+__uint_as_float(rr[1]);}
  if(hi==0)wsf[32+r32]=l_reg;asm volatile("s_waitcnt lgkmcnt(0)":::"memory");
  float rli[16];
  #pragma unroll
  for(int r=0;r<16;++r)rli[r]=__builtin_amdgcn_rcpf(wsf[32+crow(r,hi)]);
  bf16*Ow=O+(rowbase+q0+wid*QBLK)*DM+h*D;
  { bf16*stg=(bf16*)(shm+LDS_OST)+wid*2048;
    #pragma unroll
    for(int r=0;r<16;++r){const int orow=crow(r,hi);
      #pragma unroll
      for(int d0=0;d0<2;++d0)stg[orow*64+d0*32+r32]=__float2bfloat16(o[d0][r]*rli[r]);}
    asm volatile("s_waitcnt lgkmcnt(0)":::"memory");
    #pragma unroll
    for(int i=0;i<4;++i){const bf16*Gw=Gt+(rowbase+q0+wid*QBLK)*DM+h*D; const int row=i*8+(lane>>3),ch=lane&7; const u32x4 v=*(const u32x4*)(stg+row*64+ch*8); const u32x4 gq=*(const u32x4*)(Gw+(long)row*DM+ch*8); u32x4 w;
      #pragma unroll
      for(int e=0;e<4;++e){ const float a0=__uint_as_float(v[e]<<16)*__uint_as_float(gq[e]<<16), a1=__uint_as_float(v[e]&0xffff0000u)*__uint_as_float(gq[e]&0xffff0000u); w[e]=cvtpk_s(a0,a1); }
      ATTN_STORE16(Ow+(long)row*DM+ch*8,w);} }
  asm volatile("s_waitcnt lgkmcnt(0)\n\ts_barrier":::"memory");
  #undef CBIAS
  #undef DMA_K
  #undef DMA_V
  #undef CMASK
  #undef START
  #undef RESC
  #undef ROT
}
constexpr int ATTN_LDS_BYTES=LDS_BYTES;
struct AttnTensors { const bf16* Q; const bf16* K; const bf16* V; bf16* O; const bf16* G; const float* CL; };
struct AttnUnit { int bh; int qb; };
struct StaticOrder {
  int vcu, G;
  __device__ __forceinline__ explicit StaticOrder(int grid,int block):vcu((grid%8==0)?(block%8)*(grid/8)+block/8:block),G(grid){}
  __device__ __forceinline__ bool next(int i,AttnUnit&u)const{
    if(G==256){ if(i>=8)return false; const int j=2*(i>>1)+(vcu&1); u.bh=vcu>>1; u.qb=(i&1)?15-j:j; return true; }
    const int idx=i*G+vcu; if(idx>=BATCH*NHEAD*NQB)return false; u.bh=idx/NQB; u.qb=NQB-1-idx%NQB; return true; }
  __device__ __forceinline__ void a_ready(const AttnUnit&)const{}
  __device__ __forceinline__ void done(const AttnUnit&)const{}
};
template<class Sched,int THRL=8> __device__ __forceinline__ void attn_phase(char*lds,const AttnTensors&T,const Sched&S,int wave_s){
  AttnUnit u;
  for(int i=0;S.next(i,u);++i){ S.a_ready(u); attn_unit<THRL>(u.bh/NHEAD,u.bh%NHEAD,u.qb,T.Q,T.K,T.V,T.O,T.G,T.CL,lds,wave_s); S.done(u); }
}
#undef SBAR
#undef WAIT_BAR
}
#define GAS __attribute__((address_space(1)))
#define LAS __attribute__((address_space(3)))
typedef unsigned short bfu;
typedef unsigned v4u __attribute__((ext_vector_type(4)));
typedef unsigned v2u __attribute__((ext_vector_type(2)));
typedef float f32x4 __attribute__((ext_vector_type(4)));
typedef short bf16x8 __attribute__((ext_vector_type(8)));
#define LDS_WAIT() asm volatile("s_waitcnt lgkmcnt(0)" ::: "memory")
constexpr int NWAVES = 8;
constexpr int BATCH = 8, SEQ = 4096, D = 1024, FF = 2816, T = BATCH * SEQ, PLE = 256, NKVF = 2064, NKVFP = 2304;
constexpr float EPS = 1e-6f, LOG2E = 1.4426950408889634f;
constexpr size_t MiB = 1u << 20;
constexpr size_t E_W1IN = 0, N_WIN = (size_t)2 * FF * D, N_WOUT = (size_t)D * FF;
constexpr size_t E_W1OUT = E_W1IN + 2 * N_WIN, E_W2IN = E_W1OUT + 2 * N_WOUT, E_W2OUT = E_W2IN + 2 * N_WIN, E_WHIN = E_W2OUT + 2 * N_WOUT;
constexpr size_t E_WHOUT = E_WHIN + (size_t)4 * D * D, E_WKVF = E_WHOUT + (size_t)D * D, E_WQG = E_WKVF + (size_t)NKVFP * D, E_WFO = E_WQG + (size_t)2 * D * D;
constexpr size_t E_WPG = E_WFO + (size_t)D * D, E_WPP = E_WPG + (size_t)2 * D * D, E_WEND = E_WPP + (size_t)2 * D * PLE;
static_assert(E_WEND * 2 <= 92 * MiB, "weights fit");
constexpr size_t WS_P = 92 * MiB, WS_LOGF = 124 * MiB, WS_C = 126 * MiB, WS_AY = 128 * MiB, WS_BIG = 192 * MiB, WS_PROJ = 448 * MiB, WS_END = 512 * MiB;
constexpr size_t WS_V = WS_BIG + 192 * MiB, WS_K = WS_PROJ, WS_Q = WS_BIG, WS_G = WS_BIG + 64 * MiB;
constexpr int LDS_BYTES = 147456;

__device__ __forceinline__ float wave_sum(float v) {
#pragma unroll
    for (int o = 1; o < 64; o <<= 1) v += __shfl_xor(v, o);
    return v;
}
__device__ __forceinline__ unsigned pk2(float lo, float hi) { return pg8::cvt_pk_bf16(lo, hi); }
__device__ __forceinline__ float bf2f(unsigned short u) { return __uint_as_float((unsigned)u << 16); }
__device__ __forceinline__ unsigned short f2b(float f) { return (unsigned short)(pk2(f, 0.f) & 0xffffu); }

__device__ __forceinline__ void conv_item(const float* W, int K, int N, bfu* WT, const float* gain, int gmask, int sw, LAS float* scr, int item, int lane) {
    const int nblk = (N + 31) / 32, kb = item / nblk, nb = item % nblk, k0 = 64 * kb, n0 = 32 * nb;
    const int nn = n0 + (lane & 31); const bool nok = nn < N;
    const int c = lane & 7;
    f32x4 ga = (f32x4){1.f, 1.f, 1.f, 1.f}, gb = ga;
    if (gain) { ga = *(const f32x4*)(gain + ((k0 + 8 * c) & gmask)); gb = *(const f32x4*)(gain + ((k0 + 8 * c) & gmask) + 4); }
    float wv[32];
#pragma unroll
    for (int i = 0; i < 32; ++i) { const int kk = 2 * i + (lane >> 5); wv[i] = nok ? W[(size_t)(k0 + kk) * N + nn] : 0.f; }
#pragma unroll
    for (int i = 0; i < 32; ++i) { const int kk = 2 * i + (lane >> 5); scr[kk * 33 + (lane & 31)] = wv[i]; }
    LDS_WAIT(); asm volatile("" ::: "memory");
    int drow0 = n0; if (sw) { const int j0 = (n0 < FF) ? n0 : n0 - FF; drow0 = 256 * (j0 >> 7) + (j0 & 127) + ((n0 < FF) ? 0 : 128); }
#pragma unroll
    for (int j = 0; j < 4; ++j) { const int n = (lane >> 3) + 8 * j; const LAS float* s = scr + (8 * c) * 33 + n;
        v4u o; o.x = pk2(s[0 * 33] * ga[0], s[1 * 33] * ga[1]); o.y = pk2(s[2 * 33] * ga[2], s[3 * 33] * ga[3]); o.z = pk2(s[4 * 33] * gb[0], s[5 * 33] * gb[1]); o.w = pk2(s[6 * 33] * gb[2], s[7 * 33] * gb[3]);
        *(v4u*)(WT + (size_t)(drow0 + n) * K + k0 + 8 * c) = o; }
    LDS_WAIT(); asm volatile("" ::: "memory");
}
__device__ __forceinline__ void rms_row_to_bf16(const float* xrow, bfu* orow, int lane) {
    const f32x4* xr = (const f32x4*)xrow + lane;
    f32x4 v[4]; float s = 0.f;
#pragma unroll
    for (int j = 0; j < 4; ++j) { v[j] = xr[64 * j]; s += (v[j].x * v[j].x + v[j].y * v[j].y) + (v[j].z * v[j].z + v[j].w * v[j].w); }
    const float r = __builtin_amdgcn_rsqf(wave_sum(s) * (1.f / D) + EPS);
    v2u* o8 = (v2u*)orow + lane;
#pragma unroll
    for (int j = 0; j < 4; ++j) { v2u w; w.x = pk2(v[j].x * r, v[j].y * r); w.y = pk2(v[j].z * r, v[j].w * r); o8[64 * j] = w; }
}
__device__ __forceinline__ void rw_phase(const float* hin, float* hout, const bfu* Y, bfu* A, const float* gain, float scale, int gw, int ngw, int lane) {
    f32x4 g[4];
#pragma unroll
    for (int j = 0; j < 4; ++j) g[j] = *((const f32x4*)gain + lane + 64 * j);
    for (int m0 = gw; m0 < T; m0 += 2 * ngw) {
        f32x4 v[2][4], y[2][4]; float s[2] = {0.f, 0.f}; const int m1 = m0 + ngw; const bool two = m1 < T;
#pragma unroll
        for (int r = 0; r < 2; ++r) { const int m = (r == 0 || two) ? (r == 0 ? m0 : m1) : m0;
            const f32x4* hr = (const f32x4*)(hin + (size_t)m * D) + lane; const v2u* yr = (const v2u*)(Y + (size_t)m * D) + lane;
#pragma unroll
            for (int j = 0; j < 4; ++j) { v[r][j] = hr[64 * j]; const v2u w = yr[64 * j]; y[r][j] = (f32x4){pg8::bflo(w.x), pg8::bfhi(w.x), pg8::bflo(w.y), pg8::bfhi(w.y)}; } }
#pragma unroll
        for (int r = 0; r < 2; ++r)
#pragma unroll
            for (int j = 0; j < 4; ++j) s[r] += (y[r][j].x * y[r][j].x + y[r][j].y * y[r][j].y) + (y[r][j].z * y[r][j].z + y[r][j].w * y[r][j].w);
        float s2[2] = {0.f, 0.f};
#pragma unroll
        for (int r = 0; r < 2; ++r) { const float ry = __builtin_amdgcn_rsqf(wave_sum(s[r]) * (1.f / D) + EPS) * scale;
#pragma unroll
            for (int j = 0; j < 4; ++j) { v[r][j] = v[r][j] + y[r][j] * ry * g[j]; s2[r] += (v[r][j].x * v[r][j].x + v[r][j].y * v[r][j].y) + (v[r][j].z * v[r][j].z + v[r][j].w * v[r][j].w); } }
#pragma unroll
        for (int r = 0; r < 2; ++r) { if (r == 1 && !two) break; const int m = r == 0 ? m0 : m1;
            const float r2 = __builtin_amdgcn_rsqf(wave_sum(s2[r]) * (1.f / D) + EPS);
            f32x4* ho = (f32x4*)(hout + (size_t)m * D) + lane; v2u* ao = (v2u*)(A + (size_t)m * D) + lane;
#pragma unroll
            for (int j = 0; j < 4; ++j) { ho[64 * j] = v[r][j]; v2u w; w.x = pk2(v[r][j].x * r2, v[r][j].y * r2); w.y = pk2(v[r][j].z * r2, v[r][j].w * r2); ao[64 * j] = w; } }
    }
}

constexpr int HG_QH = 0, HG_QT = 17408, HG_KT = 34816, HG_KHT = 52224, HG_VT = 70656, HG_PP = 89088, HG_ST = 98304, HG_TOT = 133120, HG_DV = 135168, HG_END = 135680;
constexpr int RS = 136, RS2 = 72, OFS = 132;
static_assert(HG_END <= LDS_BYTES, "hgrn lds");
__device__ __forceinline__ f32x4 mfma16(bf16x8 a, bf16x8 b, f32x4 c) { return __builtin_amdgcn_mfma_f32_16x16x32_bf16(a, b, c, 0, 0, 0); }
constexpr int HSEG = 4, HCH = SEQ / 64 / HSEG;
template <bool OUT>
__device__ __forceinline__ void hgrn_scan(LAS unsigned char* lds, bfu* QZVG, const float* lbl, int bh, int seg, float* Ebuf, float* Lbuf, int wave_s) {
    int tid_o = tid_from(wave_s); asm volatile("" : "+v"(tid_o)); const int tid = tid_o, lane = tid & 63, wid = __builtin_amdgcn_readfirstlane(tid >> 6), col = tid & 127, rg = tid >> 7, fr = lane & 15, fq = lane >> 4;
    const int b = bh >> 3, h = bh & 7;
    LAS bfu* QH = (LAS bfu*)(lds + HG_QH); LAS bfu* QT = (LAS bfu*)(lds + HG_QT); LAS bfu* KT = (LAS bfu*)(lds + HG_KT); LAS bfu* KHT = (LAS bfu*)(lds + HG_KHT);
    LAS bfu* VT = (LAS bfu*)(lds + HG_VT); LAS bfu* PP = (LAS bfu*)(lds + HG_PP); LAS bfu* ST = (LAS bfu*)(lds + HG_ST);
    LAS float* TOT = (LAS float*)(lds + HG_TOT); LAS float* DV = (LAS float*)(lds + HG_DV); LAS float* OF = (LAS float*)(lds + HG_QT);
    const float l0 = lbl[h * 128 + col], l1 = lbl[1024 + h * 128 + col];
    const float lb = 1.f / (1.f + __expf(l1 - l0)), omlb = 1.f - lb;
    bfu* base = QZVG + ((size_t)b * SEQ + (size_t)seg * HCH * 64) * 4096 + h * 128;
    const bfu* pq = base + (size_t)(16 * rg) * 4096 + col; const bfu* pz = pq + 1024; const bfu* pv = pq + 2048;
    const int erow = tid >> 3, eseg = tid & 7;
    const bfu* pg = base + 3072 + (size_t)erow * 4096 + 16 * eseg; bfu* po = base + (size_t)erow * 4096 + 16 * eseg;
    f32x4 Sacc[8];
#pragma unroll
    for (int i = 0; i < 8; ++i) Sacc[i] = (f32x4){0.f, 0.f, 0.f, 0.f};
    float Lacc = 0.f;
    if constexpr (OUT) {
        for (int j = 0; j < seg; ++j) {
            const float* Ej = Ebuf + ((size_t)(bh * HSEG + j) * 64 * 64) * 4 + (size_t)(wid * 8) * 64 * 4; const float* Lj = Lbuf + (size_t)(bh * HSEG + j) * 128;
#pragma unroll
            for (int kb = 0; kb < 8; ++kb) { const f32x4 e = *(const f32x4*)(Ej + ((size_t)kb * 64 + lane) * 4); const f32x4 l4 = *(const f32x4*)(Lj + 16 * kb + 4 * fq);
                f32x4 s = Sacc[kb]; s[0] = s[0] * __expf(l4[0]) + e[0]; s[1] = s[1] * __expf(l4[1]) + e[1]; s[2] = s[2] * __expf(l4[2]) + e[2]; s[3] = s[3] * __expf(l4[3]) + e[3]; Sacc[kb] = s; }
        }
#pragma unroll
        for (int kb = 0; kb < 8; ++kb) *(LAS v2u*)(ST + (16 * wid + fr) * RS + 16 * kb + 4 * fq) = (v2u){pk2(Sacc[kb][0], Sacc[kb][1]), pk2(Sacc[kb][2], Sacc[kb][3])};
    }
    unsigned short zr[16], qr[16], vr[16]; v4u gr0 = (v4u){0u, 0u, 0u, 0u}, gr1 = gr0;
#define HG_LOAD() do { _Pragma("unroll") for (int j = 0; j < 16; ++j) { zr[j] = pz[(size_t)j * 4096]; vr[j] = pv[(size_t)j * 4096]; if (OUT) qr[j] = pq[(size_t)j * 4096]; else qr[j] = 0; } \
        if (OUT) { gr0 = *(const v4u*)pg; gr1 = *(const v4u*)(pg + 8); } pz += (size_t)64 * 4096; pq += (size_t)64 * 4096; pv += (size_t)64 * 4096; pg += (size_t)64 * 4096; } while (0)
    HG_LOAD();
    for (int c = 0; c < HCH; ++c) {
        float kk[16], cum[16], qf[16]; unsigned short vv[16]; const v4u g0 = gr0, g1 = gr1;
        float run = 0.f;
#pragma unroll
        for (int j = 0; j < 16; ++j) { const float z = bf2f(zr[j]); const float k = omlb * __builtin_amdgcn_rcpf(1.f + __expf(z)); run += __logf(1.f - k); cum[j] = run; kk[j] = k; qf[j] = bf2f(qr[j]); vv[j] = vr[j]; }
        TOT[rg * 128 + col] = run;
        if (c + 1 < HCH) HG_LOAD();
        LDS_WAIT(); __builtin_amdgcn_s_barrier(); asm volatile("" ::: "memory");
        const float t0 = TOT[col], t1 = TOT[128 + col], t2 = TOT[256 + col], t3 = TOT[384 + col];
        const float pre = (rg > 0 ? t0 : 0.f) + (rg > 1 ? t1 : 0.f) + (rg > 2 ? t2 : 0.f), tot = (t0 + t1) + (t2 + t3), mid = t0 + t1;
        Lacc += tot;
        unsigned khp[8], vvp[8];
#pragma unroll
        for (int j = 0; j < 16; ++j) { const float cj = pre + cum[j]; const int r = 16 * rg + j;
            if constexpr (OUT) { QH[r * RS + col] = f2b(qf[j] * __expf(cj)); QT[r * RS + col] = f2b(qf[j] * __expf(cj - mid)); KT[r * RS + col] = f2b(kk[j] * __expf(mid - cj)); }
            const unsigned short kh = f2b(kk[j] * __expf(tot - cj));
            if (j & 1) { khp[j >> 1] |= (unsigned)kh << 16; vvp[j >> 1] |= (unsigned)vv[j] << 16; } else { khp[j >> 1] = kh; vvp[j >> 1] = vv[j]; } }
        *(LAS v4u*)(KHT + col * RS2 + 16 * rg) = (v4u){khp[0], khp[1], khp[2], khp[3]}; *(LAS v4u*)(KHT + col * RS2 + 16 * rg + 8) = (v4u){khp[4], khp[5], khp[6], khp[7]};
        *(LAS v4u*)(VT + col * RS2 + 16 * rg) = (v4u){vvp[0], vvp[1], vvp[2], vvp[3]}; *(LAS v4u*)(VT + col * RS2 + 16 * rg + 8) = (v4u){vvp[4], vvp[5], vvp[6], vvp[7]};
        if (rg == 0) DV[col] = __expf(tot);
        LDS_WAIT(); __builtin_amdgcn_s_barrier(); asm volatile("" ::: "memory");
        if constexpr (OUT) {
            const int tb = wid >> 1;
#pragma unroll
            for (int ss = 0; ss < 2; ++ss) { const int sb = 2 * (wid & 1) + ss; f32x4 sc = (f32x4){0.f, 0.f, 0.f, 0.f};
                if (sb <= tb) {
#pragma unroll
                    for (int ks = 0; ks < 4; ++ks) { const bf16x8 a = *(const LAS bf16x8*)(QT + (16 * tb + fr) * RS + 32 * ks + 8 * fq), bq = *(const LAS bf16x8*)(KT + (16 * sb + fr) * RS + 32 * ks + 8 * fq); sc = mfma16(a, bq, sc); } }
#pragma unroll
                for (int i = 0; i < 4; ++i) { const int t = 16 * tb + 4 * fq + i, s = 16 * sb + fr; PP[t * RS2 + s] = f2b((sb <= tb && s <= t) ? sc[i] : 0.f); } }
            LDS_WAIT(); __builtin_amdgcn_s_barrier(); asm volatile("" ::: "memory");
        }
        {   bf16x8 vtf[2];
#pragma unroll
            for (int ks = 0; ks < 2; ++ks) vtf[ks] = *(const LAS bf16x8*)(VT + (16 * wid + fr) * RS2 + 32 * ks + 8 * fq);
            if constexpr (OUT) { bf16x8 stf[4];
#pragma unroll
                for (int ks = 0; ks < 4; ++ks) stf[ks] = *(const LAS bf16x8*)(ST + (16 * wid + fr) * RS + 32 * ks + 8 * fq);
#pragma unroll
                for (int tb = 0; tb < 4; ++tb) { f32x4 o = (f32x4){0.f, 0.f, 0.f, 0.f};
#pragma unroll
                    for (int ks = 0; ks < 4; ++ks) o = mfma16(*(const LAS bf16x8*)(QH + (16 * tb + fr) * RS + 32 * ks + 8 * fq), stf[ks], o);
#pragma unroll
                    for (int ks = 0; ks < 2; ++ks) o = mfma16(*(const LAS bf16x8*)(PP + (16 * tb + fr) * RS2 + 32 * ks + 8 * fq), vtf[ks], o);
#pragma unroll
                    for (int i = 0; i < 4; ++i) OF[(16 * tb + 4 * fq + i) * OFS + 16 * wid + fr] = o[i]; } }
#pragma unroll
            for (int kb = 0; kb < 8; ++kb) { const f32x4 d4 = *(const LAS f32x4*)(DV + 16 * kb + 4 * fq); f32x4 s = Sacc[kb] * d4;
#pragma unroll
                for (int ks = 0; ks < 2; ++ks) s = mfma16(*(const LAS bf16x8*)(KHT + (16 * kb + fr) * RS2 + 32 * ks + 8 * fq), vtf[ks], s);
                Sacc[kb] = s; if constexpr (OUT) *(LAS v2u*)(ST + (16 * wid + fr) * RS + 16 * kb + 4 * fq) = (v2u){pk2(s[0], s[1]), pk2(s[2], s[3])}; }
        }
        if constexpr (OUT) {
            LDS_WAIT(); __builtin_amdgcn_s_barrier(); asm volatile("" ::: "memory");
            f32x4 o4[4]; float ss = 0.f;
#pragma unroll
            for (int j = 0; j < 4; ++j) { o4[j] = *(const LAS f32x4*)(OF + erow * OFS + 16 * eseg + 4 * j); ss += (o4[j].x * o4[j].x + o4[j].y * o4[j].y) + (o4[j].z * o4[j].z + o4[j].w * o4[j].w); }
            ss += __shfl_xor(ss, 1); ss += __shfl_xor(ss, 2); ss += __shfl_xor(ss, 4);
            const float rs = __builtin_amdgcn_rsqf(ss * (1.f / 128.f) + EPS);
            unsigned w[8];
#pragma unroll
            for (int j = 0; j < 4; ++j) { const unsigned ga = (j < 2) ? g0[2 * j] : g1[2 * (j - 2)], gb = (j < 2) ? g0[2 * j + 1] : g1[2 * (j - 2) + 1];
                const float a0 = pg8::bflo(ga), a1 = pg8::bfhi(ga), a2 = pg8::bflo(gb), a3 = pg8::bfhi(gb);
                w[2 * j] = pk2(o4[j].x * rs * a0 * pg8::fsigmoid(a0), o4[j].y * rs * a1 * pg8::fsigmoid(a1)); w[2 * j + 1] = pk2(o4[j].z * rs * a2 * pg8::fsigmoid(a2), o4[j].w * rs * a3 * pg8::fsigmoid(a3)); }
            *(v4u*)po = (v4u){w[0], w[1], w[2], w[3]}; *(v4u*)(po + 8) = (v4u){w[4], w[5], w[6], w[7]}; po += (size_t)64 * 4096;
        }
    }
#undef HG_LOAD
    if constexpr (!OUT) {
        float* Es = Ebuf + ((size_t)(bh * HSEG + seg) * 64 * 64) * 4 + (size_t)(wid * 8) * 64 * 4;
#pragma unroll
        for (int kb = 0; kb < 8; ++kb) *(f32x4*)(Es + ((size_t)kb * 64 + lane) * 4) = Sacc[kb];
        if (rg == 0) Lbuf[(size_t)(bh * HSEG + seg) * 128 + col] = Lacc;
    }
    LDS_WAIT(); __builtin_amdgcn_s_barrier(); asm volatile("" ::: "memory");
}

__device__ __forceinline__ void cumsum_bh(LAS unsigned char* lds, const float* LOGF, float* C, int bh, int wave_s) {
    const int tid = tid_from(wave_s), lane = tid & 63, wid = tid >> 6, b = bh >> 4, h = bh & 15;
    LAS float* wsum = (LAS float*)lds;
    const float* src = LOGF + ((size_t)b * SEQ + 8 * tid) * 16 + h;
    float v[8]; float run = 0.f;
#pragma unroll
    for (int j = 0; j < 8; ++j) { run += src[j * 16]; v[j] = run; }
    float inc = run;
#pragma unroll
    for (int o = 1; o < 64; o <<= 1) { const float t = __shfl_up(inc, o); if (lane >= o) inc += t; }
    if (lane == 63) wsum[wid] = inc;
    LDS_WAIT(); __builtin_amdgcn_s_barrier(); asm volatile("" ::: "memory");
    float off = inc - run;
    for (int w = 0; w < wid; ++w) off += wsum[w];
    float* dst = C + (size_t)bh * SEQ + 8 * tid;
    *(f32x4*)dst = (f32x4){(off + v[0]) * LOG2E, (off + v[1]) * LOG2E, (off + v[2]) * LOG2E, (off + v[3]) * LOG2E};
    *(f32x4*)(dst + 4) = (f32x4){(off + v[4]) * LOG2E, (off + v[5]) * LOG2E, (off + v[6]) * LOG2E, (off + v[7]) * LOG2E};
    LDS_WAIT(); __builtin_amdgcn_s_barrier(); asm volatile("" ::: "memory");
}

#define RLX_AGENT __ATOMIC_RELAXED, __HIP_MEMORY_SCOPE_AGENT
#define XB_TMO      128
#define XB_XCNT(j)  (256  + 64 * (j))
#define XB_XSUB(j)  (1280 + 64 * (j))
#define XB_XGEN(j)  (2304 + 64 * (j))
#define XB_TOP      3328
#define XB_TOPGEN   3392
#define XCD_BAR_WORDS 3456
#define XB_SPIN_CAP (1u << 18)

__device__ __forceinline__ unsigned xb_ld(unsigned* p)              { return __hip_atomic_load(p, __ATOMIC_RELAXED, __HIP_MEMORY_SCOPE_AGENT); }
__device__ __forceinline__ unsigned xb_add(unsigned* p, unsigned v) { return __hip_atomic_fetch_add(p, v, __ATOMIC_RELAXED, __HIP_MEMORY_SCOPE_AGENT); }
__device__ __forceinline__ unsigned xb_xcc_id() { return (unsigned)__builtin_amdgcn_s_getreg((3 << 11) | 20) & 0xFu; }
#define XB_SPIN(cond, bar) do { unsigned _sp = 0; while (cond) { __builtin_amdgcn_s_sleep(1); \
    if ((++_sp & 255u) == 0u) { if (xb_ld(&(bar)[XB_TMO])) break; if (_sp > XB_SPIN_CAP) { atomicAdd(&(bar)[XB_TMO], 1u); break; } } } } while (0)

struct XcdBarrier {
    unsigned* bar; unsigned x;
    volatile LAS unsigned* st;
};

__device__ __forceinline__ XcdBarrier xcd_barrier_post(unsigned* bar, volatile LAS unsigned* st, bool is_t0) {
    XcdBarrier b; b.bar = bar; b.x = xb_xcc_id(); b.st = st;
    if (is_t0) (void)xb_add(&bar[XB_XCNT(b.x)], 1u);
    return b;
}
__device__ __forceinline__ void xcd_barrier_complete(unsigned* bar, unsigned x, unsigned& nloc, unsigned& nx) {
    const unsigned G = gridDim.x * gridDim.y * gridDim.z;
    unsigned sum, cnt, mine, sp = 0u;
    for (;;) {
        sum = 0u; cnt = 0u; mine = 0u;
#pragma unroll
        for (unsigned j = 0; j < 16; ++j) { const unsigned c = xb_ld(&bar[XB_XCNT(j)]); sum += c; cnt += (c > 0u) ? 1u : 0u; mine = (j == x) ? c : mine; }
        if (sum == G) break;
        __builtin_amdgcn_s_sleep(1);
        if ((++sp & 255u) == 0u) { if (xb_ld(&bar[XB_TMO])) break; if (sp > XB_SPIN_CAP) { atomicAdd(&bar[XB_TMO], 1u); break; } }
    }
    nloc = mine > 0u ? mine : 1u; nx = cnt > 0u ? cnt : 1u;
}

__device__ __forceinline__ void xcd_barrier(const XcdBarrier& b, bool is_t0) {
    asm volatile("s_waitcnt vmcnt(0)" ::: "memory");
    __syncthreads();
    if (is_t0) {
        unsigned* bar = b.bar;
        __builtin_amdgcn_s_waitcnt(0);
        unsigned nloc = b.st[0], nx = b.st[1];
        if (nloc == 0u) { xcd_barrier_complete(bar, b.x, nloc, nx); b.st[0] = nloc; b.st[1] = nx; }
        const unsigned old = xb_add(&bar[XB_XSUB(b.x)], 1u);
        const unsigned gen = old / nloc;
        if (old + 1u == (gen + 1u) * nloc) {
            __builtin_amdgcn_fence(__ATOMIC_RELEASE, "agent");
            asm volatile("s_waitcnt vmcnt(0)" ::: "memory");
            const unsigned og = xb_add(&bar[XB_TOP], 1u);
            const unsigned tg = og / nx;
            if (og + 1u == (tg + 1u) * nx) xb_add(&bar[XB_TOPGEN], 1u);
            else XB_SPIN(xb_ld(&bar[XB_TOPGEN]) == tg, bar);
            __builtin_amdgcn_fence(__ATOMIC_ACQUIRE, "agent");
            xb_add(&bar[XB_XGEN(b.x)], 1u);
            asm volatile("s_waitcnt vmcnt(0)" ::: "memory");
        } else {
            XB_SPIN(xb_ld(&bar[XB_XGEN(b.x)]) == gen, bar);
            __builtin_amdgcn_fence(__ATOMIC_ACQUIRE, "agent");
            asm volatile("s_waitcnt vmcnt(0)" ::: "memory");
        }
    }
    __syncthreads();
}

constexpr size_t WS_CTL = E_WEND * 2, CTL_BYTES = 16384; static_assert(WS_CTL % 256 == 0 && WS_CTL + CTL_BYTES <= WS_P && XCD_BAR_WORDS * 4 <= CTL_BYTES, "ctl");
constexpr int LDS_BARST = LDS_BYTES - 64;
struct Args { const float* in[25]; float* out; unsigned char* ws; int st_lo, st_hi; };
enum { ST_PRO, ST_F1I0, ST_F1O0, ST_RW00, ST_HIN, ST_HS1, ST_HS2, ST_HOUT, ST_RW01, ST_F2I0, ST_F2O0, ST_PP0, ST_RW02, ST_PG0, ST_RW03, ST_KVF, ST_F1I1, ST_CUM, ST_F1O1, ST_RW10, ST_QG, ST_ATT, ST_FOUT, ST_RW11, ST_F2I1, ST_F2O1, ST_PP1, ST_RW12, ST_PG1, ST_RW13, NSTEP };
__host__ __device__ constexpr bool sync_before(int s) { return !(s == ST_PRO || s == ST_PP0 || s == ST_F1I1 || s == ST_F1O1 || s == ST_PP1); }
enum { K_PRO = 0, K_FFN_IN, K_FFN_OUT, K_RW, K_HGRN_IN, K_HGRN, K_HGRN_OUT, K_PLE_PROJ, K_PLE_GATE, K_KVF, K_CUMSUM, K_QG, K_ATTN, K_FOX_OUT };

__global__ void __launch_bounds__(NWAVES * 64, 2) yoco_fwd(Args args) {
    extern __shared__ __attribute__((aligned(16))) unsigned char lds[];
    cg::grid_group grid = cg::this_grid();
    LAS unsigned char* ldsp = (LAS unsigned char*)lds;
    const int st_lo = args.st_lo, st_hi = args.st_hi;
    const int wave_s = __builtin_amdgcn_readfirstlane((int)(threadIdx.x >> 6));
    if (tid_from(wave_s) < 2) ((volatile LAS unsigned*)(ldsp + LDS_BARST))[tid_from(wave_s)] = 0u;
    __syncthreads();
    (void)xcd_barrier_post((unsigned*)(args.ws + WS_CTL), (volatile LAS unsigned*)(ldsp + LDS_BARST), tid_from(wave_s) == 0);
#define STEP_BEGIN(k) if (st_lo <= (k) && (k) < st_hi) { if ((k) > st_lo && sync_before(k)) { if ((k) == ST_F1I0) { asm volatile("s_waitcnt vmcnt(0) lgkmcnt(0)" ::: "memory"); grid.sync(); __builtin_amdgcn_fence(__ATOMIC_ACQUIRE, "agent"); asm volatile("s_waitcnt vmcnt(0)" ::: "memory"); } \
          else { XcdBarrier xb_; xb_.bar = (unsigned*)(((const __attribute__((address_space(4))) Args*)__builtin_amdgcn_kernarg_segment_ptr())->ws + WS_CTL); xb_.x = xb_xcc_id(); xb_.st = (volatile LAS unsigned*)(ldsp + LDS_BARST); xcd_barrier(xb_, tid_from(wave_s) == 0); } } \
        const __attribute__((address_space(4))) Args* ap = (const __attribute__((address_space(4))) Args*)__builtin_amdgcn_kernarg_segment_ptr(); asm volatile("" : "+s"(ap)); \
        int tid_k = tid_from(wave_s); asm volatile("" : "+v"(tid_k)); const int tid = tid_k, lane = tid & 63, wave = __builtin_amdgcn_readfirstlane(tid >> 6); \
        const int G = gridDim.x, bx = blockIdx.x; unsigned char* ws = ap->ws; bfu* Wb = (bfu*)ws; bfu* PB = (bfu*)(ws + WS_P); float* LOGF = (float*)(ws + WS_LOGF); float* CL = (float*)(ws + WS_C); \
        bfu* AY = (bfu*)(ws + WS_AY); bfu* BIG = (bfu*)(ws + WS_BIG); bfu* PROJ = (bfu*)(ws + WS_PROJ); const int gw = bx * NWAVES + wave, ngw = G * NWAVES; \
        (void)tid; (void)lane; (void)Wb; (void)PB; (void)LOGF; (void)CL; (void)AY; (void)BIG; (void)PROJ; (void)gw; (void)ngw;
#define STEP_END }
#define RUN_GEMM(MODE, A_, LDA_, Bt_, N_, K_, O_, LDC_, O2_, AUX_, SC_) do { const pg8::Gemm g{A_, Bt_, T, N_, K_, LDA_}; pg8::StaticOrder S; S.init(T, N_, G, bx); \
        const pg8::Epi<MODE, LDC_> E{O_, O2_, AUX_, LOGF, ap->in[18], SC_}; pg8::gemm_phase<pg8::Epi<MODE, LDC_>, pg8::StaticOrder, true, true, K_, LDA_>(ldsp, g, S, E, wave_s); } while (0)
#define NOB ((bfu*)nullptr)
#define S_FFN_IN(k, L, w)  STEP_BEGIN(k) RUN_GEMM(pg8::EP_SWIGLU, AY, D, Wb + ((w) == 1 ? E_W1IN : E_W2IN) + (L) * N_WIN, 2 * FF, D, BIG, FF, NOB, NOB, 1.f); STEP_END
#define S_FFN_OUT(k, L, w) STEP_BEGIN(k) RUN_GEMM(pg8::EP_PLAIN, BIG, FF, Wb + ((w) == 1 ? E_W1OUT : E_W2OUT) + (L) * N_WOUT, D, FF, AY, D, NOB, NOB, 1.f); STEP_END
#define S_PLE_PROJ(k, L)   STEP_BEGIN(k) RUN_GEMM(pg8::EP_PLAIN, PB + (size_t)(L) * T * PLE, PLE, Wb + E_WPP + (size_t)(L) * PLE * D, D, PLE, PROJ, D, NOB, NOB, 1.f); STEP_END
#define S_PLE_GATE(k, L)   STEP_BEGIN(k) RUN_GEMM(pg8::EP_PLEGATE, AY, D, Wb + E_WPG + (size_t)(L) * D * D, D, D, BIG, D, NOB, PROJ, 1.f); STEP_END
#define S_RW(k, L, w)      STEP_BEGIN(k) { const float* hin = ((L) == 0 && (w) == 0) ? ap->in[0] : ap->out; const bfu* Y = ((w) == 3) ? BIG : AY; \
        const float* gain = ((w) == 0 ? ap->in[5] : (w) == 1 ? ap->in[7] : (w) == 2 ? ap->in[11] : ap->in[24]) + (L) * D; \
        rw_phase(hin, ap->out, Y, AY, gain, ((w) == 0 || (w) == 2) ? 0.5f : 1.0f, gw, ngw, lane); } STEP_END

    STEP_BEGIN(ST_PRO) {
        LAS float* scr = (LAS float*)(ldsp + wave * 16384);
        for (int it = gw;; it += ngw) {
            int r = it;
#define CONV(src, K_, N_, dst, gain, gmask, sw) { constexpr int NI = ((K_) / 64) * (((N_) + 31) / 32); if (r < NI) { conv_item(src, K_, N_, dst, gain, gmask, sw, scr, r, lane); continue; } r -= NI; }
            CONV(ap->in[3], D, 2 * FF, Wb + E_W1IN, ap->in[2], 1023, 1)
            CONV(ap->in[3] + N_WIN, D, 2 * FF, Wb + E_W1IN + N_WIN, ap->in[2] + D, 1023, 1)
            CONV(ap->in[9], D, 2 * FF, Wb + E_W2IN, ap->in[8], 1023, 1)
            CONV(ap->in[9] + N_WIN, D, 2 * FF, Wb + E_W2IN + N_WIN, ap->in[8] + D, 1023, 1)
            CONV(ap->in[4], FF, D, Wb + E_W1OUT, (const float*)nullptr, 0, 0)
            CONV(ap->in[4] + N_WOUT, FF, D, Wb + E_W1OUT + N_WOUT, (const float*)nullptr, 0, 0)
            CONV(ap->in[10], FF, D, Wb + E_W2OUT, (const float*)nullptr, 0, 0)
            CONV(ap->in[10] + N_WOUT, FF, D, Wb + E_W2OUT + N_WOUT, (const float*)nullptr, 0, 0)
            CONV(ap->in[12], D, 4 * D, Wb + E_WHIN, ap->in[6], 1023, 0)
            CONV(ap->in[15], D, D, Wb + E_WHOUT, ap->in[14], 127, 0)
            CONV(ap->in[17], D, NKVF, Wb + E_WKVF, ap->in[16], 1023, 0)
            CONV(ap->in[19], D, 2 * D, Wb + E_WQG, ap->in[6] + D, 1023, 0)
            CONV(ap->in[20], D, D, Wb + E_WFO, (const float*)nullptr, 0, 0)
            CONV(ap->in[22], D, D, Wb + E_WPG, ap->in[21], 1023, 0)
            CONV(ap->in[22] + (size_t)D * D, D, D, Wb + E_WPG + (size_t)D * D, ap->in[21] + D, 1023, 0)
            CONV(ap->in[23], PLE, D, Wb + E_WPP, (const float*)nullptr, 0, 0)
            CONV(ap->in[23] + (size_t)PLE * D, PLE, D, Wb + E_WPP + (size_t)PLE * D, (const float*)nullptr, 0, 0)
#undef CONV
            break;
        }
        {   const float* p = ap->in[1]; const size_t n8 = (size_t)2 * T * PLE / 8;
            for (size_t i = (size_t)bx * 512 + tid; i < n8; i += (size_t)G * 512) { const f32x4 a = *((const f32x4*)p + 2 * i), c = *((const f32x4*)p + 2 * i + 1);
                *((v4u*)PB + i) = (v4u){pk2(a.x, a.y), pk2(a.z, a.w), pk2(c.x, c.y), pk2(c.z, c.w)}; } }
        const float* x = ap->in[0];
        for (int m = gw; m < T; m += 2 * ngw) { rms_row_to_bf16(x + (size_t)m * D, AY + (size_t)m * D, lane); if (m + ngw < T) rms_row_to_bf16(x + (size_t)(m + ngw) * D, AY + (size_t)(m + ngw) * D, lane); }
    } STEP_END
    S_FFN_IN(ST_F1I0, 0, 1) S_FFN_OUT(ST_F1O0, 0, 1) S_RW(ST_RW00, 0, 0)
    STEP_BEGIN(ST_HIN) RUN_GEMM(pg8::EP_PLAIN, AY, D, Wb + E_WHIN, 4 * D, D, BIG, 4 * D, NOB, NOB, 1.f); STEP_END
    STEP_BEGIN(ST_HS1) { const float* lbl = ap->in[13]; float* Eb = (float*)AY; float* Lb = (float*)(ws + WS_AY + 32 * MiB);
        for (int it = bx; it < BATCH * 8 * HSEG; it += G) if ((it & 3) != 3) hgrn_scan<false>(ldsp, BIG, lbl, it >> 2, it & 3, Eb, Lb, wave_s); } STEP_END
    STEP_BEGIN(ST_HS2) { const float* lbl = ap->in[13]; float* Eb = (float*)AY; float* Lb = (float*)(ws + WS_AY + 32 * MiB);
        for (int it = bx; it < BATCH * 8 * HSEG; it += G) hgrn_scan<true>(ldsp, BIG, lbl, it >> 2, it & 3, Eb, Lb, wave_s); } STEP_END
    STEP_BEGIN(ST_HOUT) RUN_GEMM(pg8::EP_PLAIN, BIG, 4 * D, Wb + E_WHOUT, D, D, AY, D, NOB, NOB, 1.f); STEP_END
    S_RW(ST_RW01, 0, 1) S_FFN_IN(ST_F2I0, 0, 2) S_FFN_OUT(ST_F2O0, 0, 2) S_PLE_PROJ(ST_PP0, 0) S_RW(ST_RW02, 0, 2) S_PLE_GATE(ST_PG0, 0) S_RW(ST_RW03, 0, 3)
    STEP_BEGIN(ST_KVF) RUN_GEMM(pg8::EP_KVF, AY, D, Wb + E_WKVF, NKVFP, D, (bfu*)(ws + WS_K), D, (bfu*)(ws + WS_V), NOB, 1.f); STEP_END
    S_FFN_IN(ST_F1I1, 1, 1)
    STEP_BEGIN(ST_CUM) { for (int bh = bx; bh < BATCH * 16; bh += G) cumsum_bh(ldsp, LOGF, CL, bh, wave_s); } STEP_END
    S_FFN_OUT(ST_F1O1, 1, 1) S_RW(ST_RW10, 1, 0)
    STEP_BEGIN(ST_QG) RUN_GEMM(pg8::EP_QG, AY, D, Wb + E_WQG, 2 * D, D, (bfu*)(ws + WS_Q), D, (bfu*)(ws + WS_G), NOB, attn_body::C2); STEP_END
    STEP_BEGIN(ST_ATT) {
        const attn_body::AttnTensors AT{(const attn_body::bf16*)(ws + WS_Q), (const attn_body::bf16*)(ws + WS_K), (const attn_body::bf16*)(ws + WS_V), (attn_body::bf16*)(ws + WS_Q), (const attn_body::bf16*)(ws + WS_G), CL};
        const attn_body::StaticOrder S(G, bx);
        attn_body::attn_phase<attn_body::StaticOrder>((char*)lds, AT, S, wave_s);
    } STEP_END
    STEP_BEGIN(ST_FOUT) RUN_GEMM(pg8::EP_PLAIN, (const bfu*)(ws + WS_Q), D, Wb + E_WFO, D, D, AY, D, NOB, NOB, 1.f); STEP_END
    S_RW(ST_RW11, 1, 1) S_FFN_IN(ST_F2I1, 1, 2) S_FFN_OUT(ST_F2O1, 1, 2) S_PLE_PROJ(ST_PP1, 1) S_RW(ST_RW12, 1, 2) S_PLE_GATE(ST_PG1, 1) S_RW(ST_RW13, 1, 3)
}

#ifndef MK_MULTI
#define MK_MULTI 0
#endif
extern "C" void kernel_launch(void* const* d_in, const int* in_sizes, int n_in, void* d_out, int out_size, void* d_ws, size_t ws_size, hipStream_t stream) {
    static int grid = 0;
    if (grid == 0) {
        if (n_in != 25 || out_size != T * D || ws_size < WS_END) { fprintf(stderr, "kernel_launch: unexpected shapes (n_in %d out %d ws %zu)\n", n_in, out_size, ws_size); grid = -1; return; }
        int dev = 0, cus = 0, per_cu = 0;
        (void)hipGetDevice(&dev); (void)hipDeviceGetAttribute(&cus, hipDeviceAttributeMultiprocessorCount, dev);
        if (hipFuncSetAttribute((const void*)yoco_fwd, hipFuncAttributeMaxDynamicSharedMemorySize, LDS_BYTES) != hipSuccess) { fprintf(stderr, "kernel_launch: hipFuncSetAttribute failed\n"); grid = -1; return; }
        if (hipOccupancyMaxActiveBlocksPerMultiprocessor(&per_cu, (const void*)yoco_fwd, NWAVES * 64, LDS_BYTES) != hipSuccess || per_cu < 1) per_cu = 1;
        (void)hipGetLastError();
        if (cus <= 0) cus = 256;
        grid = cus * per_cu;
    }
    if (grid < 0) return;
    if (hipMemsetAsync((char*)d_ws + WS_CTL, 0, CTL_BYTES, stream) != hipSuccess) { fprintf(stderr, "kernel_launch: memset failed\n"); return; }
    Args a{};
    for (int i = 0; i < 25; ++i) a.in[i] = (const float*)d_in[i];
    a.out = (float*)d_out; a.ws = (unsigned char*)d_ws;
#if MK_MULTI
    int lo = 0;
    for (int s = 1; s <= NSTEP; ++s) if (s == NSTEP || sync_before(s)) { a.st_lo = lo; a.st_hi = s; hipLaunchKernelGGL(yoco_fwd, dim3(grid), dim3(NWAVES * 64), LDS_BYTES, stream, a); lo = s; }
#else
#ifndef ST_CUT
#define ST_CUT NSTEP
#endif
    a.st_lo = 0; a.st_hi = ST_CUT;
    void* kargs[] = {&a};
    const hipError_t e = hipLaunchCooperativeKernel((const void*)yoco_fwd, dim3(grid), dim3(NWAVES * 64), kargs, LDS_BYTES, stream);
    if (e != hipSuccess) fprintf(stderr, "kernel_launch: cooperative launch failed: %s (grid %d)\n", hipGetErrorString(e), grid);
#endif
}
```

```cpp
#include <hip/hip_runtime.h>
#include <hip/hip_cooperative_groups.h>
#include <hip/hip_bf16.h>
#include <cstdio>
#include <cstdint>
#include <cmath>
namespace cg = cooperative_groups;
__device__ __forceinline__ int tid_from(int wave_s) { unsigned l; asm volatile("v_mbcnt_lo_u32_b32 %0, -1, 0\n\tv_mbcnt_hi_u32_b32 %0, -1, %0" : "=v"(l)); return wave_s * 64 + (int)l; }
namespace pg8 {
#define PG8_LAS __attribute__((address_space(3)))
typedef unsigned short bf16_t;
typedef short bf16x8 __attribute__((ext_vector_type(8)));
typedef float f32x4 __attribute__((ext_vector_type(4)));
typedef unsigned u32x4 __attribute__((ext_vector_type(4)));
constexpr int BM = 256, BK = 64, HALF = 128, HTB = HALF * BK * 2  , STAGE_BYTES = 8 * HTB, NXCD = 8, WGM = 8;

__host__ __device__ __forceinline__ int lds_byte(int r, int c) { const int st = (r >> 4) * 2 + (c >> 5), rr = r & 15, cc = c & 31, ob = rr * 64 + cc * 2; return st * 1024 + (ob ^ (((ob >> 9) & 1) << 5)); }
__host__ __device__ __forceinline__ void stage_rc(int b, int& R, int& C) { const int st = b / 1024, sb = b % 1024, swz = sb ^ (((sb >> 9) & 1) << 5); R = (st >> 1) * 16 + swz / 64; C = (st & 1) * 32 + (swz % 64) / 2; }
__host__ __device__ __forceinline__ int perm32(int rho) { const int n = rho >> 4, i = rho & 15; return 8 * (i >> 2) + 4 * n + (i & 3); }

struct Unit { int pm, pn; };
struct Gemm { const bf16_t* A; const bf16_t* Bt; int M, N, K, lda; };

struct StaticOrder {
    int nM, nN, nwg, G, c;
    __host__ __device__ void init(int M, int N, int G_, int c_) { nM = M / BM; nN = N / BM; nwg = nM * nN; G = G_; c = c_; }
    __host__ __device__ bool next(int i, Unit& u) const {
        const long L = (long)i * G + c; if (L >= nwg) return false;
        int wgid = (int)L; { const int q = nwg / NXCD, r = nwg % NXCD, xcd = wgid % NXCD, off = wgid / NXCD; wgid = (xcd < r ? xcd * (q + 1) : r * (q + 1) + (xcd - r) * q) + off; }
        const int nig = WGM * nN, gid = wgid / nig, fm = gid * WGM, gsz = (nM - fm) < WGM ? (nM - fm) : WGM;
        u.pm = fm + ((wgid % nig) % gsz); u.pn = (wgid % nig) / gsz; return true;
    }
    __device__ __forceinline__ void a_ready(const Unit&) const {}
    __device__ __forceinline__ void done(const Unit&) const {}
};

typedef float f32x2cv __attribute__((ext_vector_type(2))); typedef __bf16 bf16x2cv __attribute__((ext_vector_type(2)));
__device__ __forceinline__ unsigned cvt_pk_bf16_asm(float lo, float hi) { unsigned r; asm volatile("v_cvt_pk_bf16_f32 %0, %1, %2" : "=v"(r) : "v"(lo), "v"(hi)); return r; }
__device__ __forceinline__ unsigned cvt_pk_bf16(float lo, float hi) { const f32x2cv v = {lo, hi}; const bf16x2cv b = __builtin_convertvector(v, bf16x2cv); return __builtin_bit_cast(unsigned, b); }
enum { EP_PLAIN = 0, EP_SWIGLU = 1, EP_KVF = 2, EP_QG = 3, EP_PLEGATE = 4 };
__device__ __forceinline__ float fsigmoid(float x) { return __builtin_amdgcn_rcpf(1.0f + __builtin_amdgcn_exp2f(-1.4426950408889634f * x)); }
__device__ __forceinline__ float bflo(unsigned w) { return __uint_as_float(w << 16); }
__device__ __forceinline__ float bfhi(unsigned w) { return __uint_as_float(w & 0xffff0000u); }
template <int MODE, int LDC> struct Epi {
    static constexpr bool PERM = true, AFTER_DRAIN = false;
    bf16_t* O; bf16_t* O2; const bf16_t* aux; float* lf; const float* bfp; float scale0; static constexpr int ldc = LDC;
    __device__ __forceinline__ void operator()(const f32x4 (&acc)[2][2][4][2], const Unit& u, int wr, int wc, int fr, int fq) const {
        asm volatile("s_nop 15\n\ts_nop 15" ::: "memory");
        const int row0 = u.pm * BM + wr * 64 + fr;
        if constexpr (MODE == EP_SWIGLU) {
            const int col0 = u.pn * HALF + wc * 32 + 8 * fq;
#pragma unroll
            for (int ai = 0; ai < 2; ++ai)
#pragma unroll
                for (int m = 0; m < 4; ++m) { bf16_t* rowp = O + (size_t)(row0 + ai * HALF + m * 16) * ldc + col0;
                    const f32x4 g0 = acc[ai][0][m][0], g1 = acc[ai][0][m][1], u0 = acc[ai][1][m][0], u1 = acc[ai][1][m][1]; f32x4 v0, v1;
#pragma unroll
                    for (int j = 0; j < 4; ++j) { v0[j] = g0[j] * fsigmoid(g0[j]) * u0[j]; v1[j] = g1[j] * fsigmoid(g1[j]) * u1[j]; }
                    u32x4 w; w.x = cvt_pk_bf16_asm(v0[0], v0[1]); w.y = cvt_pk_bf16_asm(v0[2], v0[3]); w.z = cvt_pk_bf16_asm(v1[0], v1[1]); w.w = cvt_pk_bf16_asm(v1[2], v1[3]);
                    *(u32x4*)rowp = w; }
        } else {
            bf16_t* base = O; int colt = u.pn * BM; int kind = 0; float sc = 1.f;
            if constexpr (MODE == EP_KVF) { if (u.pn >= 8) kind = 2; else if (u.pn >= 4) { base = O2; colt -= 1024; } }
            if constexpr (MODE == EP_QG) { if (u.pn >= 4) { base = O2; colt -= 1024; kind = 1; } else sc = scale0; }
            if (MODE == EP_KVF && kind == 2) {
                if (wc == 0 && fq < 2) {
#pragma unroll
                    for (int ai = 0; ai < 2; ++ai)
#pragma unroll
                        for (int m = 0; m < 4; ++m) { float* lp = lf + (size_t)(row0 + ai * HALF + m * 16) * 16 + 8 * fq;
#pragma unroll
                            for (int n = 0; n < 2; ++n) { const f32x4 a = acc[ai][0][m][n]; f32x4 o;
#pragma unroll
                                for (int j = 0; j < 4; ++j) { const float x = a[j] + bfp[8 * fq + 4 * n + j]; o[j] = fminf(x, 0.f) - __logf(1.0f + __expf(-fabsf(x))); }
                                *(f32x4*)(lp + 4 * n) = o; } }
                }
                return;
            }
            const int col0 = colt + wc * 32 + 8 * fq;
#pragma unroll
            for (int ai = 0; ai < 2; ++ai)
#pragma unroll
                for (int m = 0; m < 4; ++m) { const size_t roff = (size_t)(row0 + ai * HALF + m * 16) * ldc + col0;
#pragma unroll
                    for (int bj = 0; bj < 2; ++bj) { f32x4 v0 = acc[ai][bj][m][0], v1 = acc[ai][bj][m][1];
                        if (MODE == EP_QG && kind == 1) {
#pragma unroll
                            for (int j = 0; j < 4; ++j) { v0[j] = fsigmoid(v0[j]); v1[j] = fsigmoid(v1[j]); } }
                        else if (MODE == EP_QG) { v0 = v0 * sc; v1 = v1 * sc; }
                        if constexpr (MODE == EP_PLEGATE) { const u32x4 pq = *(const u32x4*)(aux + roff + bj * HALF);
                            v0[0] = fsigmoid(v0[0]) * bflo(pq.x); v0[1] = fsigmoid(v0[1]) * bfhi(pq.x); v0[2] = fsigmoid(v0[2]) * bflo(pq.y); v0[3] = fsigmoid(v0[3]) * bfhi(pq.y);
                            v1[0] = fsigmoid(v1[0]) * bflo(pq.z); v1[1] = fsigmoid(v1[1]) * bfhi(pq.z); v1[2] = fsigmoid(v1[2]) * bflo(pq.w); v1[3] = fsigmoid(v1[3]) * bfhi(pq.w); }
                        u32x4 w; w.x = cvt_pk_bf16_asm(v0[0], v0[1]); w.y = cvt_pk_bf16_asm(v0[2], v0[3]); w.z = cvt_pk_bf16_asm(v1[0], v1[1]); w.w = cvt_pk_bf16_asm(v1[2], v1[3]);
                        *(u32x4*)(base + roff + bj * HALF) = w; } }
        }
    }
};

template <class Epi, class Sched, bool ALIGN_EPI, bool SP2, int KC, int LDA>
__device__ __forceinline__ void gemm_phase(PG8_LAS unsigned char* lds, const Gemm g, const Sched& S, const Epi& E, int wave_s) {
    int tid_o = tid_from(wave_s); asm volatile("" : "+v"(tid_o)); const int tid = tid_o, wid = __builtin_amdgcn_readfirstlane(tid >> 6), lane = tid & 63, wr = wid >> 2, wc = wid & 3, fr = lane & 15, fq = lane >> 4;
    constexpr int K = KC, nt = K / BK;
    unsigned voffA[2], voffB[2];
#pragma unroll
    for (int i = 0; i < 2; ++i) { int R, C; stage_rc(tid * 16 + i * 8192, R, C); const int Rb = Epi::PERM ? ((R & ~31) + perm32(R & 31)) : R;
        voffA[i] = (unsigned)(R * LDA + C) * 2u; voffB[i] = (unsigned)(Rb * K + C) * 2u; }
    const size_t kstep = (size_t)(BK * 2);
    const size_t hstep = (size_t)HALF * K * 2;
    const size_t tstep = 2 * hstep; const size_t hstepA = (size_t)HALF * LDA * 2, tstepA = 2 * hstepA;
    const unsigned ldsw = (unsigned)wid * 1024u;
    const int aoff = lds_byte(wr * 64 + fr, fq * 8), boff = lds_byte(wc * 32 + fr, fq * 8);
#define PG8_SA(b, h) (((b) * 2 + (h)) * HTB)
#define PG8_SB(b, h) ((4 + (b) * 2 + (h)) * HTB)
#define PG8_STAGE(bufoff, gbase, voff) do { _Pragma("unroll") for (int _i = 0; _i < 2; ++_i) \
        __builtin_amdgcn_global_load_lds((const unsigned*)((const char*)(gbase) + (voff)[_i]), (PG8_LAS unsigned*)(lds + (bufoff) + ldsw + _i * 8192), 16, 0, 0); } while (0)
#define PG8_LDA(dst, b, h) do { _Pragma("unroll") for (int m = 0; m < 4; ++m) _Pragma("unroll") for (int k = 0; k < 2; ++k) dst[m][k] = *(const PG8_LAS bf16x8*)(lds + PG8_SA(b, h) + aoff + m * 2048 + k * 1024); } while (0)
#define PG8_LDB(dst, b, h) do { _Pragma("unroll") for (int n = 0; n < 2; ++n) _Pragma("unroll") for (int k = 0; k < 2; ++k) dst[n][k] = *(const PG8_LAS bf16x8*)(lds + PG8_SB(b, h) + boff + n * 2048 + k * 1024); } while (0)
#define PG8_MMA(ai, bj, At, Bt) do { __builtin_amdgcn_s_setprio(1); _Pragma("unroll") for (int m = 0; m < 4; ++m) _Pragma("unroll") for (int n = 0; n < 2; ++n) _Pragma("unroll") for (int k = 0; k < 2; ++k) \
        acc[ai][bj][m][n] = __builtin_amdgcn_mfma_f32_16x16x32_bf16(Bt[n][k], At[m][k], acc[ai][bj][m][n], 0, 0, 0); __builtin_amdgcn_s_setprio(0); } while (0)
#define PG8_WAIT_V(n) asm volatile("s_waitcnt vmcnt(" #n ")" ::: "memory")
#define PG8_WAIT_L(n) asm volatile("s_waitcnt lgkmcnt(" #n ")" ::: "memory")
#define PG8_BAR __builtin_amdgcn_s_barrier()
#define PG8_SCHED __builtin_amdgcn_sched_barrier(0)
    Unit cur, nxt; int ui = 0;
    if (!S.next(0, cur)) return;
    f32x4 acc[2][2][4][2];
#pragma unroll
    for (int a = 0; a < 2; ++a)
#pragma unroll
        for (int b = 0; b < 2; ++b)
#pragma unroll
            for (int m = 0; m < 4; ++m)
#pragma unroll
                for (int n = 0; n < 2; ++n) acc[a][b][m][n] = (f32x4){0.f, 0.f, 0.f, 0.f};
    bf16x8 At[4][2], B0[2][2], B1[2][2];
    const char* cA = (const char*)g.A + (size_t)cur.pm * tstepA; const char* cB = (const char*)g.Bt + (size_t)cur.pn * tstep;
    S.a_ready(cur);
    if constexpr (SP2) {
        PG8_STAGE(PG8_SB(0, 0), cB, voffB); PG8_STAGE(PG8_SB(0, 1), cB + hstep, voffB); PG8_STAGE(PG8_SA(0, 0), cA, voffA); PG8_STAGE(PG8_SA(0, 1), cA + hstepA, voffA);
        if (wr == 1) PG8_BAR;
        PG8_WAIT_V(2); PG8_BAR;
        PG8_STAGE(PG8_SB(1, 0), cB + kstep, voffB); PG8_STAGE(PG8_SA(1, 0), cA + kstep, voffA); PG8_STAGE(PG8_SB(1, 1), cB + hstep + kstep, voffB);
        PG8_WAIT_V(6); PG8_BAR;
    } else {
        PG8_STAGE(PG8_SB(0, 0), cB, voffB); PG8_STAGE(PG8_SA(0, 0), cA, voffA); PG8_STAGE(PG8_SB(0, 1), cB + hstep, voffB); PG8_STAGE(PG8_SA(0, 1), cA + hstepA, voffA);
        if (wr == 1) PG8_BAR;
        PG8_WAIT_V(4); PG8_BAR;
        PG8_STAGE(PG8_SB(1, 0), cB + kstep, voffB); PG8_STAGE(PG8_SA(1, 0), cA + kstep, voffA); PG8_STAGE(PG8_SB(1, 1), cB + hstep + kstep, voffB);
        PG8_WAIT_V(6); PG8_BAR;
    }
    for (;;) {
        const bool has_next = S.next(ui + 1, nxt);
        const char* nA = has_next ? (const char*)g.A + (size_t)nxt.pm * tstepA : cA; const char* nB = has_next ? (const char*)g.Bt + (size_t)nxt.pn * tstep : cB;
        for (int t = 0; t < nt; t += 2) {
            const bool last = (t == nt - 2);
            const char* a1 = cA + (size_t)(t + 1) * kstep;
            const char* a2 = last ? nA : cA + (size_t)(t + 2) * kstep; const char* b2 = last ? nB : cB + (size_t)(t + 2) * kstep;
            const char* a3 = a2 + kstep; const char* b3 = b2 + kstep;
            if (last && has_next) S.a_ready(nxt);
            if constexpr (SP2) {
            PG8_LDB(B0, 0, 0); PG8_LDB(B1, 0, 1); PG8_SCHED; PG8_LDA(At, 0, 0); PG8_STAGE(PG8_SA(1, 1), a1 + hstepA, voffA);
            PG8_WAIT_V(8); PG8_WAIT_L(0); PG8_BAR; PG8_MMA(0, 0, At, B0); PG8_MMA(0, 1, At, B1); PG8_BAR; PG8_SCHED;
            PG8_LDA(At, 0, 1); PG8_STAGE(PG8_SB(0, 0), b2, voffB); PG8_STAGE(PG8_SB(0, 1), b2 + hstep, voffB); PG8_STAGE(PG8_SA(0, 0), a2, voffA);
            PG8_WAIT_V(8); PG8_WAIT_L(0); PG8_BAR; PG8_MMA(1, 0, At, B0); PG8_MMA(1, 1, At, B1); PG8_BAR; PG8_SCHED;
            PG8_LDB(B0, 1, 0); PG8_LDB(B1, 1, 1); PG8_SCHED; PG8_LDA(At, 1, 0); PG8_STAGE(PG8_SA(0, 1), a2 + hstepA, voffA);
            PG8_WAIT_V(8); PG8_WAIT_L(0); PG8_BAR; PG8_MMA(0, 0, At, B0); PG8_MMA(0, 1, At, B1); PG8_BAR; PG8_SCHED;
            PG8_LDA(At, 1, 1); PG8_STAGE(PG8_SB(1, 0), b3, voffB); PG8_STAGE(PG8_SB(1, 1), b3 + hstep, voffB); PG8_STAGE(PG8_SA(1, 0), a3, voffA);
            PG8_WAIT_V(8); PG8_WAIT_L(0); PG8_BAR; PG8_MMA(1, 0, At, B0); PG8_MMA(1, 1, At, B1); PG8_BAR; PG8_SCHED;
            } else {
            PG8_LDB(B0, 0, 0); PG8_SCHED; PG8_LDA(At, 0, 0); PG8_STAGE(PG8_SA(1, 1), a1 + hstepA, voffA);
            PG8_WAIT_L(8); PG8_BAR; PG8_WAIT_L(0); PG8_MMA(0, 0, At, B0); PG8_BAR; PG8_SCHED;
            PG8_LDB(B1, 0, 1); PG8_STAGE(PG8_SB(0, 0), b2, voffB);
            PG8_BAR; PG8_WAIT_L(0); PG8_MMA(0, 1, At, B1); PG8_BAR;
            PG8_LDA(At, 0, 1); PG8_STAGE(PG8_SA(0, 0), a2, voffA);
            PG8_BAR; PG8_WAIT_L(0); PG8_MMA(1, 0, At, B0); PG8_BAR; PG8_SCHED;
            PG8_STAGE(PG8_SB(0, 1), b2 + hstep, voffB);
            PG8_WAIT_V(6); PG8_BAR; PG8_MMA(1, 1, At, B1); PG8_BAR;
            PG8_LDB(B0, 1, 0); PG8_SCHED; PG8_LDA(At, 1, 0); PG8_STAGE(PG8_SA(0, 1), a2 + hstepA, voffA);
            PG8_WAIT_L(8); PG8_BAR; PG8_WAIT_L(0); PG8_MMA(0, 0, At, B0); PG8_BAR; PG8_SCHED;
            PG8_LDB(B1, 1, 1); PG8_STAGE(PG8_SB(1, 0), b3, voffB);
            PG8_BAR; PG8_WAIT_L(0); PG8_MMA(0, 1, At, B1); PG8_BAR;
            PG8_LDA(At, 1, 1); PG8_STAGE(PG8_SA(1, 0), a3, voffA);
            PG8_BAR; PG8_WAIT_L(0); PG8_MMA(1, 0, At, B0); PG8_BAR; PG8_SCHED;
            PG8_STAGE(PG8_SB(1, 1), b3 + hstep, voffB);
            PG8_WAIT_V(6); PG8_BAR; PG8_MMA(1, 1, At, B1); PG8_BAR;
            }
        }
        if constexpr (ALIGN_EPI) { if (wr == 0) PG8_BAR; }
        if constexpr (!Epi::AFTER_DRAIN) { E(acc, cur, wr, wc, fr, fq); S.done(cur); }
        if (!has_next) break;
#pragma unroll
        for (int a = 0; a < 2; ++a)
#pragma unroll
            for (int b = 0; b < 2; ++b)
#pragma unroll
                for (int m = 0; m < 4; ++m)
#pragma unroll
                    for (int n = 0; n < 2; ++n) acc[a][b][m][n] = (f32x4){0.f, 0.f, 0.f, 0.f};
        cur = nxt; cA = nA; cB = nB; ++ui;
        if constexpr (ALIGN_EPI) { if (wr == 1) PG8_BAR; }
    }
    PG8_WAIT_V(0);
    if constexpr (!ALIGN_EPI) { if (wr == 0) PG8_BAR; }
    PG8_BAR;
    if constexpr (Epi::AFTER_DRAIN) { E.fused(acc, cur, wr, wc, fr, fq, lds, wid, lane); S.done(cur); }
#undef PG8_SA
#undef PG8_SB
#undef PG8_STAGE
#undef PG8_LDA
#undef PG8_LDB
#undef PG8_MMA
#undef PG8_WAIT_V
#undef PG8_WAIT_L
#undef PG8_BAR
#undef PG8_SCHED
}
}
#include <hip/hip_bf16.h>
#include <cmath>
namespace attn_body {
using bf16=__hip_bfloat16;
using bf16x8=__attribute__((ext_vector_type(8)))short;
using s16x4=__attribute__((ext_vector_type(4)))short;
using f32x16=__attribute__((ext_vector_type(16)))float;
using u32x4=__attribute__((ext_vector_type(4)))unsigned;
constexpr int BATCH=8,NHEAD=16,SEQ=4096,D=64,DM=NHEAD*D;
constexpr int NW=8,QBLK=32,QB=QBLK*NW,KVBLK=64,NQB=SEQ/QB;
constexpr int ATTN_PITCH=DM, ATTN_UNIT_ROWS=QB;
__device__ __forceinline__ int crow(int r,int hi){return (r&3)+8*(r>>2)+4*hi;}
#define SBAR() __builtin_amdgcn_sched_barrier(0)
__device__ __forceinline__ void cmask(f32x16&p0,f32x16&p1,int jb,int qrel,int hi){
  const float NEG=-INFINITY; int kb=64*jb+4*hi;
  #pragma unroll
  for(int r=0;r<16;++r){int kv=kb+(r&3)+8*(r>>2); if(kv>qrel)p0[r]=NEG; if(kv+32>qrel)p1[r]=NEG;}
}

constexpr int NSLOT=3, SLOTB=8192;
constexpr int LDS_K=0, LDS_V=NSLOT*SLOTB, LDS_WS=2*NSLOT*SLOTB, LDS_OST=LDS_WS+NW*64*4, LDS_CB=LDS_OST+NW*4096, LDS_BYTES=LDS_CB+SEQ*4;
constexpr float C2=0.125f*1.4426950408889634f;
__device__ __forceinline__ void glds16(const void*gsrc,unsigned lds_dst){unsigned keep;
  asm volatile("s_mov_b32 %0, m0\n\ts_mov_b32 m0, %2\n\ts_nop 0\n\tglobal_load_lds_dwordx4 %1, off\n\ts_mov_b32 m0, %0":"=&s"(keep):"v"(gsrc),"s"(lds_dst):"memory");}
__device__ __forceinline__ float max3f(float a,float b,float c){float r;asm("v_max3_f32 %0, %1, %2, %3":"=v"(r):"v"(a),"v"(b),"v"(c));return r;}
__device__ __forceinline__ float max2f(float a,float b){float r;asm("v_max_f32_e32 %0, %1, %2":"=v"(r):"v"(a),"v"(b));return r;}
__device__ __forceinline__ float fadd_s(float a,float b){float r;asm("v_add_f32_e32 %0, %1, %2":"=v"(r):"v"(a),"v"(b));return r;}
__device__ __forceinline__ float fsub_s(float a,float b){float r;asm("v_sub_f32_e32 %0, %1, %2":"=v"(r):"v"(a),"v"(b));return r;}
typedef float f32x2_t __attribute__((ext_vector_type(2))); typedef __bf16 bf16x2_t __attribute__((ext_vector_type(2)));
__device__ __forceinline__ unsigned cvtpk_s(float lo,float hi){f32x2_t v={lo,hi};bf16x2_t b=__builtin_convertvector(v,bf16x2_t);return __builtin_bit_cast(unsigned,b);}
#define WAIT_BAR(N) asm volatile("s_waitcnt vmcnt(" #N ") lgkmcnt(0)\n\ts_barrier":::"memory")

__device__ __forceinline__ void qkt(f32x16&p0,f32x16&p1,const char*Kslot,const bf16x8*qr,const f32x16&negm,int r32,int hi){
  const char*kb=Kslot+hi*1024+r32*16;
  #pragma unroll
  for(int d0=0;d0<4;++d0){
    const bf16x8 b0=*reinterpret_cast<const bf16x8*>(kb+d0*2048);
    const bf16x8 b1=*reinterpret_cast<const bf16x8*>(kb+d0*2048+512);
    if(d0==0){p0=__builtin_amdgcn_mfma_f32_32x32x16_bf16(b0,qr[0],negm,0,0,0);p1=__builtin_amdgcn_mfma_f32_32x32x16_bf16(b1,qr[0],negm,0,0,0);}
    else{p0=__builtin_amdgcn_mfma_f32_32x32x16_bf16(b0,qr[d0],p0,0,0,0);p1=__builtin_amdgcn_mfma_f32_32x32x16_bf16(b1,qr[d0],p1,0,0,0);}}
}
typedef __attribute__((address_space(3))) const char* lds_cptr;
typedef short v4i16_t __attribute__((ext_vector_type(4)));
__device__ __forceinline__ void kload8(bf16x8*kf,lds_cptr kp){
  kf[0]=*(const __attribute__((address_space(3))) bf16x8*)(kp);      kf[1]=*(const __attribute__((address_space(3))) bf16x8*)(kp+512);
  kf[2]=*(const __attribute__((address_space(3))) bf16x8*)(kp+2048); kf[3]=*(const __attribute__((address_space(3))) bf16x8*)(kp+2560);
  kf[4]=*(const __attribute__((address_space(3))) bf16x8*)(kp+4096); kf[5]=*(const __attribute__((address_space(3))) bf16x8*)(kp+4608);
  kf[6]=*(const __attribute__((address_space(3))) bf16x8*)(kp+6144); kf[7]=*(const __attribute__((address_space(3))) bf16x8*)(kp+6656);
}
__device__ __forceinline__ void kload2(bf16x8*kf,lds_cptr kp,int j){ kf[2*j]=*(const __attribute__((address_space(3))) bf16x8*)(kp+j*2048); kf[2*j+1]=*(const __attribute__((address_space(3))) bf16x8*)(kp+j*2048+512); }
__device__ __forceinline__ s16x4 vtr(lds_cptr p){ return __builtin_bit_cast(s16x4,__builtin_amdgcn_ds_read_tr16_b64_v4i16((__attribute__((address_space(3))) v4i16_t*)p)); }
__device__ __forceinline__ float rowmax(const f32x16&p0,const f32x16&p1){
  float a=max3f(p0[0],p0[1],p1[0]),b=max3f(p0[2],p0[3],p1[1]);a=max3f(a,p1[2],p1[3]);
  #pragma unroll
  for(int r=4;r<16;r+=4){a=max3f(a,p0[r],p0[r+1]);b=max3f(b,p0[r+2],p0[r+3]);a=max3f(a,p1[r],p1[r+1]);b=max3f(b,p1[r+2],p1[r+3]);}
  const float m=max2f(a,b);
  auto rr=__builtin_amdgcn_permlane32_swap(__float_as_uint(m),__float_as_uint(m),false,false);
  return max2f(__uint_as_float(rr[0]),__uint_as_float(rr[1]));
}
__device__ __forceinline__ void pv(f32x16*o,int vb,bf16x8 pa0,bf16x8 pa1,bf16x8 pa2,bf16x8 pa3){
  #pragma unroll
  for(int d0=0;d0<2;++d0){s16x4 lo[4],hi[4];
    #pragma unroll
    for(int ks=0;ks<4;++ks){
      asm volatile("ds_read_b64_tr_b16 %0,%1 offset:%c2":"=&v"(lo[ks]):"v"(vb),"i"(d0*4096+ks*1024):"memory");
      asm volatile("ds_read_b64_tr_b16 %0,%1 offset:%c2":"=&v"(hi[ks]):"v"(vb),"i"(d0*4096+ks*1024+512):"memory");}
    asm volatile("s_waitcnt lgkmcnt(0)":::"memory");SBAR();
    #define PK(k) (bf16x8){lo[k][0],lo[k][1],lo[k][2],lo[k][3],hi[k][0],hi[k][1],hi[k][2],hi[k][3]}
    o[d0]=__builtin_amdgcn_mfma_f32_32x32x16_bf16(pa0,PK(0),o[d0],0,0,0);
    o[d0]=__builtin_amdgcn_mfma_f32_32x32x16_bf16(pa1,PK(1),o[d0],0,0,0);
    o[d0]=__builtin_amdgcn_mfma_f32_32x32x16_bf16(pa2,PK(2),o[d0],0,0,0);
    o[d0]=__builtin_amdgcn_mfma_f32_32x32x16_bf16(pa3,PK(3),o[d0],0,0,0);
    #undef PK
  }
}

#ifndef ATTN_STORE16
#define ATTN_STORE16(p,v) (*(u32x4*)(p)=(v))
#endif
template<int THRL> __device__ __forceinline__ void attn_unit(int b,int h,int qb,const bf16*Q,const bf16*__restrict__ K,const bf16*__restrict__ V,bf16*O,const bf16*__restrict__ Gt,const float*__restrict__ CL,char*shm,int wave_s){
  int tid_o=tid_from(wave_s); asm volatile("":"+v"(tid_o)); const int tid=tid_o,lane=tid&63,r32=lane&31,hi=lane>>5; const int wid=__builtin_amdgcn_readfirstlane(tid>>6);
  const long rowbase=(long)b*SEQ; const int q0=qb*QB;
  const float*cbh=CL+((long)b*NHEAD+h)*SEQ;
  typedef float f4_t __attribute__((ext_vector_type(4))); f4_t creg0=f4_t{},creg1=f4_t{}; const int n4c=(q0+QB)/4;
  if(tid<n4c)creg0=*(const f4_t*)(cbh+4*tid); if(tid+NW*64<n4c)creg1=*(const f4_t*)(cbh+4*(tid+NW*64));
  const float cq=cbh[q0+wid*QBLK+(lane&31)];
  const bf16*Qw=Q+(rowbase+q0+wid*QBLK)*DM+h*D;
  const bf16*Kh=K+rowbase*DM+h*D,*Vh=V+rowbase*DM+h*D;
  const unsigned lds0=(unsigned)(uintptr_t)shm;
  float*wsf=(float*)(shm+LDS_WS)+wid*64;
  const bf16*ksrc=Kh+(long)lane*DM+wid*8;
  const bf16*vsrc=Vh+(long)(16*(wid&3)+(lane>>2))*DM+(wid>>2)*32+(lane&3)*8;
  const unsigned kdst=lds0+LDS_K+wid*1024, vdst=lds0+LDS_V+wid*1024;
  #define DMA_K(t,slot) glds16(ksrc+(long)(t)*KVBLK*DM,(unsigned)__builtin_amdgcn_readfirstlane(kdst+(slot)))
  #define DMA_V(t,slot) glds16(vsrc+(long)(t)*KVBLK*DM,(unsigned)__builtin_amdgcn_readfirstlane(vdst+(slot)))
  const int vb0=(int)(lds0+LDS_V)+((lane>>4)&1)*32+(lane&3)*8+(4*hi+((lane&15)>>2))*64;
  const char*Kbase=shm+LDS_K; bf16x8 kf[8];
  const lds_cptr shm3=(lds_cptr)shm; const lds_cptr kp0=shm3+LDS_K+hi*1024+r32*16; const lds_cptr vp0=shm3+LDS_V+((lane>>4)&1)*32+(lane&3)*8+(4*hi+((lane&15)>>2))*64;
  const int NT=(q0+QB)/KVBLK;
  DMA_K(0,0);DMA_V(0,0);DMA_K(1,SLOTB);
  bf16x8 qr[4];
  #pragma unroll
  for(int d0=0;d0<4;++d0)qr[d0]=*reinterpret_cast<const bf16x8*>(&Qw[(long)r32*DM+d0*16+hi*8]);
  float mhat=0.f,l_reg=0.f;f32x16 o[2];o[0]=f32x16{};o[1]=f32x16{};f32x16 negm;
  #pragma unroll
  for(int r=0;r<16;++r)negm[r]=cq;
  asm volatile("":"+v"(negm));
  typedef float cf4_t __attribute__((ext_vector_type(4))); const __attribute__((address_space(3))) cf4_t*clds=(const __attribute__((address_space(3))) cf4_t*)((lds_cptr)shm+LDS_CB)+hi;
  #define CBIAS(P0,P1,t) do{ const __attribute__((address_space(3))) cf4_t*cp_=clds+16*(t); _Pragma("unroll") for(int j_=0;j_<4;++j_){ const cf4_t a_=cp_[2*j_], b_=cp_[8+2*j_]; \
      { f32x2_t u0_={P0[4*j_],P0[4*j_+1]},u1_={P0[4*j_+2],P0[4*j_+3]},w0_={P1[4*j_],P1[4*j_+1]},w1_={P1[4*j_+2],P1[4*j_+3]}; \
        u0_=u0_-(f32x2_t){a_[0],a_[1]}; u1_=u1_-(f32x2_t){a_[2],a_[3]}; w0_=w0_-(f32x2_t){b_[0],b_[1]}; w1_=w1_-(f32x2_t){b_[2],b_[3]}; \
        P0[4*j_]=u0_[0];P0[4*j_+1]=u0_[1];P0[4*j_+2]=u1_[0];P0[4*j_+3]=u1_[1]; P1[4*j_]=w0_[0];P1[4*j_+1]=w0_[1];P1[4*j_+2]=w1_[0];P1[4*j_+3]=w1_[1]; } } }while(0)
  const int qrel=wid*QBLK+r32;
  #define CMASK(P0,P1,t) do{int jb_=(t)-(NT-4); if(jb_>=0)cmask(P0,P1,jb_,qrel,hi);}while(0)
  bool resc=false;
  #define START(P0,P1) do{ const float rm=rowmax(P0,P1); resc=false; \
    { const float c63_=((const __attribute__((address_space(3))) float*)((lds_cptr)shm+LDS_CB))[63]; const float dl=rm-(cq-c63_);     \
      mhat=fadd_s(mhat,dl); \
      _Pragma("unroll") for(int r=0;r<16;++r){P0[r]=fsub_s(P0[r],dl);P1[r]=fsub_s(P1[r],dl);} \
      _Pragma("unroll") for(int r=0;r<16;++r)negm[r]=cq-mhat; asm volatile("":"+v"(negm)); } \
    _Pragma("unroll") for(int r=0;r<16;++r)P0[r]=__builtin_amdgcn_exp2f(P0[r]); }while(0)
  #define RESC() do{ if(resc){ asm volatile("s_waitcnt lgkmcnt(0)":::"memory"); \
      _Pragma("unroll") for(int d_=0;d_<2;++d_) _Pragma("unroll") for(int r=0;r<16;++r)o[d_][r]*=wsf[crow(r,hi)]; } }while(0)
  f32x16 pA0,pA1,pB0,pB1;
  int sl_prev=0,sl_cur=0,sl_next=SLOTB;
  #define ROT() do{sl_prev=sl_cur;sl_cur=sl_next;sl_next=(sl_next==(NSLOT-1)*SLOTB)?0:sl_next+SLOTB;}while(0)
  { __attribute__((address_space(3))) f4_t*cl4=(__attribute__((address_space(3))) f4_t*)((lds_cptr)shm+LDS_CB); if(tid<n4c)cl4[tid]=creg0; if(tid+NW*64<n4c)cl4[tid+NW*64]=creg1; }
  DMA_K(2,2*SLOTB);
  WAIT_BAR(3);
  qkt(pA0,pA1,Kbase,qr,negm,r32,hi);asm volatile("s_nop 15\n\ts_nop 7":"+v"(pA0),"+v"(pA1));CMASK(pA0,pA1,0);CBIAS(pA0,pA1,0);
  START(pA0,pA1);
  _Pragma("unroll") for(int r=0;r<16;++r)pA1[r]=__builtin_amdgcn_exp2f(pA1[r]);
  WAIT_BAR(0);
  DMA_K(3,0);DMA_V(1,SLOTB);
  ROT();
  kload8(kf,kp0+sl_cur);
  WAIT_BAR(2);
  s16x4 vlo[8],vhi[8]; u32x4 pw0,pw1,pw2,pw3;
  #define PKW(P,B) cvtpk_s(P[B],P[B+1])
  #define PAF(k) __builtin_bit_cast(bf16x8,pw##k)
  #define VFR(i) (bf16x8){vlo[i][0],vlo[i][1],vlo[i][2],vlo[i][3],vhi[i][0],vhi[i][1],vhi[i][2],vhi[i][3]}
  #define PIN(x) asm volatile("":"+v"(x))
  #define MX3(a,b,c) __builtin_fmaxf(__builtin_fmaxf((a),(b)),(c))
  #define GAPA(MF,A0,A1,A2,A3,W0,W1,PW) do{ MF; sacc+=A0; sacc+=A1; sacc+=A2; sacc+=A3; PIN(sacc); W0; W1; PIN(PW); SBAR(); }while(0)
  #define EX(v) __builtin_amdgcn_exp2f(v)
  #define GAPB(MF,X,B) do{ MF; X[B]=EX(X[B]); X[B+1]=EX(X[B+1]); X[B+2]=EX(X[B+2]); X[B+3]=EX(X[B+3]); PIN(X); SBAR(); }while(0)
  #define VRD(i) do{ vlo[i]=vtr(vp_+(((i)>>2)*4096+((i)&3)*1024)); vhi[i]=vtr(vp_+(((i)>>2)*4096+((i)&3)*1024+512)); }while(0)
  #define KRD(G,j) do{ if(G){ kload2(kf,kp0+sl_next,j); SBAR(); } }while(0)
  #define STEP(C0,C1,P0,P1,t,GK,GV,GL) do{ SBAR(); \
    const lds_cptr vp_=vp0+sl_prev; \
    VRD(0); SBAR(); float sacc=(P0[0]+P0[1]); \
    GAPA(C0=__builtin_amdgcn_mfma_f32_32x32x16_bf16(kf[0],qr[0],negm,0,0,0), P0[2],P0[3],P0[4],P0[5],     pw0[0]=PKW(P0,0), pw0[1]=PKW(P0,2), pw0); \
    VRD(4); SBAR(); GAPA(C1=__builtin_amdgcn_mfma_f32_32x32x16_bf16(kf[1],qr[0],negm,0,0,0), P0[6],P0[7],P0[8],P0[9],     pw0[2]=PKW(P0,4), pw0[3]=PKW(P0,6), pw0); \
    VRD(1); SBAR(); GAPA(C0=__builtin_amdgcn_mfma_f32_32x32x16_bf16(kf[2],qr[1],C0,0,0,0),   P0[10],P0[11],P0[12],P0[13], pw1[0]=PKW(P0,8), pw1[1]=PKW(P0,10), pw1); \
    VRD(5); SBAR(); GAPA(C1=__builtin_amdgcn_mfma_f32_32x32x16_bf16(kf[3],qr[1],C1,0,0,0),   P0[14],P0[15],P1[0],P1[1],   pw1[2]=PKW(P0,12),pw1[3]=PKW(P0,14), pw1); \
    VRD(2); SBAR(); GAPA(C0=__builtin_amdgcn_mfma_f32_32x32x16_bf16(kf[4],qr[2],C0,0,0,0),   P1[2],P1[3],P1[4],P1[5],     pw2[0]=PKW(P1,0), pw2[1]=PKW(P1,2), pw2); \
    VRD(6); SBAR(); GAPA(C1=__builtin_amdgcn_mfma_f32_32x32x16_bf16(kf[5],qr[2],C1,0,0,0),   P1[6],P1[7],P1[8],P1[9],     pw2[2]=PKW(P1,4), pw2[3]=PKW(P1,6), pw2); \
    VRD(3); SBAR(); GAPA(C0=__builtin_amdgcn_mfma_f32_32x32x16_bf16(kf[6],qr[3],C0,0,0,0),   P1[10],P1[11],P1[12],P1[13], pw3[0]=PKW(P1,8), pw3[1]=PKW(P1,10), pw3); \
    VRD(7); SBAR(); GAPA(C1=__builtin_amdgcn_mfma_f32_32x32x16_bf16(kf[7],qr[3],C1,0,0,0),   P1[14],P1[15],0.f,0.f,       pw3[2]=PKW(P1,12),pw3[3]=PKW(P1,14), pw3); \
    l_reg+=sacc; \
    if(GK){DMA_K((t)+3,sl_cur);} if(GV){DMA_V((t)+1,sl_next);} \
    CMASK(C0,C1,t); CBIAS(C0,C1,t); \
    { float a=MX3(C0[0],C0[1],C1[0]),b=MX3(C0[2],C0[3],C1[1]); a=MX3(a,C1[2],C1[3]); \
      _Pragma("unroll") for(int r=4;r<16;r+=4){a=MX3(a,C0[r],C0[r+1]);b=MX3(b,C0[r+2],C0[r+3]);a=MX3(a,C1[r],C1[r+1]);b=MX3(b,C1[r+2],C1[r+3]);} \
      float rm=__builtin_fmaxf(a,b); { auto rr=__builtin_amdgcn_permlane32_swap(__float_as_uint(rm),__float_as_uint(rm),false,false); rm=__builtin_fmaxf(__uint_as_float(rr[0]),__uint_as_float(rr[1])); } \
      resc=false; \
      if(__builtin_expect(__any(rm>(float)THRL),0)){ const float dl=__builtin_fmaxf(rm,0.f); mhat+=dl; \
        _Pragma("unroll") for(int r=0;r<16;++r){C0[r]-=dl;C1[r]-=dl;} \
        _Pragma("unroll") for(int r=0;r<16;++r)negm[r]=cq-mhat; asm volatile("":"+v"(negm)); \
        const float f=__builtin_amdgcn_exp2f(-dl); l_reg*=f; if(hi==0)wsf[r32]=f; resc=true; } } \
    SBAR(); \
    GAPB(o[0]=__builtin_amdgcn_mfma_f32_32x32x16_bf16(PAF(0),VFR(0),o[0],0,0,0), C0,0); \
    GAPB(o[1]=__builtin_amdgcn_mfma_f32_32x32x16_bf16(PAF(0),VFR(4),o[1],0,0,0), C0,4); \
    KRD(GL,0); GAPB(o[0]=__builtin_amdgcn_mfma_f32_32x32x16_bf16(PAF(1),VFR(1),o[0],0,0,0), C0,8); \
    KRD(GL,1); GAPB(o[1]=__builtin_amdgcn_mfma_f32_32x32x16_bf16(PAF(1),VFR(5),o[1],0,0,0), C0,12); \
    KRD(GL,2); GAPB(o[0]=__builtin_amdgcn_mfma_f32_32x32x16_bf16(PAF(2),VFR(2),o[0],0,0,0), C1,0); \
    KRD(GL,3); GAPB(o[1]=__builtin_amdgcn_mfma_f32_32x32x16_bf16(PAF(2),VFR(6),o[1],0,0,0), C1,4); \
    GAPB(o[0]=__builtin_amdgcn_mfma_f32_32x32x16_bf16(PAF(3),VFR(3),o[0],0,0,0), C1,8); \
    GAPB(o[1]=__builtin_amdgcn_mfma_f32_32x32x16_bf16(PAF(3),VFR(7),o[1],0,0,0), C1,12); \
    }while(0)
  int t=1;
  #undef CMASK
  #define CMASK(P0,P1,t) do{}while(0)
  for(;t+5<NT;t+=2){
    STEP(pB0,pB1,pA0,pA1,t,true,true,true);     WAIT_BAR(2); RESC(); ROT();
    STEP(pA0,pA1,pB0,pB1,t+1,true,true,true);   WAIT_BAR(2); RESC(); ROT();
  }
  #undef CMASK
  #define CMASK(P0,P1,t) do{int jb_=(t)-(NT-4); if(jb_>=0)cmask(P0,P1,jb_,qrel,hi);}while(0)
  #define ENDW(tt) do{ if((tt)+3<NT){WAIT_BAR(2);} else if((tt)+2<NT){WAIT_BAR(1);} else {WAIT_BAR(0);} }while(0)
  for(;t+1<NT;t+=2){
    STEP(pB0,pB1,pA0,pA1,t,(t+3<NT),(t+1<NT),(t+1<NT));       ENDW(t);   RESC(); ROT();
    STEP(pA0,pA1,pB0,pB1,t+1,(t+4<NT),(t+2<NT),(t+2<NT));     ENDW(t+1); RESC(); ROT();
  }
  STEP(pB0,pB1,pA0,pA1,NT-1,false,false,false); RESC();
  { float sacc=pB0[0]+pB0[1]; _Pragma("unroll") for(int r=2;r<16;++r)sacc+=pB0[r]; _Pragma("unroll") for(int r=0;r<16;++r)sacc+=pB1[r]; l_reg+=sacc;
    pw0=(u32x4){PKW(pB0,0),PKW(pB0,2),PKW(pB0,4),PKW(pB0,6)};pw1=(u32x4){PKW(pB0,8),PKW(pB0,10),PKW(pB0,12),PKW(pB0,14)};pw2=(u32x4){PKW(pB1,0),PKW(pB1,2),PKW(pB1,4),PKW(pB1,6)};pw3=(u32x4){PKW(pB1,8),PKW(pB1,10),PKW(pB1,12),PKW(pB1,14)};
    SBAR(); pv(o,vb0+sl_cur,PAF(0),PAF(1),PAF(2),PAF(3)); }
  #undef PKW
  #undef PAF
  #undef VFR
  #undef PIN
  #undef MX3
  #undef GAPA
  #undef GAPB
  #undef EX
  #undef VRD
  #undef KRD
  #undef STEP
  #undef ENDW
  {auto rr=__builtin_amdgcn_permlane32_swap(__float_as_uint(l_reg),__float_as_uint(l_reg),false,false);l_reg=__uint_as_float(rr[0])+__uint_as_float(rr[1]);}
  if(hi==0)wsf[32+r32]=l_reg;asm volatile("s_waitcnt lgkmcnt(0)":::"memory");
  float rli[16];
  #pragma unroll
  for(int r=0;r<16;++r)rli[r]=__builtin_amdgcn_rcpf(wsf[32+crow(r,hi)]);
  bf16*Ow=O+(rowbase+q0+wid*QBLK)*DM+h*D;
  { bf16*stg=(bf16*)(shm+LDS_OST)+wid*2048;
    #pragma unroll
    for(int r=0;r<16;++r){const int orow=crow(r,hi);
      #pragma unroll
      for(int d0=0;d0<2;++d0)stg[orow*64+d0*32+r32]=__float2bfloat16(o[d0][r]*rli[r]);}
    asm volatile("s_waitcnt lgkmcnt(0)":::"memory");
    #pragma unroll
    for(int i=0;i<4;++i){const bf16*Gw=Gt+(rowbase+q0+wid*QBLK)*DM+h*D; const int row=i*8+(lane>>3),ch=lane&7; const u32x4 v=*(const u32x4*)(stg+row*64+ch*8); const u32x4 gq=*(const u32x4*)(Gw+(long)row*DM+ch*8); u32x4 w;
      #pragma unroll
      for(int e=0;e<4;++e){ const float a0=__uint_as_float(v[e]<<16)*__uint_as_float(gq[e]<<16), a1=__uint_as_float(v[e]&0xffff0000u)*__uint_as_float(gq[e]&0xffff0000u); w[e]=cvtpk_s(a0,a1); }
      ATTN_STORE16(Ow+(long)row*DM+ch*8,w);} }
  asm volatile("s_waitcnt lgkmcnt(0)\n\ts_barrier":::"memory");
  #undef CBIAS
  #undef DMA_K
  #undef DMA_V
  #undef CMASK
  #undef START
  #undef RESC
  #undef ROT
}
constexpr int ATTN_LDS_BYTES=LDS_BYTES;
struct AttnTensors { const bf16* Q; const bf16* K; const bf16* V; bf16* O; const bf16* G; const float* CL; };
struct AttnUnit { int bh; int qb; };
struct StaticOrder {
  int vcu, G;
  __device__ __forceinline__ explicit StaticOrder(int grid,int block):vcu((grid%8==0)?(block%8)*(grid/8)+block/8:block),G(grid){}
  __device__ __forceinline__ bool next(int i,AttnUnit&u)const{
    if(G==256){ if(i>=8)return false; const int j=2*(i>>1)+(vcu&1); u.bh=vcu>>1; u.qb=(i&1)?15-j:j; return true; }
    const int idx=i*G+vcu; if(idx>=BATCH*NHEAD*NQB)return false; u.bh=idx/NQB; u.qb=NQB-1-idx%NQB; return true; }
  __device__ __forceinline__ void a_ready(const AttnUnit&)const{}
  __device__ __forceinline__ void done(const AttnUnit&)const{}
};
template<class Sched,int THRL=8> __device__ __forceinline__ void attn_phase(char*lds,const AttnTensors&T,const Sched&S,int wave_s){
  AttnUnit u;
  for(int i=0;S.next(i,u);++i){ S.a_ready(u); attn_unit<THRL>(u.bh/NHEAD,u.bh%NHEAD,u.qb,T.Q,T.K,T.V,T.O,T.G,T.CL,lds,wave_s); S.done(u); }
}
#undef SBAR
#undef WAIT_BAR
}
#define GAS __attribute__((address_space(1)))
#define LAS __attribute__((address_space(3)))
typedef unsigned short bfu;
typedef unsigned v4u __attribute__((ext_vector_type(4)));
typedef unsigned v2u __attribute__((ext_vector_type(2)));
typedef float f32x4 __attribute__((ext_vector_type(4)));
typedef short bf16x8 __attribute__((ext_vector_type(8)));
#define LDS_WAIT() asm volatile("s_waitcnt lgkmcnt(0)" ::: "memory")
constexpr int NWAVES = 8;
constexpr int BATCH = 8, SEQ = 4096, D = 1024, FF = 2816, T = BATCH * SEQ, PLE = 256, NKVF = 2064, NKVFP = 2304;
constexpr float EPS = 1e-6f, LOG2E = 1.4426950408889634f;
constexpr size_t MiB = 1u << 20;
constexpr size_t E_W1IN = 0, N_WIN = (size_t)2 * FF * D, N_WOUT = (size_t)D * FF;
constexpr size_t E_W1OUT = E_W1IN + 2 * N_WIN, E_W2IN = E_W1OUT + 2 * N_WOUT, E_W2OUT = E_W2IN + 2 * N_WIN, E_WHIN = E_W2OUT + 2 * N_WOUT;
constexpr size_t E_WHOUT = E_WHIN + (size_t)4 * D * D, E_WKVF = E_WHOUT + (size_t)D * D, E_WQG = E_WKVF + (size_t)NKVFP * D, E_WFO = E_WQG + (size_t)2 * D * D;
constexpr size_t E_WPG = E_WFO + (size_t)D * D, E_WPP = E_WPG + (size_t)2 * D * D, E_WEND = E_WPP + (size_t)2 * D * PLE;
static_assert(E_WEND * 2 <= 92 * MiB, "weights fit");
constexpr size_t WS_P = 92 * MiB, WS_LOGF = 124 * MiB, WS_C = 126 * MiB, WS_AY = 128 * MiB, WS_BIG = 192 * MiB, WS_PROJ = 448 * MiB, WS_END = 512 * MiB;
constexpr size_t WS_V = WS_BIG + 192 * MiB, WS_K = WS_PROJ, WS_Q = WS_BIG, WS_G = WS_BIG + 64 * MiB;
constexpr int LDS_BYTES = 147456;

__device__ __forceinline__ float wave_sum(float v) {
#pragma unroll
    for (int o = 1; o < 64; o <<= 1) v += __shfl_xor(v, o);
    return v;
}
__device__ __forceinline__ unsigned pk2(float lo, float hi) { return pg8::cvt_pk_bf16(lo, hi); }
__device__ __forceinline__ float bf2f(unsigned short u) { return __uint_as_float((unsigned)u << 16); }
__device__ __forceinline__ unsigned short f2b(float f) { return (unsigned short)(pk2(f, 0.f) & 0xffffu); }

__device__ __forceinline__ void conv_item(const float* W, int K, int N, bfu* WT, const float* gain, int gmask, int sw, LAS float* scr, int item, int lane) {
    const int nblk = (N + 31) / 32, kb = item / nblk, nb = item % nblk, k0 = 64 * kb, n0 = 32 * nb;
    const int nn = n0 + (lane & 31); const bool nok = nn < N;
    const int c = lane & 7;
    f32x4 ga = (f32x4){1.f, 1.f, 1.f, 1.f}, gb = ga;
    if (gain) { ga = *(const f32x4*)(gain + ((k0 + 8 * c) & gmask)); gb = *(const f32x4*)(gain + ((k0 + 8 * c) & gmask) + 4); }
    float wv[32];
#pragma unroll
    for (int i = 0; i < 32; ++i) { const int kk = 2 * i + (lane >> 5); wv[i] = nok ? W[(size_t)(k0 + kk) * N + nn] : 0.f; }
#pragma unroll
    for (int i = 0; i < 32; ++i) { const int kk = 2 * i + (lane >> 5); scr[kk * 33 + (lane & 31)] = wv[i]; }
    LDS_WAIT(); asm volatile("" ::: "memory");
    int drow0 = n0; if (sw) { const int j0 = (n0 < FF) ? n0 : n0 - FF; drow0 = 256 * (j0 >> 7) + (j0 & 127) + ((n0 < FF) ? 0 : 128); }
#pragma unroll
    for (int j = 0; j < 4; ++j) { const int n = (lane >> 3) + 8 * j; const LAS float* s = scr + (8 * c) * 33 + n;
        v4u o; o.x = pk2(s[0 * 33] * ga[0], s[1 * 33] * ga[1]); o.y = pk2(s[2 * 33] * ga[2], s[3 * 33] * ga[3]); o.z = pk2(s[4 * 33] * gb[0], s[5 * 33] * gb[1]); o.w = pk2(s[6 * 33] * gb[2], s[7 * 33] * gb[3]);
        *(v4u*)(WT + (size_t)(drow0 + n) * K + k0 + 8 * c) = o; }
    LDS_WAIT(); asm volatile("" ::: "memory");
}
__device__ __forceinline__ void rms_row_to_bf16(const float* xrow, bfu* orow, int lane) {
    const f32x4* xr = (const f32x4*)xrow + lane;
    f32x4 v[4]; float s = 0.f;
#pragma unroll
    for (int j = 0; j < 4; ++j) { v[j] = xr[64 * j]; s += (v[j].x * v[j].x + v[j].y * v[j].y) + (v[j].z * v[j].z + v[j].w * v[j].w); }
    const float r = __builtin_amdgcn_rsqf(wave_sum(s) * (1.f / D) + EPS);
    v2u* o8 = (v2u*)orow + lane;
#pragma unroll
    for (int j = 0; j < 4; ++j) { v2u w; w.x = pk2(v[j].x * r, v[j].y * r); w.y = pk2(v[j].z * r, v[j].w * r); o8[64 * j] = w; }
}
__device__ __forceinline__ void rw_phase(const float* hin, float* hout, const bfu* Y, bfu* A, const float* gain, float scale, int gw, int ngw, int lane) {
    f32x4 g[4];
#pragma unroll
    for (int j = 0; j < 4; ++j) g[j] = *((const f32x4*)gain + lane + 64 * j);
    for (int m0 = gw; m0 < T; m0 += 2 * ngw) {
        f32x4 v[2][4], y[2][4]; float s[2] = {0.f, 0.f}; const int m1 = m0 + ngw; const bool two = m1 < T;
#pragma unroll
        for (int r = 0; r < 2; ++r) { const int m = (r == 0 || two) ? (r == 0 ? m0 : m1) : m0;
            const f32x4* hr = (const f32x4*)(hin + (size_t)m * D) + lane; const v2u* yr = (const v2u*)(Y + (size_t)m * D) + lane;
#pragma unroll
            for (int j = 0; j < 4; ++j) { v[r][j] = hr[64 * j]; const v2u w = yr[64 * j]; y[r][j] = (f32x4){pg8::bflo(w.x), pg8::bfhi(w.x), pg8::bflo(w.y), pg8::bfhi(w.y)}; } }
#pragma unroll
        for (int r = 0; r < 2; ++r)
#pragma unroll
            for (int j = 0; j < 4; ++j) s[r] += (y[r][j].x * y[r][j].x + y[r][j].y * y[r][j].y) + (y[r][j].z * y[r][j].z + y[r][j].w * y[r][j].w);
        float s2[2] = {0.f, 0.f};
#pragma unroll
        for (int r = 0; r < 2; ++r) { const float ry = __builtin_amdgcn_rsqf(wave_sum(s[r]) * (1.f / D) + EPS) * scale;
#pragma unroll
            for (int j = 0; j < 4; ++j) { v[r][j] = v[r][j] + y[r][j] * ry * g[j]; s2[r] += (v[r][j].x * v[r][j].x + v[r][j].y * v[r][j].y) + (v[r][j].z * v[r][j].z + v[r][j].w * v[r][j].w); } }
#pragma unroll
        for (int r = 0; r < 2; ++r) { if (r == 1 && !two) break; const int m = r == 0 ? m0 : m1;
            const float r2 = __builtin_amdgcn_rsqf(wave_sum(s2[r]) * (1.f / D) + EPS);
            f32x4* ho = (f32x4*)(hout + (size_t)m * D) + lane; v2u* ao = (v2u*)(A + (size_t)m * D) + lane;
#pragma unroll
            for (int j = 0; j < 4; ++j) { ho[64 * j] = v[r][j]; v2u w; w.x = pk2(v[r][j].x * r2, v[r][j].y * r2); w.y = pk2(v[r][j].z * r2, v[r][j].w * r2); ao[64 * j] = w; } }
    }
}

constexpr int HG_QH = 0, HG_QT = 17408, HG_KT = 34816, HG_KHT = 52224, HG_VT = 70656, HG_PP = 89088, HG_ST = 98304, HG_TOT = 133120, HG_DV = 135168, HG_END = 135680;
constexpr int RS = 136, RS2 = 72, OFS = 132;
static_assert(HG_END <= LDS_BYTES, "hgrn lds");
__device__ __forceinline__ f32x4 mfma16(bf16x8 a, bf16x8 b, f32x4 c) { return __builtin_amdgcn_mfma_f32_16x16x32_bf16(a, b, c, 0, 0, 0); }
constexpr int HSEG = 4, HCH = SEQ / 64 / HSEG;
template <bool OUT>
__device__ __forceinline__ void hgrn_scan(LAS unsigned char* lds, bfu* QZVG, const float* lbl, int bh, int seg, float* Ebuf, float* Lbuf, int wave_s) {
    int tid_o = tid_from(wave_s); asm volatile("" : "+v"(tid_o)); const int tid = tid_o, lane = tid & 63, wid = __builtin_amdgcn_readfirstlane(tid >> 6), col = tid & 127, rg = tid >> 7, fr = lane & 15, fq = lane >> 4;
    const int b = bh >> 3, h = bh & 7;
    LAS bfu* QH = (LAS bfu*)(lds + HG_QH); LAS bfu* QT = (LAS bfu*)(lds + HG_QT); LAS bfu* KT = (LAS bfu*)(lds + HG_KT); LAS bfu* KHT = (LAS bfu*)(lds + HG_KHT);
    LAS bfu* VT = (LAS bfu*)(lds + HG_VT); LAS bfu* PP = (LAS bfu*)(lds + HG_PP); LAS bfu* ST = (LAS bfu*)(lds + HG_ST);
    LAS float* TOT = (LAS float*)(lds + HG_TOT); LAS float* DV = (LAS float*)(lds + HG_DV); LAS float* OF = (LAS float*)(lds + HG_QT);
    const float l0 = lbl[h * 128 + col], l1 = lbl[1024 + h * 128 + col];
    const float lb = 1.f / (1.f + __expf(l1 - l0)), omlb = 1.f - lb;
    bfu* base = QZVG + ((size_t)b * SEQ + (size_t)seg * HCH * 64) * 4096 + h * 128;
    const bfu* pq = base + (size_t)(16 * rg) * 4096 + col; const bfu* pz = pq + 1024; const bfu* pv = pq + 2048;
    const int erow = tid >> 3, eseg = tid & 7;
    const bfu* pg = base + 3072 + (size_t)erow * 4096 + 16 * eseg; bfu* po = base + (size_t)erow * 4096 + 16 * eseg;
    f32x4 Sacc[8];
#pragma unroll
    for (int i = 0; i < 8; ++i) Sacc[i] = (f32x4){0.f, 0.f, 0.f, 0.f};
    float Lacc = 0.f;
    if constexpr (OUT) {
        for (int j = 0; j < seg; ++j) {
            const float* Ej = Ebuf + ((size_t)(bh * HSEG + j) * 64 * 64) * 4 + (size_t)(wid * 8) * 64 * 4; const float* Lj = Lbuf + (size_t)(bh * HSEG + j) * 128;
#pragma unroll
            for (int kb = 0; kb < 8; ++kb) { const f32x4 e = *(const f32x4*)(Ej + ((size_t)kb * 64 + lane) * 4); const f32x4 l4 = *(const f32x4*)(Lj + 16 * kb + 4 * fq);
                f32x4 s = Sacc[kb]; s[0] = s[0] * __expf(l4[0]) + e[0]; s[1] = s[1] * __expf(l4[1]) + e[1]; s[2] = s[2] * __expf(l4[2]) + e[2]; s[3] = s[3] * __expf(l4[3]) + e[3]; Sacc[kb] = s; }
        }
#pragma unroll
        for (int kb = 0; kb < 8; ++kb) *(LAS v2u*)(ST + (16 * wid + fr) * RS + 16 * kb + 4 * fq) = (v2u){pk2(Sacc[kb][0], Sacc[kb][1]), pk2(Sacc[kb][2], Sacc[kb][3])};
    }
    unsigned short zr[16], qr[16], vr[16]; v4u gr0 = (v4u){0u, 0u, 0u, 0u}, gr1 = gr0;
#define HG_LOAD() do { _Pragma("unroll") for (int j = 0; j < 16; ++j) { zr[j] = pz[(size_t)j * 4096]; vr[j] = pv[(size_t)j * 4096]; if (OUT) qr[j] = pq[(size_t)j * 4096]; else qr[j] = 0; } \
        if (OUT) { gr0 = *(const v4u*)pg; gr1 = *(const v4u*)(pg + 8); } pz += (size_t)64 * 4096; pq += (size_t)64 * 4096; pv += (size_t)64 * 4096; pg += (size_t)64 * 4096; } while (0)
    HG_LOAD();
    for (int c = 0; c < HCH; ++c) {
        float kk[16], cum[16], qf[16]; unsigned short vv[16]; const v4u g0 = gr0, g1 = gr1;
        float run = 0.f;
#pragma unroll
        for (int j = 0; j < 16; ++j) { const float z = bf2f(zr[j]); const float k = omlb * __builtin_amdgcn_rcpf(1.f + __expf(z)); run += __logf(1.f - k); cum[j] = run; kk[j] = k; qf[j] = bf2f(qr[j]); vv[j] = vr[j]; }
        TOT[rg * 128 + col] = run;
        if (c + 1 < HCH) HG_LOAD();
        LDS_WAIT(); __builtin_amdgcn_s_barrier(); asm volatile("" ::: "memory");
        const float t0 = TOT[col], t1 = TOT[128 + col], t2 = TOT[256 + col], t3 = TOT[384 + col];
        const float pre = (rg > 0 ? t0 : 0.f) + (rg > 1 ? t1 : 0.f) + (rg > 2 ? t2 : 0.f), tot = (t0 + t1) + (t2 + t3), mid = t0 + t1;
        Lacc += tot;
        unsigned khp[8], vvp[8];
#pragma unroll
        for (int j = 0; j < 16; ++j) { const float cj = pre + cum[j]; const int r = 16 * rg + j;
            if constexpr (OUT) { QH[r * RS + col] = f2b(qf[j] * __expf(cj)); QT[r * RS + col] = f2b(qf[j] * __expf(cj - mid)); KT[r * RS + col] = f2b(kk[j] * __expf(mid - cj)); }
            const unsigned short kh = f2b(kk[j] * __expf(tot - cj));
            if (j & 1) { khp[j >> 1] |= (unsigned)kh << 16; vvp[j >> 1] |= (unsigned)vv[j] << 16; } else { khp[j >> 1] = kh; vvp[j >> 1] = vv[j]; } }
        *(LAS v4u*)(KHT + col * RS2 + 16 * rg) = (v4u){khp[0], khp[1], khp[2], khp[3]}; *(LAS v4u*)(KHT + col * RS2 + 16 * rg + 8) = (v4u){khp[4], khp[5], khp[6], khp[7]};
        *(LAS v4u*)(VT + col * RS2 + 16 * rg) = (v4u){vvp[0], vvp[1], vvp[2], vvp[3]}; *(LAS v4u*)(VT + col * RS2 + 16 * rg + 8) = (v4u){vvp[4], vvp[5], vvp[6], vvp[7]};
        if (rg == 0) DV[col] = __expf(tot);
        LDS_WAIT(); __builtin_amdgcn_s_barrier(); asm volatile("" ::: "memory");
        if constexpr (OUT) {
            const int tb = wid >> 1;
#pragma unroll
            for (int ss = 0; ss < 2; ++ss) { const int sb = 2 * (wid & 1) + ss; f32x4 sc = (f32x4){0.f, 0.f, 0.f, 0.f};
                if (sb <= tb) {
#pragma unroll
                    for (int ks = 0; ks < 4; ++ks) { const bf16x8 a = *(const LAS bf16x8*)(QT + (16 * tb + fr) * RS + 32 * ks + 8 * fq), bq = *(const LAS bf16x8*)(KT + (16 * sb + fr) * RS + 32 * ks + 8 * fq); sc = mfma16(a, bq, sc); } }
#pragma unroll
                for (int i = 0; i < 4; ++i) { const int t = 16 * tb + 4 * fq + i, s = 16 * sb + fr; PP[t * RS2 + s] = f2b((sb <= tb && s <= t) ? sc[i] : 0.f); } }
            LDS_WAIT(); __builtin_amdgcn_s_barrier(); asm volatile("" ::: "memory");
        }
        {   bf16x8 vtf[2];
#pragma unroll
            for (int ks = 0; ks < 2; ++ks) vtf[ks] = *(const LAS bf16x8*)(VT + (16 * wid + fr) * RS2 + 32 * ks + 8 * fq);
            if constexpr (OUT) { bf16x8 stf[4];
#pragma unroll
                for (int ks = 0; ks < 4; ++ks) stf[ks] = *(const LAS bf16x8*)(ST + (16 * wid + fr) * RS + 32 * ks + 8 * fq);
#pragma unroll
                for (int tb = 0; tb < 4; ++tb) { f32x4 o = (f32x4){0.f, 0.f, 0.f, 0.f};
#pragma unroll
                    for (int ks = 0; ks < 4; ++ks) o = mfma16(*(const LAS bf16x8*)(QH + (16 * tb + fr) * RS + 32 * ks + 8 * fq), stf[ks], o);
#pragma unroll
                    for (int ks = 0; ks < 2; ++ks) o = mfma16(*(const LAS bf16x8*)(PP + (16 * tb + fr) * RS2 + 32 * ks + 8 * fq), vtf[ks], o);
#pragma unroll
                    for (int i = 0; i < 4; ++i) OF[(16 * tb + 4 * fq + i) * OFS + 16 * wid + fr] = o[i]; } }
#pragma unroll
            for (int kb = 0; kb < 8; ++kb) { const f32x4 d4 = *(const LAS f32x4*)(DV + 16 * kb + 4 * fq); f32x4 s = Sacc[kb] * d4;
#pragma unroll
                for (int ks = 0; ks < 2; ++ks) s = mfma16(*(const LAS bf16x8*)(KHT + (16 * kb + fr) * RS2 + 32 * ks + 8 * fq), vtf[ks], s);
                Sacc[kb] = s; if constexpr (OUT) *(LAS v2u*)(ST + (16 * wid + fr) * RS + 16 * kb + 4 * fq) = (v2u){pk2(s[0], s[1]), pk2(s[2], s[3])}; }
        }
        if constexpr (OUT) {
            LDS_WAIT(); __builtin_amdgcn_s_barrier(); asm volatile("" ::: "memory");
            f32x4 o4[4]; float ss = 0.f;
#pragma unroll
            for (int j = 0; j < 4; ++j) { o4[j] = *(const LAS f32x4*)(OF + erow * OFS + 16 * eseg + 4 * j); ss += (o4[j].x * o4[j].x + o4[j].y * o4[j].y) + (o4[j].z * o4[j].z + o4[j].w * o4[j].w); }
            ss += __shfl_xor(ss, 1); ss += __shfl_xor(ss, 2); ss += __shfl_xor(ss, 4);
            const float rs = __builtin_amdgcn_rsqf(ss * (1.f / 128.f) + EPS);
            unsigned w[8];
#pragma unroll
            for (int j = 0; j < 4; ++j) { const unsigned ga = (j < 2) ? g0[2 * j] : g1[2 * (j - 2)], gb = (j < 2) ? g0[2 * j + 1] : g1[2 * (j - 2) + 1];
                const float a0 = pg8::bflo(ga), a1 = pg8::bfhi(ga), a2 = pg8::bflo(gb), a3 = pg8::bfhi(gb);
                w[2 * j] = pk2(o4[j].x * rs * a0 * pg8::fsigmoid(a0), o4[j].y * rs * a1 * pg8::fsigmoid(a1)); w[2 * j + 1] = pk2(o4[j].z * rs * a2 * pg8::fsigmoid(a2), o4[j].w * rs * a3 * pg8::fsigmoid(a3)); }
            *(v4u*)po = (v4u){w[0], w[1], w[2], w[3]}; *(v4u*)(po + 8) = (v4u){w[4], w[5], w[6], w[7]}; po += (size_t)64 * 4096;
        }
    }
#undef HG_LOAD
    if constexpr (!OUT) {
        float* Es = Ebuf + ((size_t)(bh * HSEG + seg) * 64 * 64) * 4 + (size_t)(wid * 8) * 64 * 4;
#pragma unroll
        for (int kb = 0; kb < 8; ++kb) *(f32x4*)(Es + ((size_t)kb * 64 + lane) * 4) = Sacc[kb];
        if (rg == 0) Lbuf[(size_t)(bh * HSEG + seg) * 128 + col] = Lacc;
    }
    LDS_WAIT(); __builtin_amdgcn_s_barrier(); asm volatile("" ::: "memory");
}

__device__ __forceinline__ void cumsum_bh(LAS unsigned char* lds, const float* LOGF, float* C, int bh, int wave_s) {
    const int tid = tid_from(wave_s), lane = tid & 63, wid = tid >> 6, b = bh >> 4, h = bh & 15;
    LAS float* wsum = (LAS float*)lds;
    const float* src = LOGF + ((size_t)b * SEQ + 8 * tid) * 16 + h;
    float v[8]; float run = 0.f;
#pragma unroll
    for (int j = 0; j < 8; ++j) { run += src[j * 16]; v[j] = run; }
    float inc = run;
#pragma unroll
    for (int o = 1; o < 64; o <<= 1) { const float t = __shfl_up(inc, o); if (lane >= o) inc += t; }
    if (lane == 63) wsum[wid] = inc;
    LDS_WAIT(); __builtin_amdgcn_s_barrier(); asm volatile("" ::: "memory");
    float off = inc - run;
    for (int w = 0; w < wid; ++w) off += wsum[w];
    float* dst = C + (size_t)bh * SEQ + 8 * tid;
    *(f32x4*)dst = (f32x4){(off + v[0]) * LOG2E, (off + v[1]) * LOG2E, (off + v[2]) * LOG2E, (off + v[3]) * LOG2E};
    *(f32x4*)(dst + 4) = (f32x4){(off + v[4]) * LOG2E, (off + v[5]) * LOG2E, (off + v[6]) * LOG2E, (off + v[7]) * LOG2E};
    LDS_WAIT(); __builtin_amdgcn_s_barrier(); asm volatile("" ::: "memory");
}

#define RLX_AGENT __ATOMIC_RELAXED, __HIP_MEMORY_SCOPE_AGENT
#define XB_TMO      128
#define XB_XCNT(j)  (256  + 64 * (j))
#define XB_XSUB(j)  (1280 + 64 * (j))
#define XB_XGEN(j)  (2304 + 64 * (j))
#define XB_TOP      3328
#define XB_TOPGEN   3392
#define XCD_BAR_WORDS 3456
#define XB_SPIN_CAP (1u << 18)

__device__ __forceinline__ unsigned xb_ld(unsigned* p)              { return __hip_atomic_load(p, __ATOMIC_RELAXED, __HIP_MEMORY_SCOPE_AGENT); }
__device__ __forceinline__ unsigned xb_add(unsigned* p, unsigned v) { return __hip_atomic_fetch_add(p, v, __ATOMIC_RELAXED, __HIP_MEMORY_SCOPE_AGENT); }
__device__ __forceinline__ unsigned xb_xcc_id() { return (unsigned)__builtin_amdgcn_s_getreg((3 << 11) | 20) & 0xFu; }
#define XB_SPIN(cond, bar) do { unsigned _sp = 0; while (cond) { __builtin_amdgcn_s_sleep(1); \
    if ((++_sp & 255u) == 0u) { if (xb_ld(&(bar)[XB_TMO])) break; if (_sp > XB_SPIN_CAP) { atomicAdd(&(bar)[XB_TMO], 1u); break; } } } } while (0)

struct XcdBarrier {
    unsigned* bar; unsigned x;
    volatile LAS unsigned* st;
};

__device__ __forceinline__ XcdBarrier xcd_barrier_post(unsigned* bar, volatile LAS unsigned* st, bool is_t0) {
    XcdBarrier b; b.bar = bar; b.x = xb_xcc_id(); b.st = st;
    if (is_t0) (void)xb_add(&bar[XB_XCNT(b.x)], 1u);
    return b;
}
__device__ __forceinline__ void xcd_barrier_complete(unsigned* bar, unsigned x, unsigned& nloc, unsigned& nx) {
    const unsigned G = gridDim.x * gridDim.y * gridDim.z;
    unsigned sum, cnt, mine, sp = 0u;
    for (;;) {
        sum = 0u; cnt = 0u; mine = 0u;
#pragma unroll
        for (unsigned j = 0; j < 16; ++j) { const unsigned c = xb_ld(&bar[XB_XCNT(j)]); sum += c; cnt += (c > 0u) ? 1u : 0u; mine = (j == x) ? c : mine; }
        if (sum == G) break;
        __builtin_amdgcn_s_sleep(1);
        if ((++sp & 255u) == 0u) { if (xb_ld(&bar[XB_TMO])) break; if (sp > XB_SPIN_CAP) { atomicAdd(&bar[XB_TMO], 1u); break; } }
    }
    nloc = mine > 0u ? mine : 1u; nx = cnt > 0u ? cnt : 1u;
}

__device__ __forceinline__ void xcd_barrier(const XcdBarrier& b, bool is_t0) {
    asm volatile("s_waitcnt vmcnt(0)" ::: "memory");
    __syncthreads();
    if (is_t0) {
        unsigned* bar = b.bar;
        __builtin_amdgcn_s_waitcnt(0);
        unsigned nloc = b.st[0], nx = b.st[1];
        if (nloc == 0u) { xcd_barrier_complete(bar, b.x, nloc, nx); b.st[0] = nloc; b.st[1] = nx; }
        const unsigned old = xb_add(&bar[XB_XSUB(b.x)], 1u);
        const unsigned gen = old / nloc;
        if (old + 1u == (gen + 1u) * nloc) {
            __builtin_amdgcn_fence(__ATOMIC_RELEASE, "agent");
            asm volatile("s_waitcnt vmcnt(0)" ::: "memory");
            const unsigned og = xb_add(&bar[XB_TOP], 1u);
            const unsigned tg = og / nx;
            if (og + 1u == (tg + 1u) * nx) xb_add(&bar[XB_TOPGEN], 1u);
            else XB_SPIN(xb_ld(&bar[XB_TOPGEN]) == tg, bar);
            __builtin_amdgcn_fence(__ATOMIC_ACQUIRE, "agent");
            xb_add(&bar[XB_XGEN(b.x)], 1u);
            asm volatile("s_waitcnt vmcnt(0)" ::: "memory");
        } else {
            XB_SPIN(xb_ld(&bar[XB_XGEN(b.x)]) == gen, bar);
            __builtin_amdgcn_fence(__ATOMIC_ACQUIRE, "agent");
            asm volatile("s_waitcnt vmcnt(0)" ::: "memory");
        }
    }
    __syncthreads();
}

constexpr size_t WS_CTL = E_WEND * 2, CTL_BYTES = 16384; static_assert(WS_CTL % 256 == 0 && WS_CTL + CTL_BYTES <= WS_P && XCD_BAR_WORDS * 4 <= CTL_BYTES, "ctl");
constexpr int LDS_BARST = LDS_BYTES - 64;
struct Args { const float* in[25]; float* out; unsigned char* ws; int st_lo, st_hi; };
enum { ST_PRO, ST_F1I0, ST_F1O0, ST_RW00, ST_HIN, ST_HS1, ST_HS2, ST_HOUT, ST_RW01, ST_F2I0, ST_F2O0, ST_PP0, ST_RW02, ST_PG0, ST_RW03, ST_KVF, ST_F1I1, ST_CUM, ST_F1O1, ST_RW10, ST_QG, ST_ATT, ST_FOUT, ST_RW11, ST_F2I1, ST_F2O1, ST_PP1, ST_RW12, ST_PG1, ST_RW13, NSTEP };
__host__ __device__ constexpr bool sync_before(int s) { return !(s == ST_PRO || s == ST_PP0 || s == ST_F1I1 || s == ST_F1O1 || s == ST_PP1); }
enum { K_PRO = 0, K_FFN_IN, K_FFN_OUT, K_RW, K_HGRN_IN, K_HGRN, K_HGRN_OUT, K_PLE_PROJ, K_PLE_GATE, K_KVF, K_CUMSUM, K_QG, K_ATTN, K_FOX_OUT };

__global__ void __launch_bounds__(NWAVES * 64, 2) yoco_fwd(Args args) {
    extern __shared__ __attribute__((aligned(16))) unsigned char lds[];
    cg::grid_group grid = cg::this_grid();
    LAS unsigned char* ldsp = (LAS unsigned char*)lds;
    const int st_lo = args.st_lo, st_hi = args.st_hi;
    const int wave_s = __builtin_amdgcn_readfirstlane((int)(threadIdx.x >> 6));
    if (tid_from(wave_s) < 2) ((volatile LAS unsigned*)(ldsp + LDS_BARST))[tid_from(wave_s)] = 0u;
    __syncthreads();
    (void)xcd_barrier_post((unsigned*)(args.ws + WS_CTL), (volatile LAS unsigned*)(ldsp + LDS_BARST), tid_from(wave_s) == 0);
#define STEP_BEGIN(k) if (st_lo <= (k) && (k) < st_hi) { if ((k) > st_lo && sync_before(k)) { if (st_hi < 0) { asm volatile("s_waitcnt vmcnt(0) lgkmcnt(0)" ::: "memory"); grid.sync(); __builtin_amdgcn_fence(__ATOMIC_ACQUIRE, "agent"); asm volatile("s_waitcnt vmcnt(0)" ::: "memory"); }     \
          else { XcdBarrier xb_; xb_.bar = (unsigned*)(((const __attribute__((address_space(4))) Args*)__builtin_amdgcn_kernarg_segment_ptr())->ws + WS_CTL); xb_.x = xb_xcc_id(); xb_.st = (volatile LAS unsigned*)(ldsp + LDS_BARST); xcd_barrier(xb_, tid_from(wave_s) == 0); } } \
        const __attribute__((address_space(4))) Args* ap = (const __attribute__((address_space(4))) Args*)__builtin_amdgcn_kernarg_segment_ptr(); asm volatile("" : "+s"(ap)); \
        int tid_k = tid_from(wave_s); asm volatile("" : "+v"(tid_k)); const int tid = tid_k, lane = tid & 63, wave = __builtin_amdgcn_readfirstlane(tid >> 6); \
        const int G = gridDim.x, bx = blockIdx.x; unsigned char* ws = ap->ws; bfu* Wb = (bfu*)ws; bfu* PB = (bfu*)(ws + WS_P); float* LOGF = (float*)(ws + WS_LOGF); float* CL = (float*)(ws + WS_C); \
        bfu* AY = (bfu*)(ws + WS_AY); bfu* BIG = (bfu*)(ws + WS_BIG); bfu* PROJ = (bfu*)(ws + WS_PROJ); const int gw = bx * NWAVES + wave, ngw = G * NWAVES; \
        (void)tid; (void)lane; (void)Wb; (void)PB; (void)LOGF; (void)CL; (void)AY; (void)BIG; (void)PROJ; (void)gw; (void)ngw;
#define STEP_END }
#define RUN_GEMM(MODE, A_, LDA_, Bt_, N_, K_, O_, LDC_, O2_, AUX_, SC_) do { const pg8::Gemm g{A_, Bt_, T, N_, K_, LDA_}; pg8::StaticOrder S; S.init(T, N_, G, bx); \
        const pg8::Epi<MODE, LDC_> E{O_, O2_, AUX_, LOGF, ap->in[18], SC_}; pg8::gemm_phase<pg8::Epi<MODE, LDC_>, pg8::StaticOrder, true, true, K_, LDA_>(ldsp, g, S, E, wave_s); } while (0)
#define NOB ((bfu*)nullptr)
#define S_FFN_IN(k, L, w)  STEP_BEGIN(k) RUN_GEMM(pg8::EP_SWIGLU, AY, D, Wb + ((w) == 1 ? E_W1IN : E_W2IN) + (L) * N_WIN, 2 * FF, D, BIG, FF, NOB, NOB, 1.f); STEP_END
#define S_FFN_OUT(k, L, w) STEP_BEGIN(k) RUN_GEMM(pg8::EP_PLAIN, BIG, FF, Wb + ((w) == 1 ? E_W1OUT : E_W2OUT) + (L) * N_WOUT, D, FF, AY, D, NOB, NOB, 1.f); STEP_END
#define S_PLE_PROJ(k, L)   STEP_BEGIN(k) RUN_GEMM(pg8::EP_PLAIN, PB + (size_t)(L) * T * PLE, PLE, Wb + E_WPP + (size_t)(L) * PLE * D, D, PLE, PROJ, D, NOB, NOB, 1.f); STEP_END
#define S_PLE_GATE(k, L)   STEP_BEGIN(k) RUN_GEMM(pg8::EP_PLEGATE, AY, D, Wb + E_WPG + (size_t)(L) * D * D, D, D, BIG, D, NOB, PROJ, 1.f); STEP_END
#define S_RW(k, L, w)      STEP_BEGIN(k) { const float* hin = ((L) == 0 && (w) == 0) ? ap->in[0] : ap->out; const bfu* Y = ((w) == 3) ? BIG : AY; \
        const float* gain = ((w) == 0 ? ap->in[5] : (w) == 1 ? ap->in[7] : (w) == 2 ? ap->in[11] : ap->in[24]) + (L) * D; \
        rw_phase(hin, ap->out, Y, AY, gain, ((w) == 0 || (w) == 2) ? 0.5f : 1.0f, gw, ngw, lane); } STEP_END

    STEP_BEGIN(ST_PRO) {
        LAS float* scr = (LAS float*)(ldsp + wave * 16384);
        for (int it = gw;; it += ngw) {
            int r = it;
#define CONV(src, K_, N_, dst, gain, gmask, sw) { constexpr int NI = ((K_) / 64) * (((N_) + 31) / 32); if (r < NI) { conv_item(src, K_, N_, dst, gain, gmask, sw, scr, r, lane); continue; } r -= NI; }
            CONV(ap->in[3], D, 2 * FF, Wb + E_W1IN, ap->in[2], 1023, 1)
            CONV(ap->in[3] + N_WIN, D, 2 * FF, Wb + E_W1IN + N_WIN, ap->in[2] + D, 1023, 1)
            CONV(ap->in[9], D, 2 * FF, Wb + E_W2IN, ap->in[8], 1023, 1)
            CONV(ap->in[9] + N_WIN, D, 2 * FF, Wb + E_W2IN + N_WIN, ap->in[8] + D, 1023, 1)
            CONV(ap->in[4], FF, D, Wb + E_W1OUT, (const float*)nullptr, 0, 0)
            CONV(ap->in[4] + N_WOUT, FF, D, Wb + E_W1OUT + N_WOUT, (const float*)nullptr, 0, 0)
            CONV(ap->in[10], FF, D, Wb + E_W2OUT, (const float*)nullptr, 0, 0)
            CONV(ap->in[10] + N_WOUT, FF, D, Wb + E_W2OUT + N_WOUT, (const float*)nullptr, 0, 0)
            CONV(ap->in[12], D, 4 * D, Wb + E_WHIN, ap->in[6], 1023, 0)
            CONV(ap->in[15], D, D, Wb + E_WHOUT, ap->in[14], 127, 0)
            CONV(ap->in[17], D, NKVF, Wb + E_WKVF, ap->in[16], 1023, 0)
            CONV(ap->in[19], D, 2 * D, Wb + E_WQG, ap->in[6] + D, 1023, 0)
            CONV(ap->in[20], D, D, Wb + E_WFO, (const float*)nullptr, 0, 0)
            CONV(ap->in[22], D, D, Wb + E_WPG, ap->in[21], 1023, 0)
            CONV(ap->in[22] + (size_t)D * D, D, D, Wb + E_WPG + (size_t)D * D, ap->in[21] + D, 1023, 0)
            CONV(ap->in[23], PLE, D, Wb + E_WPP, (const float*)nullptr, 0, 0)
            CONV(ap->in[23] + (size_t)PLE * D, PLE, D, Wb + E_WPP + (size_t)PLE * D, (const float*)nullptr, 0, 0)
#undef CONV
            break;
        }
        {   const float* p = ap->in[1]; const size_t n8 = (size_t)2 * T * PLE / 8;
            for (size_t i = (size_t)bx * 512 + tid; i < n8; i += (size_t)G * 512) { const f32x4 a = *((const f32x4*)p + 2 * i), c = *((const f32x4*)p + 2 * i + 1);
                *((v4u*)PB + i) = (v4u){pk2(a.x, a.y), pk2(a.z, a.w), pk2(c.x, c.y), pk2(c.z, c.w)}; } }
        const float* x = ap->in[0];
        for (int m = gw; m < T; m += 2 * ngw) { rms_row_to_bf16(x + (size_t)m * D, AY + (size_t)m * D, lane); if (m + ngw < T) rms_row_to_bf16(x + (size_t)(m + ngw) * D, AY + (size_t)(m + ngw) * D, lane); }
    } STEP_END
    S_FFN_IN(ST_F1I0, 0, 1) S_FFN_OUT(ST_F1O0, 0, 1) S_RW(ST_RW00, 0, 0)
    STEP_BEGIN(ST_HIN) RUN_GEMM(pg8::EP_PLAIN, AY, D, Wb + E_WHIN, 4 * D, D, BIG, 4 * D, NOB, NOB, 1.f); STEP_END
    STEP_BEGIN(ST_HS1) { const float* lbl = ap->in[13]; float* Eb = (float*)AY; float* Lb = (float*)(ws + WS_AY + 32 * MiB);
        for (int it = bx; it < BATCH * 8 * HSEG; it += G) if ((it & 3) != 3) hgrn_scan<false>(ldsp, BIG, lbl, it >> 2, it & 3, Eb, Lb, wave_s); } STEP_END
    STEP_BEGIN(ST_HS2) { const float* lbl = ap->in[13]; float* Eb = (float*)AY; float* Lb = (float*)(ws + WS_AY + 32 * MiB);
        for (int it = bx; it < BATCH * 8 * HSEG; it += G) hgrn_scan<true>(ldsp, BIG, lbl, it >> 2, it & 3, Eb, Lb, wave_s); } STEP_END
    STEP_BEGIN(ST_HOUT) RUN_GEMM(pg8::EP_PLAIN, BIG, 4 * D, Wb + E_WHOUT, D, D, AY, D, NOB, NOB, 1.f); STEP_END
    S_RW(ST_RW01, 0, 1) S_FFN_IN(ST_F2I0, 0, 2) S_FFN_OUT(ST_F2O0, 0, 2) S_PLE_PROJ(ST_PP0, 0) S_RW(ST_RW02, 0, 2) S_PLE_GATE(ST_PG0, 0) S_RW(ST_RW03, 0, 3)
    STEP_BEGIN(ST_KVF) RUN_GEMM(pg8::EP_KVF, AY, D, Wb + E_WKVF, NKVFP, D, (bfu*)(ws + WS_K), D, (bfu*)(ws + WS_V), NOB, 1.f); STEP_END
    S_FFN_IN(ST_F1I1, 1, 1)
    STEP_BEGIN(ST_CUM) { for (int bh = bx; bh < BATCH * 16; bh += G) cumsum_bh(ldsp, LOGF, CL, bh, wave_s); } STEP_END
    S_FFN_OUT(ST_F1O1, 1, 1) S_RW(ST_RW10, 1, 0)
    STEP_BEGIN(ST_QG) RUN_GEMM(pg8::EP_QG, AY, D, Wb + E_WQG, 2 * D, D, (bfu*)(ws + WS_Q), D, (bfu*)(ws + WS_G), NOB, attn_body::C2); STEP_END
    STEP_BEGIN(ST_ATT) {
        const attn_body::AttnTensors AT{(const attn_body::bf16*)(ws + WS_Q), (const attn_body::bf16*)(ws + WS_K), (const attn_body::bf16*)(ws + WS_V), (attn_body::bf16*)(ws + WS_Q), (const attn_body::bf16*)(ws + WS_G), CL};
        const attn_body::StaticOrder S(G, bx);
        attn_body::attn_phase<attn_body::StaticOrder>((char*)lds, AT, S, wave_s);
    } STEP_END
    STEP_BEGIN(ST_FOUT) RUN_GEMM(pg8::EP_PLAIN, (const bfu*)(ws + WS_Q), D, Wb + E_WFO, D, D, AY, D, NOB, NOB, 1.f); STEP_END
    S_RW(ST_RW11, 1, 1) S_FFN_IN(ST_F2I1, 1, 2) S_FFN_OUT(ST_F2O1, 1, 2) S_PLE_PROJ(ST_PP1, 1) S_RW(ST_RW12, 1, 2) S_PLE_GATE(ST_PG1, 1) S_RW(ST_RW13, 1, 3)
}

#ifndef MK_MULTI
#define MK_MULTI 0
#endif
extern "C" void kernel_launch(void* const* d_in, const int* in_sizes, int n_in, void* d_out, int out_size, void* d_ws, size_t ws_size, hipStream_t stream) {
    static int grid = 0;
    if (grid == 0) {
        if (n_in != 25 || out_size != T * D || ws_size < WS_END) { fprintf(stderr, "kernel_launch: unexpected shapes (n_in %d out %d ws %zu)\n", n_in, out_size, ws_size); grid = -1; return; }
        int dev = 0, cus = 0, per_cu = 0;
        (void)hipGetDevice(&dev); (void)hipDeviceGetAttribute(&cus, hipDeviceAttributeMultiprocessorCount, dev);
        if (hipFuncSetAttribute((const void*)yoco_fwd, hipFuncAttributeMaxDynamicSharedMemorySize, LDS_BYTES) != hipSuccess) { fprintf(stderr, "kernel_launch: hipFuncSetAttribute failed\n"); grid = -1; return; }
        if (hipOccupancyMaxActiveBlocksPerMultiprocessor(&per_cu, (const void*)yoco_fwd, NWAVES * 64, LDS_BYTES) != hipSuccess || per_cu < 1) per_cu = 1;
        (void)hipGetLastError();
        if (cus <= 0) cus = 256;
        grid = cus * per_cu;
    }
    if (grid < 0) return;
    if (hipMemsetAsync((char*)d_ws + WS_CTL, 0, CTL_BYTES, stream) != hipSuccess) { fprintf(stderr, "kernel_launch: memset failed\n"); return; }
    Args a{};
    for (int i = 0; i < 25; ++i) a.in[i] = (const float*)d_in[i];
    a.out = (float*)d_out; a.ws = (unsigned char*)d_ws;
#if MK_MULTI
    int lo = 0;
    for (int s = 1; s <= NSTEP; ++s) if (s == NSTEP || sync_before(s)) { a.st_lo = lo; a.st_hi = s; hipLaunchKernelGGL(yoco_fwd, dim3(grid), dim3(NWAVES * 64), LDS_BYTES, stream, a); lo = s; }
#else
#ifndef ST_CUT
#define ST_CUT NSTEP
#endif
    a.st_lo = 0; a.st_hi = ST_CUT;
    void* kargs[] = {&a};
    const hipError_t e = hipLaunchCooperativeKernel((const void*)yoco_fwd, dim3(grid), dim3(NWAVES * 64), kargs, LDS_BYTES, stream);
    if (e != hipSuccess) fprintf(stderr, "kernel_launch: cooperative launch failed: %s (grid %d)\n", hipGetErrorString(e), grid);
#endif
}
```

```cpp
#include <hip/hip_runtime.h>
#include <hip/hip_cooperative_groups.h>
#include <hip/hip_bf16.h>
#include <cstdio>
#include <cstdint>
#include <cmath>
namespace cg = cooperative_groups;
__device__ __forceinline__ int tid_from(int wave_s) { unsigned l; asm volatile("v_mbcnt_lo_u32_b32 %0, -1, 0\n\tv_mbcnt_hi_u32_b32 %0, -1, %0" : "=v"(l)); return wave_s * 64 + (int)l; }
namespace pg8 {
#define PG8_LAS __attribute__((address_space(3)))
typedef unsigned short bf16_t;
typedef short bf16x8 __attribute__((ext_vector_type(8)));
typedef float f32x4 __attribute__((ext_vector_type(4)));
typedef unsigned u32x4 __attribute__((ext_vector_type(4)));
constexpr int BM = 256, BK = 64, HALF = 128, HTB = HALF * BK * 2  , STAGE_BYTES = 8 * HTB, NXCD = 8, WGM = 8;

__host__ __device__ __forceinline__ int lds_byte(int r, int c) { const int st = (r >> 4) * 2 + (c >> 5), rr = r & 15, cc = c & 31, ob = rr * 64 + cc * 2; return st * 1024 + (ob ^ (((ob >> 9) & 1) << 5)); }
__host__ __device__ __forceinline__ void stage_rc(int b, int& R, int& C) { const int st = b / 1024, sb = b % 1024, swz = sb ^ (((sb >> 9) & 1) << 5); R = (st >> 1) * 16 + swz / 64; C = (st & 1) * 32 + (swz % 64) / 2; }
__host__ __device__ __forceinline__ int perm32(int rho) { const int n = rho >> 4, i = rho & 15; return 8 * (i >> 2) + 4 * n + (i & 3); }

struct Unit { int pm, pn; };
struct Gemm { const bf16_t* A; const bf16_t* Bt; int M, N, K, lda; };

struct StaticOrder {
    int nM, nN, nwg, G, c;
    __host__ __device__ void init(int M, int N, int G_, int c_) { nM = M / BM; nN = N / BM; nwg = nM * nN; G = G_; c = c_; }
    __host__ __device__ bool next(int i, Unit& u) const {
        const long L = (long)i * G + c; if (L >= nwg) return false;
        int wgid = (int)L; { const int q = nwg / NXCD, r = nwg % NXCD, xcd = wgid % NXCD, off = wgid / NXCD; wgid = (xcd < r ? xcd * (q + 1) : r * (q + 1) + (xcd - r) * q) + off; }
        const int nig = WGM * nN, gid = wgid / nig, fm = gid * WGM, gsz = (nM - fm) < WGM ? (nM - fm) : WGM;
        u.pm = fm + ((wgid % nig) % gsz); u.pn = (wgid % nig) / gsz; return true;
    }
    __device__ __forceinline__ void a_ready(const Unit&) const {}
    __device__ __forceinline__ void done(const Unit&) const {}
};

typedef float f32x2cv __attribute__((ext_vector_type(2))); typedef __bf16 bf16x2cv __attribute__((ext_vector_type(2)));
__device__ __forceinline__ unsigned cvt_pk_bf16_asm(float lo, float hi) { unsigned r; asm volatile("v_cvt_pk_bf16_f32 %0, %1, %2" : "=v"(r) : "v"(lo), "v"(hi)); return r; }
__device__ __forceinline__ unsigned cvt_pk_bf16(float lo, float hi) { const f32x2cv v = {lo, hi}; const bf16x2cv b = __builtin_convertvector(v, bf16x2cv); return __builtin_bit_cast(unsigned, b); }
enum { EP_PLAIN = 0, EP_SWIGLU = 1, EP_KVF = 2, EP_QG = 3, EP_PLEGATE = 4 };
__device__ __forceinline__ float fsigmoid(float x) { return __builtin_amdgcn_rcpf(1.0f + __builtin_amdgcn_exp2f(-1.4426950408889634f * x)); }
__device__ __forceinline__ float bflo(unsigned w) { return __uint_as_float(w << 16); }
__device__ __forceinline__ float bfhi(unsigned w) { return __uint_as_float(w & 0xffff0000u); }
template <int MODE, int LDC> struct Epi {
    static constexpr bool PERM = true, AFTER_DRAIN = false;
    bf16_t* O; bf16_t* O2; const bf16_t* aux; float* lf; const float* bfp; float scale0; static constexpr int ldc = LDC;
    __device__ __forceinline__ void operator()(const f32x4 (&acc)[2][2][4][2], const Unit& u, int wr, int wc, int fr, int fq) const {
        asm volatile("s_nop 15\n\ts_nop 15" ::: "memory");
        const int row0 = u.pm * BM + wr * 64 + fr;
        if constexpr (MODE == EP_SWIGLU) {
            const int col0 = u.pn * HALF + wc * 32 + 8 * fq;
#pragma unroll
            for (int ai = 0; ai < 2; ++ai)
#pragma unroll
                for (int m = 0; m < 4; ++m) { bf16_t* rowp = O + (size_t)(row0 + ai * HALF + m * 16) * ldc + col0;
                    const f32x4 g0 = acc[ai][0][m][0], g1 = acc[ai][0][m][1], u0 = acc[ai][1][m][0], u1 = acc[ai][1][m][1]; f32x4 v0, v1;
#pragma unroll
                    for (int j = 0; j < 4; ++j) { v0[j] = g0[j] * fsigmoid(g0[j]) * u0[j]; v1[j] = g1[j] * fsigmoid(g1[j]) * u1[j]; }
                    u32x4 w; w.x = cvt_pk_bf16_asm(v0[0], v0[1]); w.y = cvt_pk_bf16_asm(v0[2], v0[3]); w.z = cvt_pk_bf16_asm(v1[0], v1[1]); w.w = cvt_pk_bf16_asm(v1[2], v1[3]);
                    *(u32x4*)rowp = w; }
        } else {
            bf16_t* base = O; int colt = u.pn * BM; int kind = 0; float sc = 1.f;
            if constexpr (MODE == EP_KVF) { if (u.pn >= 8) kind = 2; else if (u.pn >= 4) { base = O2; colt -= 1024; } }
            if constexpr (MODE == EP_QG) { if (u.pn >= 4) { base = O2; colt -= 1024; kind = 1; } else sc = scale0; }
            if (MODE == EP_KVF && kind == 2) {
                if (wc == 0 && fq < 2) {
#pragma unroll
                    for (int ai = 0; ai < 2; ++ai)
#pragma unroll
                        for (int m = 0; m < 4; ++m) { float* lp = lf + (size_t)(row0 + ai * HALF + m * 16) * 16 + 8 * fq;
#pragma unroll
                            for (int n = 0; n < 2; ++n) { const f32x4 a = acc[ai][0][m][n]; f32x4 o;
#pragma unroll
                                for (int j = 0; j < 4; ++j) { const float x = a[j] + bfp[8 * fq + 4 * n + j]; o[j] = fminf(x, 0.f) - __logf(1.0f + __expf(-fabsf(x))); }
                                *(f32x4*)(lp + 4 * n) = o; } }
                }
                return;
            }
            const int col0 = colt + wc * 32 + 8 * fq;
#pragma unroll
            for (int ai = 0; ai < 2; ++ai)
#pragma unroll
                for (int m = 0; m < 4; ++m) { const size_t roff = (size_t)(row0 + ai * HALF + m * 16) * ldc + col0;
#pragma unroll
                    for (int bj = 0; bj < 2; ++bj) { f32x4 v0 = acc[ai][bj][m][0], v1 = acc[ai][bj][m][1];
                        if (MODE == EP_QG && kind == 1) {
#pragma unroll
                            for (int j = 0; j < 4; ++j) { v0[j] = fsigmoid(v0[j]); v1[j] = fsigmoid(v1[j]); } }
                        else if (MODE == EP_QG) { v0 = v0 * sc; v1 = v1 * sc; }
                        if constexpr (MODE == EP_PLEGATE) { const u32x4 pq = *(const u32x4*)(aux + roff + bj * HALF);
                            v0[0] = fsigmoid(v0[0]) * bflo(pq.x); v0[1] = fsigmoid(v0[1]) * bfhi(pq.x); v0[2] = fsigmoid(v0[2]) * bflo(pq.y); v0[3] = fsigmoid(v0[3]) * bfhi(pq.y);
                            v1[0] = fsigmoid(v1[0]) * bflo(pq.z); v1[1] = fsigmoid(v1[1]) * bfhi(pq.z); v1[2] = fsigmoid(v1[2]) * bflo(pq.w); v1[3] = fsigmoid(v1[3]) * bfhi(pq.w); }
                        u32x4 w; w.x = cvt_pk_bf16_asm(v0[0], v0[1]); w.y = cvt_pk_bf16_asm(v0[2], v0[3]); w.z = cvt_pk_bf16_asm(v1[0], v1[1]); w.w = cvt_pk_bf16_asm(v1[2], v1[3]);
                        *(u32x4*)(base + roff + bj * HALF) = w; } }
        }
    }
};

template <class Epi, class Sched, bool ALIGN_EPI, bool SP2, int KC, int LDA>
__device__ __forceinline__ void gemm_phase(PG8_LAS unsigned char* lds, const Gemm g, const Sched& S, const Epi& E, int wave_s) {
    int tid_o = tid_from(wave_s); asm volatile("" : "+v"(tid_o)); const int tid = tid_o, wid = __builtin_amdgcn_readfirstlane(tid >> 6), lane = tid & 63, wr = wid >> 2, wc = wid & 3, fr = lane & 15, fq = lane >> 4;
    constexpr int K = KC, nt = K / BK;
    unsigned voffA[2], voffB[2];
#pragma unroll
    for (int i = 0; i < 2; ++i) { int R, C; stage_rc(tid * 16 + i * 8192, R, C); const int Rb = Epi::PERM ? ((R & ~31) + perm32(R & 31)) : R;
        voffA[i] = (unsigned)(R * LDA + C) * 2u; voffB[i] = (unsigned)(Rb * K + C) * 2u; }
    const size_t kstep = (size_t)(BK * 2);
    const size_t hstep = (size_t)HALF * K * 2;
    const size_t tstep = 2 * hstep; const size_t hstepA = (size_t)HALF * LDA * 2, tstepA = 2 * hstepA;
    const unsigned ldsw = (unsigned)wid * 1024u;
    const int aoff = lds_byte(wr * 64 + fr, fq * 8), boff = lds_byte(wc * 32 + fr, fq * 8);
#define PG8_SA(b, h) (((b) * 2 + (h)) * HTB)
#define PG8_SB(b, h) ((4 + (b) * 2 + (h)) * HTB)
#define PG8_STAGE(bufoff, gbase, voff) do { _Pragma("unroll") for (int _i = 0; _i < 2; ++_i) \
        __builtin_amdgcn_global_load_lds((const unsigned*)((const char*)(gbase) + (voff)[_i]), (PG8_LAS unsigned*)(lds + (bufoff) + ldsw + _i * 8192), 16, 0, 0); } while (0)
#define PG8_LDA(dst, b, h) do { _Pragma("unroll") for (int m = 0; m < 4; ++m) _Pragma("unroll") for (int k = 0; k < 2; ++k) dst[m][k] = *(const PG8_LAS bf16x8*)(lds + PG8_SA(b, h) + aoff + m * 2048 + k * 1024); } while (0)
#define PG8_LDB(dst, b, h) do { _Pragma("unroll") for (int n = 0; n < 2; ++n) _Pragma("unroll") for (int k = 0; k < 2; ++k) dst[n][k] = *(const PG8_LAS bf16x8*)(lds + PG8_SB(b, h) + boff + n * 2048 + k * 1024); } while (0)
#define PG8_MMA(ai, bj, At, Bt) do { __builtin_amdgcn_s_setprio(1); _Pragma("unroll") for (int m = 0; m < 4; ++m) _Pragma("unroll") for (int n = 0; n < 2; ++n) _Pragma("unroll") for (int k = 0; k < 2; ++k) \
        acc[ai][bj][m][n] = __builtin_amdgcn_mfma_f32_16x16x32_bf16(Bt[n][k], At[m][k], acc[ai][bj][m][n], 0, 0, 0); __builtin_amdgcn_s_setprio(0); } while (0)
#define PG8_WAIT_V(n) asm volatile("s_waitcnt vmcnt(" #n ")" ::: "memory")
#define PG8_WAIT_L(n) asm volatile("s_waitcnt lgkmcnt(" #n ")" ::: "memory")
#define PG8_BAR __builtin_amdgcn_s_barrier()
#define PG8_SCHED __builtin_amdgcn_sched_barrier(0)
    Unit cur, nxt; int ui = 0;
    if (!S.next(0, cur)) return;
    f32x4 acc[2][2][4][2];
#pragma unroll
    for (int a = 0; a < 2; ++a)
#pragma unroll
        for (int b = 0; b < 2; ++b)
#pragma unroll
            for (int m = 0; m < 4; ++m)
#pragma unroll
                for (int n = 0; n < 2; ++n) acc[a][b][m][n] = (f32x4){0.f, 0.f, 0.f, 0.f};
    bf16x8 At[4][2], B0[2][2], B1[2][2];
    const char* cA = (const char*)g.A + (size_t)cur.pm * tstepA; const char* cB = (const char*)g.Bt + (size_t)cur.pn * tstep;
    S.a_ready(cur);
    if constexpr (SP2) {
        PG8_STAGE(PG8_SB(0, 0), cB, voffB); PG8_STAGE(PG8_SB(0, 1), cB + hstep, voffB); PG8_STAGE(PG8_SA(0, 0), cA, voffA); PG8_STAGE(PG8_SA(0, 1), cA + hstepA, voffA);
        if (wr == 1) PG8_BAR;
        PG8_WAIT_V(2); PG8_BAR;
        PG8_STAGE(PG8_SB(1, 0), cB + kstep, voffB); PG8_STAGE(PG8_SA(1, 0), cA + kstep, voffA); PG8_STAGE(PG8_SB(1, 1), cB + hstep + kstep, voffB);
        PG8_WAIT_V(6); PG8_BAR;
    } else {
        PG8_STAGE(PG8_SB(0, 0), cB, voffB); PG8_STAGE(PG8_SA(0, 0), cA, voffA); PG8_STAGE(PG8_SB(0, 1), cB + hstep, voffB); PG8_STAGE(PG8_SA(0, 1), cA + hstepA, voffA);
        if (wr == 1) PG8_BAR;
        PG8_WAIT_V(4); PG8_BAR;
        PG8_STAGE(PG8_SB(1, 0), cB + kstep, voffB); PG8_STAGE(PG8_SA(1, 0), cA + kstep, voffA); PG8_STAGE(PG8_SB(1, 1), cB + hstep + kstep, voffB);
        PG8_WAIT_V(6); PG8_BAR;
    }
    for (;;) {
        const bool has_next = S.next(ui + 1, nxt);
        const char* nA = has_next ? (const char*)g.A + (size_t)nxt.pm * tstepA : cA; const char* nB = has_next ? (const char*)g.Bt + (size_t)nxt.pn * tstep : cB;
        for (int t = 0; t < nt; t += 2) {
            const bool last = (t == nt - 2);
            const char* a1 = cA + (size_t)(t + 1) * kstep;
            const char* a2 = last ? nA : cA + (size_t)(t + 2) * kstep; const char* b2 = last ? nB : cB + (size_t)(t + 2) * kstep;
            const char* a3 = a2 + kstep; const char* b3 = b2 + kstep;
            if (last && has_next) S.a_ready(nxt);
            if constexpr (SP2) {
            PG8_LDB(B0, 0, 0); PG8_LDB(B1, 0, 1); PG8_SCHED; PG8_LDA(At, 0, 0); PG8_STAGE(PG8_SA(1, 1), a1 + hstepA, voffA);
            PG8_WAIT_V(8); PG8_WAIT_L(0); PG8_BAR; PG8_MMA(0, 0, At, B0); PG8_MMA(0, 1, At, B1); PG8_BAR; PG8_SCHED;
            PG8_LDA(At, 0, 1); PG8_STAGE(PG8_SB(0, 0), b2, voffB); PG8_STAGE(PG8_SB(0, 1), b2 + hstep, voffB); PG8_STAGE(PG8_SA(0, 0), a2, voffA);
            PG8_WAIT_V(8); PG8_WAIT_L(0); PG8_BAR; PG8_MMA(1, 0, At, B0); PG8_MMA(1, 1, At, B1); PG8_BAR; PG8_SCHED;
            PG8_LDB(B0, 1, 0); PG8_LDB(B1, 1, 1); PG8_SCHED; PG8_LDA(At, 1, 0); PG8_STAGE(PG8_SA(0, 1), a2 + hstepA, voffA);
            PG8_WAIT_V(8); PG8_WAIT_L(0); PG8_BAR; PG8_MMA(0, 0, At, B0); PG8_MMA(0, 1, At, B1); PG8_BAR; PG8_SCHED;
            PG8_LDA(At, 1, 1); PG8_STAGE(PG8_SB(1, 0), b3, voffB); PG8_STAGE(PG8_SB(1, 1), b3 + hstep, voffB); PG8_STAGE(PG8_SA(1, 0), a3, voffA);
            PG8_WAIT_V(8); PG8_WAIT_L(0); PG8_BAR; PG8_MMA(1, 0, At, B0); PG8_MMA(1, 1, At, B1); PG8_BAR; PG8_SCHED;
            } else {
            PG8_LDB(B0, 0, 0); PG8_SCHED; PG8_LDA(At, 0, 0); PG8_STAGE(PG8_SA(1, 1), a1 + hstepA, voffA);
            PG8_WAIT_L(8); PG8_BAR; PG8_WAIT_L(0); PG8_MMA(0, 0, At, B0); PG8_BAR; PG8_SCHED;
            PG8_LDB(B1, 0, 1); PG8_STAGE(PG8_SB(0, 0), b2, voffB);
            PG8_BAR; PG8_WAIT_L(0); PG8_MMA(0, 1, At, B1); PG8_BAR;
            PG8_LDA(At, 0, 1); PG8_STAGE(PG8_SA(0, 0), a2, voffA);
            PG8_BAR; PG8_WAIT_L(0); PG8_MMA(1, 0, At, B0); PG8_BAR; PG8_SCHED;
            PG8_STAGE(PG8_SB(0, 1), b2 + hstep, voffB);
            PG8_WAIT_V(6); PG8_BAR; PG8_MMA(1, 1, At, B1); PG8_BAR;
            PG8_LDB(B0, 1, 0); PG8_SCHED; PG8_LDA(At, 1, 0); PG8_STAGE(PG8_SA(0, 1), a2 + hstepA, voffA);
            PG8_WAIT_L(8); PG8_BAR; PG8_WAIT_L(0); PG8_MMA(0, 0, At, B0); PG8_BAR; PG8_SCHED;
            PG8_LDB(B1, 1, 1); PG8_STAGE(PG8_SB(1, 0), b3, voffB);
            PG8_BAR; PG8_WAIT_L(0); PG8_MMA(0, 1, At, B1); PG8_BAR;
            PG8_LDA(At, 1, 1); PG8_STAGE(PG8_SA(1, 0), a3, voffA);
            PG8_BAR; PG8_WAIT_L(0); PG8_MMA(1, 0, At, B0); PG8_BAR; PG8_SCHED;
            PG8_STAGE(PG8_SB(1, 1), b3 + hstep, voffB);
            PG8_WAIT_V(6); PG8_BAR; PG8_MMA(1, 1, At, B1); PG8_BAR;
            }
        }
        if constexpr (ALIGN_EPI) { if (wr == 0) PG8_BAR; }
        if constexpr (!Epi::AFTER_DRAIN) { E(acc, cur, wr, wc, fr, fq); S.done(cur); }
        if (!has_next) break;
#pragma unroll
        for (int a = 0; a < 2; ++a)
#pragma unroll
            for (int b = 0; b < 2; ++b)
#pragma unroll
                for (int m = 0; m < 4; ++m)
#pragma unroll
                    for (int n = 0; n < 2; ++n) acc[a][b][m][n] = (f32x4){0.f, 0.f, 0.f, 0.f};
        cur = nxt; cA = nA; cB = nB; ++ui;
        if constexpr (ALIGN_EPI) { if (wr == 1) PG8_BAR; }
    }
    PG8_WAIT_V(0);
    if constexpr (!ALIGN_EPI) { if (wr == 0) PG8_BAR; }
    PG8_BAR;
    if constexpr (Epi::AFTER_DRAIN) { E.fused(acc, cur, wr, wc, fr, fq, lds, wid, lane); S.done(cur); }
#undef PG8_SA
#undef PG8_SB
#undef PG8_STAGE
#undef PG8_LDA
#undef PG8_LDB
#undef PG8_MMA
#undef PG8_WAIT_V
#undef PG8_WAIT_L
#undef PG8_BAR
#undef PG8_SCHED
}
}
#include <hip/hip_bf16.h>
#include <cmath>
namespace attn_body {
using bf16=__hip_bfloat16;
using bf16x8=__attribute__((ext_vector_type(8)))short;
using s16x4=__attribute__((ext_vector_type(4)))short;
using f32x16=__attribute__((ext_vector_type(16)))float;
using u32x4=__attribute__((ext_vector_type(4)))unsigned;
constexpr int BATCH=8,NHEAD=16,SEQ=4096,D=64,DM=NHEAD*D;
constexpr int NW=8,QBLK=32,QB=QBLK*NW,KVBLK=64,NQB=SEQ/QB;
constexpr int ATTN_PITCH=DM, ATTN_UNIT_ROWS=QB;
__device__ __forceinline__ int crow(int r,int hi){return (r&3)+8*(r>>2)+4*hi;}
#define SBAR() __builtin_amdgcn_sched_barrier(0)
__device__ __forceinline__ void cmask(f32x16&p0,f32x16&p1,int jb,int qrel,int hi){
  const float NEG=-INFINITY; int kb=64*jb+4*hi;
  #pragma unroll
  for(int r=0;r<16;++r){int kv=kb+(r&3)+8*(r>>2); if(kv>qrel)p0[r]=NEG; if(kv+32>qrel)p1[r]=NEG;}
}

constexpr int NSLOT=3, SLOTB=8192;
constexpr int LDS_K=0, LDS_V=NSLOT*SLOTB, LDS_WS=2*NSLOT*SLOTB, LDS_OST=LDS_WS+NW*64*4, LDS_CB=LDS_OST+NW*4096, LDS_BYTES=LDS_CB+SEQ*4;
constexpr float C2=0.125f*1.4426950408889634f;
__device__ __forceinline__ void glds16(const void*gsrc,unsigned lds_dst){unsigned keep;
  asm volatile("s_mov_b32 %0, m0\n\ts_mov_b32 m0, %2\n\ts_nop 0\n\tglobal_load_lds_dwordx4 %1, off\n\ts_mov_b32 m0, %0":"=&s"(keep):"v"(gsrc),"s"(lds_dst):"memory");}
__device__ __forceinline__ float max3f(float a,float b,float c){float r;asm("v_max3_f32 %0, %1, %2, %3":"=v"(r):"v"(a),"v"(b),"v"(c));return r;}
__device__ __forceinline__ float max2f(float a,float b){float r;asm("v_max_f32_e32 %0, %1, %2":"=v"(r):"v"(a),"v"(b));return r;}
__device__ __forceinline__ float fadd_s(float a,float b){float r;asm("v_add_f32_e32 %0, %1, %2":"=v"(r):"v"(a),"v"(b));return r;}
__device__ __forceinline__ float fsub_s(float a,float b){float r;asm("v_sub_f32_e32 %0, %1, %2":"=v"(r):"v"(a),"v"(b));return r;}
typedef float f32x2_t __attribute__((ext_vector_type(2))); typedef __bf16 bf16x2_t __attribute__((ext_vector_type(2)));
__device__ __forceinline__ unsigned cvtpk_s(float lo,float hi){f32x2_t v={lo,hi};bf16x2_t b=__builtin_convertvector(v,bf16x2_t);return __builtin_bit_cast(unsigned,b);}
#define WAIT_BAR(N) asm volatile("s_waitcnt vmcnt(" #N ") lgkmcnt(0)\n\ts_barrier":::"memory")

__device__ __forceinline__ void qkt(f32x16&p0,f32x16&p1,const char*Kslot,const bf16x8*qr,const f32x16&negm,int r32,int hi){
  const char*kb=Kslot+hi*1024+r32*16;
  #pragma unroll
  for(int d0=0;d0<4;++d0){
    const bf16x8 b0=*reinterpret_cast<const bf16x8*>(kb+d0*2048);
    const bf16x8 b1=*reinterpret_cast<const bf16x8*>(kb+d0*2048+512);
    if(d0==0){p0=__builtin_amdgcn_mfma_f32_32x32x16_bf16(b0,qr[0],negm,0,0,0);p1=__builtin_amdgcn_mfma_f32_32x32x16_bf16(b1,qr[0],negm,0,0,0);}
    else{p0=__builtin_amdgcn_mfma_f32_32x32x16_bf16(b0,qr[d0],p0,0,0,0);p1=__builtin_amdgcn_mfma_f32_32x32x16_bf16(b1,qr[d0],p1,0,0,0);}}
}
typedef __attribute__((address_space(3))) const char* lds_cptr;
typedef short v4i16_t __attribute__((ext_vector_type(4)));
__device__ __forceinline__ void kload8(bf16x8*kf,lds_cptr kp){
  kf[0]=*(const __attribute__((address_space(3))) bf16x8*)(kp);      kf[1]=*(const __attribute__((address_space(3))) bf16x8*)(kp+512);
  kf[2]=*(const __attribute__((address_space(3))) bf16x8*)(kp+2048); kf[3]=*(const __attribute__((address_space(3))) bf16x8*)(kp+2560);
  kf[4]=*(const __attribute__((address_space(3))) bf16x8*)(kp+4096); kf[5]=*(const __attribute__((address_space(3))) bf16x8*)(kp+4608);
  kf[6]=*(const __attribute__((address_space(3))) bf16x8*)(kp+6144); kf[7]=*(const __attribute__((address_space(3))) bf16x8*)(kp+6656);
}
__device__ __forceinline__ void kload2(bf16x8*kf,lds_cptr kp,int j){ kf[2*j]=*(const __attribute__((address_space(3))) bf16x8*)(kp+j*2048); kf[2*j+1]=*(const __attribute__((address_space(3))) bf16x8*)(kp+j*2048+512); }
__device__ __forceinline__ s16x4 vtr(lds_cptr p){ return __builtin_bit_cast(s16x4,__builtin_amdgcn_ds_read_tr16_b64_v4i16((__attribute__((address_space(3))) v4i16_t*)p)); }
__device__ __forceinline__ float rowmax(const f32x16&p0,const f32x16&p1){
  float a=max3f(p0[0],p0[1],p1[0]),b=max3f(p0[2],p0[3],p1[1]);a=max3f(a,p1[2],p1[3]);
  #pragma unroll
  for(int r=4;r<16;r+=4){a=max3f(a,p0[r],p0[r+1]);b=max3f(b,p0[r+2],p0[r+3]);a=max3f(a,p1[r],p1[r+1]);b=max3f(b,p1[r+2],p1[r+3]);}
  const float m=max2f(a,b);
  auto rr=__builtin_amdgcn_permlane32_swap(__float_as_uint(m),__float_as_uint(m),false,false);
  return max2f(__uint_as_float(rr[0]),__uint_as_float(rr[1]));
}
__device__ __forceinline__ void pv(f32x16*o,int vb,bf16x8 pa0,bf16x8 pa1,bf16x8 pa2,bf16x8 pa3){
  #pragma unroll
  for(int d0=0;d0<2;++d0){s16x4 lo[4],hi[4];
    #pragma unroll
    for(int ks=0;ks<4;++ks){
      asm volatile("ds_read_b64_tr_b16 %0,%1 offset:%c2":"=&v"(lo[ks]):"v"(vb),"i"(d0*4096+ks*1024):"memory");
      asm volatile("ds_read_b64_tr_b16 %0,%1 offset:%c2":"=&v"(hi[ks]):"v"(vb),"i"(d0*4096+ks*1024+512):"memory");}
    asm volatile("s_waitcnt lgkmcnt(0)":::"memory");SBAR();
    #define PK(k) (bf16x8){lo[k][0],lo[k][1],lo[k][2],lo[k][3],hi[k][0],hi[k][1],hi[k][2],hi[k][3]}
    o[d0]=__builtin_amdgcn_mfma_f32_32x32x16_bf16(pa0,PK(0),o[d0],0,0,0);
    o[d0]=__builtin_amdgcn_mfma_f32_32x32x16_bf16(pa1,PK(1),o[d0],0,0,0);
    o[d0]=__builtin_amdgcn_mfma_f32_32x32x16_bf16(pa2,PK(2),o[d0],0,0,0);
    o[d0]=__builtin_amdgcn_mfma_f32_32x32x16_bf16(pa3,PK(3),o[d0],0,0,0);
    #undef PK
  }
}

#ifndef ATTN_STORE16
#define ATTN_STORE16(p,v) (*(u32x4*)(p)=(v))
#endif
template<int THRL> __device__ __forceinline__ void attn_unit(int b,int h,int qb,const bf16*Q,const bf16*__restrict__ K,const bf16*__restrict__ V,bf16*O,const bf16*__restrict__ Gt,const float*__restrict__ CL,char*shm,int wave_s){
  int tid_o=tid_from(wave_s); asm volatile("":"+v"(tid_o)); const int tid=tid_o,lane=tid&63,r32=lane&31,hi=lane>>5; const int wid=__builtin_amdgcn_readfirstlane(tid>>6);
  const long rowbase=(long)b*SEQ; const int q0=qb*QB;
  const float*cbh=CL+((long)b*NHEAD+h)*SEQ;
  typedef float f4_t __attribute__((ext_vector_type(4))); f4_t creg0=f4_t{},creg1=f4_t{}; const int n4c=(q0+QB)/4;
  if(tid<n4c)creg0=*(const f4_t*)(cbh+4*tid); if(tid+NW*64<n4c)creg1=*(const f4_t*)(cbh+4*(tid+NW*64));
  const float cq=cbh[q0+wid*QBLK+(lane&31)];
  const bf16*Qw=Q+(rowbase+q0+wid*QBLK)*DM+h*D;
  const bf16*Kh=K+rowbase*DM+h*D,*Vh=V+rowbase*DM+h*D;
  const unsigned lds0=(unsigned)(uintptr_t)shm;
  float*wsf=(float*)(shm+LDS_WS)+wid*64;
  const bf16*ksrc=Kh+(long)lane*DM+wid*8;
  const bf16*vsrc=Vh+(long)(16*(wid&3)+(lane>>2))*DM+(wid>>2)*32+(lane&3)*8;
  const unsigned kdst=lds0+LDS_K+wid*1024, vdst=lds0+LDS_V+wid*1024;
  #define DMA_K(t,slot) glds16(ksrc+(long)(t)*KVBLK*DM,(unsigned)__builtin_amdgcn_readfirstlane(kdst+(slot)))
  #define DMA_V(t,slot) glds16(vsrc+(long)(t)*KVBLK*DM,(unsigned)__builtin_amdgcn_readfirstlane(vdst+(slot)))
  const int vb0=(int)(lds0+LDS_V)+((lane>>4)&1)*32+(lane&3)*8+(4*hi+((lane&15)>>2))*64;
  const char*Kbase=shm+LDS_K; bf16x8 kf[8];
  const lds_cptr shm3=(lds_cptr)shm; const lds_cptr kp0=shm3+LDS_K+hi*1024+r32*16; const lds_cptr vp0=shm3+LDS_V+((lane>>4)&1)*32+(lane&3)*8+(4*hi+((lane&15)>>2))*64;
  const int NT=(q0+QB)/KVBLK;
  DMA_K(0,0);DMA_V(0,0);DMA_K(1,SLOTB);
  bf16x8 qr[4];
  #pragma unroll
  for(int d0=0;d0<4;++d0)qr[d0]=*reinterpret_cast<const bf16x8*>(&Qw[(long)r32*DM+d0*16+hi*8]);
  float mhat=0.f,l_reg=0.f;f32x16 o[2];o[0]=f32x16{};o[1]=f32x16{};f32x16 negm;
  #pragma unroll
  for(int r=0;r<16;++r)negm[r]=cq;
  asm volatile("":"+v"(negm));
  typedef float cf4_t __attribute__((ext_vector_type(4))); const __attribute__((address_space(3))) cf4_t*clds=(const __attribute__((address_space(3))) cf4_t*)((lds_cptr)shm+LDS_CB)+hi;
  #define CBIAS(P0,P1,t) do{ const __attribute__((address_space(3))) cf4_t*cp_=clds+16*(t); _Pragma("unroll") for(int j_=0;j_<4;++j_){ const cf4_t a_=cp_[2*j_], b_=cp_[8+2*j_]; \
      { f32x2_t u0_={P0[4*j_],P0[4*j_+1]},u1_={P0[4*j_+2],P0[4*j_+3]},w0_={P1[4*j_],P1[4*j_+1]},w1_={P1[4*j_+2],P1[4*j_+3]}; \
        u0_=u0_-(f32x2_t){a_[0],a_[1]}; u1_=u1_-(f32x2_t){a_[2],a_[3]}; w0_=w0_-(f32x2_t){b_[0],b_[1]}; w1_=w1_-(f32x2_t){b_[2],b_[3]}; \
        P0[4*j_]=u0_[0];P0[4*j_+1]=u0_[1];P0[4*j_+2]=u1_[0];P0[4*j_+3]=u1_[1]; P1[4*j_]=w0_[0];P1[4*j_+1]=w0_[1];P1[4*j_+2]=w1_[0];P1[4*j_+3]=w1_[1]; } } }while(0)
  const int qrel=wid*QBLK+r32;
  #define CMASK(P0,P1,t) do{int jb_=(t)-(NT-4); if(jb_>=0)cmask(P0,P1,jb_,qrel,hi);}while(0)
  bool resc=false;
  #define START(P0,P1) do{ const float rm=rowmax(P0,P1); resc=false; \
    { const float c63_=((const __attribute__((address_space(3))) float*)((lds_cptr)shm+LDS_CB))[63]; const float dl=rm-(cq-c63_);     \
      mhat=fadd_s(mhat,dl); \
      _Pragma("unroll") for(int r=0;r<16;++r){P0[r]=fsub_s(P0[r],dl);P1[r]=fsub_s(P1[r],dl);} \
      _Pragma("unroll") for(int r=0;r<16;++r)negm[r]=cq-mhat; asm volatile("":"+v"(negm)); } \
    _Pragma("unroll") for(int r=0;r<16;++r)P0[r]=__builtin_amdgcn_exp2f(P0[r]); }while(0)
  #define RESC() do{ if(resc){ asm volatile("s_waitcnt lgkmcnt(0)":::"memory"); \
      _Pragma("unroll") for(int d_=0;d_<2;++d_) _Pragma("unroll") for(int r=0;r<16;++r)o[d_][r]*=wsf[crow(r,hi)]; } }while(0)
  f32x16 pA0,pA1,pB0,pB1;
  int sl_prev=0,sl_cur=0,sl_next=SLOTB;
  #define ROT() do{sl_prev=sl_cur;sl_cur=sl_next;sl_next=(sl_next==(NSLOT-1)*SLOTB)?0:sl_next+SLOTB;}while(0)
  { __attribute__((address_space(3))) f4_t*cl4=(__attribute__((address_space(3))) f4_t*)((lds_cptr)shm+LDS_CB); if(tid<n4c)cl4[tid]=creg0; if(tid+NW*64<n4c)cl4[tid+NW*64]=creg1; }
  DMA_K(2,2*SLOTB);
  WAIT_BAR(3);
  qkt(pA0,pA1,Kbase,qr,negm,r32,hi);asm volatile("s_nop 15\n\ts_nop 7":"+v"(pA0),"+v"(pA1));CMASK(pA0,pA1,0);CBIAS(pA0,pA1,0);
  START(pA0,pA1);
  _Pragma("unroll") for(int r=0;r<16;++r)pA1[r]=__builtin_amdgcn_exp2f(pA1[r]);
  WAIT_BAR(0);
  DMA_K(3,0);DMA_V(1,SLOTB);
  ROT();
  kload8(kf,kp0+sl_cur);
  WAIT_BAR(2);
  s16x4 vlo[8],vhi[8]; u32x4 pw0,pw1,pw2,pw3;
  #define PKW(P,B) cvtpk_s(P[B],P[B+1])
  #define PAF(k) __builtin_bit_cast(bf16x8,pw##k)
  #define VFR(i) (bf16x8){vlo[i][0],vlo[i][1],vlo[i][2],vlo[i][3],vhi[i][0],vhi[i][1],vhi[i][2],vhi[i][3]}
  #define PIN(x) asm volatile("":"+v"(x))
  #define MX3(a,b,c) __builtin_fmaxf(__builtin_fmaxf((a),(b)),(c))
  #define GAPA(MF,A0,A1,A2,A3,W0,W1,PW) do{ MF; sacc+=A0; sacc+=A1; sacc+=A2; sacc+=A3; PIN(sacc); W0; W1; PIN(PW); SBAR(); }while(0)
  #define EX(v) __builtin_amdgcn_exp2f(v)
  #define GAPB(MF,X,B) do{ MF; X[B]=EX(X[B]); X[B+1]=EX(X[B+1]); X[B+2]=EX(X[B+2]); X[B+3]=EX(X[B+3]); PIN(X); SBAR(); }while(0)
  #define VRD(i) do{ vlo[i]=vtr(vp_+(((i)>>2)*4096+((i)&3)*1024)); vhi[i]=vtr(vp_+(((i)>>2)*4096+((i)&3)*1024+512)); }while(0)
  #define KRD(G,j) do{ if(G){ kload2(kf,kp0+sl_next,j); SBAR(); } }while(0)
  #define STEP(C0,C1,P0,P1,t,GK,GV,GL) do{ SBAR(); \
    const lds_cptr vp_=vp0+sl_prev; \
    VRD(0); SBAR(); float sacc=(P0[0]+P0[1]); \
    GAPA(C0=__builtin_amdgcn_mfma_f32_32x32x16_bf16(kf[0],qr[0],negm,0,0,0), P0[2],P0[3],P0[4],P0[5],     pw0[0]=PKW(P0,0), pw0[1]=PKW(P0,2), pw0); \
    VRD(4); SBAR(); GAPA(C1=__builtin_amdgcn_mfma_f32_32x32x16_bf16(kf[1],qr[0],negm,0,0,0), P0[6],P0[7],P0[8],P0[9],     pw0[2]=PKW(P0,4), pw0[3]=PKW(P0,6), pw0); \
    VRD(1); SBAR(); GAPA(C0=__builtin_amdgcn_mfma_f32_32x32x16_bf16(kf[2],qr[1],C0,0,0,0),   P0[10],P0[11],P0[12],P0[13], pw1[0]=PKW(P0,8), pw1[1]=PKW(P0,10), pw1); \
    VRD(5); SBAR(); GAPA(C1=__builtin_amdgcn_mfma_f32_32x32x16_bf16(kf[3],qr[1],C1,0,0,0),   P0[14],P0[15],P1[0],P1[1],   pw1[2]=PKW(P0,12),pw1[3]=PKW(P0,14), pw1); \
    VRD(2); SBAR(); GAPA(C0=__builtin_amdgcn_mfma_f32_32x32x16_bf16(kf[4],qr[2],C0,0,0,0),   P1[2],P1[3],P1[4],P1[5],     pw2[0]=PKW(P1,0), pw2[1]=PKW(P1,2), pw2); \
    VRD(6); SBAR(); GAPA(C1=__builtin_amdgcn_mfma_f32_32x32x16_bf16(kf[5],qr[2],C1,0,0,0),   P1[6],P1[7],P1[8],P1[9],     pw2[2]=PKW(P1,4), pw2[3]=PKW(P1,6), pw2); \
    VRD(3); SBAR(); GAPA(C0=__builtin_amdgcn_mfma_f32_32x32x16_bf16(kf[6],qr[3],C0,0,0,0),   P1[10],P1[11],P1[12],P1[13], pw3[0]=PKW(P1,8), pw3[1]=PKW(P1,10), pw3); \
    VRD(7); SBAR(); GAPA(C1=__builtin_amdgcn_mfma_f32_32x32x16_bf16(kf[7],qr[3],C1,0,0,0),   P1[14],P1[15],0.f,0.f,       pw3[2]=PKW(P1,12),pw3[3]=PKW(P1,14), pw3); \
    l_reg+=sacc; \
    if(GK){DMA_K((t)+3,sl_cur);} if(GV){DMA_V((t)+1,sl_next);} \
    CMASK(C0,C1,t); CBIAS(C0,C1,t); \
    { float a=MX3(C0[0],C0[1],C1[0]),b=MX3(C0[2],C0[3],C1[1]); a=MX3(a,C1[2],C1[3]); \
      _Pragma("unroll") for(int r=4;r<16;r+=4){a=MX3(a,C0[r],C0[r+1]);b=MX3(b,C0[r+2],C0[r+3]);a=MX3(a,C1[r],C1[r+1]);b=MX3(b,C1[r+2],C1[r+3]);} \
      float rm=__builtin_fmaxf(a,b); { auto rr=__builtin_amdgcn_permlane32_swap(__float_as_uint(rm),__float_as_uint(rm),false,false); rm=__builtin_fmaxf(__uint_as_float(rr[0]),__uint_as_float(rr[1])); } \
      resc=false; \
      if(__builtin_expect(__any(rm>(float)THRL),0)){ const float dl=__builtin_fmaxf(rm,0.f); mhat+=dl; \
        _Pragma("unroll") for(int r=0;r<16;++r){C0[r]-=dl;C1[r]-=dl;} \
        _Pragma("unroll") for(int r=0;r<16;++r)negm[r]=cq-mhat; asm volatile("":"+v"(negm)); \
        const float f=__builtin_amdgcn_exp2f(-dl); l_reg*=f; if(hi==0)wsf[r32]=f; resc=true; } } \
    SBAR(); \
    GAPB(o[0]=__builtin_amdgcn_mfma_f32_32x32x16_bf16(PAF(0),VFR(0),o[0],0,0,0), C0,0); \
    GAPB(o[1]=__builtin_amdgcn_mfma_f32_32x32x16_bf16(PAF(0),VFR(4),o[1],0,0,0), C0,4); \
    KRD(GL,0); GAPB(o[0]=__builtin_amdgcn_mfma_f32_32x32x16_bf16(PAF(1),VFR(1),o[0],0,0,0), C0,8); \
    KRD(GL,1); GAPB(o[1]=__builtin_amdgcn_mfma_f32_32x32x16_bf16(PAF(1),VFR(5),o[1],0,0,0), C0,12); \
    KRD(GL,2); GAPB(o[0]=__builtin_amdgcn_mfma_f32_32x32x16_bf16(PAF(2),VFR(2),o[0],0,0,0), C1,0); \
    KRD(GL,3); GAPB(o[1]=__builtin_amdgcn_mfma_f32_32x32x16_bf16(PAF(2),VFR(6),o[1],0,0,0), C1,4); \
    GAPB(o[0]=__builtin_amdgcn_mfma_f32_32x32x16_bf16(PAF(3),VFR(3),o[0],0,0,0), C1,8); \
    GAPB(o[1]=__builtin_amdgcn_mfma_f32_32x32x16_bf16(PAF(3),VFR(7),o[1],0,0,0), C1,12); \
    }while(0)
  int t=1;
  #undef CMASK
  #define CMASK(P0,P1,t) do{}while(0)
  for(;t+5<NT;t+=2){
    STEP(pB0,pB1,pA0,pA1,t,true,true,true);     WAIT_BAR(2); RESC(); ROT();
    STEP(pA0,pA1,pB0,pB1,t+1,true,true,true);   WAIT_BAR(2); RESC(); ROT();
  }
  #undef CMASK
  #define CMASK(P0,P1,t) do{int jb_=(t)-(NT-4); if(jb_>=0)cmask(P0,P1,jb_,qrel,hi);}while(0)
  #define ENDW(tt) do{ if((tt)+3<NT){WAIT_BAR(2);} else if((tt)+2<NT){WAIT_BAR(1);} else {WAIT_BAR(0);} }while(0)
  for(;t+1<NT;t+=2){
    STEP(pB0,pB1,pA0,pA1,t,(t+3<NT),(t+1<NT),(t+1<NT));       ENDW(t);   RESC(); ROT();
    STEP(pA0,pA1,pB0,pB1,t+1,(t+4<NT),(t+2<NT),(t+2<NT));     ENDW(t+1); RESC(); ROT();
  }
  STEP(pB0,pB1,pA0,pA1,NT-1,false,false,false); RESC();
  { float sacc=pB0[0]+pB0[1]; _Pragma("unroll") for(int r=2;r<16;++r)sacc+=pB0[r]; _Pragma("unroll") for(int r=0;r<16;++r)sacc+=pB1[r]; l_reg+=sacc;
    pw0=(u32x4){PKW(pB0,0),PKW(pB0,2),PKW(pB0,4),PKW(pB0,6)};pw1=(u32x4){PKW(pB0,8),PKW(pB0,10),PKW(pB0,12),PKW(pB0,14)};pw2=(u32x4){PKW(pB1,0),PKW(pB1,2),PKW(pB1,4),PKW(pB1,6)};pw3=(u32x4){PKW(pB1,8),PKW(pB1,10),PKW(pB1,12),PKW(pB1,14)};
    SBAR(); pv(o,vb0+sl_cur,PAF(0),PAF(1),PAF(2),PAF(3)); }
  #undef PKW
  #undef PAF
  #undef VFR
  #undef PIN
  #undef MX3
  #undef GAPA
  #undef GAPB
  #undef EX
  #undef VRD
  #undef KRD
  #undef STEP
  #undef ENDW
  {auto rr=__builtin_amdgcn_permlane32_swap(__float_as_uint(l_reg),__float_as_uint(l_reg),false,false);l_reg=__uint_as_float(rr[0])+__uint_as_float(rr[1]);}
  if(hi==0)wsf[32+r32]=l_reg;asm volatile("s_waitcnt lgkmcnt(0)":::"memory");
  float rli[16];
  #pragma unroll
  for(int r=0;r<16;++r)rli[r]=__builtin_amdgcn_rcpf(wsf[32+crow(r,hi)]);
  bf16*Ow=O+(rowbase+q0+wid*QBLK)*DM+h*D;
  { bf16*stg=(bf16*)(shm+LDS_OST)+wid*2048;
    #pragma unroll
    for(int r=0;r<16;++r){const int orow=crow(r,hi);
      #pragma unroll
      for(int d0=0;d0<2;++d0)stg[orow*64+d0*32+r32]=__float2bfloat16(o[d0][r]*rli[r]);}
    asm volatile("s_waitcnt lgkmcnt(0)":::"memory");
    #pragma unroll
    for(int i=0;i<4;++i){const bf16*Gw=Gt+(rowbase+q0+wid*QBLK)*DM+h*D; const int row=i*8+(lane>>3),ch=lane&7; const u32x4 v=*(const u32x4*)(stg+row*64+ch*8); const u32x4 gq=*(const u32x4*)(Gw+(long)row*DM+ch*8); u32x4 w;
      #pragma unroll
      for(int e=0;e<4;++e){ const float a0=__uint_as_float(v[e]<<16)*__uint_as_float(gq[e]<<16), a1=__uint_as_float(v[e]&0xffff0000u)*__uint_as_float(gq[e]&0xffff0000u); w[e]=cvtpk_s(a0,a1); }
      ATTN_STORE16(Ow+(long)row*DM+ch*8,w);} }
  asm volatile("s_waitcnt lgkmcnt(0)\n\ts_barrier":::"memory");
  #undef CBIAS
  #undef DMA_K
  #undef DMA_V
  #undef CMASK
  #undef START
  #undef RESC
  #undef ROT
}
constexpr int ATTN_LDS_BYTES=LDS_BYTES;
struct AttnTensors { const bf16* Q; const bf16* K; const bf16* V; bf16* O; const bf16* G; const float* CL; };
struct AttnUnit { int bh; int qb; };
struct StaticOrder {
  int vcu, G;
  __device__ __forceinline__ explicit StaticOrder(int grid,int block):vcu((grid%8==0)?(block%8)*(grid/8)+block/8:block),G(grid){}
  __device__ __forceinline__ bool next(int i,AttnUnit&u)const{
    if(G==256){ if(i>=8)return false; const int j=2*(i>>1)+(vcu&1); u.bh=vcu>>1; u.qb=(i&1)?15-j:j; return true; }
    const int idx=i*G+vcu; if(idx>=BATCH*NHEAD*NQB)return false; u.bh=idx/NQB; u.qb=NQB-1-idx%NQB; return true; }
  __device__ __forceinline__ void a_ready(const AttnUnit&)const{}
  __device__ __forceinline__ void done(const AttnUnit&)const{}
};
template<class Sched,int THRL=8> __device__ __forceinline__ void attn_phase(char*lds,const AttnTensors&T,const Sched&S,int wave_s){
  AttnUnit u;
  for(int i=0;S.next(i,u);++i){ S.a_ready(u); attn_unit<THRL>(u.bh/NHEAD,u.bh%NHEAD,u.qb,T.Q,T.K,T.V,T.O,T.G,T.CL,lds,wave_s); S.done(u); }
}
#undef SBAR
#undef WAIT_BAR
}
#define GAS __attribute__((address_space(1)))
#define LAS __attribute__((address_space(3)))
typedef unsigned short bfu;
typedef unsigned v4u __attribute__((ext_vector_type(4)));
typedef unsigned v2u __attribute__((ext_vector_type(2)));
typedef float f32x4 __attribute__((ext_vector_type(4)));
typedef short bf16x8 __attribute__((ext_vector_type(8)));
#define LDS_WAIT() asm volatile("s_waitcnt lgkmcnt(0)" ::: "memory")
constexpr int NWAVES = 8;
constexpr int BATCH = 8, SEQ = 4096, D = 1024, FF = 2816, T = BATCH * SEQ, PLE = 256, NKVF = 2064, NKVFP = 2304;
constexpr float EPS = 1e-6f, LOG2E = 1.4426950408889634f;
constexpr size_t MiB = 1u << 20;
constexpr size_t E_W1IN = 0, N_WIN = (size_t)2 * FF * D, N_WOUT = (size_t)D * FF;
constexpr size_t E_W1OUT = E_W1IN + 2 * N_WIN, E_W2IN = E_W1OUT + 2 * N_WOUT, E_W2OUT = E_W2IN + 2 * N_WIN, E_WHIN = E_W2OUT + 2 * N_WOUT;
constexpr size_t E_WHOUT = E_WHIN + (size_t)4 * D * D, E_WKVF = E_WHOUT + (size_t)D * D, E_WQG = E_WKVF + (size_t)NKVFP * D, E_WFO = E_WQG + (size_t)2 * D * D;
constexpr size_t E_WPG = E_WFO + (size_t)D * D, E_WPP = E_WPG + (size_t)2 * D * D, E_WEND = E_WPP + (size_t)2 * D * PLE;
static_assert(E_WEND * 2 <= 92 * MiB, "weights fit");
constexpr size_t WS_P = 92 * MiB, WS_LOGF = 124 * MiB, WS_C = 126 * MiB, WS_AY = 128 * MiB, WS_BIG = 192 * MiB, WS_PROJ = 448 * MiB, WS_END = 512 * MiB;
constexpr size_t WS_V = WS_BIG + 192 * MiB, WS_K = WS_PROJ, WS_Q = WS_BIG, WS_G = WS_BIG + 64 * MiB;
constexpr int LDS_BYTES = 147456;

__device__ __forceinline__ float wave_sum(float v) {
#pragma unroll
    for (int o = 1; o < 64; o <<= 1) v += __shfl_xor(v, o);
    return v;
}
__device__ __forceinline__ unsigned pk2(float lo, float hi) { return pg8::cvt_pk_bf16(lo, hi); }
__device__ __forceinline__ float bf2f(unsigned short u) { return __uint_as_float((unsigned)u << 16); }
__device__ __forceinline__ unsigned short f2b(float f) { return (unsigned short)(pk2(f, 0.f) & 0xffffu); }

__device__ __forceinline__ void conv_item(const float* W, int K, int N, bfu* WT, const float* gain, int gmask, int sw, LAS float* scr, int item, int lane) {
    const int nblk = (N + 31) / 32, kb = item / nblk, nb = item % nblk, k0 = 64 * kb, n0 = 32 * nb;
    const int nn = n0 + (lane & 31); const bool nok = nn < N;
    const int c = lane & 7;
    f32x4 ga = (f32x4){1.f, 1.f, 1.f, 1.f}, gb = ga;
    if (gain) { ga = *(const f32x4*)(gain + ((k0 + 8 * c) & gmask)); gb = *(const f32x4*)(gain + ((k0 + 8 * c) & gmask) + 4); }
    float wv[32];
#pragma unroll
    for (int i = 0; i < 32; ++i) { const int kk = 2 * i + (lane >> 5); wv[i] = nok ? W[(size_t)(k0 + kk) * N + nn] : 0.f; }
#pragma unroll
    for (int i = 0; i < 32; ++i) { const int kk = 2 * i + (lane >> 5); scr[kk * 33 + (lane & 31)] = wv[i]; }
    LDS_WAIT(); asm volatile("" ::: "memory");
    int drow0 = n0; if (sw) { const int j0 = (n0 < FF) ? n0 : n0 - FF; drow0 = 256 * (j0 >> 7) + (j0 & 127) + ((n0 < FF) ? 0 : 128); }
#pragma unroll
    for (int j = 0; j < 4; ++j) { const int n = (lane >> 3) + 8 * j; const LAS float* s = scr + (8 * c) * 33 + n;
        v4u o; o.x = pk2(s[0 * 33] * ga[0], s[1 * 33] * ga[1]); o.y = pk2(s[2 * 33] * ga[2], s[3 * 33] * ga[3]); o.z = pk2(s[4 * 33] * gb[0], s[5 * 33] * gb[1]); o.w = pk2(s[6 * 33] * gb[2], s[7 * 33] * gb[3]);
        *(v4u*)(WT + (size_t)(drow0 + n) * K + k0 + 8 * c) = o; }
    LDS_WAIT(); asm volatile("" ::: "memory");
}
__device__ __forceinline__ void rms_row_to_bf16(const float* xrow, bfu* orow, int lane) {
    const f32x4* xr = (const f32x4*)xrow + lane;
    f32x4 v[4]; float s = 0.f;
#pragma unroll
    for (int j = 0; j < 4; ++j) { v[j] = xr[64 * j]; s += (v[j].x * v[j].x + v[j].y * v[j].y) + (v[j].z * v[j].z + v[j].w * v[j].w); }
    const float r = __builtin_amdgcn_rsqf(wave_sum(s) * (1.f / D) + EPS);
    v2u* o8 = (v2u*)orow + lane;
#pragma unroll
    for (int j = 0; j < 4; ++j) { v2u w; w.x = pk2(v[j].x * r, v[j].y * r); w.y = pk2(v[j].z * r, v[j].w * r); o8[64 * j] = w; }
}
template <bool WRITE_A>
__device__ __forceinline__ void rw_phase(const float* hin, float* hout, const bfu* Y, bfu* A, const float* gain, float scale, int gw, int ngw, int lane) {
    f32x4 g[4];
#pragma unroll
    for (int j = 0; j < 4; ++j) g[j] = *((const f32x4*)gain + lane + 64 * j);
    for (int m0 = gw; m0 < T; m0 += 2 * ngw) {
        f32x4 v[2][4], y[2][4]; float s[2] = {0.f, 0.f}; const int m1 = m0 + ngw; const bool two = m1 < T;
#pragma unroll
        for (int r = 0; r < 2; ++r) { const int m = (r == 0 || two) ? (r == 0 ? m0 : m1) : m0;
            const f32x4* hr = (const f32x4*)(hin + (size_t)m * D) + lane; const v2u* yr = (const v2u*)(Y + (size_t)m * D) + lane;
#pragma unroll
            for (int j = 0; j < 4; ++j) { v[r][j] = hr[64 * j]; const v2u w = yr[64 * j]; y[r][j] = (f32x4){pg8::bflo(w.x), pg8::bfhi(w.x), pg8::bflo(w.y), pg8::bfhi(w.y)}; } }
#pragma unroll
        for (int r = 0; r < 2; ++r)
#pragma unroll
            for (int j = 0; j < 4; ++j) s[r] += (y[r][j].x * y[r][j].x + y[r][j].y * y[r][j].y) + (y[r][j].z * y[r][j].z + y[r][j].w * y[r][j].w);
        float s2[2] = {0.f, 0.f};
#pragma unroll
        for (int r = 0; r < 2; ++r) { const float ry = __builtin_amdgcn_rsqf(wave_sum(s[r]) * (1.f / D) + EPS) * scale;
#pragma unroll
            for (int j = 0; j < 4; ++j) { v[r][j] = v[r][j] + y[r][j] * ry * g[j]; s2[r] += (v[r][j].x * v[r][j].x + v[r][j].y * v[r][j].y) + (v[r][j].z * v[r][j].z + v[r][j].w * v[r][j].w); } }
#pragma unroll
        for (int r = 0; r < 2; ++r) { if (r == 1 && !two) break; const int m = r == 0 ? m0 : m1;
            f32x4* ho = (f32x4*)(hout + (size_t)m * D) + lane;
            if constexpr (WRITE_A) { const float r2 = __builtin_amdgcn_rsqf(wave_sum(s2[r]) * (1.f / D) + EPS); v2u* ao = (v2u*)(A + (size_t)m * D) + lane;
#pragma unroll
                for (int j = 0; j < 4; ++j) { ho[64 * j] = v[r][j]; v2u w; w.x = pk2(v[r][j].x * r2, v[r][j].y * r2); w.y = pk2(v[r][j].z * r2, v[r][j].w * r2); ao[64 * j] = w; } }
            else {
#pragma unroll
                for (int j = 0; j < 4; ++j) ho[64 * j] = v[r][j]; } }
    }
}

constexpr int HG_QH = 0, HG_QT = 17408, HG_KT = 34816, HG_KHT = 52224, HG_VT = 70656, HG_PP = 89088, HG_ST = 98304, HG_TOT = 133120, HG_DV = 135168, HG_END = 135680;
constexpr int RS = 136, RS2 = 72, OFS = 132;
static_assert(HG_END <= LDS_BYTES, "hgrn lds");
__device__ __forceinline__ f32x4 mfma16(bf16x8 a, bf16x8 b, f32x4 c) { return __builtin_amdgcn_mfma_f32_16x16x32_bf16(a, b, c, 0, 0, 0); }
constexpr int HSEG = 4, HCH = SEQ / 64 / HSEG;
template <bool OUT>
__device__ __forceinline__ void hgrn_scan(LAS unsigned char* lds, bfu* QZVG, const float* lbl, int bh, int seg, float* Ebuf, float* Lbuf, int wave_s) {
    int tid_o = tid_from(wave_s); asm volatile("" : "+v"(tid_o)); const int tid = tid_o, lane = tid & 63, wid = __builtin_amdgcn_readfirstlane(tid >> 6), col = tid & 127, rg = tid >> 7, fr = lane & 15, fq = lane >> 4;
    const int b = bh >> 3, h = bh & 7;
    LAS bfu* QH = (LAS bfu*)(lds + HG_QH); LAS bfu* QT = (LAS bfu*)(lds + HG_QT); LAS bfu* KT = (LAS bfu*)(lds + HG_KT); LAS bfu* KHT = (LAS bfu*)(lds + HG_KHT);
    LAS bfu* VT = (LAS bfu*)(lds + HG_VT); LAS bfu* PP = (LAS bfu*)(lds + HG_PP); LAS bfu* ST = (LAS bfu*)(lds + HG_ST);
    LAS float* TOT = (LAS float*)(lds + HG_TOT); LAS float* DV = (LAS float*)(lds + HG_DV); LAS float* OF = (LAS float*)(lds + HG_QT);
    const float l0 = lbl[h * 128 + col], l1 = lbl[1024 + h * 128 + col];
    const float lb = 1.f / (1.f + __expf(l1 - l0)), omlb = 1.f - lb;
    bfu* base = QZVG + ((size_t)b * SEQ + (size_t)seg * HCH * 64) * 4096 + h * 128;
    const bfu* pq = base + (size_t)(16 * rg) * 4096 + col; const bfu* pz = pq + 1024; const bfu* pv = pq + 2048;
    const int erow = tid >> 3, eseg = tid & 7;
    const bfu* pg = base + 3072 + (size_t)erow * 4096 + 16 * eseg; bfu* po = base + (size_t)erow * 4096 + 16 * eseg;
    f32x4 Sacc[8];
#pragma unroll
    for (int i = 0; i < 8; ++i) Sacc[i] = (f32x4){0.f, 0.f, 0.f, 0.f};
    float Lacc = 0.f;
    if constexpr (OUT) {
        for (int j = 0; j < seg; ++j) {
            const float* Ej = Ebuf + ((size_t)(bh * HSEG + j) * 64 * 64) * 4 + (size_t)(wid * 8) * 64 * 4; const float* Lj = Lbuf + (size_t)(bh * HSEG + j) * 128;
#pragma unroll
            for (int kb = 0; kb < 8; ++kb) { const f32x4 e = *(const f32x4*)(Ej + ((size_t)kb * 64 + lane) * 4); const f32x4 l4 = *(const f32x4*)(Lj + 16 * kb + 4 * fq);
                f32x4 s = Sacc[kb]; s[0] = s[0] * __expf(l4[0]) + e[0]; s[1] = s[1] * __expf(l4[1]) + e[1]; s[2] = s[2] * __expf(l4[2]) + e[2]; s[3] = s[3] * __expf(l4[3]) + e[3]; Sacc[kb] = s; }
        }
#pragma unroll
        for (int kb = 0; kb < 8; ++kb) *(LAS v2u*)(ST + (16 * wid + fr) * RS + 16 * kb + 4 * fq) = (v2u){pk2(Sacc[kb][0], Sacc[kb][1]), pk2(Sacc[kb][2], Sacc[kb][3])};
    }
    unsigned short zr[16], qr[16], vr[16]; v4u gr0 = (v4u){0u, 0u, 0u, 0u}, gr1 = gr0;
#define HG_LOAD() do { _Pragma("unroll") for (int j = 0; j < 16; ++j) { zr[j] = pz[(size_t)j * 4096]; vr[j] = pv[(size_t)j * 4096]; if (OUT) qr[j] = pq[(size_t)j * 4096]; else qr[j] = 0; } \
        if (OUT) { gr0 = *(const v4u*)pg; gr1 = *(const v4u*)(pg + 8); } pz += (size_t)64 * 4096; pq += (size_t)64 * 4096; pv += (size_t)64 * 4096; pg += (size_t)64 * 4096; } while (0)
    HG_LOAD();
    for (int c = 0; c < HCH; ++c) {
        float kk[16], cum[16], qf[16]; unsigned short vv[16]; const v4u g0 = gr0, g1 = gr1;
        float run = 0.f;
#pragma unroll
        for (int j = 0; j < 16; ++j) { const float z = bf2f(zr[j]); const float k = omlb * __builtin_amdgcn_rcpf(1.f + __expf(z)); run += __logf(1.f - k); cum[j] = run; kk[j] = k; qf[j] = bf2f(qr[j]); vv[j] = vr[j]; }
        TOT[rg * 128 + col] = run;
        if (c + 1 < HCH) HG_LOAD();
        LDS_WAIT(); __builtin_amdgcn_s_barrier(); asm volatile("" ::: "memory");
        const float t0 = TOT[col], t1 = TOT[128 + col], t2 = TOT[256 + col], t3 = TOT[384 + col];
        const float pre = (rg > 0 ? t0 : 0.f) + (rg > 1 ? t1 : 0.f) + (rg > 2 ? t2 : 0.f), tot = (t0 + t1) + (t2 + t3), mid = t0 + t1;
        Lacc += tot;
        unsigned khp[8], vvp[8];
#pragma unroll
        for (int j = 0; j < 16; ++j) { const float cj = pre + cum[j]; const int r = 16 * rg + j;
            if constexpr (OUT) { QH[r * RS + col] = f2b(qf[j] * __expf(cj)); QT[r * RS + col] = f2b(qf[j] * __expf(cj - mid)); KT[r * RS + col] = f2b(kk[j] * __expf(mid - cj)); }
            const unsigned short kh = f2b(kk[j] * __expf(tot - cj));
            if (j & 1) { khp[j >> 1] |= (unsigned)kh << 16; vvp[j >> 1] |= (unsigned)vv[j] << 16; } else { khp[j >> 1] = kh; vvp[j >> 1] = vv[j]; } }
        *(LAS v4u*)(KHT + col * RS2 + 16 * rg) = (v4u){khp[0], khp[1], khp[2], khp[3]}; *(LAS v4u*)(KHT + col * RS2 + 16 * rg + 8) = (v4u){khp[4], khp[5], khp[6], khp[7]};
        *(LAS v4u*)(VT + col * RS2 + 16 * rg) = (v4u){vvp[0], vvp[1], vvp[2], vvp[3]}; *(LAS v4u*)(VT + col * RS2 + 16 * rg + 8) = (v4u){vvp[4], vvp[5], vvp[6], vvp[7]};
        if (rg == 0) DV[col] = __expf(tot);
        LDS_WAIT(); __builtin_amdgcn_s_barrier(); asm volatile("" ::: "memory");
        if constexpr (OUT) {
            const int tb = wid >> 1;
#pragma unroll
            for (int ss = 0; ss < 2; ++ss) { const int sb = 2 * (wid & 1) + ss; f32x4 sc = (f32x4){0.f, 0.f, 0.f, 0.f};
                if (sb <= tb) {
#pragma unroll
                    for (int ks = 0; ks < 4; ++ks) { const bf16x8 a = *(const LAS bf16x8*)(QT + (16 * tb + fr) * RS + 32 * ks + 8 * fq), bq = *(const LAS bf16x8*)(KT + (16 * sb + fr) * RS + 32 * ks + 8 * fq); sc = mfma16(a, bq, sc); } }
#pragma unroll
                for (int i = 0; i < 4; ++i) { const int t = 16 * tb + 4 * fq + i, s = 16 * sb + fr; PP[t * RS2 + s] = f2b((sb <= tb && s <= t) ? sc[i] : 0.f); } }
            LDS_WAIT(); __builtin_amdgcn_s_barrier(); asm volatile("" ::: "memory");
        }
        {   bf16x8 vtf[2];
#pragma unroll
            for (int ks = 0; ks < 2; ++ks) vtf[ks] = *(const LAS bf16x8*)(VT + (16 * wid + fr) * RS2 + 32 * ks + 8 * fq);
            if constexpr (OUT) { bf16x8 stf[4];
#pragma unroll
                for (int ks = 0; ks < 4; ++ks) stf[ks] = *(const LAS bf16x8*)(ST + (16 * wid + fr) * RS + 32 * ks + 8 * fq);
#pragma unroll
                for (int tb = 0; tb < 4; ++tb) { f32x4 o = (f32x4){0.f, 0.f, 0.f, 0.f};
#pragma unroll
                    for (int ks = 0; ks < 4; ++ks) o = mfma16(*(const LAS bf16x8*)(QH + (16 * tb + fr) * RS + 32 * ks + 8 * fq), stf[ks], o);
#pragma unroll
                    for (int ks = 0; ks < 2; ++ks) o = mfma16(*(const LAS bf16x8*)(PP + (16 * tb + fr) * RS2 + 32 * ks + 8 * fq), vtf[ks], o);
#pragma unroll
                    for (int i = 0; i < 4; ++i) OF[(16 * tb + 4 * fq + i) * OFS + 16 * wid + fr] = o[i]; } }
#pragma unroll
            for (int kb = 0; kb < 8; ++kb) { const f32x4 d4 = *(const LAS f32x4*)(DV + 16 * kb + 4 * fq); f32x4 s = Sacc[kb] * d4;
#pragma unroll
                for (int ks = 0; ks < 2; ++ks) s = mfma16(*(const LAS bf16x8*)(KHT + (16 * kb + fr) * RS2 + 32 * ks + 8 * fq), vtf[ks], s);
                Sacc[kb] = s; if constexpr (OUT) *(LAS v2u*)(ST + (16 * wid + fr) * RS + 16 * kb + 4 * fq) = (v2u){pk2(s[0], s[1]), pk2(s[2], s[3])}; }
        }
        if constexpr (OUT) {
            LDS_WAIT(); __builtin_amdgcn_s_barrier(); asm volatile("" ::: "memory");
            f32x4 o4[4]; float ss = 0.f;
#pragma unroll
            for (int j = 0; j < 4; ++j) { o4[j] = *(const LAS f32x4*)(OF + erow * OFS + 16 * eseg + 4 * j); ss += (o4[j].x * o4[j].x + o4[j].y * o4[j].y) + (o4[j].z * o4[j].z + o4[j].w * o4[j].w); }
            ss += __shfl_xor(ss, 1); ss += __shfl_xor(ss, 2); ss += __shfl_xor(ss, 4);
            const float rs = __builtin_amdgcn_rsqf(ss * (1.f / 128.f) + EPS);
            unsigned w[8];
#pragma unroll
            for (int j = 0; j < 4; ++j) { const unsigned ga = (j < 2) ? g0[2 * j] : g1[2 * (j - 2)], gb = (j < 2) ? g0[2 * j + 1] : g1[2 * (j - 2) + 1];
                const float a0 = pg8::bflo(ga), a1 = pg8::bfhi(ga), a2 = pg8::bflo(gb), a3 = pg8::bfhi(gb);
                w[2 * j] = pk2(o4[j].x * rs * a0 * pg8::fsigmoid(a0), o4[j].y * rs * a1 * pg8::fsigmoid(a1)); w[2 * j + 1] = pk2(o4[j].z * rs * a2 * pg8::fsigmoid(a2), o4[j].w * rs * a3 * pg8::fsigmoid(a3)); }
            *(v4u*)po = (v4u){w[0], w[1], w[2], w[3]}; *(v4u*)(po + 8) = (v4u){w[4], w[5], w[6], w[7]}; po += (size_t)64 * 4096;
        }
    }
#undef HG_LOAD
    if constexpr (!OUT) {
        float* Es = Ebuf + ((size_t)(bh * HSEG + seg) * 64 * 64) * 4 + (size_t)(wid * 8) * 64 * 4;
#pragma unroll
        for (int kb = 0; kb < 8; ++kb) *(f32x4*)(Es + ((size_t)kb * 64 + lane) * 4) = Sacc[kb];
        if (rg == 0) Lbuf[(size_t)(bh * HSEG + seg) * 128 + col] = Lacc;
    }
    LDS_WAIT(); __builtin_amdgcn_s_barrier(); asm volatile("" ::: "memory");
}

__device__ __forceinline__ void cumsum_bh(LAS unsigned char* lds, const float* LOGF, float* C, int bh, int wave_s) {
    const int tid = tid_from(wave_s), lane = tid & 63, wid = tid >> 6, b = bh >> 4, h = bh & 15;
    LAS float* wsum = (LAS float*)lds;
    const float* src = LOGF + ((size_t)b * SEQ + 8 * tid) * 16 + h;
    float v[8]; float run = 0.f;
#pragma unroll
    for (int j = 0; j < 8; ++j) { run += src[j * 16]; v[j] = run; }
    float inc = run;
#pragma unroll
    for (int o = 1; o < 64; o <<= 1) { const float t = __shfl_up(inc, o); if (lane >= o) inc += t; }
    if (lane == 63) wsum[wid] = inc;
    LDS_WAIT(); __builtin_amdgcn_s_barrier(); asm volatile("" ::: "memory");
    float off = inc - run;
    for (int w = 0; w < wid; ++w) off += wsum[w];
    float* dst = C + (size_t)bh * SEQ + 8 * tid;
    *(f32x4*)dst = (f32x4){(off + v[0]) * LOG2E, (off + v[1]) * LOG2E, (off + v[2]) * LOG2E, (off + v[3]) * LOG2E};
    *(f32x4*)(dst + 4) = (f32x4){(off + v[4]) * LOG2E, (off + v[5]) * LOG2E, (off + v[6]) * LOG2E, (off + v[7]) * LOG2E};
    LDS_WAIT(); __builtin_amdgcn_s_barrier(); asm volatile("" ::: "memory");
}

#define RLX_AGENT __ATOMIC_RELAXED, __HIP_MEMORY_SCOPE_AGENT
#define XB_TMO      128
#define XB_XCNT(j)  (256  + 64 * (j))
#define XB_XSUB(j)  (1280 + 64 * (j))
#define XB_XGEN(j)  (2304 + 64 * (j))
#define XB_TOP      3328
#define XB_TOPGEN   3392
#define XCD_BAR_WORDS 3456
#define XB_SPIN_CAP (1u << 18)

__device__ __forceinline__ unsigned xb_ld(unsigned* p)              { return __hip_atomic_load(p, __ATOMIC_RELAXED, __HIP_MEMORY_SCOPE_AGENT); }
__device__ __forceinline__ unsigned xb_add(unsigned* p, unsigned v) { return __hip_atomic_fetch_add(p, v, __ATOMIC_RELAXED, __HIP_MEMORY_SCOPE_AGENT); }
__device__ __forceinline__ unsigned xb_xcc_id() { return (unsigned)__builtin_amdgcn_s_getreg((3 << 11) | 20) & 0xFu; }
#define XB_SPIN(cond, bar) do { unsigned _sp = 0; while (cond) { __builtin_amdgcn_s_sleep(1); \
    if ((++_sp & 255u) == 0u) { if (xb_ld(&(bar)[XB_TMO])) break; if (_sp > XB_SPIN_CAP) { atomicAdd(&(bar)[XB_TMO], 1u); break; } } } } while (0)

struct XcdBarrier {
    unsigned* bar; unsigned x;
    volatile LAS unsigned* st;
};

__device__ __forceinline__ XcdBarrier xcd_barrier_post(unsigned* bar, volatile LAS unsigned* st, bool is_t0) {
    XcdBarrier b; b.bar = bar; b.x = xb_xcc_id(); b.st = st;
    if (is_t0) (void)xb_add(&bar[XB_XCNT(b.x)], 1u);
    return b;
}
__device__ __forceinline__ void xcd_barrier_complete(unsigned* bar, unsigned x, unsigned& nloc, unsigned& nx) {
    const unsigned G = gridDim.x * gridDim.y * gridDim.z;
    unsigned sum, cnt, mine, sp = 0u;
    for (;;) {
        sum = 0u; cnt = 0u; mine = 0u;
#pragma unroll
        for (unsigned j = 0; j < 16; ++j) { const unsigned c = xb_ld(&bar[XB_XCNT(j)]); sum += c; cnt += (c > 0u) ? 1u : 0u; mine = (j == x) ? c : mine; }
        if (sum == G) break;
        __builtin_amdgcn_s_sleep(1);
        if ((++sp & 255u) == 0u) { if (xb_ld(&bar[XB_TMO])) break; if (sp > XB_SPIN_CAP) { atomicAdd(&bar[XB_TMO], 1u); break; } }
    }
    nloc = mine > 0u ? mine : 1u; nx = cnt > 0u ? cnt : 1u;
}

__device__ __forceinline__ void xcd_barrier(const XcdBarrier& b, bool is_t0) {
    asm volatile("s_waitcnt vmcnt(0)" ::: "memory");
    __syncthreads();
    if (is_t0) {
        unsigned* bar = b.bar;
        __builtin_amdgcn_s_waitcnt(0);
        unsigned nloc = b.st[0], nx = b.st[1];
        if (nloc == 0u) { xcd_barrier_complete(bar, b.x, nloc, nx); b.st[0] = nloc; b.st[1] = nx; }
        const unsigned old = xb_add(&bar[XB_XSUB(b.x)], 1u);
        const unsigned gen = old / nloc;
        if (old + 1u == (gen + 1u) * nloc) {
            __builtin_amdgcn_fence(__ATOMIC_RELEASE, "agent");
            asm volatile("s_waitcnt vmcnt(0)" ::: "memory");
            const unsigned og = xb_add(&bar[XB_TOP], 1u);
            const unsigned tg = og / nx;
            if (og + 1u == (tg + 1u) * nx) xb_add(&bar[XB_TOPGEN], 1u);
            else XB_SPIN(xb_ld(&bar[XB_TOPGEN]) == tg, bar);
            __builtin_amdgcn_fence(__ATOMIC_ACQUIRE, "agent");
            xb_add(&bar[XB_XGEN(b.x)], 1u);
            asm volatile("s_waitcnt vmcnt(0)" ::: "memory");
        } else {
            XB_SPIN(xb_ld(&bar[XB_XGEN(b.x)]) == gen, bar);
            __builtin_amdgcn_fence(__ATOMIC_ACQUIRE, "agent");
            asm volatile("s_waitcnt vmcnt(0)" ::: "memory");
        }
    }
    __syncthreads();
}

constexpr size_t WS_CTL = E_WEND * 2, CTL_BYTES = 16384; static_assert(WS_CTL % 256 == 0 && WS_CTL + CTL_BYTES <= WS_P && XCD_BAR_WORDS * 4 <= CTL_BYTES, "ctl");
constexpr int LDS_BARST = LDS_BYTES - 64;
struct Args { const float* in[25]; float* out; unsigned char* ws; int st_lo, st_hi; };
enum { ST_PRO, ST_F1I0, ST_F1O0, ST_RW00, ST_HIN, ST_HS1, ST_HS2, ST_HOUT, ST_RW01, ST_F2I0, ST_F2O0, ST_PP0, ST_RW02, ST_PG0, ST_RW03, ST_KVF, ST_F1I1, ST_CUM, ST_F1O1, ST_RW10, ST_QG, ST_ATT, ST_FOUT, ST_RW11, ST_F2I1, ST_F2O1, ST_PP1, ST_RW12, ST_PG1, ST_RW13, NSTEP };
__host__ __device__ constexpr bool sync_before(int s) { return !(s == ST_PRO || s == ST_PP0 || s == ST_F1I1 || s == ST_F1O1 || s == ST_PP1); }
enum { K_PRO = 0, K_FFN_IN, K_FFN_OUT, K_RW, K_HGRN_IN, K_HGRN, K_HGRN_OUT, K_PLE_PROJ, K_PLE_GATE, K_KVF, K_CUMSUM, K_QG, K_ATTN, K_FOX_OUT };

__global__ void __launch_bounds__(NWAVES * 64, 2) yoco_fwd(Args args) {
    extern __shared__ __attribute__((aligned(16))) unsigned char lds[];
    cg::grid_group grid = cg::this_grid();
    LAS unsigned char* ldsp = (LAS unsigned char*)lds;
    const int st_lo = args.st_lo, st_hi = args.st_hi;
    const int wave_s = __builtin_amdgcn_readfirstlane((int)(threadIdx.x >> 6));
    if (tid_from(wave_s) < 2) ((volatile LAS unsigned*)(ldsp + LDS_BARST))[tid_from(wave_s)] = 0u;
    __syncthreads();
    (void)xcd_barrier_post((unsigned*)(args.ws + WS_CTL), (volatile LAS unsigned*)(ldsp + LDS_BARST), tid_from(wave_s) == 0);
#define STEP_BEGIN(k) if (st_lo <= (k) && (k) < st_hi) { if ((k) > st_lo && sync_before(k)) { if (st_hi < 0) { asm volatile("s_waitcnt vmcnt(0) lgkmcnt(0)" ::: "memory"); grid.sync(); __builtin_amdgcn_fence(__ATOMIC_ACQUIRE, "agent"); asm volatile("s_waitcnt vmcnt(0)" ::: "memory"); }     \
          else { XcdBarrier xb_; xb_.bar = (unsigned*)(((const __attribute__((address_space(4))) Args*)__builtin_amdgcn_kernarg_segment_ptr())->ws + WS_CTL); xb_.x = xb_xcc_id(); xb_.st = (volatile LAS unsigned*)(ldsp + LDS_BARST); xcd_barrier(xb_, tid_from(wave_s) == 0); } } \
        const __attribute__((address_space(4))) Args* ap = (const __attribute__((address_space(4))) Args*)__builtin_amdgcn_kernarg_segment_ptr(); asm volatile("" : "+s"(ap)); \
        int tid_k = tid_from(wave_s); asm volatile("" : "+v"(tid_k)); const int tid = tid_k, lane = tid & 63, wave = __builtin_amdgcn_readfirstlane(tid >> 6); \
        const int G = gridDim.x, bx = blockIdx.x; unsigned char* ws = ap->ws; bfu* Wb = (bfu*)ws; bfu* PB = (bfu*)(ws + WS_P); float* LOGF = (float*)(ws + WS_LOGF); float* CL = (float*)(ws + WS_C); \
        bfu* AY = (bfu*)(ws + WS_AY); bfu* BIG = (bfu*)(ws + WS_BIG); bfu* PROJ = (bfu*)(ws + WS_PROJ); const int gw = bx * NWAVES + wave, ngw = G * NWAVES; \
        (void)tid; (void)lane; (void)Wb; (void)PB; (void)LOGF; (void)CL; (void)AY; (void)BIG; (void)PROJ; (void)gw; (void)ngw;
#define STEP_END }
#define RUN_GEMM(MODE, A_, LDA_, Bt_, N_, K_, O_, LDC_, O2_, AUX_, SC_) do { const pg8::Gemm g{A_, Bt_, T, N_, K_, LDA_}; pg8::StaticOrder S; S.init(T, N_, G, bx); \
        const pg8::Epi<MODE, LDC_> E{O_, O2_, AUX_, LOGF, ap->in[18], SC_}; pg8::gemm_phase<pg8::Epi<MODE, LDC_>, pg8::StaticOrder, true, true, K_, LDA_>(ldsp, g, S, E, wave_s); } while (0)
#define NOB ((bfu*)nullptr)
#define S_FFN_IN(k, L, w)  STEP_BEGIN(k) RUN_GEMM(pg8::EP_SWIGLU, AY, D, Wb + ((w) == 1 ? E_W1IN : E_W2IN) + (L) * N_WIN, 2 * FF, D, BIG, FF, NOB, NOB, 1.f); STEP_END
#define S_FFN_OUT(k, L, w) STEP_BEGIN(k) RUN_GEMM(pg8::EP_PLAIN, BIG, FF, Wb + ((w) == 1 ? E_W1OUT : E_W2OUT) + (L) * N_WOUT, D, FF, AY, D, NOB, NOB, 1.f); STEP_END
#define S_PLE_PROJ(k, L)   STEP_BEGIN(k) RUN_GEMM(pg8::EP_PLAIN, PB + (size_t)(L) * T * PLE, PLE, Wb + E_WPP + (size_t)(L) * PLE * D, D, PLE, PROJ, D, NOB, NOB, 1.f); STEP_END
#define S_PLE_GATE(k, L)   STEP_BEGIN(k) RUN_GEMM(pg8::EP_PLEGATE, AY, D, Wb + E_WPG + (size_t)(L) * D * D, D, D, BIG, D, NOB, PROJ, 1.f); STEP_END
#define S_RW(k, L, w)      STEP_BEGIN(k) { const float* hin = ((L) == 0 && (w) == 0) ? ap->in[0] : ap->out; const bfu* Y = ((w) == 3) ? BIG : AY; \
        const float* gain = ((w) == 0 ? ap->in[5] : (w) == 1 ? ap->in[7] : (w) == 2 ? ap->in[11] : ap->in[24]) + (L) * D; \
        rw_phase<!((L) == 1 && (w) == 3)>(hin, ap->out, Y, AY, gain, ((w) == 0 || (w) == 2) ? 0.5f : 1.0f, gw, ngw, lane); } STEP_END

    STEP_BEGIN(ST_PRO) {
        LAS float* scr = (LAS float*)(ldsp + wave * 16384);
        for (int it = gw;; it += ngw) {
            int r = it;
#define CONV(src, K_, N_, dst, gain, gmask, sw) { constexpr int NI = ((K_) / 64) * (((N_) + 31) / 32); if (r < NI) { conv_item(src, K_, N_, dst, gain, gmask, sw, scr, r, lane); continue; } r -= NI; }
            CONV(ap->in[3], D, 2 * FF, Wb + E_W1IN, ap->in[2], 1023, 1)
            CONV(ap->in[3] + N_WIN, D, 2 * FF, Wb + E_W1IN + N_WIN, ap->in[2] + D, 1023, 1)
            CONV(ap->in[9], D, 2 * FF, Wb + E_W2IN, ap->in[8], 1023, 1)
            CONV(ap->in[9] + N_WIN, D, 2 * FF, Wb + E_W2IN + N_WIN, ap->in[8] + D, 1023, 1)
            CONV(ap->in[4], FF, D, Wb + E_W1OUT, (const float*)nullptr, 0, 0)
            CONV(ap->in[4] + N_WOUT, FF, D, Wb + E_W1OUT + N_WOUT, (const float*)nullptr, 0, 0)
            CONV(ap->in[10], FF, D, Wb + E_W2OUT, (const float*)nullptr, 0, 0)
            CONV(ap->in[10] + N_WOUT, FF, D, Wb + E_W2OUT + N_WOUT, (const float*)nullptr, 0, 0)
            CONV(ap->in[12], D, 4 * D, Wb + E_WHIN, ap->in[6], 1023, 0)
            CONV(ap->in[15], D, D, Wb + E_WHOUT, ap->in[14], 127, 0)
            CONV(ap->in[17], D, NKVF, Wb + E_WKVF, ap->in[16], 1023, 0)
            CONV(ap->in[19], D, 2 * D, Wb + E_WQG, ap->in[6] + D, 1023, 0)
            CONV(ap->in[20], D, D, Wb + E_WFO, (const float*)nullptr, 0, 0)
            CONV(ap->in[22], D, D, Wb + E_WPG, ap->in[21], 1023, 0)
            CONV(ap->in[22] + (size_t)D * D, D, D, Wb + E_WPG + (size_t)D * D, ap->in[21] + D, 1023, 0)
            CONV(ap->in[23], PLE, D, Wb + E_WPP, (const float*)nullptr, 0, 0)
            CONV(ap->in[23] + (size_t)PLE * D, PLE, D, Wb + E_WPP + (size_t)PLE * D, (const float*)nullptr, 0, 0)
#undef CONV
            break;
        }
        {   const float* p = ap->in[1]; const size_t n8 = (size_t)2 * T * PLE / 8;
            for (size_t i = (size_t)bx * 512 + tid; i < n8; i += (size_t)G * 512) { const f32x4 a = *((const f32x4*)p + 2 * i), c = *((const f32x4*)p + 2 * i + 1);
                *((v4u*)PB + i) = (v4u){pk2(a.x, a.y), pk2(a.z, a.w), pk2(c.x, c.y), pk2(c.z, c.w)}; } }
        const float* x = ap->in[0];
        for (int m = gw; m < T; m += 2 * ngw) { rms_row_to_bf16(x + (size_t)m * D, AY + (size_t)m * D, lane); if (m + ngw < T) rms_row_to_bf16(x + (size_t)(m + ngw) * D, AY + (size_t)(m + ngw) * D, lane); }
    } STEP_END
    S_FFN_IN(ST_F1I0, 0, 1) S_FFN_OUT(ST_F1O0, 0, 1) S_RW(ST_RW00, 0, 0)
    STEP_BEGIN(ST_HIN) RUN_GEMM(pg8::EP_PLAIN, AY, D, Wb + E_WHIN, 4 * D, D, BIG, 4 * D, NOB, NOB, 1.f); STEP_END
    STEP_BEGIN(ST_HS1) { const float* lbl = ap->in[13]; float* Eb = (float*)AY; float* Lb = (float*)(ws + WS_AY + 32 * MiB);
        for (int it = bx; it < BATCH * 8 * HSEG; it += G) if ((it & 3) != 3) hgrn_scan<false>(ldsp, BIG, lbl, it >> 2, it & 3, Eb, Lb, wave_s); } STEP_END
    STEP_BEGIN(ST_HS2) { const float* lbl = ap->in[13]; float* Eb = (float*)AY; float* Lb = (float*)(ws + WS_AY + 32 * MiB);
        for (int it = bx; it < BATCH * 8 * HSEG; it += G) hgrn_scan<true>(ldsp, BIG, lbl, it >> 2, it & 3, Eb, Lb, wave_s); } STEP_END
    STEP_BEGIN(ST_HOUT) RUN_GEMM(pg8::EP_PLAIN, BIG, 4 * D, Wb + E_WHOUT, D, D, AY, D, NOB, NOB, 1.f); STEP_END
    S_RW(ST_RW01, 0, 1) S_FFN_IN(ST_F2I0, 0, 2) S_FFN_OUT(ST_F2O0, 0, 2) S_PLE_PROJ(ST_PP0, 0) S_RW(ST_RW02, 0, 2) S_PLE_GATE(ST_PG0, 0) S_RW(ST_RW03, 0, 3)
    STEP_BEGIN(ST_KVF) RUN_GEMM(pg8::EP_KVF, AY, D, Wb + E_WKVF, NKVFP, D, (bfu*)(ws + WS_K), D, (bfu*)(ws + WS_V), NOB, 1.f); STEP_END
    S_FFN_IN(ST_F1I1, 1, 1)
    STEP_BEGIN(ST_CUM) { for (int bh = bx; bh < BATCH * 16; bh += G) cumsum_bh(ldsp, LOGF, CL, bh, wave_s); } STEP_END
    S_FFN_OUT(ST_F1O1, 1, 1) S_RW(ST_RW10, 1, 0)
    STEP_BEGIN(ST_QG) RUN_GEMM(pg8::EP_QG, AY, D, Wb + E_WQG, 2 * D, D, (bfu*)(ws + WS_Q), D, (bfu*)(ws + WS_G), NOB, attn_body::C2); STEP_END
    STEP_BEGIN(ST_ATT) {
        const attn_body::AttnTensors AT{(const attn_body::bf16*)(ws + WS_Q), (const attn_body::bf16*)(ws + WS_K), (const attn_body::bf16*)(ws + WS_V), (attn_body::bf16*)(ws + WS_Q), (const attn_body::bf16*)(ws + WS_G), CL};
        const attn_body::StaticOrder S(G, bx);
        attn_body::attn_phase<attn_body::StaticOrder>((char*)lds, AT, S, wave_s);
    } STEP_END
    STEP_BEGIN(ST_FOUT) RUN_GEMM(pg8::EP_PLAIN, (const bfu*)(ws + WS_Q), D, Wb + E_WFO, D, D, AY, D, NOB, NOB, 1.f); STEP_END
    S_RW(ST_RW11, 1, 1) S_FFN_IN(ST_F2I1, 1, 2) S_FFN_OUT(ST_F2O1, 1, 2) S_PLE_PROJ(ST_PP1, 1) S_RW(ST_RW12, 1, 2) S_PLE_GATE(ST_PG1, 1) S_RW(ST_RW13, 1, 3)
}

#ifndef MK_MULTI
#define MK_MULTI 0
#endif
extern "C" void kernel_launch(void* const* d_in, const int* in_sizes, int n_in, void* d_out, int out_size, void* d_ws, size_t ws_size, hipStream_t stream) {
    static int grid = 0;
    if (grid == 0) {
        if (n_in != 25 || out_size != T * D || ws_size < WS_END) { fprintf(stderr, "kernel_launch: unexpected shapes (n_in %d out %d ws %zu)\n", n_in, out_size, ws_size); grid = -1; return; }
        int dev = 0, cus = 0, per_cu = 0;
        (void)hipGetDevice(&dev); (void)hipDeviceGetAttribute(&cus, hipDeviceAttributeMultiprocessorCount, dev);
        if (hipFuncSetAttribute((const void*)yoco_fwd, hipFuncAttributeMaxDynamicSharedMemorySize, LDS_BYTES) != hipSuccess) { fprintf(stderr, "kernel_launch: hipFuncSetAttribute failed\n"); grid = -1; return; }
        if (hipOccupancyMaxActiveBlocksPerMultiprocessor(&per_cu, (const void*)yoco_fwd, NWAVES * 64, LDS_BYTES) != hipSuccess || per_cu < 1) per_cu = 1;
        (void)hipGetLastError();
        if (cus <= 0) cus = 256;
        grid = cus * per_cu;
    }
    if (grid < 0) return;
    if (hipMemsetAsync((char*)d_ws + WS_CTL, 0, CTL_BYTES, stream) != hipSuccess) { fprintf(stderr, "kernel_launch: memset failed\n"); return; }
    Args a{};
    for (int i = 0; i < 25; ++i) a.in[i] = (const float*)d_in[i];
    a.out = (float*)d_out; a.ws = (unsigned char*)d_ws;
#if MK_MULTI
    int lo = 0;
    for (int s = 1; s <= NSTEP; ++s) if (s == NSTEP || sync_before(s)) { a.st_lo = lo; a.st_hi = s; hipLaunchKernelGGL(yoco_fwd, dim3(grid), dim3(NWAVES * 64), LDS_BYTES, stream, a); lo = s; }
#else
#ifndef ST_CUT
#define ST_CUT NSTEP
#endif
    a.st_lo = 0; a.st_hi = ST_CUT;
    void* kargs[] = {&a};
    const hipError_t e = hipLaunchCooperativeKernel((const void*)yoco_fwd, dim3(grid), dim3(NWAVES * 64), kargs, LDS_BYTES, stream);
    if (e != hipSuccess) fprintf(stderr, "kernel_launch: cooperative launch failed: %s (grid %d)\n", hipGetErrorString(e), grid);
#endif
}
```

```cpp
#include <hip/hip_runtime.h>
#include <hip/hip_cooperative_groups.h>
#include <hip/hip_bf16.h>
#include <cstdio>
#include <cstdint>
#include <cmath>
namespace cg = cooperative_groups;
__device__ __forceinline__ int tid_from(int wave_s) { unsigned l; asm volatile("v_mbcnt_lo_u32_b32 %0, -1, 0\n\tv_mbcnt_hi_u32_b32 %0, -1, %0" : "=v"(l)); return wave_s * 64 + (int)l; }
namespace pg8 {
#define PG8_LAS __attribute__((address_space(3)))
typedef unsigned short bf16_t;
typedef short bf16x8 __attribute__((ext_vector_type(8)));
typedef float f32x4 __attribute__((ext_vector_type(4)));
typedef unsigned u32x4 __attribute__((ext_vector_type(4)));
constexpr int BM = 256, BK = 64, HALF = 128, HTB = HALF * BK * 2  , STAGE_BYTES = 8 * HTB, NXCD = 8, WGM = 8;

__host__ __device__ __forceinline__ int lds_byte(int r, int c) { const int st = (r >> 4) * 2 + (c >> 5), rr = r & 15, cc = c & 31, ob = rr * 64 + cc * 2; return st * 1024 + (ob ^ (((ob >> 9) & 1) << 5)); }
__host__ __device__ __forceinline__ void stage_rc(int b, int& R, int& C) { const int st = b / 1024, sb = b % 1024, swz = sb ^ (((sb >> 9) & 1) << 5); R = (st >> 1) * 16 + swz / 64; C = (st & 1) * 32 + (swz % 64) / 2; }
__host__ __device__ __forceinline__ int perm32(int rho) { const int n = rho >> 4, i = rho & 15; return 8 * (i >> 2) + 4 * n + (i & 3); }

struct Unit { int pm, pn; };
struct Gemm { const bf16_t* A; const bf16_t* Bt; int M, N, K, lda; };

struct StaticOrder {
    int nM, nN, nwg, G, c;
    __host__ __device__ void init(int M, int N, int G_, int c_) { nM = M / BM; nN = N / BM; nwg = nM * nN; G = G_; c = c_; }
    __host__ __device__ bool next(int i, Unit& u) const {
        const long L = (long)i * G + c; if (L >= nwg) return false;
        int wgid = (int)L; { const int q = nwg / NXCD, r = nwg % NXCD, xcd = wgid % NXCD, off = wgid / NXCD; wgid = (xcd < r ? xcd * (q + 1) : r * (q + 1) + (xcd - r) * q) + off; }
        const int nig = WGM * nN, gid = wgid / nig, fm = gid * WGM, gsz = (nM - fm) < WGM ? (nM - fm) : WGM;
        u.pm = fm + ((wgid % nig) % gsz); u.pn = (wgid % nig) / gsz; return true;
    }
    __device__ __forceinline__ void a_ready(const Unit&) const {}
    __device__ __forceinline__ void done(const Unit&) const {}
};

typedef float f32x2cv __attribute__((ext_vector_type(2))); typedef __bf16 bf16x2cv __attribute__((ext_vector_type(2)));
__device__ __forceinline__ unsigned cvt_pk_bf16_asm(float lo, float hi) { unsigned r; asm volatile("v_cvt_pk_bf16_f32 %0, %1, %2" : "=v"(r) : "v"(lo), "v"(hi)); return r; }
__device__ __forceinline__ unsigned cvt_pk_bf16(float lo, float hi) { const f32x2cv v = {lo, hi}; const bf16x2cv b = __builtin_convertvector(v, bf16x2cv); return __builtin_bit_cast(unsigned, b); }
enum { EP_PLAIN = 0, EP_SWIGLU = 1, EP_KVF = 2, EP_QG = 3, EP_PLEGATE = 4 };
__device__ __forceinline__ float fsigmoid(float x) { return __builtin_amdgcn_rcpf(1.0f + __builtin_amdgcn_exp2f(-1.4426950408889634f * x)); }
__device__ __forceinline__ float bflo(unsigned w) { return __uint_as_float(w << 16); }
__device__ __forceinline__ float bfhi(unsigned w) { return __uint_as_float(w & 0xffff0000u); }
template <int MODE, int LDC> struct Epi {
    static constexpr bool PERM = true, AFTER_DRAIN = false;
    bf16_t* O; bf16_t* O2; const bf16_t* aux; float* lf; const float* bfp; float scale0; static constexpr int ldc = LDC;
    __device__ __forceinline__ void operator()(const f32x4 (&acc)[2][2][4][2], const Unit& u, int wr, int wc, int fr, int fq) const {
        asm volatile("s_nop 15\n\ts_nop 15" ::: "memory");
        const int row0 = u.pm * BM + wr * 64 + fr;
        if constexpr (MODE == EP_SWIGLU) {
            const int col0 = u.pn * HALF + wc * 32 + 8 * fq;
#pragma unroll
            for (int ai = 0; ai < 2; ++ai)
#pragma unroll
                for (int m = 0; m < 4; ++m) { bf16_t* rowp = O + (size_t)(row0 + ai * HALF + m * 16) * ldc + col0;
                    const f32x4 g0 = acc[ai][0][m][0], g1 = acc[ai][0][m][1], u0 = acc[ai][1][m][0], u1 = acc[ai][1][m][1]; f32x4 v0, v1;
#pragma unroll
                    for (int j = 0; j < 4; ++j) { v0[j] = g0[j] * fsigmoid(g0[j]) * u0[j]; v1[j] = g1[j] * fsigmoid(g1[j]) * u1[j]; }
                    u32x4 w; w.x = cvt_pk_bf16_asm(v0[0], v0[1]); w.y = cvt_pk_bf16_asm(v0[2], v0[3]); w.z = cvt_pk_bf16_asm(v1[0], v1[1]); w.w = cvt_pk_bf16_asm(v1[2], v1[3]);
                    *(u32x4*)rowp = w; }
        } else {
            bf16_t* base = O; int colt = u.pn * BM; int kind = 0; float sc = 1.f;
            if constexpr (MODE == EP_KVF) { if (u.pn >= 8) kind = 2; else if (u.pn >= 4) { base = O2; colt -= 1024; } }
            if constexpr (MODE == EP_QG) { if (u.pn >= 4) { base = O2; colt -= 1024; kind = 1; } else sc = scale0; }
            if (MODE == EP_KVF && kind == 2) {
                if (wc == 0 && fq < 2) {
#pragma unroll
                    for (int ai = 0; ai < 2; ++ai)
#pragma unroll
                        for (int m = 0; m < 4; ++m) { float* lp = lf + (size_t)(row0 + ai * HALF + m * 16) * 16 + 8 * fq;
#pragma unroll
                            for (int n = 0; n < 2; ++n) { const f32x4 a = acc[ai][0][m][n]; f32x4 o;
#pragma unroll
                                for (int j = 0; j < 4; ++j) { const float x = a[j] + bfp[8 * fq + 4 * n + j]; o[j] = fminf(x, 0.f) - __logf(1.0f + __expf(-fabsf(x))); }
                                *(f32x4*)(lp + 4 * n) = o; } }
                }
                return;
            }
            const int col0 = colt + wc * 32 + 8 * fq;
#pragma unroll
            for (int ai = 0; ai < 2; ++ai)
#pragma unroll
                for (int m = 0; m < 4; ++m) { const size_t roff = (size_t)(row0 + ai * HALF + m * 16) * ldc + col0;
#pragma unroll
                    for (int bj = 0; bj < 2; ++bj) { f32x4 v0 = acc[ai][bj][m][0], v1 = acc[ai][bj][m][1];
                        if (MODE == EP_QG && kind == 1) {
#pragma unroll
                            for (int j = 0; j < 4; ++j) { v0[j] = fsigmoid(v0[j]); v1[j] = fsigmoid(v1[j]); } }
                        else if (MODE == EP_QG) { v0 = v0 * sc; v1 = v1 * sc; }
                        if constexpr (MODE == EP_PLEGATE) { const u32x4 pq = __builtin_nontemporal_load((const u32x4*)(aux + roff + bj * HALF));
                            v0[0] = fsigmoid(v0[0]) * bflo(pq.x); v0[1] = fsigmoid(v0[1]) * bfhi(pq.x); v0[2] = fsigmoid(v0[2]) * bflo(pq.y); v0[3] = fsigmoid(v0[3]) * bfhi(pq.y);
                            v1[0] = fsigmoid(v1[0]) * bflo(pq.z); v1[1] = fsigmoid(v1[1]) * bfhi(pq.z); v1[2] = fsigmoid(v1[2]) * bflo(pq.w); v1[3] = fsigmoid(v1[3]) * bfhi(pq.w); }
                        u32x4 w; w.x = cvt_pk_bf16_asm(v0[0], v0[1]); w.y = cvt_pk_bf16_asm(v0[2], v0[3]); w.z = cvt_pk_bf16_asm(v1[0], v1[1]); w.w = cvt_pk_bf16_asm(v1[2], v1[3]);
                        if constexpr (MODE == EP_KVF) __builtin_nontemporal_store(w, (u32x4*)(base + roff + bj * HALF));
                        else *(u32x4*)(base + roff + bj * HALF) = w; } }
        }
    }
};

struct PanelSS {
    unsigned* xbuf;
    unsigned* cnt;
    float eps;
    __device__ __forceinline__ bool run(const f32x4 (&v)[2][2][4][2], const Unit& u, int wr, int wc, int fr, int fq, PG8_LAS unsigned char* lds, int wid, int lane) const {
        PG8_LAS float* P = (PG8_LAS float*)lds;
        PG8_LAS float* S = (PG8_LAS float*)(lds + 4096);
        PG8_LAS unsigned* flag = (PG8_LAS unsigned*)(lds + 4096 + 1024);
#pragma unroll
        for (int ai = 0; ai < 2; ++ai)
#pragma unroll
            for (int m = 0; m < 4; ++m) {
                float s = 0.f;
#pragma unroll
                for (int bj = 0; bj < 2; ++bj)
#pragma unroll
                    for (int n = 0; n < 2; ++n) { const f32x4 x = v[ai][bj][m][n]; s += (x[0] * x[0] + x[1] * x[1]) + (x[2] * x[2] + x[3] * x[3]); }
                s += __shfl_xor(s, 16); s += __shfl_xor(s, 32);
                if (fq == 0) P[(ai * HALF + wr * 64 + m * 16 + fr) * 4 + wc] = s;
            }
        asm volatile("s_waitcnt lgkmcnt(0)" ::: "memory"); __builtin_amdgcn_s_barrier(); asm volatile("" ::: "memory");
        const int row = wid * 32 + (lane & 31);
        if (lane < 32) {
            const float t = (P[row * 4 + 0] + P[row * 4 + 1]) + (P[row * 4 + 2] + P[row * 4 + 3]);
            __hip_atomic_store(xbuf + ((size_t)(u.pm * BM + row) * 4 + u.pn), __float_as_uint(t), __ATOMIC_RELAXED, __HIP_MEMORY_SCOPE_AGENT);
        }
        asm volatile("s_waitcnt vmcnt(0)" ::: "memory");
        if (lane == 0) __hip_atomic_fetch_add(cnt + 16 * u.pm, 1u, __ATOMIC_RELAXED, __HIP_MEMORY_SCOPE_AGENT);
        if (wid == 0) {
            bool dead = false; const unsigned long long t0 = __builtin_amdgcn_s_memrealtime();
            for (;;) {
                if ((unsigned)__builtin_amdgcn_readfirstlane(__hip_atomic_load(cnt + 16 * u.pm, __ATOMIC_RELAXED, __HIP_MEMORY_SCOPE_AGENT)) >= 32u) break;
                if (__builtin_amdgcn_s_memrealtime() - t0 > 20000000ull) { dead = true; break; }
                __builtin_amdgcn_s_sleep(2);
            }
            __builtin_amdgcn_fence(__ATOMIC_ACQUIRE, "agent");
            if (lane == 0) flag[0] = dead ? 1u : 0u;
        }
        asm volatile("s_waitcnt vmcnt(0) lgkmcnt(0)" ::: "memory"); __builtin_amdgcn_s_barrier(); asm volatile("" ::: "memory");
        const bool bad = flag[0] != 0u;
        if (lane < 32) {
            const unsigned* slot = xbuf + (size_t)(u.pm * BM + row) * 4; float q = 0.f;
#pragma unroll
            for (int t = 0; t < 4; ++t) q += __uint_as_float(__hip_atomic_load(slot + t, __ATOMIC_RELAXED, __HIP_MEMORY_SCOPE_AGENT));
            S[row] = __builtin_amdgcn_rsqf(q * (1.0f / 1024.0f) + eps);
        }
        asm volatile("s_waitcnt lgkmcnt(0)" ::: "memory"); __builtin_amdgcn_s_barrier(); asm volatile("" ::: "memory");
        return bad;
    }
};
template <int PRE, bool WRITE_A> struct EpiRmsRes {
    static constexpr bool PERM = false, AFTER_DRAIN = true;
    const float* base; float* out; bf16_t* xn; const bf16_t* aux; const float* gain; float scale; PanelSS st1, st2;
    __device__ __forceinline__ void fused(f32x4 (&acc)[2][2][4][2], const Unit& u, int wr, int wc, int fr, int fq, PG8_LAS unsigned char* lds, int wid, int lane) const {
        typedef unsigned u32x2v __attribute__((ext_vector_type(2)));
        const PG8_LAS float* S = (const PG8_LAS float*)(lds + 4096);
        const int col0 = u.pn * BM + wc * 32 + 4 * fq;
        if constexpr (PRE == 1) {
#pragma unroll
            for (int ai = 0; ai < 2; ++ai)
#pragma unroll
                for (int m = 0; m < 4; ++m) { const size_t off = (size_t)(u.pm * BM + ai * HALF + wr * 64 + m * 16 + fr) * 1024 + col0;
#pragma unroll
                    for (int bj = 0; bj < 2; ++bj)
#pragma unroll
                        for (int n = 0; n < 2; ++n) { const u32x2v pq = *(const u32x2v*)(aux + off + bj * HALF + n * 16); f32x4 a = acc[ai][bj][m][n];
                            a[0] = fsigmoid(a[0]) * bflo(pq.x); a[1] = fsigmoid(a[1]) * bfhi(pq.x); a[2] = fsigmoid(a[2]) * bflo(pq.y); a[3] = fsigmoid(a[3]) * bfhi(pq.y); acc[ai][bj][m][n] = a; }
                    if (m & 1) asm volatile("" ::: "memory"); }
        }
        bool bad = st1.run(acc, u, wr, wc, fr, fq, lds, wid, lane);
        const float qnan = __builtin_nanf("");
        f32x4 gv[2][2];
#pragma unroll
        for (int bj = 0; bj < 2; ++bj)
#pragma unroll
            for (int n = 0; n < 2; ++n) gv[bj][n] = *(const f32x4*)(gain + col0 + bj * HALF + n * 16) * scale;
#pragma unroll
        for (int ai = 0; ai < 2; ++ai)
#pragma unroll
            for (int m = 0; m < 4; ++m) { const int r = ai * HALF + wr * 64 + m * 16 + fr; const float sr = S[r]; const size_t off = (size_t)(u.pm * BM + r) * 1024 + col0;
#pragma unroll
                for (int bj = 0; bj < 2; ++bj)
#pragma unroll
                    for (int n = 0; n < 2; ++n) { const f32x4 bs = *(const f32x4*)(base + off + bj * HALF + n * 16); acc[ai][bj][m][n] = bs + acc[ai][bj][m][n] * sr * gv[bj][n]; }
                asm volatile("" : "+v"(acc[ai][0][m][0]), "+v"(acc[ai][0][m][1]), "+v"(acc[ai][1][m][0]), "+v"(acc[ai][1][m][1]));
                if (m & 1) asm volatile("" ::: "memory"); }
        if constexpr (WRITE_A) bad = st2.run(acc, u, wr, wc, fr, fq, lds, wid, lane) || bad;
#pragma unroll
        for (int ai = 0; ai < 2; ++ai)
#pragma unroll
            for (int m = 0; m < 4; ++m) { const int r = ai * HALF + wr * 64 + m * 16 + fr; const float sr = WRITE_A ? S[r] : 0.f; const size_t off = (size_t)(u.pm * BM + r) * 1024 + col0;
#pragma unroll
                for (int bj = 0; bj < 2; ++bj)
#pragma unroll
                    for (int n = 0; n < 2; ++n) { const f32x4 x1 = acc[ai][bj][m][n]; *(f32x4*)(out + off + bj * HALF + n * 16) = bad ? (f32x4){qnan, qnan, qnan, qnan} : x1;
                        if constexpr (WRITE_A) { const f32x4 o = x1 * sr; u32x2v w; w.x = cvt_pk_bf16(o[0], o[1]); w.y = cvt_pk_bf16(o[2], o[3]);
                            if (bad) { w.x = 0x7fc07fc0u; w.y = 0x7fc07fc0u; } *(u32x2v*)(xn + off + bj * HALF + n * 16) = w; } }
                asm volatile("" ::: "memory"); }
        asm volatile("s_waitcnt lgkmcnt(0)" ::: "memory"); __builtin_amdgcn_s_barrier(); asm volatile("" ::: "memory");
    }
};
struct HalfOrder {
    int p, c;
    __device__ __forceinline__ bool next(int i, Unit& u) const { if (i > 0) return false; const int x = c & 7, k = c >> 3; u.pn = k & 3; u.pm = 64 * p + 8 * (k >> 2) + x; return true; }
    __device__ __forceinline__ void a_ready(const Unit&) const {}
    __device__ __forceinline__ void done(const Unit&) const {}
};

template <class Epi, class Sched, bool ALIGN_EPI, bool SP2, int KC, int LDA>
__device__ __forceinline__ void gemm_phase(PG8_LAS unsigned char* lds, const Gemm g, const Sched& S, const Epi& E, int wave_s) {
    int tid_o = tid_from(wave_s); asm volatile("" : "+v"(tid_o)); const int tid = tid_o, wid = __builtin_amdgcn_readfirstlane(tid >> 6), lane = tid & 63, wr = wid >> 2, wc = wid & 3, fr = lane & 15, fq = lane >> 4;
    constexpr int K = KC, nt = K / BK;
    unsigned voffA[2], voffB[2];
#pragma unroll
    for (int i = 0; i < 2; ++i) { int R, C; stage_rc(tid * 16 + i * 8192, R, C); const int Rb = Epi::PERM ? ((R & ~31) + perm32(R & 31)) : R;
        voffA[i] = (unsigned)(R * LDA + C) * 2u; voffB[i] = (unsigned)(Rb * K + C) * 2u; }
    const size_t kstep = (size_t)(BK * 2);
    const size_t hstep = (size_t)HALF * K * 2;
    const size_t tstep = 2 * hstep; const size_t hstepA = (size_t)HALF * LDA * 2, tstepA = 2 * hstepA;
    const unsigned ldsw = (unsigned)wid * 1024u;
    const int aoff = lds_byte(wr * 64 + fr, fq * 8), boff = lds_byte(wc * 32 + fr, fq * 8);
#define PG8_SA(b, h) (((b) * 2 + (h)) * HTB)
#define PG8_SB(b, h) ((4 + (b) * 2 + (h)) * HTB)
#define PG8_STAGE(bufoff, gbase, voff) do { _Pragma("unroll") for (int _i = 0; _i < 2; ++_i) \
        __builtin_amdgcn_global_load_lds((const unsigned*)((const char*)(gbase) + (voff)[_i]), (PG8_LAS unsigned*)(lds + (bufoff) + ldsw + _i * 8192), 16, 0, 0); } while (0)
#define PG8_LDA(dst, b, h) do { _Pragma("unroll") for (int m = 0; m < 4; ++m) _Pragma("unroll") for (int k = 0; k < 2; ++k) dst[m][k] = *(const PG8_LAS bf16x8*)(lds + PG8_SA(b, h) + aoff + m * 2048 + k * 1024); } while (0)
#define PG8_LDB(dst, b, h) do { _Pragma("unroll") for (int n = 0; n < 2; ++n) _Pragma("unroll") for (int k = 0; k < 2; ++k) dst[n][k] = *(const PG8_LAS bf16x8*)(lds + PG8_SB(b, h) + boff + n * 2048 + k * 1024); } while (0)
#define PG8_MMA(ai, bj, At, Bt) do { __builtin_amdgcn_s_setprio(1); _Pragma("unroll") for (int m = 0; m < 4; ++m) _Pragma("unroll") for (int n = 0; n < 2; ++n) _Pragma("unroll") for (int k = 0; k < 2; ++k) \
        acc[ai][bj][m][n] = __builtin_amdgcn_mfma_f32_16x16x32_bf16(Bt[n][k], At[m][k], acc[ai][bj][m][n], 0, 0, 0); __builtin_amdgcn_s_setprio(0); } while (0)
#define PG8_WAIT_V(n) asm volatile("s_waitcnt vmcnt(" #n ")" ::: "memory")
#define PG8_WAIT_L(n) asm volatile("s_waitcnt lgkmcnt(" #n ")" ::: "memory")
#define PG8_BAR __builtin_amdgcn_s_barrier()
#define PG8_SCHED __builtin_amdgcn_sched_barrier(0)
    Unit cur, nxt; int ui = 0;
    if (!S.next(0, cur)) return;
    f32x4 acc[2][2][4][2];
#pragma unroll
    for (int a = 0; a < 2; ++a)
#pragma unroll
        for (int b = 0; b < 2; ++b)
#pragma unroll
            for (int m = 0; m < 4; ++m)
#pragma unroll
                for (int n = 0; n < 2; ++n) acc[a][b][m][n] = (f32x4){0.f, 0.f, 0.f, 0.f};
    bf16x8 At[4][2], B0[2][2], B1[2][2];
    const char* cA = (const char*)g.A + (size_t)cur.pm * tstepA; const char* cB = (const char*)g.Bt + (size_t)cur.pn * tstep;
    S.a_ready(cur);
    if constexpr (SP2) {
        PG8_STAGE(PG8_SB(0, 0), cB, voffB); PG8_STAGE(PG8_SB(0, 1), cB + hstep, voffB); PG8_STAGE(PG8_SA(0, 0), cA, voffA); PG8_STAGE(PG8_SA(0, 1), cA + hstepA, voffA);
        if (wr == 1) PG8_BAR;
        PG8_WAIT_V(2); PG8_BAR;
        PG8_STAGE(PG8_SB(1, 0), cB + kstep, voffB); PG8_STAGE(PG8_SA(1, 0), cA + kstep, voffA); PG8_STAGE(PG8_SB(1, 1), cB + hstep + kstep, voffB);
        PG8_WAIT_V(6); PG8_BAR;
    } else {
        PG8_STAGE(PG8_SB(0, 0), cB, voffB); PG8_STAGE(PG8_SA(0, 0), cA, voffA); PG8_STAGE(PG8_SB(0, 1), cB + hstep, voffB); PG8_STAGE(PG8_SA(0, 1), cA + hstepA, voffA);
        if (wr == 1) PG8_BAR;
        PG8_WAIT_V(4); PG8_BAR;
        PG8_STAGE(PG8_SB(1, 0), cB + kstep, voffB); PG8_STAGE(PG8_SA(1, 0), cA + kstep, voffA); PG8_STAGE(PG8_SB(1, 1), cB + hstep + kstep, voffB);
        PG8_WAIT_V(6); PG8_BAR;
    }
    for (;;) {
        const bool has_next = S.next(ui + 1, nxt);
        const char* nA = has_next ? (const char*)g.A + (size_t)nxt.pm * tstepA : cA; const char* nB = has_next ? (const char*)g.Bt + (size_t)nxt.pn * tstep : cB;
        for (int t = 0; t < nt; t += 2) {
            const bool last = (t == nt - 2);
            const char* a1 = cA + (size_t)(t + 1) * kstep;
            const char* a2 = last ? nA : cA + (size_t)(t + 2) * kstep; const char* b2 = last ? nB : cB + (size_t)(t + 2) * kstep;
            const char* a3 = a2 + kstep; const char* b3 = b2 + kstep;
            if (last && has_next) S.a_ready(nxt);
            if constexpr (SP2) {
            PG8_LDB(B0, 0, 0); PG8_LDB(B1, 0, 1); PG8_SCHED; PG8_LDA(At, 0, 0); PG8_STAGE(PG8_SA(1, 1), a1 + hstepA, voffA);
            PG8_WAIT_V(8); PG8_WAIT_L(0); PG8_BAR; PG8_MMA(0, 0, At, B0); PG8_MMA(0, 1, At, B1); PG8_BAR; PG8_SCHED;
            PG8_LDA(At, 0, 1); PG8_STAGE(PG8_SB(0, 0), b2, voffB); PG8_STAGE(PG8_SB(0, 1), b2 + hstep, voffB); PG8_STAGE(PG8_SA(0, 0), a2, voffA);
            PG8_WAIT_V(8); PG8_WAIT_L(0); PG8_BAR; PG8_MMA(1, 0, At, B0); PG8_MMA(1, 1, At, B1); PG8_BAR; PG8_SCHED;
            PG8_LDB(B0, 1, 0); PG8_LDB(B1, 1, 1); PG8_SCHED; PG8_LDA(At, 1, 0); PG8_STAGE(PG8_SA(0, 1), a2 + hstepA, voffA);
            PG8_WAIT_V(8); PG8_WAIT_L(0); PG8_BAR; PG8_MMA(0, 0, At, B0); PG8_MMA(0, 1, At, B1); PG8_BAR; PG8_SCHED;
            PG8_LDA(At, 1, 1); PG8_STAGE(PG8_SB(1, 0), b3, voffB); PG8_STAGE(PG8_SB(1, 1), b3 + hstep, voffB); PG8_STAGE(PG8_SA(1, 0), a3, voffA);
            PG8_WAIT_V(8); PG8_WAIT_L(0); PG8_BAR; PG8_MMA(1, 0, At, B0); PG8_MMA(1, 1, At, B1); PG8_BAR; PG8_SCHED;
            } else {
            PG8_LDB(B0, 0, 0); PG8_SCHED; PG8_LDA(At, 0, 0); PG8_STAGE(PG8_SA(1, 1), a1 + hstepA, voffA);
            PG8_WAIT_L(8); PG8_BAR; PG8_WAIT_L(0); PG8_MMA(0, 0, At, B0); PG8_BAR; PG8_SCHED;
            PG8_LDB(B1, 0, 1); PG8_STAGE(PG8_SB(0, 0), b2, voffB);
            PG8_BAR; PG8_WAIT_L(0); PG8_MMA(0, 1, At, B1); PG8_BAR;
            PG8_LDA(At, 0, 1); PG8_STAGE(PG8_SA(0, 0), a2, voffA);
            PG8_BAR; PG8_WAIT_L(0); PG8_MMA(1, 0, At, B0); PG8_BAR; PG8_SCHED;
            PG8_STAGE(PG8_SB(0, 1), b2 + hstep, voffB);
            PG8_WAIT_V(6); PG8_BAR; PG8_MMA(1, 1, At, B1); PG8_BAR;
            PG8_LDB(B0, 1, 0); PG8_SCHED; PG8_LDA(At, 1, 0); PG8_STAGE(PG8_SA(0, 1), a2 + hstepA, voffA);
            PG8_WAIT_L(8); PG8_BAR; PG8_WAIT_L(0); PG8_MMA(0, 0, At, B0); PG8_BAR; PG8_SCHED;
            PG8_LDB(B1, 1, 1); PG8_STAGE(PG8_SB(1, 0), b3, voffB);
            PG8_BAR; PG8_WAIT_L(0); PG8_MMA(0, 1, At, B1); PG8_BAR;
            PG8_LDA(At, 1, 1); PG8_STAGE(PG8_SA(1, 0), a3, voffA);
            PG8_BAR; PG8_WAIT_L(0); PG8_MMA(1, 0, At, B0); PG8_BAR; PG8_SCHED;
            PG8_STAGE(PG8_SB(1, 1), b3 + hstep, voffB);
            PG8_WAIT_V(6); PG8_BAR; PG8_MMA(1, 1, At, B1); PG8_BAR;
            }
        }
        if constexpr (ALIGN_EPI) { if (wr == 0) PG8_BAR; }
        if constexpr (!Epi::AFTER_DRAIN) { E(acc, cur, wr, wc, fr, fq); S.done(cur); }
        if (!has_next) break;
#pragma unroll
        for (int a = 0; a < 2; ++a)
#pragma unroll
            for (int b = 0; b < 2; ++b)
#pragma unroll
                for (int m = 0; m < 4; ++m)
#pragma unroll
                    for (int n = 0; n < 2; ++n) acc[a][b][m][n] = (f32x4){0.f, 0.f, 0.f, 0.f};
        cur = nxt; cA = nA; cB = nB; ++ui;
        if constexpr (ALIGN_EPI) { if (wr == 1) PG8_BAR; }
    }
    PG8_WAIT_V(0);
    if constexpr (!ALIGN_EPI) { if (wr == 0) PG8_BAR; }
    PG8_BAR;
    if constexpr (Epi::AFTER_DRAIN) { E.fused(acc, cur, wr, wc, fr, fq, lds, wid, lane); S.done(cur); }
#undef PG8_SA
#undef PG8_SB
#undef PG8_STAGE
#undef PG8_LDA
#undef PG8_LDB
#undef PG8_MMA
#undef PG8_WAIT_V
#undef PG8_WAIT_L
#undef PG8_BAR
#undef PG8_SCHED
}
}
#include <hip/hip_bf16.h>
#include <cmath>
namespace attn_body {
using bf16=__hip_bfloat16;
using bf16x8=__attribute__((ext_vector_type(8)))short;
using s16x4=__attribute__((ext_vector_type(4)))short;
using f32x16=__attribute__((ext_vector_type(16)))float;
using u32x4=__attribute__((ext_vector_type(4)))unsigned;
constexpr int BATCH=8,NHEAD=16,SEQ=4096,D=64,DM=NHEAD*D;
constexpr int NW=8,QBLK=32,QB=QBLK*NW,KVBLK=64,NQB=SEQ/QB;
constexpr int ATTN_PITCH=DM, ATTN_UNIT_ROWS=QB;
__device__ __forceinline__ int crow(int r,int hi){return (r&3)+8*(r>>2)+4*hi;}
#define SBAR() __builtin_amdgcn_sched_barrier(0)
__device__ __forceinline__ void cmask(f32x16&p0,f32x16&p1,int jb,int qrel,int hi){
  const float NEG=-INFINITY; int kb=64*jb+4*hi;
  #pragma unroll
  for(int r=0;r<16;++r){int kv=kb+(r&3)+8*(r>>2); if(kv>qrel)p0[r]=NEG; if(kv+32>qrel)p1[r]=NEG;}
}

constexpr int NSLOT=3, SLOTB=8192;
constexpr int LDS_K=0, LDS_V=NSLOT*SLOTB, LDS_WS=2*NSLOT*SLOTB, LDS_OST=LDS_WS+NW*64*4, LDS_CB=LDS_OST+NW*4096, LDS_BYTES=LDS_CB+SEQ*4;
constexpr float C2=0.125f*1.4426950408889634f;
__device__ __forceinline__ void glds16(const void*gsrc,unsigned lds_dst){unsigned keep;
  asm volatile("s_mov_b32 %0, m0\n\ts_mov_b32 m0, %2\n\ts_nop 0\n\tglobal_load_lds_dwordx4 %1, off\n\ts_mov_b32 m0, %0":"=&s"(keep):"v"(gsrc),"s"(lds_dst):"memory");}
__device__ __forceinline__ float max3f(float a,float b,float c){float r;asm("v_max3_f32 %0, %1, %2, %3":"=v"(r):"v"(a),"v"(b),"v"(c));return r;}
__device__ __forceinline__ float max2f(float a,float b){float r;asm("v_max_f32_e32 %0, %1, %2":"=v"(r):"v"(a),"v"(b));return r;}
__device__ __forceinline__ float fadd_s(float a,float b){float r;asm("v_add_f32_e32 %0, %1, %2":"=v"(r):"v"(a),"v"(b));return r;}
__device__ __forceinline__ float fsub_s(float a,float b){float r;asm("v_sub_f32_e32 %0, %1, %2":"=v"(r):"v"(a),"v"(b));return r;}
typedef float f32x2_t __attribute__((ext_vector_type(2))); typedef __bf16 bf16x2_t __attribute__((ext_vector_type(2)));
__device__ __forceinline__ unsigned cvtpk_s(float lo,float hi){f32x2_t v={lo,hi};bf16x2_t b=__builtin_convertvector(v,bf16x2_t);return __builtin_bit_cast(unsigned,b);}
#define WAIT_BAR(N) asm volatile("s_waitcnt vmcnt(" #N ") lgkmcnt(0)\n\ts_barrier":::"memory")

__device__ __forceinline__ void qkt(f32x16&p0,f32x16&p1,const char*Kslot,const bf16x8*qr,const f32x16&negm,int r32,int hi){
  const char*kb=Kslot+hi*1024+r32*16;
  #pragma unroll
  for(int d0=0;d0<4;++d0){
    const bf16x8 b0=*reinterpret_cast<const bf16x8*>(kb+d0*2048);
    const bf16x8 b1=*reinterpret_cast<const bf16x8*>(kb+d0*2048+512);
    if(d0==0){p0=__builtin_amdgcn_mfma_f32_32x32x16_bf16(b0,qr[0],negm,0,0,0);p1=__builtin_amdgcn_mfma_f32_32x32x16_bf16(b1,qr[0],negm,0,0,0);}
    else{p0=__builtin_amdgcn_mfma_f32_32x32x16_bf16(b0,qr[d0],p0,0,0,0);p1=__builtin_amdgcn_mfma_f32_32x32x16_bf16(b1,qr[d0],p1,0,0,0);}}
}
typedef __attribute__((address_space(3))) const char* lds_cptr;
typedef short v4i16_t __attribute__((ext_vector_type(4)));
__device__ __forceinline__ void kload8(bf16x8*kf,lds_cptr kp){
  kf[0]=*(const __attribute__((address_space(3))) bf16x8*)(kp);      kf[1]=*(const __attribute__((address_space(3))) bf16x8*)(kp+512);
  kf[2]=*(const __attribute__((address_space(3))) bf16x8*)(kp+2048); kf[3]=*(const __attribute__((address_space(3))) bf16x8*)(kp+2560);
  kf[4]=*(const __attribute__((address_space(3))) bf16x8*)(kp+4096); kf[5]=*(const __attribute__((address_space(3))) bf16x8*)(kp+4608);
  kf[6]=*(const __attribute__((address_space(3))) bf16x8*)(kp+6144); kf[7]=*(const __attribute__((address_space(3))) bf16x8*)(kp+6656);
}
__device__ __forceinline__ void kload2(bf16x8*kf,lds_cptr kp,int j){ kf[2*j]=*(const __attribute__((address_space(3))) bf16x8*)(kp+j*2048); kf[2*j+1]=*(const __attribute__((address_space(3))) bf16x8*)(kp+j*2048+512); }
__device__ __forceinline__ s16x4 vtr(lds_cptr p){ return __builtin_bit_cast(s16x4,__builtin_amdgcn_ds_read_tr16_b64_v4i16((__attribute__((address_space(3))) v4i16_t*)p)); }
__device__ __forceinline__ float rowmax(const f32x16&p0,const f32x16&p1){
  float a=max3f(p0[0],p0[1],p1[0]),b=max3f(p0[2],p0[3],p1[1]);a=max3f(a,p1[2],p1[3]);
  #pragma unroll
  for(int r=4;r<16;r+=4){a=max3f(a,p0[r],p0[r+1]);b=max3f(b,p0[r+2],p0[r+3]);a=max3f(a,p1[r],p1[r+1]);b=max3f(b,p1[r+2],p1[r+3]);}
  const float m=max2f(a,b);
  auto rr=__builtin_amdgcn_permlane32_swap(__float_as_uint(m),__float_as_uint(m),false,false);
  return max2f(__uint_as_float(rr[0]),__uint_as_float(rr[1]));
}
__device__ __forceinline__ void pv(f32x16*o,int vb,bf16x8 pa0,bf16x8 pa1,bf16x8 pa2,bf16x8 pa3){
  #pragma unroll
  for(int d0=0;d0<2;++d0){s16x4 lo[4],hi[4];
    #pragma unroll
    for(int ks=0;ks<4;++ks){
      asm volatile("ds_read_b64_tr_b16 %0,%1 offset:%c2":"=&v"(lo[ks]):"v"(vb),"i"(d0*4096+ks*1024):"memory");
      asm volatile("ds_read_b64_tr_b16 %0,%1 offset:%c2":"=&v"(hi[ks]):"v"(vb),"i"(d0*4096+ks*1024+512):"memory");}
    asm volatile("s_waitcnt lgkmcnt(0)":::"memory");SBAR();
    #define PK(k) (bf16x8){lo[k][0],lo[k][1],lo[k][2],lo[k][3],hi[k][0],hi[k][1],hi[k][2],hi[k][3]}
    o[d0]=__builtin_amdgcn_mfma_f32_32x32x16_bf16(pa0,PK(0),o[d0],0,0,0);
    o[d0]=__builtin_amdgcn_mfma_f32_32x32x16_bf16(pa1,PK(1),o[d0],0,0,0);
    o[d0]=__builtin_amdgcn_mfma_f32_32x32x16_bf16(pa2,PK(2),o[d0],0,0,0);
    o[d0]=__builtin_amdgcn_mfma_f32_32x32x16_bf16(pa3,PK(3),o[d0],0,0,0);
    #undef PK
  }
}

#ifndef ATTN_STORE16
#define ATTN_STORE16(p,v) (*(u32x4*)(p)=(v))
#endif
template<int THRL> __device__ __forceinline__ void attn_unit(int b,int h,int qb,const bf16*Q,const bf16*__restrict__ K,const bf16*__restrict__ V,bf16*O,const bf16*__restrict__ Gt,const float*__restrict__ CL,char*shm,int wave_s){
  int tid_o=tid_from(wave_s); asm volatile("":"+v"(tid_o)); const int tid=tid_o,lane=tid&63,r32=lane&31,hi=lane>>5; const int wid=__builtin_amdgcn_readfirstlane(tid>>6);
  const long rowbase=(long)b*SEQ; const int q0=qb*QB;
  const float*cbh=CL+((long)b*NHEAD+h)*SEQ;
  typedef float f4_t __attribute__((ext_vector_type(4))); f4_t creg0=f4_t{},creg1=f4_t{}; const int n4c=(q0+QB)/4;
  if(tid<n4c)creg0=*(const f4_t*)(cbh+4*tid); if(tid+NW*64<n4c)creg1=*(const f4_t*)(cbh+4*(tid+NW*64));
  const float cq=cbh[q0+wid*QBLK+(lane&31)];
  const bf16*Qw=Q+(rowbase+q0+wid*QBLK)*DM+h*D;
  const bf16*Kh=K+rowbase*DM+h*D,*Vh=V+rowbase*DM+h*D;
  const unsigned lds0=(unsigned)(uintptr_t)shm;
  float*wsf=(float*)(shm+LDS_WS)+wid*64;
  const bf16*ksrc=Kh+(long)lane*DM+wid*8;
  const bf16*vsrc=Vh+(long)(16*(wid&3)+(lane>>2))*DM+(wid>>2)*32+(lane&3)*8;
  const unsigned kdst=lds0+LDS_K+wid*1024, vdst=lds0+LDS_V+wid*1024;
  #define DMA_K(t,slot) glds16(ksrc+(long)(t)*KVBLK*DM,(unsigned)__builtin_amdgcn_readfirstlane(kdst+(slot)))
  #define DMA_V(t,slot) glds16(vsrc+(long)(t)*KVBLK*DM,(unsigned)__builtin_amdgcn_readfirstlane(vdst+(slot)))
  const int vb0=(int)(lds0+LDS_V)+((lane>>4)&1)*32+(lane&3)*8+(4*hi+((lane&15)>>2))*64;
  const char*Kbase=shm+LDS_K; bf16x8 kf[8];
  const lds_cptr shm3=(lds_cptr)shm; const lds_cptr kp0=shm3+LDS_K+hi*1024+r32*16; const lds_cptr vp0=shm3+LDS_V+((lane>>4)&1)*32+(lane&3)*8+(4*hi+((lane&15)>>2))*64;
  const int NT=(q0+QB)/KVBLK;
  DMA_K(0,0);DMA_V(0,0);DMA_K(1,SLOTB);
  bf16x8 qr[4];
  #pragma unroll
  for(int d0=0;d0<4;++d0)qr[d0]=*reinterpret_cast<const bf16x8*>(&Qw[(long)r32*DM+d0*16+hi*8]);
  float mhat=0.f,l_reg=0.f;f32x16 o[2];o[0]=f32x16{};o[1]=f32x16{};f32x16 negm;
  #pragma unroll
  for(int r=0;r<16;++r)negm[r]=cq;
  asm volatile("":"+v"(negm));
  typedef float cf4_t __attribute__((ext_vector_type(4))); const __attribute__((address_space(3))) cf4_t*clds=(const __attribute__((address_space(3))) cf4_t*)((lds_cptr)shm+LDS_CB)+hi;
  #define CBIAS(P0,P1,t) do{ const __attribute__((address_space(3))) cf4_t*cp_=clds+16*(t); _Pragma("unroll") for(int j_=0;j_<4;++j_){ const cf4_t a_=cp_[2*j_], b_=cp_[8+2*j_]; \
      { f32x2_t u0_={P0[4*j_],P0[4*j_+1]},u1_={P0[4*j_+2],P0[4*j_+3]},w0_={P1[4*j_],P1[4*j_+1]},w1_={P1[4*j_+2],P1[4*j_+3]}; \
        u0_=u0_-(f32x2_t){a_[0],a_[1]}; u1_=u1_-(f32x2_t){a_[2],a_[3]}; w0_=w0_-(f32x2_t){b_[0],b_[1]}; w1_=w1_-(f32x2_t){b_[2],b_[3]}; \
        P0[4*j_]=u0_[0];P0[4*j_+1]=u0_[1];P0[4*j_+2]=u1_[0];P0[4*j_+3]=u1_[1]; P1[4*j_]=w0_[0];P1[4*j_+1]=w0_[1];P1[4*j_+2]=w1_[0];P1[4*j_+3]=w1_[1]; } } }while(0)
  const int qrel=wid*QBLK+r32;
  #define CMASK(P0,P1,t) do{int jb_=(t)-(NT-4); if(jb_>=0)cmask(P0,P1,jb_,qrel,hi);}while(0)
  bool resc=false;
  #define START(P0,P1) do{ const float rm=rowmax(P0,P1); resc=false; \
    { const float c63_=((const __attribute__((address_space(3))) float*)((lds_cptr)shm+LDS_CB))[63]; const float dl=rm-(cq-c63_);     \
      mhat=fadd_s(mhat,dl); \
      _Pragma("unroll") for(int r=0;r<16;++r){P0[r]=fsub_s(P0[r],dl);P1[r]=fsub_s(P1[r],dl);} \
      _Pragma("unroll") for(int r=0;r<16;++r)negm[r]=cq-mhat; asm volatile("":"+v"(negm)); } \
    _Pragma("unroll") for(int r=0;r<16;++r)P0[r]=__builtin_amdgcn_exp2f(P0[r]); }while(0)
  #define RESC() do{ if(resc){ asm volatile("s_waitcnt lgkmcnt(0)":::"memory"); \
      _Pragma("unroll") for(int d_=0;d_<2;++d_) _Pragma("unroll") for(int r=0;r<16;++r)o[d_][r]*=wsf[crow(r,hi)]; } }while(0)
  f32x16 pA0,pA1,pB0,pB1;
  int sl_prev=0,sl_cur=0,sl_next=SLOTB;
  #define ROT() do{sl_prev=sl_cur;sl_cur=sl_next;sl_next=(sl_next==(NSLOT-1)*SLOTB)?0:sl_next+SLOTB;}while(0)
  { __attribute__((address_space(3))) f4_t*cl4=(__attribute__((address_space(3))) f4_t*)((lds_cptr)shm+LDS_CB); if(tid<n4c)cl4[tid]=creg0; if(tid+NW*64<n4c)cl4[tid+NW*64]=creg1; }
  DMA_K(2,2*SLOTB);
  WAIT_BAR(3);
  qkt(pA0,pA1,Kbase,qr,negm,r32,hi);asm volatile("s_nop 15\n\ts_nop 7":"+v"(pA0),"+v"(pA1));CMASK(pA0,pA1,0);CBIAS(pA0,pA1,0);
  START(pA0,pA1);
  _Pragma("unroll") for(int r=0;r<16;++r)pA1[r]=__builtin_amdgcn_exp2f(pA1[r]);
  WAIT_BAR(0);
  DMA_K(3,0);DMA_V(1,SLOTB);
  ROT();
  kload8(kf,kp0+sl_cur);
  WAIT_BAR(2);
  s16x4 vlo[8],vhi[8]; u32x4 pw0,pw1,pw2,pw3;
  #define PKW(P,B) cvtpk_s(P[B],P[B+1])
  #define PAF(k) __builtin_bit_cast(bf16x8,pw##k)
  #define VFR(i) (bf16x8){vlo[i][0],vlo[i][1],vlo[i][2],vlo[i][3],vhi[i][0],vhi[i][1],vhi[i][2],vhi[i][3]}
  #define PIN(x) asm volatile("":"+v"(x))
  #define MX3(a,b,c) __builtin_fmaxf(__builtin_fmaxf((a),(b)),(c))
  #define GAPA(MF,A0,A1,A2,A3,W0,W1,PW) do{ MF; sacc+=A0; sacc+=A1; sacc+=A2; sacc+=A3; PIN(sacc); W0; W1; PIN(PW); SBAR(); }while(0)
  #define EX(v) __builtin_amdgcn_exp2f(v)
  #define GAPB(MF,X,B) do{ MF; X[B]=EX(X[B]); X[B+1]=EX(X[B+1]); X[B+2]=EX(X[B+2]); X[B+3]=EX(X[B+3]); PIN(X); SBAR(); }while(0)
  #define VRD(i) do{ vlo[i]=vtr(vp_+(((i)>>2)*4096+((i)&3)*1024)); vhi[i]=vtr(vp_+(((i)>>2)*4096+((i)&3)*1024+512)); }while(0)
  #define KRD(G,j) do{ if(G){ kload2(kf,kp0+sl_next,j); SBAR(); } }while(0)
  #define STEP(C0,C1,P0,P1,t,GK,GV,GL) do{ SBAR(); \
    const lds_cptr vp_=vp0+sl_prev; \
    VRD(0); SBAR(); float sacc=(P0[0]+P0[1]); \
    GAPA(C0=__builtin_amdgcn_mfma_f32_32x32x16_bf16(kf[0],qr[0],negm,0,0,0), P0[2],P0[3],P0[4],P0[5],     pw0[0]=PKW(P0,0), pw0[1]=PKW(P0,2), pw0); \
    VRD(4); SBAR(); GAPA(C1=__builtin_amdgcn_mfma_f32_32x32x16_bf16(kf[1],qr[0],negm,0,0,0), P0[6],P0[7],P0[8],P0[9],     pw0[2]=PKW(P0,4), pw0[3]=PKW(P0,6), pw0); \
    VRD(1); SBAR(); GAPA(C0=__builtin_amdgcn_mfma_f32_32x32x16_bf16(kf[2],qr[1],C0,0,0,0),   P0[10],P0[11],P0[12],P0[13], pw1[0]=PKW(P0,8), pw1[1]=PKW(P0,10), pw1); \
    VRD(5); SBAR(); GAPA(C1=__builtin_amdgcn_mfma_f32_32x32x16_bf16(kf[3],qr[1],C1,0,0,0),   P0[14],P0[15],P1[0],P1[1],   pw1[2]=PKW(P0,12),pw1[3]=PKW(P0,14), pw1); \
    VRD(2); SBAR(); GAPA(C0=__builtin_amdgcn_mfma_f32_32x32x16_bf16(kf[4],qr[2],C0,0,0,0),   P1[2],P1[3],P1[4],P1[5],     pw2[0]=PKW(P1,0), pw2[1]=PKW(P1,2), pw2); \
    VRD(6); SBAR(); GAPA(C1=__builtin_amdgcn_mfma_f32_32x32x16_bf16(kf[5],qr[2],C1,0,0,0),   P1[6],P1[7],P1[8],P1[9],     pw2[2]=PKW(P1,4), pw2[3]=PKW(P1,6), pw2); \
    VRD(3); SBAR(); GAPA(C0=__builtin_amdgcn_mfma_f32_32x32x16_bf16(kf[6],qr[3],C0,0,0,0),   P1[10],P1[11],P1[12],P1[13], pw3[0]=PKW(P1,8), pw3[1]=PKW(P1,10), pw3); \
    VRD(7); SBAR(); GAPA(C1=__builtin_amdgcn_mfma_f32_32x32x16_bf16(kf[7],qr[3],C1,0,0,0),   P1[14],P1[15],0.f,0.f,       pw3[2]=PKW(P1,12),pw3[3]=PKW(P1,14), pw3); \
    l_reg+=sacc; \
    if(GK){DMA_K((t)+3,sl_cur);} if(GV){DMA_V((t)+1,sl_next);} \
    CMASK(C0,C1,t); CBIAS(C0,C1,t); \
    { float a=MX3(C0[0],C0[1],C1[0]),b=MX3(C0[2],C0[3],C1[1]); a=MX3(a,C1[2],C1[3]); \
      _Pragma("unroll") for(int r=4;r<16;r+=4){a=MX3(a,C0[r],C0[r+1]);b=MX3(b,C0[r+2],C0[r+3]);a=MX3(a,C1[r],C1[r+1]);b=MX3(b,C1[r+2],C1[r+3]);} \
      float rm=__builtin_fmaxf(a,b); { auto rr=__builtin_amdgcn_permlane32_swap(__float_as_uint(rm),__float_as_uint(rm),false,false); rm=__builtin_fmaxf(__uint_as_float(rr[0]),__uint_as_float(rr[1])); } \
      resc=false; \
      if(__builtin_expect(__any(rm>(float)THRL),0)){ const float dl=__builtin_fmaxf(rm,0.f); mhat+=dl; \
        _Pragma("unroll") for(int r=0;r<16;++r){C0[r]-=dl;C1[r]-=dl;} \
        _Pragma("unroll") for(int r=0;r<16;++r)negm[r]=cq-mhat; asm volatile("":"+v"(negm)); \
        const float f=__builtin_amdgcn_exp2f(-dl); l_reg*=f; if(hi==0)wsf[r32]=f; resc=true; } } \
    SBAR(); \
    GAPB(o[0]=__builtin_amdgcn_mfma_f32_32x32x16_bf16(PAF(0),VFR(0),o[0],0,0,0), C0,0); \
    GAPB(o[1]=__builtin_amdgcn_mfma_f32_32x32x16_bf16(PAF(0),VFR(4),o[1],0,0,0), C0,4); \
    KRD(GL,0); GAPB(o[0]=__builtin_amdgcn_mfma_f32_32x32x16_bf16(PAF(1),VFR(1),o[0],0,0,0), C0,8); \
    KRD(GL,1); GAPB(o[1]=__builtin_amdgcn_mfma_f32_32x32x16_bf16(PAF(1),VFR(5),o[1],0,0,0), C0,12); \
    KRD(GL,2); GAPB(o[0]=__builtin_amdgcn_mfma_f32_32x32x16_bf16(PAF(2),VFR(2),o[0],0,0,0), C1,0); \
    KRD(GL,3); GAPB(o[1]=__builtin_amdgcn_mfma_f32_32x32x16_bf16(PAF(2),VFR(6),o[1],0,0,0), C1,4); \
    GAPB(o[0]=__builtin_amdgcn_mfma_f32_32x32x16_bf16(PAF(3),VFR(3),o[0],0,0,0), C1,8); \
    GAPB(o[1]=__builtin_amdgcn_mfma_f32_32x32x16_bf16(PAF(3),VFR(7),o[1],0,0,0), C1,12); \
    }while(0)
  int t=1;
  #undef CMASK
  #define CMASK(P0,P1,t) do{}while(0)
  for(;t+5<NT;t+=2){
    STEP(pB0,pB1,pA0,pA1,t,true,true,true);     WAIT_BAR(2); RESC(); ROT();
    STEP(pA0,pA1,pB0,pB1,t+1,true,true,true);   WAIT_BAR(2); RESC(); ROT();
  }
  #undef CMASK
  #define CMASK(P0,P1,t) do{int jb_=(t)-(NT-4); if(jb_>=0)cmask(P0,P1,jb_,qrel,hi);}while(0)
  #define ENDW(tt) do{ if((tt)+3<NT){WAIT_BAR(2);} else if((tt)+2<NT){WAIT_BAR(1);} else {WAIT_BAR(0);} }while(0)
  for(;t+1<NT;t+=2){
    STEP(pB0,pB1,pA0,pA1,t,(t+3<NT),(t+1<NT),(t+1<NT));       ENDW(t);   RESC(); ROT();
    STEP(pA0,pA1,pB0,pB1,t+1,(t+4<NT),(t+2<NT),(t+2<NT));     ENDW(t+1); RESC(); ROT();
  }
  STEP(pB0,pB1,pA0,pA1,NT-1,false,false,false); RESC();
  { float sacc=pB0[0]+pB0[1]; _Pragma("unroll") for(int r=2;r<16;++r)sacc+=pB0[r]; _Pragma("unroll") for(int r=0;r<16;++r)sacc+=pB1[r]; l_reg+=sacc;
    pw0=(u32x4){PKW(pB0,0),PKW(pB0,2),PKW(pB0,4),PKW(pB0,6)};pw1=(u32x4){PKW(pB0,8),PKW(pB0,10),PKW(pB0,12),PKW(pB0,14)};pw2=(u32x4){PKW(pB1,0),PKW(pB1,2),PKW(pB1,4),PKW(pB1,6)};pw3=(u32x4){PKW(pB1,8),PKW(pB1,10),PKW(pB1,12),PKW(pB1,14)};
    SBAR(); pv(o,vb0+sl_cur,PAF(0),PAF(1),PAF(2),PAF(3)); }
  #undef PKW
  #undef PAF
  #undef VFR
  #undef PIN
  #undef MX3
  #undef GAPA
  #undef GAPB
  #undef EX
  #undef VRD
  #undef KRD
  #undef STEP
  #undef ENDW
  u32x4 gq4[4];
  { const bf16*Gw=Gt+(rowbase+q0+wid*QBLK)*DM+h*D;
    #pragma unroll
    for(int i=0;i<4;++i)gq4[i]=*(const u32x4*)(Gw+(long)(i*8+(lane>>3))*DM+(lane&7)*8); }
  {auto rr=__builtin_amdgcn_permlane32_swap(__float_as_uint(l_reg),__float_as_uint(l_reg),false,false);l_reg=__uint_as_float(rr[0])+__uint_as_float(rr[1]);}
  if(hi==0)wsf[32+r32]=l_reg;asm volatile("s_waitcnt lgkmcnt(0)":::"memory");
  float rli[16];
  #pragma unroll
  for(int r=0;r<16;++r)rli[r]=__builtin_amdgcn_rcpf(wsf[32+crow(r,hi)]);
  bf16*Ow=O+(rowbase+q0+wid*QBLK)*DM+h*D;
  { bf16*stg=(bf16*)(shm+LDS_OST)+wid*2048;
    #pragma unroll
    for(int r=0;r<16;++r){const int orow=crow(r,hi);
      #pragma unroll
      for(int d0=0;d0<2;++d0)stg[orow*64+d0*32+r32]=__float2bfloat16(o[d0][r]*rli[r]);}
    asm volatile("s_waitcnt lgkmcnt(0)":::"memory");
    #pragma unroll
    for(int i=0;i<4;++i){const bf16*Gw=Gt+(rowbase+q0+wid*QBLK)*DM+h*D; const int row=i*8+(lane>>3),ch=lane&7; const u32x4 v=*(const u32x4*)(stg+row*64+ch*8); const u32x4 gq=gq4[i]; u32x4 w;
      #pragma unroll
      for(int e=0;e<4;++e){ const float a0=__uint_as_float(v[e]<<16)*__uint_as_float(gq[e]<<16), a1=__uint_as_float(v[e]&0xffff0000u)*__uint_as_float(gq[e]&0xffff0000u); w[e]=cvtpk_s(a0,a1); }
      ATTN_STORE16(Ow+(long)row*DM+ch*8,w);} }
  asm volatile("s_waitcnt lgkmcnt(0)\n\ts_barrier":::"memory");
  #undef CBIAS
  #undef DMA_K
  #undef DMA_V
  #undef CMASK
  #undef START
  #undef RESC
  #undef ROT
}
constexpr int ATTN_LDS_BYTES=LDS_BYTES;
struct AttnTensors { const bf16* Q; const bf16* K; const bf16* V; bf16* O; const bf16* G; const float* CL; };
struct AttnUnit { int bh; int qb; };
struct StaticOrder {
  int vcu, G;
  __device__ __forceinline__ explicit StaticOrder(int grid,int block):vcu((grid%8==0)?(block%8)*(grid/8)+block/8:block),G(grid){}
  __device__ __forceinline__ bool next(int i,AttnUnit&u)const{
    if(G==256){ if(i>=8)return false; const int j=2*(i>>1)+(vcu&1); u.bh=vcu>>1; u.qb=(i&1)?15-j:j; return true; }
    const int idx=i*G+vcu; if(idx>=BATCH*NHEAD*NQB)return false; u.bh=idx/NQB; u.qb=NQB-1-idx%NQB; return true; }
  __device__ __forceinline__ void a_ready(const AttnUnit&)const{}
  __device__ __forceinline__ void done(const AttnUnit&)const{}
};
template<class Sched,int THRL=8> __device__ __forceinline__ void attn_phase(char*lds,const AttnTensors&T,const Sched&S,int wave_s){
  AttnUnit u;
  for(int i=0;S.next(i,u);++i){ S.a_ready(u); attn_unit<THRL>(u.bh/NHEAD,u.bh%NHEAD,u.qb,T.Q,T.K,T.V,T.O,T.G,T.CL,lds,wave_s); S.done(u); }
}
#undef SBAR
#undef WAIT_BAR
}
#define GAS __attribute__((address_space(1)))
#define LAS __attribute__((address_space(3)))
typedef unsigned short bfu;
typedef unsigned v4u __attribute__((ext_vector_type(4)));
typedef unsigned v2u __attribute__((ext_vector_type(2)));
typedef float f32x4 __attribute__((ext_vector_type(4)));
typedef short bf16x8 __attribute__((ext_vector_type(8)));
#define LDS_WAIT() asm volatile("s_waitcnt lgkmcnt(0)" ::: "memory")
constexpr int NWAVES = 8;
constexpr int BATCH = 8, SEQ = 4096, D = 1024, FF = 2816, T = BATCH * SEQ, PLE = 256, NKVF = 2064, NKVFP = 2304;
constexpr float EPS = 1e-6f, LOG2E = 1.4426950408889634f;
constexpr size_t MiB = 1u << 20;
constexpr size_t E_W1IN = 0, N_WIN = (size_t)2 * FF * D, N_WOUT = (size_t)D * FF;
constexpr size_t E_W1OUT = E_W1IN + 2 * N_WIN, E_W2IN = E_W1OUT + 2 * N_WOUT, E_W2OUT = E_W2IN + 2 * N_WIN, E_WHIN = E_W2OUT + 2 * N_WOUT;
constexpr size_t E_WHOUT = E_WHIN + (size_t)4 * D * D, E_WKVF = E_WHOUT + (size_t)D * D, E_WQG = E_WKVF + (size_t)NKVFP * D, E_WFO = E_WQG + (size_t)2 * D * D;
constexpr size_t E_WPG = E_WFO + (size_t)D * D, E_WPP = E_WPG + (size_t)2 * D * D, E_WEND = E_WPP + (size_t)2 * D * PLE;
static_assert(E_WEND * 2 <= 92 * MiB, "weights fit");
constexpr size_t WS_P = 92 * MiB, WS_LOGF = 124 * MiB, WS_C = 126 * MiB, WS_AY = 128 * MiB, WS_BIG = 192 * MiB, WS_PROJ = 448 * MiB, WS_END = 512 * MiB;
constexpr size_t WS_V = WS_BIG + 192 * MiB, WS_K = WS_PROJ, WS_Q = WS_BIG, WS_G = WS_BIG + 64 * MiB;
constexpr int LDS_BYTES = 147456;

__device__ __forceinline__ float wave_sum(float v) {
#pragma unroll
    for (int o = 1; o < 64; o <<= 1) v += __shfl_xor(v, o);
    return v;
}
__device__ __forceinline__ unsigned pk2(float lo, float hi) { return pg8::cvt_pk_bf16(lo, hi); }
__device__ __forceinline__ float bf2f(unsigned short u) { return __uint_as_float((unsigned)u << 16); }
__device__ __forceinline__ unsigned short f2b(float f) { return (unsigned short)(pk2(f, 0.f) & 0xffffu); }

__device__ __forceinline__ void conv_item(const float* W, int K, int N, bfu* WT, const float* gain, int gmask, int sw, LAS float* scr, int item, int lane) {
    const int nblk = (N + 31) / 32, kb = item / nblk, nb = item % nblk, k0 = 64 * kb, n0 = 32 * nb;
    const int nn = n0 + (lane & 31); const bool nok = nn < N;
    const int c = lane & 7;
    f32x4 ga = (f32x4){1.f, 1.f, 1.f, 1.f}, gb = ga;
    if (gain) { ga = *(const f32x4*)(gain + ((k0 + 8 * c) & gmask)); gb = *(const f32x4*)(gain + ((k0 + 8 * c) & gmask) + 4); }
    float wv[32];
#pragma unroll
    for (int i = 0; i < 32; ++i) { const int kk = 2 * i + (lane >> 5); wv[i] = nok ? __builtin_nontemporal_load(W + (size_t)(k0 + kk) * N + nn) : 0.f; }
#pragma unroll
    for (int i = 0; i < 32; ++i) { const int kk = 2 * i + (lane >> 5); scr[kk * 33 + (lane & 31)] = wv[i]; }
    LDS_WAIT(); asm volatile("" ::: "memory");
    int drow0 = n0; if (sw) { const int j0 = (n0 < FF) ? n0 : n0 - FF; drow0 = 256 * (j0 >> 7) + (j0 & 127) + ((n0 < FF) ? 0 : 128); }
#pragma unroll
    for (int j = 0; j < 4; ++j) { const int n = (lane >> 3) + 8 * j; const LAS float* s = scr + (8 * c) * 33 + n;
        v4u o; o.x = pk2(s[0 * 33] * ga[0], s[1 * 33] * ga[1]); o.y = pk2(s[2 * 33] * ga[2], s[3 * 33] * ga[3]); o.z = pk2(s[4 * 33] * gb[0], s[5 * 33] * gb[1]); o.w = pk2(s[6 * 33] * gb[2], s[7 * 33] * gb[3]);
        *(v4u*)(WT + (size_t)(drow0 + n) * K + k0 + 8 * c) = o; }
    LDS_WAIT(); asm volatile("" ::: "memory");
}
__device__ __forceinline__ void rms_row_to_bf16(const float* xrow, bfu* orow, int lane) {
    const f32x4* xr = (const f32x4*)xrow + lane;
    f32x4 v[4]; float s = 0.f;
#pragma unroll
    for (int j = 0; j < 4; ++j) { v[j] = __builtin_nontemporal_load(xr + 64 * j); s += (v[j].x * v[j].x + v[j].y * v[j].y) + (v[j].z * v[j].z + v[j].w * v[j].w); }
    const float r = __builtin_amdgcn_rsqf(wave_sum(s) * (1.f / D) + EPS);
    v2u* o8 = (v2u*)orow + lane;
#pragma unroll
    for (int j = 0; j < 4; ++j) { v2u w; w.x = pk2(v[j].x * r, v[j].y * r); w.y = pk2(v[j].z * r, v[j].w * r); o8[64 * j] = w; }
}
template <bool WRITE_A>
__device__ __forceinline__ void rw_phase(const float* hin, float* hout, const bfu* Y, bfu* A, const float* gain, float scale, int gw, int ngw, int lane) {
    f32x4 g[4];
#pragma unroll
    for (int j = 0; j < 4; ++j) g[j] = *((const f32x4*)gain + lane + 64 * j);
    for (int m0 = gw; m0 < T; m0 += 2 * ngw) {
        f32x4 v[2][4], y[2][4]; float s[2] = {0.f, 0.f}; const int m1 = m0 + ngw; const bool two = m1 < T;
#pragma unroll
        for (int r = 0; r < 2; ++r) { const int m = (r == 0 || two) ? (r == 0 ? m0 : m1) : m0;
            const f32x4* hr = (const f32x4*)(hin + (size_t)m * D) + lane; const v2u* yr = (const v2u*)(Y + (size_t)m * D) + lane;
#pragma unroll
            for (int j = 0; j < 4; ++j) { v[r][j] = __builtin_nontemporal_load(hr + 64 * j); const v2u w = __builtin_nontemporal_load(yr + 64 * j); y[r][j] = (f32x4){pg8::bflo(w.x), pg8::bfhi(w.x), pg8::bflo(w.y), pg8::bfhi(w.y)}; } }
#pragma unroll
        for (int r = 0; r < 2; ++r)
#pragma unroll
            for (int j = 0; j < 4; ++j) s[r] += (y[r][j].x * y[r][j].x + y[r][j].y * y[r][j].y) + (y[r][j].z * y[r][j].z + y[r][j].w * y[r][j].w);
        float s2[2] = {0.f, 0.f};
#pragma unroll
        for (int r = 0; r < 2; ++r) { const float ry = __builtin_amdgcn_rsqf(wave_sum(s[r]) * (1.f / D) + EPS) * scale;
#pragma unroll
            for (int j = 0; j < 4; ++j) { v[r][j] = v[r][j] + y[r][j] * ry * g[j]; s2[r] += (v[r][j].x * v[r][j].x + v[r][j].y * v[r][j].y) + (v[r][j].z * v[r][j].z + v[r][j].w * v[r][j].w); } }
#pragma unroll
        for (int r = 0; r < 2; ++r) { if (r == 1 && !two) break; const int m = r == 0 ? m0 : m1;
            f32x4* ho = (f32x4*)(hout + (size_t)m * D) + lane;
            if constexpr (WRITE_A) { const float r2 = __builtin_amdgcn_rsqf(wave_sum(s2[r]) * (1.f / D) + EPS); v2u* ao = (v2u*)(A + (size_t)m * D) + lane;
#pragma unroll
                for (int j = 0; j < 4; ++j) { __builtin_nontemporal_store(v[r][j], ho + 64 * j); v2u w; w.x = pk2(v[r][j].x * r2, v[r][j].y * r2); w.y = pk2(v[r][j].z * r2, v[r][j].w * r2); ao[64 * j] = w; } }
            else {
#pragma unroll
                for (int j = 0; j < 4; ++j) __builtin_nontemporal_store(v[r][j], ho + 64 * j); } }
    }
}

constexpr int HG_QH = 0, HG_QT = 17408, HG_KT = 34816, HG_KHT = 52224, HG_VT = 70656, HG_PP = 89088, HG_ST = 98304, HG_TOT = 133120, HG_DV = 135168, HG_END = 135680;
constexpr int RS = 136, RS2 = 72, OFS = 132;
static_assert(HG_END + 64 <= LDS_BYTES - 64, "hgrn lds");
__device__ __forceinline__ f32x4 mfma16(bf16x8 a, bf16x8 b, f32x4 c) { return __builtin_amdgcn_mfma_f32_16x16x32_bf16(a, b, c, 0, 0, 0); }
constexpr int HSEG = 4, HCH = SEQ / 64 / HSEG;
template <bool OUT>
__device__ __forceinline__ void hgrn_scan(LAS unsigned char* lds, bfu* QZVG, const float* lbl, int bh, int seg, float* Ebuf, float* Lbuf, int wave_s, const float* QZ0 = nullptr) {
    int tid_o = tid_from(wave_s); asm volatile("" : "+v"(tid_o)); const int tid = tid_o, lane = tid & 63, wid = __builtin_amdgcn_readfirstlane(tid >> 6), col = tid & 127, rg = tid >> 7, fr = lane & 15, fq = lane >> 4;
    const int b = bh >> 3, h = bh & 7;
    LAS bfu* QH = (LAS bfu*)(lds + HG_QH); LAS bfu* QT = (LAS bfu*)(lds + HG_QT); LAS bfu* KT = (LAS bfu*)(lds + HG_KT); LAS bfu* KHT = (LAS bfu*)(lds + HG_KHT);
    LAS bfu* VT = (LAS bfu*)(lds + HG_VT); LAS bfu* PP = (LAS bfu*)(lds + HG_PP); LAS bfu* ST = (LAS bfu*)(lds + HG_ST);
    LAS float* TOT = (LAS float*)(lds + HG_TOT); LAS float* DV = (LAS float*)(lds + HG_DV); LAS float* OF = (LAS float*)(lds + HG_QT);
    const float l0 = lbl[h * 128 + col], l1 = lbl[1024 + h * 128 + col];
    const float lb = 1.f / (1.f + __expf(l1 - l0)), omlb = 1.f - lb;
    float c0f = 0.f; bool use_c0 = false;
    if constexpr (OUT) { if (QZ0 != nullptr && seg == 0) {
        LAS float* cw = (LAS float*)(lds + HG_END);
        float pr = 0.f; if (tid < 128) { const float q0 = QZ0[(size_t)b * 2 * D + h * 128 + tid], z0 = QZ0[(size_t)b * 2 * D + D + h * 128 + tid]; pr = q0 * (omlb / (1.f + __expf(z0))); }
        pr = wave_sum(pr); if (lane == 0 && wid < 2) cw[wid] = pr;
        LDS_WAIT(); __builtin_amdgcn_s_barrier(); asm volatile("" ::: "memory");
        c0f = cw[0] + cw[1]; use_c0 = true; } }
    bfu* base = QZVG + ((size_t)b * SEQ + (size_t)seg * HCH * 64) * 4096 + h * 128;
    const bfu* pq = base + (size_t)(16 * rg) * 4096 + col; const bfu* pz = pq + 1024; const bfu* pv = pq + 2048;
    const int erow = tid >> 3, eseg = tid & 7;
    const bfu* pg = base + 3072 + (size_t)erow * 4096 + 16 * eseg; bfu* po = base + (size_t)erow * 4096 + 16 * eseg;
    f32x4 Sacc[8];
#pragma unroll
    for (int i = 0; i < 8; ++i) Sacc[i] = (f32x4){0.f, 0.f, 0.f, 0.f};
    float Lacc = 0.f;
    if constexpr (OUT) {
        for (int j = 0; j < seg; ++j) {
            const float* Ej = Ebuf + ((size_t)(bh * HSEG + j) * 64 * 64) * 4 + (size_t)(wid * 8) * 64 * 4; const float* Lj = Lbuf + (size_t)(bh * HSEG + j) * 128;
#pragma unroll
            for (int kb = 0; kb < 8; ++kb) { const f32x4 e = *(const f32x4*)(Ej + ((size_t)kb * 64 + lane) * 4); const f32x4 l4 = *(const f32x4*)(Lj + 16 * kb + 4 * fq);
                f32x4 s = Sacc[kb]; s[0] = s[0] * __expf(l4[0]) + e[0]; s[1] = s[1] * __expf(l4[1]) + e[1]; s[2] = s[2] * __expf(l4[2]) + e[2]; s[3] = s[3] * __expf(l4[3]) + e[3]; Sacc[kb] = s; }
        }
#pragma unroll
        for (int kb = 0; kb < 8; ++kb) *(LAS v2u*)(ST + (16 * wid + fr) * RS + 16 * kb + 4 * fq) = (v2u){pk2(Sacc[kb][0], Sacc[kb][1]), pk2(Sacc[kb][2], Sacc[kb][3])};
    }
    unsigned short zr[16], qr[16], vr[16]; v4u gr0 = (v4u){0u, 0u, 0u, 0u}, gr1 = gr0;
#define HG_LD(p_) (OUT ? __builtin_nontemporal_load(p_) : *(p_))
#define HG_LOAD() do { _Pragma("unroll") for (int j = 0; j < 16; ++j) { zr[j] = HG_LD(pz + (size_t)j * 4096); vr[j] = HG_LD(pv + (size_t)j * 4096); if (OUT) qr[j] = HG_LD(pq + (size_t)j * 4096); else qr[j] = 0; } \
        if (OUT) { gr0 = __builtin_nontemporal_load((const v4u*)pg); gr1 = __builtin_nontemporal_load((const v4u*)(pg + 8)); } pz += (size_t)64 * 4096; pq += (size_t)64 * 4096; pv += (size_t)64 * 4096; pg += (size_t)64 * 4096; } while (0)
    HG_LOAD();
    for (int c = 0; c < HCH; ++c) {
        float kk[16], cum[16], qf[16]; unsigned short vv[16]; const v4u g0 = gr0, g1 = gr1;
        float run = 0.f;
#pragma unroll
        for (int j = 0; j < 16; ++j) { const float z = bf2f(zr[j]); const float k = omlb * __builtin_amdgcn_rcpf(1.f + __expf(z)); run += __logf(1.f - k); cum[j] = run; kk[j] = k; qf[j] = bf2f(qr[j]); vv[j] = vr[j]; }
        TOT[rg * 128 + col] = run;
        if (c + 1 < HCH) HG_LOAD();
        LDS_WAIT(); __builtin_amdgcn_s_barrier(); asm volatile("" ::: "memory");
        const float t0 = TOT[col], t1 = TOT[128 + col], t2 = TOT[256 + col], t3 = TOT[384 + col];
        const float pre = (rg > 0 ? t0 : 0.f) + (rg > 1 ? t1 : 0.f) + (rg > 2 ? t2 : 0.f), tot = (t0 + t1) + (t2 + t3), mid = t0 + t1;
        Lacc += tot;
        unsigned khp[8], vvp[8];
#pragma unroll
        for (int j = 0; j < 16; ++j) { const float cj = pre + cum[j]; const int r = 16 * rg + j;
            if constexpr (OUT) { QH[r * RS + col] = f2b(qf[j] * __expf(cj)); QT[r * RS + col] = f2b(qf[j] * __expf(cj - mid)); KT[r * RS + col] = f2b(kk[j] * __expf(mid - cj)); }
            const unsigned short kh = f2b(kk[j] * __expf(tot - cj));
            if (j & 1) { khp[j >> 1] |= (unsigned)kh << 16; vvp[j >> 1] |= (unsigned)vv[j] << 16; } else { khp[j >> 1] = kh; vvp[j >> 1] = vv[j]; } }
        *(LAS v4u*)(KHT + col * RS2 + 16 * rg) = (v4u){khp[0], khp[1], khp[2], khp[3]}; *(LAS v4u*)(KHT + col * RS2 + 16 * rg + 8) = (v4u){khp[4], khp[5], khp[6], khp[7]};
        *(LAS v4u*)(VT + col * RS2 + 16 * rg) = (v4u){vvp[0], vvp[1], vvp[2], vvp[3]}; *(LAS v4u*)(VT + col * RS2 + 16 * rg + 8) = (v4u){vvp[4], vvp[5], vvp[6], vvp[7]};
        if (rg == 0) DV[col] = __expf(tot);
        LDS_WAIT(); __builtin_amdgcn_s_barrier(); asm volatile("" ::: "memory");
        if constexpr (OUT) {
            const int tb = wid >> 1;
#pragma unroll
            for (int ss = 0; ss < 2; ++ss) { const int sb = 2 * (wid & 1) + ss; f32x4 sc = (f32x4){0.f, 0.f, 0.f, 0.f};
                if (sb <= tb) {
#pragma unroll
                    for (int ks = 0; ks < 4; ++ks) { const bf16x8 a = *(const LAS bf16x8*)(QT + (16 * tb + fr) * RS + 32 * ks + 8 * fq), bq = *(const LAS bf16x8*)(KT + (16 * sb + fr) * RS + 32 * ks + 8 * fq); sc = mfma16(a, bq, sc); } }
#pragma unroll
                for (int i = 0; i < 4; ++i) { const int t = 16 * tb + 4 * fq + i, s = 16 * sb + fr; float pv_ = (sb <= tb && s <= t) ? sc[i] : 0.f; if (use_c0 && c == 0 && t == 0 && s == 0) pv_ = c0f; PP[t * RS2 + s] = f2b(pv_); } }
            LDS_WAIT(); __builtin_amdgcn_s_barrier(); asm volatile("" ::: "memory");
        }
        {   bf16x8 vtf[2];
#pragma unroll
            for (int ks = 0; ks < 2; ++ks) vtf[ks] = *(const LAS bf16x8*)(VT + (16 * wid + fr) * RS2 + 32 * ks + 8 * fq);
            if constexpr (OUT) { bf16x8 stf[4];
#pragma unroll
                for (int ks = 0; ks < 4; ++ks) stf[ks] = *(const LAS bf16x8*)(ST + (16 * wid + fr) * RS + 32 * ks + 8 * fq);
#pragma unroll
                for (int tb = 0; tb < 4; ++tb) { f32x4 o = (f32x4){0.f, 0.f, 0.f, 0.f};
#pragma unroll
                    for (int ks = 0; ks < 4; ++ks) o = mfma16(*(const LAS bf16x8*)(QH + (16 * tb + fr) * RS + 32 * ks + 8 * fq), stf[ks], o);
#pragma unroll
                    for (int ks = 0; ks < 2; ++ks) o = mfma16(*(const LAS bf16x8*)(PP + (16 * tb + fr) * RS2 + 32 * ks + 8 * fq), vtf[ks], o);
#pragma unroll
                    for (int i = 0; i < 4; ++i) OF[(16 * tb + 4 * fq + i) * OFS + 16 * wid + fr] = o[i]; } }
#pragma unroll
            for (int kb = 0; kb < 8; ++kb) { const f32x4 d4 = *(const LAS f32x4*)(DV + 16 * kb + 4 * fq); f32x4 s = Sacc[kb] * d4;
#pragma unroll
                for (int ks = 0; ks < 2; ++ks) s = mfma16(*(const LAS bf16x8*)(KHT + (16 * kb + fr) * RS2 + 32 * ks + 8 * fq), vtf[ks], s);
                Sacc[kb] = s; if constexpr (OUT) *(LAS v2u*)(ST + (16 * wid + fr) * RS + 16 * kb + 4 * fq) = (v2u){pk2(s[0], s[1]), pk2(s[2], s[3])}; }
        }
        if constexpr (OUT) {
            LDS_WAIT(); __builtin_amdgcn_s_barrier(); asm volatile("" ::: "memory");
            f32x4 o4[4]; float ss = 0.f;
#pragma unroll
            for (int j = 0; j < 4; ++j) { o4[j] = *(const LAS f32x4*)(OF + erow * OFS + 16 * eseg + 4 * j); ss += (o4[j].x * o4[j].x + o4[j].y * o4[j].y) + (o4[j].z * o4[j].z + o4[j].w * o4[j].w); }
            ss += __shfl_xor(ss, 1); ss += __shfl_xor(ss, 2); ss += __shfl_xor(ss, 4);
            const float rs = __builtin_amdgcn_rsqf(ss * (1.f / 128.f) + EPS);
            unsigned w[8];
#pragma unroll
            for (int j = 0; j < 4; ++j) { const unsigned ga = (j < 2) ? g0[2 * j] : g1[2 * (j - 2)], gb = (j < 2) ? g0[2 * j + 1] : g1[2 * (j - 2) + 1];
                const float a0 = pg8::bflo(ga), a1 = pg8::bfhi(ga), a2 = pg8::bflo(gb), a3 = pg8::bfhi(gb);
                w[2 * j] = pk2(o4[j].x * rs * a0 * pg8::fsigmoid(a0), o4[j].y * rs * a1 * pg8::fsigmoid(a1)); w[2 * j + 1] = pk2(o4[j].z * rs * a2 * pg8::fsigmoid(a2), o4[j].w * rs * a3 * pg8::fsigmoid(a3)); }
            *(v4u*)po = (v4u){w[0], w[1], w[2], w[3]}; *(v4u*)(po + 8) = (v4u){w[4], w[5], w[6], w[7]}; po += (size_t)64 * 4096;
        }
    }
#undef HG_LOAD
#undef HG_LD
    if constexpr (!OUT) {
        float* Es = Ebuf + ((size_t)(bh * HSEG + seg) * 64 * 64) * 4 + (size_t)(wid * 8) * 64 * 4;
#pragma unroll
        for (int kb = 0; kb < 8; ++kb) *(f32x4*)(Es + ((size_t)kb * 64 + lane) * 4) = Sacc[kb];
        if (rg == 0) Lbuf[(size_t)(bh * HSEG + seg) * 128 + col] = Lacc;
    }
    LDS_WAIT(); __builtin_amdgcn_s_barrier(); asm volatile("" ::: "memory");
}

__device__ __forceinline__ void cumsum_bh(LAS unsigned char* lds, const float* LOGF, float* C, int bh, int wave_s) {
    const int tid = tid_from(wave_s), lane = tid & 63, wid = tid >> 6, b = bh >> 4, h = bh & 15;
    LAS float* wsum = (LAS float*)lds;
    const float* src = LOGF + ((size_t)b * SEQ + 8 * tid) * 16 + h;
    float v[8]; float run = 0.f;
#pragma unroll
    for (int j = 0; j < 8; ++j) { run += src[j * 16]; v[j] = run; }
    float inc = run;
#pragma unroll
    for (int o = 1; o < 64; o <<= 1) { const float t = __shfl_up(inc, o); if (lane >= o) inc += t; }
    if (lane == 63) wsum[wid] = inc;
    LDS_WAIT(); __builtin_amdgcn_s_barrier(); asm volatile("" ::: "memory");
    float off = inc - run;
    for (int w = 0; w < wid; ++w) off += wsum[w];
    float* dst = C + (size_t)bh * SEQ + 8 * tid;
    *(f32x4*)dst = (f32x4){(off + v[0]) * LOG2E, (off + v[1]) * LOG2E, (off + v[2]) * LOG2E, (off + v[3]) * LOG2E};
    *(f32x4*)(dst + 4) = (f32x4){(off + v[4]) * LOG2E, (off + v[5]) * LOG2E, (off + v[6]) * LOG2E, (off + v[7]) * LOG2E};
    LDS_WAIT(); __builtin_amdgcn_s_barrier(); asm volatile("" ::: "memory");
}

#define RLX_AGENT __ATOMIC_RELAXED, __HIP_MEMORY_SCOPE_AGENT
#define XB_TMO      128
#define XB_XCNT(j)  (256  + 64 * (j))
#define XB_XSUB(j)  (1280 + 64 * (j))
#define XB_XGEN(j)  (2304 + 64 * (j))
#define XB_TOP      3328
#define XB_TOPGEN   3392
#define XCD_BAR_WORDS 3456
#define XB_SPIN_CAP (1u << 18)

__device__ __forceinline__ unsigned xb_ld(unsigned* p)              { return __hip_atomic_load(p, __ATOMIC_RELAXED, __HIP_MEMORY_SCOPE_AGENT); }
__device__ __forceinline__ unsigned xb_add(unsigned* p, unsigned v) { return __hip_atomic_fetch_add(p, v, __ATOMIC_RELAXED, __HIP_MEMORY_SCOPE_AGENT); }
__device__ __forceinline__ unsigned xb_xcc_id() { return (unsigned)__builtin_amdgcn_s_getreg((3 << 11) | 20) & 0xFu; }
#define XB_SPIN(cond, bar) do { unsigned _sp = 0; while (cond) { __builtin_amdgcn_s_sleep(1); \
    if ((++_sp & 255u) == 0u) { if (xb_ld(&(bar)[XB_TMO])) break; if (_sp > XB_SPIN_CAP) { atomicAdd(&(bar)[XB_TMO], 1u); break; } } } } while (0)

struct XcdBarrier {
    unsigned* bar; unsigned x;
    volatile LAS unsigned* st;
};

__device__ __forceinline__ XcdBarrier xcd_barrier_post(unsigned* bar, volatile LAS unsigned* st, bool is_t0) {
    XcdBarrier b; b.bar = bar; b.x = xb_xcc_id(); b.st = st;
    if (is_t0) (void)xb_add(&bar[XB_XCNT(b.x)], 1u);
    return b;
}
__device__ __forceinline__ void xcd_barrier_complete(unsigned* bar, unsigned x, unsigned& nloc, unsigned& nx) {
    const unsigned G = gridDim.x * gridDim.y * gridDim.z;
    unsigned sum, cnt, mine, sp = 0u;
    for (;;) {
        sum = 0u; cnt = 0u; mine = 0u;
#pragma unroll
        for (unsigned j = 0; j < 16; ++j) { const unsigned c = xb_ld(&bar[XB_XCNT(j)]); sum += c; cnt += (c > 0u) ? 1u : 0u; mine = (j == x) ? c : mine; }
        if (sum == G) break;
        __builtin_amdgcn_s_sleep(1);
        if ((++sp & 255u) == 0u) { if (xb_ld(&bar[XB_TMO])) break; if (sp > XB_SPIN_CAP) { atomicAdd(&bar[XB_TMO], 1u); break; } }
    }
    nloc = mine > 0u ? mine : 1u; nx = cnt > 0u ? cnt : 1u;
}

__device__ __forceinline__ void xcd_barrier(const XcdBarrier& b, bool is_t0) {
    asm volatile("s_waitcnt vmcnt(0)" ::: "memory");
    __syncthreads();
    if (is_t0) {
        unsigned* bar = b.bar;
        __builtin_amdgcn_s_waitcnt(0);
        unsigned nloc = b.st[0], nx = b.st[1];
        if (nloc == 0u) { xcd_barrier_complete(bar, b.x, nloc, nx); b.st[0] = nloc; b.st[1] = nx; }
        const unsigned old = xb_add(&bar[XB_XSUB(b.x)], 1u);
        const unsigned gen = old / nloc;
        if (old + 1u == (gen + 1u) * nloc) {
            __builtin_amdgcn_fence(__ATOMIC_RELEASE, "agent");
            asm volatile("s_waitcnt vmcnt(0)" ::: "memory");
            const unsigned og = xb_add(&bar[XB_TOP], 1u);
            const unsigned tg = og / nx;
            if (og + 1u == (tg + 1u) * nx) xb_add(&bar[XB_TOPGEN], 1u);
            else XB_SPIN(xb_ld(&bar[XB_TOPGEN]) == tg, bar);
            __builtin_amdgcn_fence(__ATOMIC_ACQUIRE, "agent");
            xb_add(&bar[XB_XGEN(b.x)], 1u);
            asm volatile("s_waitcnt vmcnt(0)" ::: "memory");
        } else {
            XB_SPIN(xb_ld(&bar[XB_XGEN(b.x)]) == gen, bar);
            __builtin_amdgcn_fence(__ATOMIC_ACQUIRE, "agent");
            asm volatile("s_waitcnt vmcnt(0)" ::: "memory");
        }
    }
    __syncthreads();
}

constexpr size_t WS_CTL = E_WEND * 2, CTL_BAR_BYTES = 16384, CTL_BYTES = CTL_BAR_BYTES + 16 * 2048 * 4;
constexpr size_t WS_XB0 = WS_BIG + 176 * MiB, WS_XB1 = WS_LOGF;
constexpr int LDS_BARST = LDS_BYTES - 64;

constexpr size_t WS_T0U = WS_CTL + 147456, WS_T0Y = WS_T0U + (size_t)8 * 2 * FF * 4, WS_T0Q = WS_T0Y + (size_t)8 * D * 4, WS_T0END = WS_T0Q + (size_t)8 * 2 * D * 4;
static_assert(WS_T0U % 256 == 0 && WS_T0END <= WS_P, "token-0 scratch fits below the p copy");
#define WG_BAR() do { LDS_WAIT(); __builtin_amdgcn_s_barrier(); asm volatile("" ::: "memory"); } while (0)
template <int NC, int K, int KS>
__device__ __forceinline__ void t0_gemv(const LAS float* in, LAS float* red, const float* W, int ldw, int N, float* out, int ldo, int bx, int G, int tid) {
    static_assert(NC * KS == 512 && K % KS == 0, "t0_gemv geometry");
    constexpr int KL = K / KS;
    const int col = tid % NC, ks = tid / NC;
    for (int c0 = bx * NC; c0 < N; c0 += G * NC) {
        float acc[8], wv[KL];
        const float* wp = W + (size_t)(ks * KL) * ldw + c0 + col; const LAS float* ip = in + ks * KL;
#pragma unroll
        for (int k = 0; k < KL; ++k) wv[k] = __builtin_nontemporal_load(wp + (size_t)k * ldw);
        constexpr int VEC = (KL % 4 == 0) ? 4 : 2;
        typedef float fvec_t __attribute__((ext_vector_type(VEC)));
#pragma unroll
        for (int r = 0; r < 8; ++r) { float s = 0.f;
#pragma unroll
            for (int k = 0; k < KL; k += VEC) { const fvec_t a = *(const LAS fvec_t*)(ip + r * K + k);
#pragma unroll
                for (int e = 0; e < VEC; ++e) s += a[e] * wv[k + e]; }
            acc[r] = s; }
#pragma unroll
        for (int r = 0; r < 8; ++r) red[(ks * 8 + r) * NC + col] = acc[r];
        WG_BAR();
        if (tid < 8 * NC) { const int r = tid / NC, c = tid % NC; float s = 0.f; for (int q = 0; q < KS; ++q) s += red[(q * 8 + r) * NC + c]; out[(size_t)r * ldo + c0 + c] = s; }
        WG_BAR();
    }
}
__device__ __forceinline__ void t0_stage_a(LAS unsigned char* lds, const float* x, const float* g1, const float* W, float* U, int bx, int G, int tid) {
    LAS float* a = (LAS float*)lds; LAS float* red = (LAS float*)(lds + 8 * D * 4);
    const int lane = tid & 63, w = tid >> 6;
    WG_BAR();
    { const f32x4* xr = (const f32x4*)(x + (size_t)w * SEQ * D) + lane; f32x4 v[4]; float s = 0.f;
#pragma unroll
      for (int j = 0; j < 4; ++j) { v[j] = xr[64 * j]; s += (v[j].x * v[j].x + v[j].y * v[j].y) + (v[j].z * v[j].z + v[j].w * v[j].w); }
      const float r = 1.0f / sqrtf(wave_sum(s) * (1.f / D) + EPS);
#pragma unroll
      for (int j = 0; j < 4; ++j) { const f32x4 g = *((const f32x4*)g1 + lane + 64 * j); *(LAS f32x4*)(a + w * D + 4 * (lane + 64 * j)) = v[j] * r * g; } }
    WG_BAR();
    t0_gemv<32, D, 16>(a, red, W, 2 * FF, 2 * FF, U, 2 * FF, bx, G, tid);
}
__device__ __forceinline__ void t0_stage_b(LAS unsigned char* lds, const float* U, const float* W, float* Y, int bx, int G, int tid) {
    LAS float* act = (LAS float*)lds; LAS float* red = (LAS float*)(lds + 8 * FF * 4);
    WG_BAR();
    for (int i = tid; i < 8 * FF; i += 512) { const int r = i / FF, j = i % FF; const float g = U[(size_t)r * 2 * FF + j], u = U[(size_t)r * 2 * FF + FF + j]; act[i] = g / (1.0f + __expf(-g)) * u; }
    WG_BAR();
    t0_gemv<4, FF, 128>(act, red, W, D, D, Y, D, bx, G, tid);
}
__device__ __forceinline__ void t0_stage_c(LAS unsigned char* lds, const float* x, const float* Y, const float* gpost, const float* gmix, const float* W, float* QZ, int bx, int G, int tid) {
    LAS float* xn = (LAS float*)lds; LAS float* red = (LAS float*)(lds + 8 * D * 4);
    const int lane = tid & 63, w = tid >> 6;
    WG_BAR();
    { const f32x4* xr = (const f32x4*)(x + (size_t)w * SEQ * D) + lane; const f32x4* yr = (const f32x4*)(Y + (size_t)w * D) + lane; f32x4 v[4], y[4]; float s = 0.f;
#pragma unroll
      for (int j = 0; j < 4; ++j) { v[j] = xr[64 * j]; y[j] = yr[64 * j]; s += (y[j].x * y[j].x + y[j].y * y[j].y) + (y[j].z * y[j].z + y[j].w * y[j].w); }
      const float r1 = 0.5f / sqrtf(wave_sum(s) * (1.f / D) + EPS); float s2 = 0.f;
#pragma unroll
      for (int j = 0; j < 4; ++j) { const f32x4 g = *((const f32x4*)gpost + lane + 64 * j); v[j] = v[j] + y[j] * r1 * g; s2 += (v[j].x * v[j].x + v[j].y * v[j].y) + (v[j].z * v[j].z + v[j].w * v[j].w); }
      const float r2 = 1.0f / sqrtf(wave_sum(s2) * (1.f / D) + EPS);
#pragma unroll
      for (int j = 0; j < 4; ++j) { const f32x4 g = *((const f32x4*)gmix + lane + 64 * j); *(LAS f32x4*)(xn + w * D + 4 * (lane + 64 * j)) = v[j] * r2 * g; } }
    WG_BAR();
    t0_gemv<8, D, 64>(xn, red, W, 4 * D, 2 * D, QZ, 2 * D, bx, G, tid);
}

struct Args { const float* in[25]; float* out; unsigned char* ws; int st_lo, st_hi; };
enum { ST_PRO, ST_F1I0, ST_F1O0, ST_RW00, ST_HIN, ST_HS1, ST_HS2, ST_HOUT, ST_RW01, ST_F2I0, ST_F2O0, ST_PP0, ST_RW02, ST_PG0, ST_RW03, ST_KVF, ST_F1I1, ST_CUM, ST_F1O1, ST_RW10, ST_QG, ST_ATT, ST_FOUT, ST_RW11, ST_F2I1, ST_F2O1, ST_PP1, ST_RW12, ST_PG1, ST_RW13, NSTEP };
#ifndef FUSE_MASK
#define FUSE_MASK 0x00
#endif
#define FUSED(b) (((FUSE_MASK) >> (b)) & 1)
__host__ __device__ constexpr bool sync_before(int s) { return !(s == ST_PRO || s == ST_PP0 || s == ST_F1I1 || s == ST_F1O1 || s == ST_PP1); }
enum { K_PRO = 0, K_FFN_IN, K_FFN_OUT, K_RW, K_HGRN_IN, K_HGRN, K_HGRN_OUT, K_PLE_PROJ, K_PLE_GATE, K_KVF, K_CUMSUM, K_QG, K_ATTN, K_FOX_OUT };

__global__ void __launch_bounds__(NWAVES * 64, 2) yoco_fwd(Args args) {
    extern __shared__ __attribute__((aligned(16))) unsigned char lds[];
    cg::grid_group grid = cg::this_grid();
    LAS unsigned char* ldsp = (LAS unsigned char*)lds;
    const int st_lo = args.st_lo, st_hi = args.st_hi;
    const int wave_s = __builtin_amdgcn_readfirstlane((int)(threadIdx.x >> 6));
    if (tid_from(wave_s) < 2) ((volatile LAS unsigned*)(ldsp + LDS_BARST))[tid_from(wave_s)] = 0u;
    __syncthreads();
    (void)xcd_barrier_post((unsigned*)(args.ws + WS_CTL), (volatile LAS unsigned*)(ldsp + LDS_BARST), tid_from(wave_s) == 0);
#define STEP_BEGIN(k) if (st_lo <= (k) && (k) < st_hi) { if ((k) > st_lo && sync_before(k)) { if (st_hi < 0) { asm volatile("s_waitcnt vmcnt(0) lgkmcnt(0)" ::: "memory"); grid.sync(); __builtin_amdgcn_fence(__ATOMIC_ACQUIRE, "agent"); asm volatile("s_waitcnt vmcnt(0)" ::: "memory"); }     \
          else { XcdBarrier xb_; xb_.bar = (unsigned*)(((const __attribute__((address_space(4))) Args*)__builtin_amdgcn_kernarg_segment_ptr())->ws + WS_CTL); xb_.x = xb_xcc_id(); xb_.st = (volatile LAS unsigned*)(ldsp + LDS_BARST); xcd_barrier(xb_, tid_from(wave_s) == 0); } } \
        const __attribute__((address_space(4))) Args* ap = (const __attribute__((address_space(4))) Args*)__builtin_amdgcn_kernarg_segment_ptr(); asm volatile("" : "+s"(ap)); \
        int tid_k = tid_from(wave_s); asm volatile("" : "+v"(tid_k)); const int tid = tid_k, lane = tid & 63, wave = __builtin_amdgcn_readfirstlane(tid >> 6); \
        const int G = gridDim.x, bx = blockIdx.x; unsigned char* ws = ap->ws; bfu* Wb = (bfu*)ws; bfu* PB = (bfu*)(ws + WS_P); float* LOGF = (float*)(ws + WS_LOGF); float* CL = (float*)(ws + WS_C); \
        bfu* AY = (bfu*)(ws + WS_AY); bfu* BIG = (bfu*)(ws + WS_BIG); bfu* PROJ = (bfu*)(ws + WS_PROJ); const int gw = bx * NWAVES + wave, ngw = G * NWAVES; \
        (void)tid; (void)lane; (void)Wb; (void)PB; (void)LOGF; (void)CL; (void)AY; (void)BIG; (void)PROJ; (void)gw; (void)ngw;
#define STEP_END }
#define RUN_GEMM(MODE, A_, LDA_, Bt_, N_, K_, O_, LDC_, O2_, AUX_, SC_) RUN_GEMM_ON(G, bx, MODE, A_, LDA_, Bt_, N_, K_, O_, LDC_, O2_, AUX_, SC_)
#define RUN_GEMM_ON(GS_, CS_, MODE, A_, LDA_, Bt_, N_, K_, O_, LDC_, O2_, AUX_, SC_) do { const pg8::Gemm g{A_, Bt_, T, N_, K_, LDA_}; pg8::StaticOrder S; S.init(T, N_, GS_, CS_); \
        const pg8::Epi<MODE, LDC_> E{O_, O2_, AUX_, LOGF, ap->in[18], SC_}; pg8::gemm_phase<pg8::Epi<MODE, LDC_>, pg8::StaticOrder, true, true, K_, LDA_>(ldsp, g, S, E, wave_s); } while (0)
#define NOB ((bfu*)nullptr)
#define S_FFN_IN(k, L, w)  STEP_BEGIN(k) if ((L) == 0 && (w) == 1) t0_stage_b(ldsp, (const float*)(ws + WS_T0U), ap->in[4], (float*)(ws + WS_T0Y), bx, G, tid); RUN_GEMM(pg8::EP_SWIGLU, AY, D, Wb + ((w) == 1 ? E_W1IN : E_W2IN) + (L) * N_WIN, 2 * FF, D, BIG, FF, NOB, NOB, 1.f); STEP_END
#define RUN_FUSED(PRE, WA, A_, LDA_, Bt_, K_, HIN_, AUX_, GAIN_, SCALE_, BANK_, XB_) do { \
        if (G != 256) { const float qn_ = __builtin_nanf(""); for (int m_ = gw; m_ < T; m_ += ngw) { f32x4* o_ = (f32x4*)(ap->out + (size_t)m_ * D) + lane; for (int j_ = 0; j_ < 4; ++j_) o_[64 * j_] = (f32x4){qn_, qn_, qn_, qn_}; } } \
        else { const pg8::Gemm g{A_, Bt_, T, D, K_, LDA_}; unsigned* cw_ = (unsigned*)(ws + WS_CTL + CTL_BAR_BYTES); \
            unsigned* xb_ = (unsigned*)((XB_) + (size_t)(BANK_) * MiB);     \
            const pg8::PanelSS s1_{xb_, cw_ + ((BANK_) * 2 + 0) * 2048, EPS}, s2_{xb_ + (size_t)T * 4, cw_ + ((BANK_) * 2 + 1) * 2048, EPS}; \
            const pg8::EpiRmsRes<PRE, WA> E{HIN_, ap->out, AY, AUX_, GAIN_, SCALE_, s1_, s2_}; \
            for (int p_ = 0; p_ < 2; ++p_) { const pg8::HalfOrder S{p_, bx}; pg8::gemm_phase<pg8::EpiRmsRes<PRE, WA>, pg8::HalfOrder, false, true, K_, LDA_>(ldsp, g, S, E, wave_s); } } } while (0)
#define S_FFN_OUT(k, L, w) STEP_BEGIN(k) if (FUSED((L) * 4 + ((w) == 1 ? 0 : 2))) RUN_FUSED(0, true, BIG, FF, Wb + ((w) == 1 ? E_W1OUT : E_W2OUT) + (L) * N_WOUT, FF, (((L) == 0 && (w) == 1) ? ap->in[0] : (const float*)ap->out), NOB, \
        ((w) == 1 ? ap->in[5] : ap->in[11]) + (L) * D, 0.5f, (L) * 4 + ((w) == 1 ? 0 : 2), ws + WS_XB0); \
        else RUN_GEMM(pg8::EP_PLAIN, BIG, FF, Wb + ((w) == 1 ? E_W1OUT : E_W2OUT) + (L) * N_WOUT, D, FF, AY, D, NOB, NOB, 1.f); STEP_END
#define S_PLE_PROJ(k, L)   STEP_BEGIN(k) RUN_GEMM(pg8::EP_PLAIN, PB + (size_t)(L) * T * PLE, PLE, Wb + E_WPP + (size_t)(L) * PLE * D, D, PLE, PROJ, D, NOB, NOB, 1.f); STEP_END
#define S_PLE_GATE(k, L)   STEP_BEGIN(k) if (FUSED((L) * 4 + 3)) RUN_FUSED(1, ((L) == 0), AY, D, Wb + E_WPG + (size_t)(L) * D * D, D, (const float*)ap->out, PROJ, ap->in[24] + (L) * D, 1.0f, (L) * 4 + 3, ws + WS_XB0); \
        else RUN_GEMM(pg8::EP_PLEGATE, AY, D, Wb + E_WPG + (size_t)(L) * D * D, D, D, BIG, D, NOB, PROJ, 1.f); STEP_END
#define S_RW(k, L, w, b)   STEP_BEGIN(k) if (!FUSED(b)) { const float* hin = ((L) == 0 && (w) == 0) ? ap->in[0] : ap->out; const bfu* Y = ((w) == 3) ? BIG : AY; \
        const float* gain = ((w) == 0 ? ap->in[5] : (w) == 1 ? ap->in[7] : (w) == 2 ? ap->in[11] : ap->in[24]) + (L) * D; \
        rw_phase<!((L) == 1 && (w) == 3)>(hin, ap->out, Y, AY, gain, ((w) == 0 || (w) == 2) ? 0.5f : 1.0f, gw, ngw, lane); } STEP_END

    STEP_BEGIN(ST_PRO) {
        LAS float* scr = (LAS float*)(ldsp + wave * 16384);
        for (int it = gw;; it += ngw) {
            int r = it;
#define CONV(src, K_, N_, dst, gain, gmask, sw) { constexpr int NI = ((K_) / 64) * (((N_) + 31) / 32); if (r < NI) { conv_item(src, K_, N_, dst, gain, gmask, sw, scr, r, lane); continue; } r -= NI; }
            CONV(ap->in[3], D, 2 * FF, Wb + E_W1IN, ap->in[2], 1023, 1)
            CONV(ap->in[3] + N_WIN, D, 2 * FF, Wb + E_W1IN + N_WIN, ap->in[2] + D, 1023, 1)
            CONV(ap->in[9], D, 2 * FF, Wb + E_W2IN, ap->in[8], 1023, 1)
            CONV(ap->in[9] + N_WIN, D, 2 * FF, Wb + E_W2IN + N_WIN, ap->in[8] + D, 1023, 1)
            CONV(ap->in[4], FF, D, Wb + E_W1OUT, (const float*)nullptr, 0, 0)
            CONV(ap->in[4] + N_WOUT, FF, D, Wb + E_W1OUT + N_WOUT, (const float*)nullptr, 0, 0)
            CONV(ap->in[10], FF, D, Wb + E_W2OUT, (const float*)nullptr, 0, 0)
            CONV(ap->in[10] + N_WOUT, FF, D, Wb + E_W2OUT + N_WOUT, (const float*)nullptr, 0, 0)
            CONV(ap->in[12], D, 4 * D, Wb + E_WHIN, ap->in[6], 1023, 0)
            CONV(ap->in[15], D, D, Wb + E_WHOUT, ap->in[14], 127, 0)
            CONV(ap->in[17], D, NKVF, Wb + E_WKVF, ap->in[16], 1023, 0)
            CONV(ap->in[19], D, 2 * D, Wb + E_WQG, ap->in[6] + D, 1023, 0)
            CONV(ap->in[20], D, D, Wb + E_WFO, (const float*)nullptr, 0, 0)
            CONV(ap->in[22], D, D, Wb + E_WPG, ap->in[21], 1023, 0)
            CONV(ap->in[22] + (size_t)D * D, D, D, Wb + E_WPG + (size_t)D * D, ap->in[21] + D, 1023, 0)
            CONV(ap->in[23], PLE, D, Wb + E_WPP, (const float*)nullptr, 0, 0)
            CONV(ap->in[23] + (size_t)PLE * D, PLE, D, Wb + E_WPP + (size_t)PLE * D, (const float*)nullptr, 0, 0)
#undef CONV
            break;
        }
        {   const float* p = ap->in[1]; const size_t n8 = (size_t)2 * T * PLE / 8;
            for (size_t i = (size_t)bx * 512 + tid; i < n8; i += (size_t)G * 512) { const f32x4 a = __builtin_nontemporal_load((const f32x4*)p + 2 * i), c = __builtin_nontemporal_load((const f32x4*)p + 2 * i + 1);
                __builtin_nontemporal_store((v4u){pk2(a.x, a.y), pk2(a.z, a.w), pk2(c.x, c.y), pk2(c.z, c.w)}, (v4u*)PB + i); } }
        const float* x = ap->in[0];
        for (int m = gw; m < T; m += 2 * ngw) { rms_row_to_bf16(x + (size_t)m * D, AY + (size_t)m * D, lane); if (m + ngw < T) rms_row_to_bf16(x + (size_t)(m + ngw) * D, AY + (size_t)(m + ngw) * D, lane); }
        t0_stage_a(ldsp, x, ap->in[2], ap->in[3], (float*)(ws + WS_T0U), bx, G, tid);
    } STEP_END
    S_FFN_IN(ST_F1I0, 0, 1) S_FFN_OUT(ST_F1O0, 0, 1) S_RW(ST_RW00, 0, 0, 0)
    STEP_BEGIN(ST_HIN) RUN_GEMM(pg8::EP_PLAIN, AY, D, Wb + E_WHIN, 4 * D, D, BIG, 4 * D, NOB, NOB, 1.f); STEP_END
    STEP_BEGIN(ST_HS1) { const float* lbl = ap->in[13]; float* Eb = (float*)AY; float* Lb = (float*)(ws + WS_AY + 32 * MiB);
        for (int it = bx; it < BATCH * 8 * HSEG; it += G) if ((it & 3) != 3) hgrn_scan<false>(ldsp, BIG, lbl, it >> 2, it & 3, Eb, Lb, wave_s);
        const bool side = (G >= 256) ? ((bx & 3) == 3 && bx < 256) : true; const int gs = (G >= 256) ? 64 : G, cs = (G >= 256) ? (bx >> 2) : bx;
        if (side) t0_stage_c(ldsp, ap->in[0], (const float*)(ws + WS_T0Y), ap->in[5], ap->in[6], ap->in[12], (float*)(ws + WS_T0Q), cs, gs, tid); } STEP_END
    STEP_BEGIN(ST_HS2) { const float* lbl = ap->in[13]; float* Eb = (float*)AY; float* Lb = (float*)(ws + WS_AY + 32 * MiB);
        for (int it = bx; it < BATCH * 8 * HSEG; it += G) hgrn_scan<true>(ldsp, BIG, lbl, it >> 2, it & 3, Eb, Lb, wave_s, (const float*)(ws + WS_T0Q)); } STEP_END
    STEP_BEGIN(ST_HOUT) if (FUSED(1)) RUN_FUSED(0, true, BIG, 4 * D, Wb + E_WHOUT, D, (const float*)ap->out, NOB, ap->in[7], 1.0f, 1, ws + WS_XB1);
        else RUN_GEMM(pg8::EP_PLAIN, BIG, 4 * D, Wb + E_WHOUT, D, D, AY, D, NOB, NOB, 1.f); STEP_END
    S_RW(ST_RW01, 0, 1, 1) S_FFN_IN(ST_F2I0, 0, 2) S_FFN_OUT(ST_F2O0, 0, 2) S_PLE_PROJ(ST_PP0, 0) S_RW(ST_RW02, 0, 2, 2) S_PLE_GATE(ST_PG0, 0) S_RW(ST_RW03, 0, 3, 3)
    STEP_BEGIN(ST_KVF) RUN_GEMM(pg8::EP_KVF, AY, D, Wb + E_WKVF, NKVFP, D, (bfu*)(ws + WS_K), D, (bfu*)(ws + WS_V), NOB, 1.f); STEP_END
    S_FFN_IN(ST_F1I1, 1, 1)
    STEP_BEGIN(ST_CUM) { for (int bh = bx; bh < BATCH * 16; bh += G) cumsum_bh(ldsp, LOGF, CL, bh, wave_s); } STEP_END
    S_FFN_OUT(ST_F1O1, 1, 1) S_RW(ST_RW10, 1, 0, 4)
    STEP_BEGIN(ST_QG) RUN_GEMM(pg8::EP_QG, AY, D, Wb + E_WQG, 2 * D, D, (bfu*)(ws + WS_Q), D, (bfu*)(ws + WS_G), NOB, attn_body::C2); STEP_END
    STEP_BEGIN(ST_ATT) {
        const attn_body::AttnTensors AT{(const attn_body::bf16*)(ws + WS_Q), (const attn_body::bf16*)(ws + WS_K), (const attn_body::bf16*)(ws + WS_V), (attn_body::bf16*)(ws + WS_Q), (const attn_body::bf16*)(ws + WS_G), CL};
        const attn_body::StaticOrder S(G, bx);
        attn_body::attn_phase<attn_body::StaticOrder>((char*)lds, AT, S, wave_s);
    } STEP_END
    STEP_BEGIN(ST_FOUT) if (FUSED(5)) RUN_FUSED(0, true, (const bfu*)(ws + WS_Q), D, Wb + E_WFO, D, (const float*)ap->out, NOB, ap->in[7] + D, 1.0f, 5, ws + WS_XB0);
        else RUN_GEMM(pg8::EP_PLAIN, (const bfu*)(ws + WS_Q), D, Wb + E_WFO, D, D, AY, D, NOB, NOB, 1.f); STEP_END
    S_RW(ST_RW11, 1, 1, 5) S_FFN_IN(ST_F2I1, 1, 2) S_FFN_OUT(ST_F2O1, 1, 2) S_PLE_PROJ(ST_PP1, 1) S_RW(ST_RW12, 1, 2, 6) S_PLE_GATE(ST_PG1, 1) S_RW(ST_RW13, 1, 3, 7)
}

#ifndef MK_MULTI
#define MK_MULTI 0
#endif
extern "C" void kernel_launch(void* const* d_in, const int* in_sizes, int n_in, void* d_out, int out_size, void* d_ws, size_t ws_size, hipStream_t stream) {
    static int grid = 0;
    if (grid == 0) {
        if (n_in != 25 || out_size != T * D || ws_size < WS_END) { fprintf(stderr, "kernel_launch: unexpected shapes (n_in %d out %d ws %zu)\n", n_in, out_size, ws_size); grid = -1; return; }
        int dev = 0, cus = 0, per_cu = 0;
        (void)hipGetDevice(&dev); (void)hipDeviceGetAttribute(&cus, hipDeviceAttributeMultiprocessorCount, dev);
        if (hipFuncSetAttribute((const void*)yoco_fwd, hipFuncAttributeMaxDynamicSharedMemorySize, LDS_BYTES) != hipSuccess) { fprintf(stderr, "kernel_launch: hipFuncSetAttribute failed\n"); grid = -1; return; }
        if (hipOccupancyMaxActiveBlocksPerMultiprocessor(&per_cu, (const void*)yoco_fwd, NWAVES * 64, LDS_BYTES) != hipSuccess || per_cu < 1) per_cu = 1;
        (void)hipGetLastError();
        if (cus <= 0) cus = 256;
        grid = cus * per_cu;
    }
    if (grid < 0) return;
    if (hipMemsetAsync((char*)d_ws + WS_CTL, 0, CTL_BYTES, stream) != hipSuccess) { fprintf(stderr, "kernel_launch: memset failed\n"); return; }
    Args a{};
    for (int i = 0; i < 25; ++i) a.in[i] = (const float*)d_in[i];
    a.out = (float*)d_out; a.ws = (unsigned char*)d_ws;
#ifndef ST_CUT
#define ST_CUT NSTEP
    a.st_lo = 0; a.st_hi = ST_CUT;
    void* kargs[] = {&a};
    const hipError_t e = hipLaunchCooperativeKernel((const void*)yoco_fwd, dim3(grid), dim3(NWAVES * 64), kargs, LDS_BYTES, stream);
    if (e != hipSuccess) fprintf(stderr, "kernel_launch: cooperative launch failed: %s (grid %d)\n", hipGetErrorString(e), grid);
#endif
}
```

```cpp
#include <hip/hip_runtime.h>
#include <hip/hip_cooperative_groups.h>
#include <hip/hip_bf16.h>
#include <cstdio>
#include <cstdint>
#include <cmath>
namespace cg = cooperative_groups;
__device__ __forceinline__ int tid_from(int wave_s) { unsigned l; asm volatile("v_mbcnt_lo_u32_b32 %0, -1, 0\n\tv_mbcnt_hi_u32_b32 %0, -1, %0" : "=v"(l)); return wave_s * 64 + (int)l; }
namespace pg8 {
#define PG8_LAS __attribute__((address_space(3)))
typedef unsigned short bf16_t;
typedef short bf16x8 __attribute__((ext_vector_type(8)));
typedef float f32x4 __attribute__((ext_vector_type(4)));
typedef unsigned u32x4 __attribute__((ext_vector_type(4)));
constexpr int BM = 256, BK = 64, HALF = 128, HTB = HALF * BK * 2  , STAGE_BYTES = 8 * HTB, NXCD = 8, WGM = 8;

__host__ __device__ __forceinline__ int lds_byte(int r, int c) { const int st = (r >> 4) * 2 + (c >> 5), rr = r & 15, cc = c & 31, ob = rr * 64 + cc * 2; return st * 1024 + (ob ^ (((ob >> 9) & 1) << 5)); }
__host__ __device__ __forceinline__ void stage_rc(int b, int& R, int& C) { const int st = b / 1024, sb = b % 1024, swz = sb ^ (((sb >> 9) & 1) << 5); R = (st >> 1) * 16 + swz / 64; C = (st & 1) * 32 + (swz % 64) / 2; }
__host__ __device__ __forceinline__ int perm32(int rho) { const int n = rho >> 4, i = rho & 15; return 8 * (i >> 2) + 4 * n + (i & 3); }

struct Unit { int pm, pn; };
struct Gemm { const bf16_t* A; const bf16_t* Bt; int M, N, K, lda; };

struct StaticOrder {
    int nM, nN, nwg, G, c;
    __host__ __device__ void init(int M, int N, int G_, int c_) { nM = M / BM; nN = N / BM; nwg = nM * nN; G = G_; c = c_; }
    __host__ __device__ bool next(int i, Unit& u) const {
        const long L = (long)i * G + c; if (L >= nwg) return false;
        int wgid = (int)L; { const int q = nwg / NXCD, r = nwg % NXCD, xcd = wgid % NXCD, off = wgid / NXCD; wgid = (xcd < r ? xcd * (q + 1) : r * (q + 1) + (xcd - r) * q) + off; }
        const int nig = WGM * nN, gid = wgid / nig, fm = gid * WGM, gsz = (nM - fm) < WGM ? (nM - fm) : WGM;
        u.pm = fm + ((wgid % nig) % gsz); u.pn = (wgid % nig) / gsz; return true;
    }
    __device__ __forceinline__ void a_ready(const Unit&) const {}
    __device__ __forceinline__ void done(const Unit&) const {}
};

typedef float f32x2cv __attribute__((ext_vector_type(2))); typedef __bf16 bf16x2cv __attribute__((ext_vector_type(2)));
__device__ __forceinline__ unsigned cvt_pk_bf16_asm(float lo, float hi) { unsigned r; asm volatile("v_cvt_pk_bf16_f32 %0, %1, %2" : "=v"(r) : "v"(lo), "v"(hi)); return r; }
__device__ __forceinline__ unsigned cvt_pk_bf16(float lo, float hi) { const f32x2cv v = {lo, hi}; const bf16x2cv b = __builtin_convertvector(v, bf16x2cv); return __builtin_bit_cast(unsigned, b); }
enum { EP_PLAIN = 0, EP_SWIGLU = 1, EP_KVF = 2, EP_QG = 3, EP_PLEGATE = 4 };
__device__ __forceinline__ float fsigmoid(float x) { return __builtin_amdgcn_rcpf(1.0f + __builtin_amdgcn_exp2f(-1.4426950408889634f * x)); }
__device__ __forceinline__ float bflo(unsigned w) { return __uint_as_float(w << 16); }
__device__ __forceinline__ float bfhi(unsigned w) { return __uint_as_float(w & 0xffff0000u); }
template <int MODE, int LDC> struct Epi {
    static constexpr bool PERM = true, AFTER_DRAIN = false;
    bf16_t* O; bf16_t* O2; const bf16_t* aux; float* lf; const float* bfp; float scale0; static constexpr int ldc = LDC;
    __device__ __forceinline__ void operator()(const f32x4 (&acc)[2][2][4][2], const Unit& u, int wr, int wc, int fr, int fq) const {
        asm volatile("s_nop 15\n\ts_nop 15" ::: "memory");
        const int row0 = u.pm * BM + wr * 64 + fr;
        if constexpr (MODE == EP_SWIGLU) {
            const int col0 = u.pn * HALF + wc * 32 + 8 * fq;
#pragma unroll
            for (int ai = 0; ai < 2; ++ai)
#pragma unroll
                for (int m = 0; m < 4; ++m) { bf16_t* rowp = O + (size_t)(row0 + ai * HALF + m * 16) * ldc + col0;
                    const f32x4 g0 = acc[ai][0][m][0], g1 = acc[ai][0][m][1], u0 = acc[ai][1][m][0], u1 = acc[ai][1][m][1]; f32x4 v0, v1;
#pragma unroll
                    for (int j = 0; j < 4; ++j) { v0[j] = g0[j] * fsigmoid(g0[j]) * u0[j]; v1[j] = g1[j] * fsigmoid(g1[j]) * u1[j]; }
                    u32x4 w; w.x = cvt_pk_bf16_asm(v0[0], v0[1]); w.y = cvt_pk_bf16_asm(v0[2], v0[3]); w.z = cvt_pk_bf16_asm(v1[0], v1[1]); w.w = cvt_pk_bf16_asm(v1[2], v1[3]);
                    *(u32x4*)rowp = w; }
        } else {
            bf16_t* base = O; int colt = u.pn * BM; int kind = 0; float sc = 1.f;
            if constexpr (MODE == EP_KVF) { if (u.pn >= 8) kind = 2; else if (u.pn >= 4) { base = O2; colt -= 1024; } }
            if constexpr (MODE == EP_QG) { if (u.pn >= 4) { base = O2; colt -= 1024; kind = 1; } else sc = scale0; }
            if (MODE == EP_KVF && kind == 2) {
                if (wc == 0 && fq < 2) {
#pragma unroll
                    for (int ai = 0; ai < 2; ++ai)
#pragma unroll
                        for (int m = 0; m < 4; ++m) { float* lp = lf + (size_t)(row0 + ai * HALF + m * 16) * 16 + 8 * fq;
#pragma unroll
                            for (int n = 0; n < 2; ++n) { const f32x4 a = acc[ai][0][m][n]; f32x4 o;
#pragma unroll
                                for (int j = 0; j < 4; ++j) { const float x = a[j] + bfp[8 * fq + 4 * n + j]; o[j] = fminf(x, 0.f) - __logf(1.0f + __expf(-fabsf(x))); }
                                *(f32x4*)(lp + 4 * n) = o; } }
                }
                return;
            }
            const int col0 = colt + wc * 32 + 8 * fq;
#pragma unroll
            for (int ai = 0; ai < 2; ++ai)
#pragma unroll
                for (int m = 0; m < 4; ++m) { const size_t roff = (size_t)(row0 + ai * HALF + m * 16) * ldc + col0;
#pragma unroll
                    for (int bj = 0; bj < 2; ++bj) { f32x4 v0 = acc[ai][bj][m][0], v1 = acc[ai][bj][m][1];
                        if (MODE == EP_QG && kind == 1) {
#pragma unroll
                            for (int j = 0; j < 4; ++j) { v0[j] = fsigmoid(v0[j]); v1[j] = fsigmoid(v1[j]); } }
                        else if (MODE == EP_QG) { v0 = v0 * sc; v1 = v1 * sc; }
                        if constexpr (MODE == EP_PLEGATE) { const u32x4 pq = __builtin_nontemporal_load((const u32x4*)(aux + roff + bj * HALF));
                            v0[0] = fsigmoid(v0[0]) * bflo(pq.x); v0[1] = fsigmoid(v0[1]) * bfhi(pq.x); v0[2] = fsigmoid(v0[2]) * bflo(pq.y); v0[3] = fsigmoid(v0[3]) * bfhi(pq.y);
                            v1[0] = fsigmoid(v1[0]) * bflo(pq.z); v1[1] = fsigmoid(v1[1]) * bfhi(pq.z); v1[2] = fsigmoid(v1[2]) * bflo(pq.w); v1[3] = fsigmoid(v1[3]) * bfhi(pq.w); }
                        u32x4 w; w.x = cvt_pk_bf16_asm(v0[0], v0[1]); w.y = cvt_pk_bf16_asm(v0[2], v0[3]); w.z = cvt_pk_bf16_asm(v1[0], v1[1]); w.w = cvt_pk_bf16_asm(v1[2], v1[3]);
                        if (MODE == EP_PLAIN && LDC == 4096 && (u.pn < 4 || u.pn >= 12)) __builtin_nontemporal_store(w, (u32x4*)(base + roff + bj * HALF));
                        else *(u32x4*)(base + roff + bj * HALF) = w; } }
        }
    }
};

struct PanelSS {
    unsigned* xbuf;
    unsigned* cnt;
    float eps;
    __device__ __forceinline__ bool run(const f32x4 (&v)[2][2][4][2], const Unit& u, int wr, int wc, int fr, int fq, PG8_LAS unsigned char* lds, int wid, int lane) const {
        PG8_LAS float* P = (PG8_LAS float*)lds;
        PG8_LAS float* S = (PG8_LAS float*)(lds + 4096);
        PG8_LAS unsigned* flag = (PG8_LAS unsigned*)(lds + 4096 + 1024);
#pragma unroll
        for (int ai = 0; ai < 2; ++ai)
#pragma unroll
            for (int m = 0; m < 4; ++m) {
                float s = 0.f;
#pragma unroll
                for (int bj = 0; bj < 2; ++bj)
#pragma unroll
                    for (int n = 0; n < 2; ++n) { const f32x4 x = v[ai][bj][m][n]; s += (x[0] * x[0] + x[1] * x[1]) + (x[2] * x[2] + x[3] * x[3]); }
                s += __shfl_xor(s, 16); s += __shfl_xor(s, 32);
                if (fq == 0) P[(ai * HALF + wr * 64 + m * 16 + fr) * 4 + wc] = s;
            }
        asm volatile("s_waitcnt lgkmcnt(0)" ::: "memory"); __builtin_amdgcn_s_barrier(); asm volatile("" ::: "memory");
        const int row = wid * 32 + (lane & 31);
        if (lane < 32) {
            const float t = (P[row * 4 + 0] + P[row * 4 + 1]) + (P[row * 4 + 2] + P[row * 4 + 3]);
            __hip_atomic_store(xbuf + ((size_t)(u.pm * BM + row) * 4 + u.pn), __float_as_uint(t), __ATOMIC_RELAXED, __HIP_MEMORY_SCOPE_AGENT);
        }
        asm volatile("s_waitcnt vmcnt(0)" ::: "memory");
        if (lane == 0) __hip_atomic_fetch_add(cnt + 16 * u.pm, 1u, __ATOMIC_RELAXED, __HIP_MEMORY_SCOPE_AGENT);
        if (wid == 0) {
            bool dead = false; const unsigned long long t0 = __builtin_amdgcn_s_memrealtime();
            for (;;) {
                if ((unsigned)__builtin_amdgcn_readfirstlane(__hip_atomic_load(cnt + 16 * u.pm, __ATOMIC_RELAXED, __HIP_MEMORY_SCOPE_AGENT)) >= 32u) break;
                if (__builtin_amdgcn_s_memrealtime() - t0 > 20000000ull) { dead = true; break; }
                __builtin_amdgcn_s_sleep(2);
            }
            __builtin_amdgcn_fence(__ATOMIC_ACQUIRE, "agent");
            if (lane == 0) flag[0] = dead ? 1u : 0u;
        }
        asm volatile("s_waitcnt vmcnt(0) lgkmcnt(0)" ::: "memory"); __builtin_amdgcn_s_barrier(); asm volatile("" ::: "memory");
        const bool bad = flag[0] != 0u;
        if (lane < 32) {
            const unsigned* slot = xbuf + (size_t)(u.pm * BM + row) * 4; float q = 0.f;
#pragma unroll
            for (int t = 0; t < 4; ++t) q += __uint_as_float(__hip_atomic_load(slot + t, __ATOMIC_RELAXED, __HIP_MEMORY_SCOPE_AGENT));
            S[row] = __builtin_amdgcn_rsqf(q * (1.0f / 1024.0f) + eps);
        }
        asm volatile("s_waitcnt lgkmcnt(0)" ::: "memory"); __builtin_amdgcn_s_barrier(); asm volatile("" ::: "memory");
        return bad;
    }
};
template <int PRE, bool WRITE_A> struct EpiRmsRes {
    static constexpr bool PERM = false, AFTER_DRAIN = true;
    const float* base; float* out; bf16_t* xn; const bf16_t* aux; const float* gain; float scale; PanelSS st1, st2;
    __device__ __forceinline__ void fused(f32x4 (&acc)[2][2][4][2], const Unit& u, int wr, int wc, int fr, int fq, PG8_LAS unsigned char* lds, int wid, int lane) const {
        typedef unsigned u32x2v __attribute__((ext_vector_type(2)));
        const PG8_LAS float* S = (const PG8_LAS float*)(lds + 4096);
        const int col0 = u.pn * BM + wc * 32 + 4 * fq;
        if constexpr (PRE == 1) {
#pragma unroll
            for (int ai = 0; ai < 2; ++ai)
#pragma unroll
                for (int m = 0; m < 4; ++m) { const size_t off = (size_t)(u.pm * BM + ai * HALF + wr * 64 + m * 16 + fr) * 1024 + col0;
#pragma unroll
                    for (int bj = 0; bj < 2; ++bj)
#pragma unroll
                        for (int n = 0; n < 2; ++n) { const u32x2v pq = *(const u32x2v*)(aux + off + bj * HALF + n * 16); f32x4 a = acc[ai][bj][m][n];
                            a[0] = fsigmoid(a[0]) * bflo(pq.x); a[1] = fsigmoid(a[1]) * bfhi(pq.x); a[2] = fsigmoid(a[2]) * bflo(pq.y); a[3] = fsigmoid(a[3]) * bfhi(pq.y); acc[ai][bj][m][n] = a; }
                    if (m & 1) asm volatile("" ::: "memory"); }
        }
        bool bad = st1.run(acc, u, wr, wc, fr, fq, lds, wid, lane);
        const float qnan = __builtin_nanf("");
        f32x4 gv[2][2];
#pragma unroll
        for (int bj = 0; bj < 2; ++bj)
#pragma unroll
            for (int n = 0; n < 2; ++n) gv[bj][n] = *(const f32x4*)(gain + col0 + bj * HALF + n * 16) * scale;
#pragma unroll
        for (int ai = 0; ai < 2; ++ai)
#pragma unroll
            for (int m = 0; m < 4; ++m) { const int r = ai * HALF + wr * 64 + m * 16 + fr; const float sr = S[r]; const size_t off = (size_t)(u.pm * BM + r) * 1024 + col0;
#pragma unroll
                for (int bj = 0; bj < 2; ++bj)
#pragma unroll
                    for (int n = 0; n < 2; ++n) { const f32x4 bs = *(const f32x4*)(base + off + bj * HALF + n * 16); acc[ai][bj][m][n] = bs + acc[ai][bj][m][n] * sr * gv[bj][n]; }
                asm volatile("" : "+v"(acc[ai][0][m][0]), "+v"(acc[ai][0][m][1]), "+v"(acc[ai][1][m][0]), "+v"(acc[ai][1][m][1]));
                if (m & 1) asm volatile("" ::: "memory"); }
        if constexpr (WRITE_A) bad = st2.run(acc, u, wr, wc, fr, fq, lds, wid, lane) || bad;
#pragma unroll
        for (int ai = 0; ai < 2; ++ai)
#pragma unroll
            for (int m = 0; m < 4; ++m) { const int r = ai * HALF + wr * 64 + m * 16 + fr; const float sr = WRITE_A ? S[r] : 0.f; const size_t off = (size_t)(u.pm * BM + r) * 1024 + col0;
#pragma unroll
                for (int bj = 0; bj < 2; ++bj)
#pragma unroll
                    for (int n = 0; n < 2; ++n) { const f32x4 x1 = acc[ai][bj][m][n]; *(f32x4*)(out + off + bj * HALF + n * 16) = bad ? (f32x4){qnan, qnan, qnan, qnan} : x1;
                        if constexpr (WRITE_A) { const f32x4 o = x1 * sr; u32x2v w; w.x = cvt_pk_bf16(o[0], o[1]); w.y = cvt_pk_bf16(o[2], o[3]);
                            if (bad) { w.x = 0x7fc07fc0u; w.y = 0x7fc07fc0u; } *(u32x2v*)(xn + off + bj * HALF + n * 16) = w; } }
                asm volatile("" ::: "memory"); }
        asm volatile("s_waitcnt lgkmcnt(0)" ::: "memory"); __builtin_amdgcn_s_barrier(); asm volatile("" ::: "memory");
    }
};
struct HalfOrder {
    int p, c;
    __device__ __forceinline__ bool next(int i, Unit& u) const { if (i > 0) return false; const int x = c & 7, k = c >> 3; u.pn = k & 3; u.pm = 64 * p + 8 * (k >> 2) + x; return true; }
    __device__ __forceinline__ void a_ready(const Unit&) const {}
    __device__ __forceinline__ void done(const Unit&) const {}
};

template <class Epi, class Sched, bool ALIGN_EPI, bool SP2, int KC, int LDA>
__device__ __forceinline__ void gemm_phase(PG8_LAS unsigned char* lds, const Gemm g, const Sched& S, const Epi& E, int wave_s) {
    int tid_o = tid_from(wave_s); asm volatile("" : "+v"(tid_o)); const int tid = tid_o, wid = __builtin_amdgcn_readfirstlane(tid >> 6), lane = tid & 63, wr = wid >> 2, wc = wid & 3, fr = lane & 15, fq = lane >> 4;
    constexpr int K = KC, nt = K / BK;
    unsigned voffA[2], voffB[2];
#pragma unroll
    for (int i = 0; i < 2; ++i) { int R, C; stage_rc(tid * 16 + i * 8192, R, C); const int Rb = Epi::PERM ? ((R & ~31) + perm32(R & 31)) : R;
        voffA[i] = (unsigned)(R * LDA + C) * 2u; voffB[i] = (unsigned)(Rb * K + C) * 2u; }
    const size_t kstep = (size_t)(BK * 2);
    const size_t hstep = (size_t)HALF * K * 2;
    const size_t tstep = 2 * hstep; const size_t hstepA = (size_t)HALF * LDA * 2, tstepA = 2 * hstepA;
    const unsigned ldsw = (unsigned)wid * 1024u;
    const int aoff = lds_byte(wr * 64 + fr, fq * 8), boff = lds_byte(wc * 32 + fr, fq * 8);
#define PG8_SA(b, h) (((b) * 2 + (h)) * HTB)
#define PG8_SB(b, h) ((4 + (b) * 2 + (h)) * HTB)
#define PG8_STAGE(bufoff, gbase, voff) do { _Pragma("unroll") for (int _i = 0; _i < 2; ++_i) \
        __builtin_amdgcn_global_load_lds((const unsigned*)((const char*)(gbase) + (voff)[_i]), (PG8_LAS unsigned*)(lds + (bufoff) + ldsw + _i * 8192), 16, 0, 0); } while (0)
#define PG8_LDA(dst, b, h) do { _Pragma("unroll") for (int m = 0; m < 4; ++m) _Pragma("unroll") for (int k = 0; k < 2; ++k) dst[m][k] = *(const PG8_LAS bf16x8*)(lds + PG8_SA(b, h) + aoff + m * 2048 + k * 1024); } while (0)
#define PG8_LDB(dst, b, h) do { _Pragma("unroll") for (int n = 0; n < 2; ++n) _Pragma("unroll") for (int k = 0; k < 2; ++k) dst[n][k] = *(const PG8_LAS bf16x8*)(lds + PG8_SB(b, h) + boff + n * 2048 + k * 1024); } while (0)
#define PG8_MMA(ai, bj, At, Bt) do { __builtin_amdgcn_s_setprio(1); _Pragma("unroll") for (int m = 0; m < 4; ++m) _Pragma("unroll") for (int n = 0; n < 2; ++n) _Pragma("unroll") for (int k = 0; k < 2; ++k) \
        acc[ai][bj][m][n] = __builtin_amdgcn_mfma_f32_16x16x32_bf16(Bt[n][k], At[m][k], acc[ai][bj][m][n], 0, 0, 0); __builtin_amdgcn_s_setprio(0); } while (0)
#define PG8_WAIT_V(n) asm volatile("s_waitcnt vmcnt(" #n ")" ::: "memory")
#define PG8_WAIT_L(n) asm volatile("s_waitcnt lgkmcnt(" #n ")" ::: "memory")
#define PG8_BAR __builtin_amdgcn_s_barrier()
#define PG8_SCHED __builtin_amdgcn_sched_barrier(0)
    Unit cur, nxt; int ui = 0;
    if (!S.next(0, cur)) return;
    f32x4 acc[2][2][4][2];
#pragma unroll
    for (int a = 0; a < 2; ++a)
#pragma unroll
        for (int b = 0; b < 2; ++b)
#pragma unroll
            for (int m = 0; m < 4; ++m)
#pragma unroll
                for (int n = 0; n < 2; ++n) acc[a][b][m][n] = (f32x4){0.f, 0.f, 0.f, 0.f};
    bf16x8 At[4][2], B0[2][2], B1[2][2];
    const char* cA = (const char*)g.A + (size_t)cur.pm * tstepA; const char* cB = (const char*)g.Bt + (size_t)cur.pn * tstep;
    S.a_ready(cur);
    if constexpr (SP2) {
        PG8_STAGE(PG8_SB(0, 0), cB, voffB); PG8_STAGE(PG8_SB(0, 1), cB + hstep, voffB); PG8_STAGE(PG8_SA(0, 0), cA, voffA); PG8_STAGE(PG8_SA(0, 1), cA + hstepA, voffA);
        if (wr == 1) PG8_BAR;
        PG8_WAIT_V(2); PG8_BAR;
        PG8_STAGE(PG8_SB(1, 0), cB + kstep, voffB); PG8_STAGE(PG8_SA(1, 0), cA + kstep, voffA); PG8_STAGE(PG8_SB(1, 1), cB + hstep + kstep, voffB);
        PG8_WAIT_V(6); PG8_BAR;
    } else {
        PG8_STAGE(PG8_SB(0, 0), cB, voffB); PG8_STAGE(PG8_SA(0, 0), cA, voffA); PG8_STAGE(PG8_SB(0, 1), cB + hstep, voffB); PG8_STAGE(PG8_SA(0, 1), cA + hstepA, voffA);
        if (wr == 1) PG8_BAR;
        PG8_WAIT_V(4); PG8_BAR;
        PG8_STAGE(PG8_SB(1, 0), cB + kstep, voffB); PG8_STAGE(PG8_SA(1, 0), cA + kstep, voffA); PG8_STAGE(PG8_SB(1, 1), cB + hstep + kstep, voffB);
        PG8_WAIT_V(6); PG8_BAR;
    }
    for (;;) {
        const bool has_next = S.next(ui + 1, nxt);
        const char* nA = has_next ? (const char*)g.A + (size_t)nxt.pm * tstepA : cA; const char* nB = has_next ? (const char*)g.Bt + (size_t)nxt.pn * tstep : cB;
        for (int t = 0; t < nt; t += 2) {
            const bool last = (t == nt - 2);
            const char* a1 = cA + (size_t)(t + 1) * kstep;
            const char* a2 = last ? nA : cA + (size_t)(t + 2) * kstep; const char* b2 = last ? nB : cB + (size_t)(t + 2) * kstep;
            const char* a3 = a2 + kstep; const char* b3 = b2 + kstep;
            if (last && has_next) S.a_ready(nxt);
            if constexpr (SP2) {
            PG8_LDB(B0, 0, 0); PG8_LDB(B1, 0, 1); PG8_SCHED; PG8_LDA(At, 0, 0); PG8_STAGE(PG8_SA(1, 1), a1 + hstepA, voffA);
            PG8_WAIT_V(8); PG8_WAIT_L(0); PG8_BAR; PG8_MMA(0, 0, At, B0); PG8_MMA(0, 1, At, B1); PG8_BAR; PG8_SCHED;
            PG8_LDA(At, 0, 1); PG8_STAGE(PG8_SB(0, 0), b2, voffB); PG8_STAGE(PG8_SB(0, 1), b2 + hstep, voffB); PG8_STAGE(PG8_SA(0, 0), a2, voffA);
            PG8_WAIT_V(8); PG8_WAIT_L(0); PG8_BAR; PG8_MMA(1, 0, At, B0); PG8_MMA(1, 1, At, B1); PG8_BAR; PG8_SCHED;
            PG8_LDB(B0, 1, 0); PG8_LDB(B1, 1, 1); PG8_SCHED; PG8_LDA(At, 1, 0); PG8_STAGE(PG8_SA(0, 1), a2 + hstepA, voffA);
            PG8_WAIT_V(8); PG8_WAIT_L(0); PG8_BAR; PG8_MMA(0, 0, At, B0); PG8_MMA(0, 1, At, B1); PG8_BAR; PG8_SCHED;
            PG8_LDA(At, 1, 1); PG8_STAGE(PG8_SB(1, 0), b3, voffB); PG8_STAGE(PG8_SB(1, 1), b3 + hstep, voffB); PG8_STAGE(PG8_SA(1, 0), a3, voffA);
            PG8_WAIT_V(8); PG8_WAIT_L(0); PG8_BAR; PG8_MMA(1, 0, At, B0); PG8_MMA(1, 1, At, B1); PG8_BAR; PG8_SCHED;
            } else {
            PG8_LDB(B0, 0, 0); PG8_SCHED; PG8_LDA(At, 0, 0); PG8_STAGE(PG8_SA(1, 1), a1 + hstepA, voffA);
            PG8_WAIT_L(8); PG8_BAR; PG8_WAIT_L(0); PG8_MMA(0, 0, At, B0); PG8_BAR; PG8_SCHED;
            PG8_LDB(B1, 0, 1); PG8_STAGE(PG8_SB(0, 0), b2, voffB);
            PG8_BAR; PG8_WAIT_L(0); PG8_MMA(0, 1, At, B1); PG8_BAR;
            PG8_LDA(At, 0, 1); PG8_STAGE(PG8_SA(0, 0), a2, voffA);
            PG8_BAR; PG8_WAIT_L(0); PG8_MMA(1, 0, At, B0); PG8_BAR; PG8_SCHED;
            PG8_STAGE(PG8_SB(0, 1), b2 + hstep, voffB);
            PG8_WAIT_V(6); PG8_BAR; PG8_MMA(1, 1, At, B1); PG8_BAR;
            PG8_LDB(B0, 1, 0); PG8_SCHED; PG8_LDA(At, 1, 0); PG8_STAGE(PG8_SA(0, 1), a2 + hstepA, voffA);
            PG8_WAIT_L(8); PG8_BAR; PG8_WAIT_L(0); PG8_MMA(0, 0, At, B0); PG8_BAR; PG8_SCHED;
            PG8_LDB(B1, 1, 1); PG8_STAGE(PG8_SB(1, 0), b3, voffB);
            PG8_BAR; PG8_WAIT_L(0); PG8_MMA(0, 1, At, B1); PG8_BAR;
            PG8_LDA(At, 1, 1); PG8_STAGE(PG8_SA(1, 0), a3, voffA);
            PG8_BAR; PG8_WAIT_L(0); PG8_MMA(1, 0, At, B0); PG8_BAR; PG8_SCHED;
            PG8_STAGE(PG8_SB(1, 1), b3 + hstep, voffB);
            PG8_WAIT_V(6); PG8_BAR; PG8_MMA(1, 1, At, B1); PG8_BAR;
            }
        }
        if constexpr (ALIGN_EPI) { if (wr == 0) PG8_BAR; }
        if constexpr (!Epi::AFTER_DRAIN) { E(acc, cur, wr, wc, fr, fq); S.done(cur); }
        if (!has_next) break;
#pragma unroll
        for (int a = 0; a < 2; ++a)
#pragma unroll
            for (int b = 0; b < 2; ++b)
#pragma unroll
                for (int m = 0; m < 4; ++m)
#pragma unroll
                    for (int n = 0; n < 2; ++n) acc[a][b][m][n] = (f32x4){0.f, 0.f, 0.f, 0.f};
        cur = nxt; cA = nA; cB = nB; ++ui;
        if constexpr (ALIGN_EPI) { if (wr == 1) PG8_BAR; }
    }
    PG8_WAIT_V(0);
    if constexpr (!ALIGN_EPI) { if (wr == 0) PG8_BAR; }
    PG8_BAR;
    if constexpr (Epi::AFTER_DRAIN) { E.fused(acc, cur, wr, wc, fr, fq, lds, wid, lane); S.done(cur); }
#undef PG8_SA
#undef PG8_SB
#undef PG8_STAGE
#undef PG8_LDA
#undef PG8_LDB
#undef PG8_MMA
#undef PG8_WAIT_V
#undef PG8_WAIT_L
#undef PG8_BAR
#undef PG8_SCHED
}
}
#include <hip/hip_bf16.h>
#include <cmath>
namespace attn_body {
using bf16=__hip_bfloat16;
using bf16x8=__attribute__((ext_vector_type(8)))short;
using s16x4=__attribute__((ext_vector_type(4)))short;
using f32x16=__attribute__((ext_vector_type(16)))float;
using u32x4=__attribute__((ext_vector_type(4)))unsigned;
constexpr int BATCH=8,NHEAD=16,SEQ=4096,D=64,DM=NHEAD*D;
constexpr int NW=8,QBLK=32,QB=QBLK*NW,KVBLK=64,NQB=SEQ/QB;
constexpr int ATTN_PITCH=DM, ATTN_UNIT_ROWS=QB;
__device__ __forceinline__ int crow(int r,int hi){return (r&3)+8*(r>>2)+4*hi;}
#define SBAR() __builtin_amdgcn_sched_barrier(0)
__device__ __forceinline__ void cmask(f32x16&p0,f32x16&p1,int jb,int qrel,int hi){
  const float NEG=-INFINITY; int kb=64*jb+4*hi;
  #pragma unroll
  for(int r=0;r<16;++r){int kv=kb+(r&3)+8*(r>>2); if(kv>qrel)p0[r]=NEG; if(kv+32>qrel)p1[r]=NEG;}
}

constexpr int NSLOT=3, SLOTB=8192;
constexpr int LDS_K=0, LDS_V=NSLOT*SLOTB, LDS_WS=2*NSLOT*SLOTB, LDS_OST=LDS_WS+NW*64*4, LDS_CB=LDS_OST+NW*4096, LDS_BYTES=LDS_CB+SEQ*4;
constexpr float C2=0.125f*1.4426950408889634f;
__device__ __forceinline__ void glds16(const void*gsrc,unsigned lds_dst){unsigned keep;
  asm volatile("s_mov_b32 %0, m0\n\ts_mov_b32 m0, %2\n\ts_nop 0\n\tglobal_load_lds_dwordx4 %1, off\n\ts_mov_b32 m0, %0":"=&s"(keep):"v"(gsrc),"s"(lds_dst):"memory");}
__device__ __forceinline__ float max3f(float a,float b,float c){float r;asm("v_max3_f32 %0, %1, %2, %3":"=v"(r):"v"(a),"v"(b),"v"(c));return r;}
__device__ __forceinline__ float max2f(float a,float b){float r;asm("v_max_f32_e32 %0, %1, %2":"=v"(r):"v"(a),"v"(b));return r;}
__device__ __forceinline__ float fadd_s(float a,float b){float r;asm("v_add_f32_e32 %0, %1, %2":"=v"(r):"v"(a),"v"(b));return r;}
__device__ __forceinline__ float fsub_s(float a,float b){float r;asm("v_sub_f32_e32 %0, %1, %2":"=v"(r):"v"(a),"v"(b));return r;}
typedef float f32x2_t __attribute__((ext_vector_type(2))); typedef __bf16 bf16x2_t __attribute__((ext_vector_type(2)));
__device__ __forceinline__ unsigned cvtpk_s(float lo,float hi){f32x2_t v={lo,hi};bf16x2_t b=__builtin_convertvector(v,bf16x2_t);return __builtin_bit_cast(unsigned,b);}
#define WAIT_BAR(N) asm volatile("s_waitcnt vmcnt(" #N ") lgkmcnt(0)\n\ts_barrier":::"memory")

__device__ __forceinline__ void qkt(f32x16&p0,f32x16&p1,const char*Kslot,const bf16x8*qr,const f32x16&negm,int r32,int hi){
  const char*kb=Kslot+hi*1024+r32*16;
  #pragma unroll
  for(int d0=0;d0<4;++d0){
    const bf16x8 b0=*reinterpret_cast<const bf16x8*>(kb+d0*2048);
    const bf16x8 b1=*reinterpret_cast<const bf16x8*>(kb+d0*2048+512);
    if(d0==0){p0=__builtin_amdgcn_mfma_f32_32x32x16_bf16(b0,qr[0],negm,0,0,0);p1=__builtin_amdgcn_mfma_f32_32x32x16_bf16(b1,qr[0],negm,0,0,0);}
    else{p0=__builtin_amdgcn_mfma_f32_32x32x16_bf16(b0,qr[d0],p0,0,0,0);p1=__builtin_amdgcn_mfma_f32_32x32x16_bf16(b1,qr[d0],p1,0,0,0);}}
}
typedef __attribute__((address_space(3))) const char* lds_cptr;
typedef short v4i16_t __attribute__((ext_vector_type(4)));
__device__ __forceinline__ void kload8(bf16x8*kf,lds_cptr kp){
  kf[0]=*(const __attribute__((address_space(3))) bf16x8*)(kp);      kf[1]=*(const __attribute__((address_space(3))) bf16x8*)(kp+512);
  kf[2]=*(const __attribute__((address_space(3))) bf16x8*)(kp+2048); kf[3]=*(const __attribute__((address_space(3))) bf16x8*)(kp+2560);
  kf[4]=*(const __attribute__((address_space(3))) bf16x8*)(kp+4096); kf[5]=*(const __attribute__((address_space(3))) bf16x8*)(kp+4608);
  kf[6]=*(const __attribute__((address_space(3))) bf16x8*)(kp+6144); kf[7]=*(const __attribute__((address_space(3))) bf16x8*)(kp+6656);
}
__device__ __forceinline__ void kload2(bf16x8*kf,lds_cptr kp,int j){ kf[2*j]=*(const __attribute__((address_space(3))) bf16x8*)(kp+j*2048); kf[2*j+1]=*(const __attribute__((address_space(3))) bf16x8*)(kp+j*2048+512); }
__device__ __forceinline__ s16x4 vtr(lds_cptr p){ return __builtin_bit_cast(s16x4,__builtin_amdgcn_ds_read_tr16_b64_v4i16((__attribute__((address_space(3))) v4i16_t*)p)); }
__device__ __forceinline__ float rowmax(const f32x16&p0,const f32x16&p1){
  float a=max3f(p0[0],p0[1],p1[0]),b=max3f(p0[2],p0[3],p1[1]);a=max3f(a,p1[2],p1[3]);
  #pragma unroll
  for(int r=4;r<16;r+=4){a=max3f(a,p0[r],p0[r+1]);b=max3f(b,p0[r+2],p0[r+3]);a=max3f(a,p1[r],p1[r+1]);b=max3f(b,p1[r+2],p1[r+3]);}
  const float m=max2f(a,b);
  auto rr=__builtin_amdgcn_permlane32_swap(__float_as_uint(m),__float_as_uint(m),false,false);
  return max2f(__uint_as_float(rr[0]),__uint_as_float(rr[1]));
}
__device__ __forceinline__ void pv(f32x16*o,int vb,bf16x8 pa0,bf16x8 pa1,bf16x8 pa2,bf16x8 pa3){
  #pragma unroll
  for(int d0=0;d0<2;++d0){s16x4 lo[4],hi[4];
    #pragma unroll
    for(int ks=0;ks<4;++ks){
      asm volatile("ds_read_b64_tr_b16 %0,%1 offset:%c2":"=&v"(lo[ks]):"v"(vb),"i"(d0*4096+ks*1024):"memory");
      asm volatile("ds_read_b64_tr_b16 %0,%1 offset:%c2":"=&v"(hi[ks]):"v"(vb),"i"(d0*4096+ks*1024+512):"memory");}
    asm volatile("s_waitcnt lgkmcnt(0)":::"memory");SBAR();
    #define PK(k) (bf16x8){lo[k][0],lo[k][1],lo[k][2],lo[k][3],hi[k][0],hi[k][1],hi[k][2],hi[k][3]}
    o[d0]=__builtin_amdgcn_mfma_f32_32x32x16_bf16(pa0,PK(0),o[d0],0,0,0);
    o[d0]=__builtin_amdgcn_mfma_f32_32x32x16_bf16(pa1,PK(1),o[d0],0,0,0);
    o[d0]=__builtin_amdgcn_mfma_f32_32x32x16_bf16(pa2,PK(2),o[d0],0,0,0);
    o[d0]=__builtin_amdgcn_mfma_f32_32x32x16_bf16(pa3,PK(3),o[d0],0,0,0);
    #undef PK
  }
}

#ifndef ATTN_STORE16
#define ATTN_STORE16(p,v) (*(u32x4*)(p)=(v))
#endif
template<int THRL> __device__ __forceinline__ void attn_unit(int b,int h,int qb,const bf16*Q,const bf16*__restrict__ K,const bf16*__restrict__ V,bf16*O,const bf16*__restrict__ Gt,const float*__restrict__ CL,char*shm,int wave_s){
  int tid_o=tid_from(wave_s); asm volatile("":"+v"(tid_o)); const int tid=tid_o,lane=tid&63,r32=lane&31,hi=lane>>5; const int wid=__builtin_amdgcn_readfirstlane(tid>>6);
  const long rowbase=(long)b*SEQ; const int q0=qb*QB;
  const float*cbh=CL+((long)b*NHEAD+h)*SEQ;
  typedef float f4_t __attribute__((ext_vector_type(4))); f4_t creg0=f4_t{},creg1=f4_t{}; const int n4c=(q0+QB)/4;
  if(tid<n4c)creg0=*(const f4_t*)(cbh+4*tid); if(tid+NW*64<n4c)creg1=*(const f4_t*)(cbh+4*(tid+NW*64));
  const float cq=cbh[q0+wid*QBLK+(lane&31)];
  const bf16*Qw=Q+(rowbase+q0+wid*QBLK)*DM+h*D;
  const bf16*Kh=K+rowbase*DM+h*D,*Vh=V+rowbase*DM+h*D;
  const unsigned lds0=(unsigned)(uintptr_t)shm;
  float*wsf=(float*)(shm+LDS_WS)+wid*64;
  const bf16*ksrc=Kh+(long)lane*DM+wid*8;
  const bf16*vsrc=Vh+(long)(16*(wid&3)+(lane>>2))*DM+(wid>>2)*32+(lane&3)*8;
  const unsigned kdst=lds0+LDS_K+wid*1024, vdst=lds0+LDS_V+wid*1024;
  #define DMA_K(t,slot) glds16(ksrc+(long)(t)*KVBLK*DM,(unsigned)__builtin_amdgcn_readfirstlane(kdst+(slot)))
  #define DMA_V(t,slot) glds16(vsrc+(long)(t)*KVBLK*DM,(unsigned)__builtin_amdgcn_readfirstlane(vdst+(slot)))
  const int vb0=(int)(lds0+LDS_V)+((lane>>4)&1)*32+(lane&3)*8+(4*hi+((lane&15)>>2))*64;
  const char*Kbase=shm+LDS_K; bf16x8 kf[8];
  const lds_cptr shm3=(lds_cptr)shm; const lds_cptr kp0=shm3+LDS_K+hi*1024+r32*16; const lds_cptr vp0=shm3+LDS_V+((lane>>4)&1)*32+(lane&3)*8+(4*hi+((lane&15)>>2))*64;
  const int NT=(q0+QB)/KVBLK;
  DMA_K(0,0);DMA_V(0,0);DMA_K(1,SLOTB);
  bf16x8 qr[4];
  #pragma unroll
  for(int d0=0;d0<4;++d0)qr[d0]=*reinterpret_cast<const bf16x8*>(&Qw[(long)r32*DM+d0*16+hi*8]);
  float mhat=0.f,l_reg=0.f;f32x16 o[2];o[0]=f32x16{};o[1]=f32x16{};f32x16 negm;
  #pragma unroll
  for(int r=0;r<16;++r)negm[r]=cq;
  asm volatile("":"+v"(negm));
  typedef float cf4_t __attribute__((ext_vector_type(4))); const __attribute__((address_space(3))) cf4_t*clds=(const __attribute__((address_space(3))) cf4_t*)((lds_cptr)shm+LDS_CB)+hi;
  #define CBIAS(P0,P1,t) do{ const __attribute__((address_space(3))) cf4_t*cp_=clds+16*(t); _Pragma("unroll") for(int j_=0;j_<4;++j_){ const cf4_t a_=cp_[2*j_], b_=cp_[8+2*j_]; \
      { f32x2_t u0_={P0[4*j_],P0[4*j_+1]},u1_={P0[4*j_+2],P0[4*j_+3]},w0_={P1[4*j_],P1[4*j_+1]},w1_={P1[4*j_+2],P1[4*j_+3]}; \
        u0_=u0_-(f32x2_t){a_[0],a_[1]}; u1_=u1_-(f32x2_t){a_[2],a_[3]}; w0_=w0_-(f32x2_t){b_[0],b_[1]}; w1_=w1_-(f32x2_t){b_[2],b_[3]}; \
        P0[4*j_]=u0_[0];P0[4*j_+1]=u0_[1];P0[4*j_+2]=u1_[0];P0[4*j_+3]=u1_[1]; P1[4*j_]=w0_[0];P1[4*j_+1]=w0_[1];P1[4*j_+2]=w1_[0];P1[4*j_+3]=w1_[1]; } } }while(0)
  const int qrel=wid*QBLK+r32;
  #define CMASK(P0,P1,t) do{int jb_=(t)-(NT-4); if(jb_>=0)cmask(P0,P1,jb_,qrel,hi);}while(0)
  bool resc=false;
  #define START(P0,P1) do{ const float rm=rowmax(P0,P1); resc=false; \
    { const float c63_=((const __attribute__((address_space(3))) float*)((lds_cptr)shm+LDS_CB))[63]; const float dl=rm-(cq-c63_);     \
      mhat=fadd_s(mhat,dl); \
      _Pragma("unroll") for(int r=0;r<16;++r){P0[r]=fsub_s(P0[r],dl);P1[r]=fsub_s(P1[r],dl);} \
      _Pragma("unroll") for(int r=0;r<16;++r)negm[r]=cq-mhat; asm volatile("":"+v"(negm)); } \
    _Pragma("unroll") for(int r=0;r<16;++r)P0[r]=__builtin_amdgcn_exp2f(P0[r]); }while(0)
  #define RESC() do{ if(resc){ asm volatile("s_waitcnt lgkmcnt(0)":::"memory"); \
      _Pragma("unroll") for(int d_=0;d_<2;++d_) _Pragma("unroll") for(int r=0;r<16;++r)o[d_][r]*=wsf[crow(r,hi)]; } }while(0)
  f32x16 pA0,pA1,pB0,pB1;
  int sl_prev=0,sl_cur=0,sl_next=SLOTB;
  #define ROT() do{sl_prev=sl_cur;sl_cur=sl_next;sl_next=(sl_next==(NSLOT-1)*SLOTB)?0:sl_next+SLOTB;}while(0)
  { __attribute__((address_space(3))) f4_t*cl4=(__attribute__((address_space(3))) f4_t*)((lds_cptr)shm+LDS_CB); if(tid<n4c)cl4[tid]=creg0; if(tid+NW*64<n4c)cl4[tid+NW*64]=creg1; }
  DMA_K(2,2*SLOTB);
  WAIT_BAR(3);
  qkt(pA0,pA1,Kbase,qr,negm,r32,hi);asm volatile("s_nop 15\n\ts_nop 7":"+v"(pA0),"+v"(pA1));CMASK(pA0,pA1,0);CBIAS(pA0,pA1,0);
  START(pA0,pA1);
  _Pragma("unroll") for(int r=0;r<16;++r)pA1[r]=__builtin_amdgcn_exp2f(pA1[r]);
  WAIT_BAR(0);
  DMA_K(3,0);DMA_V(1,SLOTB);
  ROT();
  kload8(kf,kp0+sl_cur);
  WAIT_BAR(2);
  s16x4 vlo[8],vhi[8]; u32x4 pw0,pw1,pw2,pw3;
  #define PKW(P,B) cvtpk_s(P[B],P[B+1])
  #define PAF(k) __builtin_bit_cast(bf16x8,pw##k)
  #define VFR(i) (bf16x8){vlo[i][0],vlo[i][1],vlo[i][2],vlo[i][3],vhi[i][0],vhi[i][1],vhi[i][2],vhi[i][3]}
  #define PIN(x) asm volatile("":"+v"(x))
  #define MX3(a,b,c) __builtin_fmaxf(__builtin_fmaxf((a),(b)),(c))
  #define GAPA(MF,A0,A1,A2,A3,W0,W1,PW) do{ MF; sacc+=A0; sacc+=A1; sacc+=A2; sacc+=A3; PIN(sacc); W0; W1; PIN(PW); SBAR(); }while(0)
  #define EX(v) __builtin_amdgcn_exp2f(v)
  #define GAPB(MF,X,B) do{ MF; X[B]=EX(X[B]); X[B+1]=EX(X[B+1]); X[B+2]=EX(X[B+2]); X[B+3]=EX(X[B+3]); PIN(X); SBAR(); }while(0)
  #define VRD(i) do{ vlo[i]=vtr(vp_+(((i)>>2)*4096+((i)&3)*1024)); vhi[i]=vtr(vp_+(((i)>>2)*4096+((i)&3)*1024+512)); }while(0)
  #define KRD(G,j) do{ if(G){ kload2(kf,kp0+sl_next,j); SBAR(); } }while(0)
  #define STEP(C0,C1,P0,P1,t,GK,GV,GL) do{ SBAR(); \
    const lds_cptr vp_=vp0+sl_prev; \
    VRD(0); SBAR(); float sacc=(P0[0]+P0[1]); \
    GAPA(C0=__builtin_amdgcn_mfma_f32_32x32x16_bf16(kf[0],qr[0],negm,0,0,0), P0[2],P0[3],P0[4],P0[5],     pw0[0]=PKW(P0,0), pw0[1]=PKW(P0,2), pw0); \
    VRD(4); SBAR(); GAPA(C1=__builtin_amdgcn_mfma_f32_32x32x16_bf16(kf[1],qr[0],negm,0,0,0), P0[6],P0[7],P0[8],P0[9],     pw0[2]=PKW(P0,4), pw0[3]=PKW(P0,6), pw0); \
    VRD(1); SBAR(); GAPA(C0=__builtin_amdgcn_mfma_f32_32x32x16_bf16(kf[2],qr[1],C0,0,0,0),   P0[10],P0[11],P0[12],P0[13], pw1[0]=PKW(P0,8), pw1[1]=PKW(P0,10), pw1); \
    VRD(5); SBAR(); GAPA(C1=__builtin_amdgcn_mfma_f32_32x32x16_bf16(kf[3],qr[1],C1,0,0,0),   P0[14],P0[15],P1[0],P1[1],   pw1[2]=PKW(P0,12),pw1[3]=PKW(P0,14), pw1); \
    VRD(2); SBAR(); GAPA(C0=__builtin_amdgcn_mfma_f32_32x32x16_bf16(kf[4],qr[2],C0,0,0,0),   P1[2],P1[3],P1[4],P1[5],     pw2[0]=PKW(P1,0), pw2[1]=PKW(P1,2), pw2); \
    VRD(6); SBAR(); GAPA(C1=__builtin_amdgcn_mfma_f32_32x32x16_bf16(kf[5],qr[2],C1,0,0,0),   P1[6],P1[7],P1[8],P1[9],     pw2[2]=PKW(P1,4), pw2[3]=PKW(P1,6), pw2); \
    VRD(3); SBAR(); GAPA(C0=__builtin_amdgcn_mfma_f32_32x32x16_bf16(kf[6],qr[3],C0,0,0,0),   P1[10],P1[11],P1[12],P1[13], pw3[0]=PKW(P1,8), pw3[1]=PKW(P1,10), pw3); \
    VRD(7); SBAR(); GAPA(C1=__builtin_amdgcn_mfma_f32_32x32x16_bf16(kf[7],qr[3],C1,0,0,0),   P1[14],P1[15],0.f,0.f,       pw3[2]=PKW(P1,12),pw3[3]=PKW(P1,14), pw3); \
    l_reg+=sacc; \
    if(GK){DMA_K((t)+3,sl_cur);} if(GV){DMA_V((t)+1,sl_next);} \
    CMASK(C0,C1,t); CBIAS(C0,C1,t); \
    { float a=MX3(C0[0],C0[1],C1[0]),b=MX3(C0[2],C0[3],C1[1]); a=MX3(a,C1[2],C1[3]); \
      _Pragma("unroll") for(int r=4;r<16;r+=4){a=MX3(a,C0[r],C0[r+1]);b=MX3(b,C0[r+2],C0[r+3]);a=MX3(a,C1[r],C1[r+1]);b=MX3(b,C1[r+2],C1[r+3]);} \
      float rm=__builtin_fmaxf(a,b); { auto rr=__builtin_amdgcn_permlane32_swap(__float_as_uint(rm),__float_as_uint(rm),false,false); rm=__builtin_fmaxf(__uint_as_float(rr[0]),__uint_as_float(rr[1])); } \
      resc=false; \
      if(__builtin_expect(__any(rm>(float)THRL),0)){ const float dl=__builtin_fmaxf(rm,0.f); mhat+=dl; \
        _Pragma("unroll") for(int r=0;r<16;++r){C0[r]-=dl;C1[r]-=dl;} \
        _Pragma("unroll") for(int r=0;r<16;++r)negm[r]=cq-mhat; asm volatile("":"+v"(negm)); \
        const float f=__builtin_amdgcn_exp2f(-dl); l_reg*=f; if(hi==0)wsf[r32]=f; resc=true; } } \
    SBAR(); \
    GAPB(o[0]=__builtin_amdgcn_mfma_f32_32x32x16_bf16(PAF(0),VFR(0),o[0],0,0,0), C0,0); \
    GAPB(o[1]=__builtin_amdgcn_mfma_f32_32x32x16_bf16(PAF(0),VFR(4),o[1],0,0,0), C0,4); \
    KRD(GL,0); GAPB(o[0]=__builtin_amdgcn_mfma_f32_32x32x16_bf16(PAF(1),VFR(1),o[0],0,0,0), C0,8); \
    KRD(GL,1); GAPB(o[1]=__builtin_amdgcn_mfma_f32_32x32x16_bf16(PAF(1),VFR(5),o[1],0,0,0), C0,12); \
    KRD(GL,2); GAPB(o[0]=__builtin_amdgcn_mfma_f32_32x32x16_bf16(PAF(2),VFR(2),o[0],0,0,0), C1,0); \
    KRD(GL,3); GAPB(o[1]=__builtin_amdgcn_mfma_f32_32x32x16_bf16(PAF(2),VFR(6),o[1],0,0,0), C1,4); \
    GAPB(o[0]=__builtin_amdgcn_mfma_f32_32x32x16_bf16(PAF(3),VFR(3),o[0],0,0,0), C1,8); \
    GAPB(o[1]=__builtin_amdgcn_mfma_f32_32x32x16_bf16(PAF(3),VFR(7),o[1],0,0,0), C1,12); \
    }while(0)
  int t=1;
  #undef CMASK
  #define CMASK(P0,P1,t) do{}while(0)
  for(;t+5<NT;t+=2){
    STEP(pB0,pB1,pA0,pA1,t,true,true,true);     WAIT_BAR(2); RESC(); ROT();
    STEP(pA0,pA1,pB0,pB1,t+1,true,true,true);   WAIT_BAR(2); RESC(); ROT();
  }
  #undef CMASK
  #define CMASK(P0,P1,t) do{int jb_=(t)-(NT-4); if(jb_>=0)cmask(P0,P1,jb_,qrel,hi);}while(0)
  #define ENDW(tt) do{ if((tt)+3<NT){WAIT_BAR(2);} else if((tt)+2<NT){WAIT_BAR(1);} else {WAIT_BAR(0);} }while(0)
  for(;t+1<NT;t+=2){
    STEP(pB0,pB1,pA0,pA1,t,(t+3<NT),(t+1<NT),(t+1<NT));       ENDW(t);   RESC(); ROT();
    STEP(pA0,pA1,pB0,pB1,t+1,(t+4<NT),(t+2<NT),(t+2<NT));     ENDW(t+1); RESC(); ROT();
  }
  STEP(pB0,pB1,pA0,pA1,NT-1,false,false,false); RESC();
  { float sacc=pB0[0]+pB0[1]; _Pragma("unroll") for(int r=2;r<16;++r)sacc+=pB0[r]; _Pragma("unroll") for(int r=0;r<16;++r)sacc+=pB1[r]; l_reg+=sacc;
    pw0=(u32x4){PKW(pB0,0),PKW(pB0,2),PKW(pB0,4),PKW(pB0,6)};pw1=(u32x4){PKW(pB0,8),PKW(pB0,10),PKW(pB0,12),PKW(pB0,14)};pw2=(u32x4){PKW(pB1,0),PKW(pB1,2),PKW(pB1,4),PKW(pB1,6)};pw3=(u32x4){PKW(pB1,8),PKW(pB1,10),PKW(pB1,12),PKW(pB1,14)};
    SBAR(); pv(o,vb0+sl_cur,PAF(0),PAF(1),PAF(2),PAF(3)); }
  #undef PKW
  #undef PAF
  #undef VFR
  #undef PIN
  #undef MX3
  #undef GAPA
  #undef GAPB
  #undef EX
  #undef VRD
  #undef KRD
  #undef STEP
  #undef ENDW
  u32x4 gq4[4];
  { const bf16*Gw=Gt+(rowbase+q0+wid*QBLK)*DM+h*D;
    #pragma unroll
    for(int i=0;i<4;++i)gq4[i]=*(const u32x4*)(Gw+(long)(i*8+(lane>>3))*DM+(lane&7)*8); }
  {auto rr=__builtin_amdgcn_permlane32_swap(__float_as_uint(l_reg),__float_as_uint(l_reg),false,false);l_reg=__uint_as_float(rr[0])+__uint_as_float(rr[1]);}
  if(hi==0)wsf[32+r32]=l_reg;asm volatile("s_waitcnt lgkmcnt(0)":::"memory");
  float rli[16];
  #pragma unroll
  for(int r=0;r<16;++r)rli[r]=__builtin_amdgcn_rcpf(wsf[32+crow(r,hi)]);
  bf16*Ow=O+(rowbase+q0+wid*QBLK)*DM+h*D;
  { bf16*stg=(bf16*)(shm+LDS_OST)+wid*2048;
    #pragma unroll
    for(int r=0;r<16;++r){const int orow=crow(r,hi);
      #pragma unroll
      for(int d0=0;d0<2;++d0)stg[orow*64+d0*32+r32]=__float2bfloat16(o[d0][r]*rli[r]);}
    asm volatile("s_waitcnt lgkmcnt(0)":::"memory");
    #pragma unroll
    for(int i=0;i<4;++i){const bf16*Gw=Gt+(rowbase+q0+wid*QBLK)*DM+h*D; const int row=i*8+(lane>>3),ch=lane&7; const u32x4 v=*(const u32x4*)(stg+row*64+ch*8); const u32x4 gq=gq4[i]; u32x4 w;
      #pragma unroll
      for(int e=0;e<4;++e){ const float a0=__uint_as_float(v[e]<<16)*__uint_as_float(gq[e]<<16), a1=__uint_as_float(v[e]&0xffff0000u)*__uint_as_float(gq[e]&0xffff0000u); w[e]=cvtpk_s(a0,a1); }
      ATTN_STORE16(Ow+(long)row*DM+ch*8,w);} }
  asm volatile("s_waitcnt lgkmcnt(0)\n\ts_barrier":::"memory");
  #undef CBIAS
  #undef DMA_K
  #undef DMA_V
  #undef CMASK
  #undef START
  #undef RESC
  #undef ROT
}
constexpr int ATTN_LDS_BYTES=LDS_BYTES;
struct AttnTensors { const bf16* Q; const bf16* K; const bf16* V; bf16* O; const bf16* G; const float* CL; };
struct AttnUnit { int bh; int qb; };
struct StaticOrder {
  int vcu, G;
  __device__ __forceinline__ explicit StaticOrder(int grid,int block):vcu((grid%8==0)?(block%8)*(grid/8)+block/8:block),G(grid){}
  __device__ __forceinline__ bool next(int i,AttnUnit&u)const{
    if(G==256){ if(i>=8)return false; const int j=2*(i>>1)+(vcu&1); u.bh=vcu>>1; u.qb=(i&1)?15-j:j; return true; }
    const int idx=i*G+vcu; if(idx>=BATCH*NHEAD*NQB)return false; u.bh=idx/NQB; u.qb=NQB-1-idx%NQB; return true; }
  __device__ __forceinline__ void a_ready(const AttnUnit&)const{}
  __device__ __forceinline__ void done(const AttnUnit&)const{}
};
template<class Sched,int THRL=8> __device__ __forceinline__ void attn_phase(char*lds,const AttnTensors&T,const Sched&S,int wave_s){
  AttnUnit u;
  for(int i=0;S.next(i,u);++i){ S.a_ready(u); attn_unit<THRL>(u.bh/NHEAD,u.bh%NHEAD,u.qb,T.Q,T.K,T.V,T.O,T.G,T.CL,lds,wave_s); S.done(u); }
}
#undef SBAR
#undef WAIT_BAR
}
#define GAS __attribute__((address_space(1)))
#define LAS __attribute__((address_space(3)))
typedef unsigned short bfu;
typedef unsigned v4u __attribute__((ext_vector_type(4)));
typedef unsigned v2u __attribute__((ext_vector_type(2)));
typedef float f32x4 __attribute__((ext_vector_type(4)));
typedef short bf16x8 __attribute__((ext_vector_type(8)));
#define LDS_WAIT() asm volatile("s_waitcnt lgkmcnt(0)" ::: "memory")
constexpr int NWAVES = 8;
constexpr int BATCH = 8, SEQ = 4096, D = 1024, FF = 2816, T = BATCH * SEQ, PLE = 256, NKVF = 2064, NKVFP = 2304;
constexpr float EPS = 1e-6f, LOG2E = 1.4426950408889634f;
constexpr size_t MiB = 1u << 20;
constexpr size_t E_W1IN = 0, N_WIN = (size_t)2 * FF * D, N_WOUT = (size_t)D * FF;
constexpr size_t E_W1OUT = E_W1IN + 2 * N_WIN, E_W2IN = E_W1OUT + 2 * N_WOUT, E_W2OUT = E_W2IN + 2 * N_WIN, E_WHIN = E_W2OUT + 2 * N_WOUT;
constexpr size_t E_WHOUT = E_WHIN + (size_t)4 * D * D, E_WKVF = E_WHOUT + (size_t)D * D, E_WQG = E_WKVF + (size_t)NKVFP * D, E_WFO = E_WQG + (size_t)2 * D * D;
constexpr size_t E_WPG = E_WFO + (size_t)D * D, E_WPP = E_WPG + (size_t)2 * D * D, E_WEND = E_WPP + (size_t)2 * D * PLE;
static_assert(E_WEND * 2 <= 92 * MiB, "weights fit");
constexpr size_t WS_P = 92 * MiB, WS_LOGF = 124 * MiB, WS_C = 126 * MiB, WS_AY = 128 * MiB, WS_BIG = 192 * MiB, WS_PROJ = 448 * MiB, WS_END = 512 * MiB;
constexpr size_t WS_V = WS_BIG + 192 * MiB, WS_K = WS_PROJ, WS_Q = WS_BIG, WS_G = WS_BIG + 64 * MiB;
constexpr int LDS_BYTES = 147456;

__device__ __forceinline__ float wave_sum(float v) {
#pragma unroll
    for (int o = 1; o < 64; o <<= 1) v += __shfl_xor(v, o);
    return v;
}
__device__ __forceinline__ unsigned pk2(float lo, float hi) { return pg8::cvt_pk_bf16(lo, hi); }
__device__ __forceinline__ float bf2f(unsigned short u) { return __uint_as_float((unsigned)u << 16); }
__device__ __forceinline__ unsigned short f2b(float f) { return (unsigned short)(pk2(f, 0.f) & 0xffffu); }

__device__ __forceinline__ void conv_item(const float* W, int K, int N, bfu* WT, const float* gain, int gmask, int sw, LAS float* scr, int item, int lane) {
    const int nblk = (N + 31) / 32, kb = item / nblk, nb = item % nblk, k0 = 64 * kb, n0 = 32 * nb;
    const int nn = n0 + (lane & 31); const bool nok = nn < N;
    const int c = lane & 7;
    f32x4 ga = (f32x4){1.f, 1.f, 1.f, 1.f}, gb = ga;
    if (gain) { ga = *(const f32x4*)(gain + ((k0 + 8 * c) & gmask)); gb = *(const f32x4*)(gain + ((k0 + 8 * c) & gmask) + 4); }
    float wv[32];
#pragma unroll
    for (int i = 0; i < 32; ++i) { const int kk = 2 * i + (lane >> 5); wv[i] = nok ? __builtin_nontemporal_load(W + (size_t)(k0 + kk) * N + nn) : 0.f; }
#pragma unroll
    for (int i = 0; i < 32; ++i) { const int kk = 2 * i + (lane >> 5); scr[kk * 33 + (lane & 31)] = wv[i]; }
    LDS_WAIT(); asm volatile("" ::: "memory");
    int drow0 = n0; if (sw) { const int j0 = (n0 < FF) ? n0 : n0 - FF; drow0 = 256 * (j0 >> 7) + (j0 & 127) + ((n0 < FF) ? 0 : 128); }
#pragma unroll
    for (int j = 0; j < 4; ++j) { const int n = (lane >> 3) + 8 * j; const LAS float* s = scr + (8 * c) * 33 + n;
        v4u o; o.x = pk2(s[0 * 33] * ga[0], s[1 * 33] * ga[1]); o.y = pk2(s[2 * 33] * ga[2], s[3 * 33] * ga[3]); o.z = pk2(s[4 * 33] * gb[0], s[5 * 33] * gb[1]); o.w = pk2(s[6 * 33] * gb[2], s[7 * 33] * gb[3]);
        *(v4u*)(WT + (size_t)(drow0 + n) * K + k0 + 8 * c) = o; }
    LDS_WAIT(); asm volatile("" ::: "memory");
}
__device__ __forceinline__ void rms_row_to_bf16(const float* xrow, bfu* orow, int lane) {
    const f32x4* xr = (const f32x4*)xrow + lane;
    f32x4 v[4]; float s = 0.f;
#pragma unroll
    for (int j = 0; j < 4; ++j) { v[j] = __builtin_nontemporal_load(xr + 64 * j); s += (v[j].x * v[j].x + v[j].y * v[j].y) + (v[j].z * v[j].z + v[j].w * v[j].w); }
    const float r = __builtin_amdgcn_rsqf(wave_sum(s) * (1.f / D) + EPS);
    v2u* o8 = (v2u*)orow + lane;
#pragma unroll
    for (int j = 0; j < 4; ++j) { v2u w; w.x = pk2(v[j].x * r, v[j].y * r); w.y = pk2(v[j].z * r, v[j].w * r); o8[64 * j] = w; }
}
template <bool WRITE_A>
__device__ __forceinline__ void rw_phase(const float* hin, float* hout, const bfu* Y, bfu* A, const float* gain, float scale, int gw, int ngw, int lane) {
    f32x4 g[4];
#pragma unroll
    for (int j = 0; j < 4; ++j) g[j] = *((const f32x4*)gain + lane + 64 * j);
    for (int m0 = gw; m0 < T; m0 += 2 * ngw) {
        f32x4 v[2][4], y[2][4]; float s[2] = {0.f, 0.f}; const int m1 = m0 + ngw; const bool two = m1 < T;
#pragma unroll
        for (int r = 0; r < 2; ++r) { const int m = (r == 0 || two) ? (r == 0 ? m0 : m1) : m0;
            const f32x4* hr = (const f32x4*)(hin + (size_t)m * D) + lane; const v2u* yr = (const v2u*)(Y + (size_t)m * D) + lane;
#pragma unroll
            for (int j = 0; j < 4; ++j) { v[r][j] = __builtin_nontemporal_load(hr + 64 * j); const v2u w = __builtin_nontemporal_load(yr + 64 * j); y[r][j] = (f32x4){pg8::bflo(w.x), pg8::bfhi(w.x), pg8::bflo(w.y), pg8::bfhi(w.y)}; } }
#pragma unroll
        for (int r = 0; r < 2; ++r)
#pragma unroll
            for (int j = 0; j < 4; ++j) s[r] += (y[r][j].x * y[r][j].x + y[r][j].y * y[r][j].y) + (y[r][j].z * y[r][j].z + y[r][j].w * y[r][j].w);
        float s2[2] = {0.f, 0.f};
#pragma unroll
        for (int r = 0; r < 2; ++r) { const float ry = __builtin_amdgcn_rsqf(wave_sum(s[r]) * (1.f / D) + EPS) * scale;
#pragma unroll
            for (int j = 0; j < 4; ++j) { v[r][j] = v[r][j] + y[r][j] * ry * g[j]; s2[r] += (v[r][j].x * v[r][j].x + v[r][j].y * v[r][j].y) + (v[r][j].z * v[r][j].z + v[r][j].w * v[r][j].w); } }
#pragma unroll
        for (int r = 0; r < 2; ++r) { if (r == 1 && !two) break; const int m = r == 0 ? m0 : m1;
            f32x4* ho = (f32x4*)(hout + (size_t)m * D) + lane;
            if constexpr (WRITE_A) { const float r2 = __builtin_amdgcn_rsqf(wave_sum(s2[r]) * (1.f / D) + EPS); v2u* ao = (v2u*)(A + (size_t)m * D) + lane;
#pragma unroll
                for (int j = 0; j < 4; ++j) { __builtin_nontemporal_store(v[r][j], ho + 64 * j); v2u w; w.x = pk2(v[r][j].x * r2, v[r][j].y * r2); w.y = pk2(v[r][j].z * r2, v[r][j].w * r2); ao[64 * j] = w; } }
            else {
#pragma unroll
                for (int j = 0; j < 4; ++j) __builtin_nontemporal_store(v[r][j], ho + 64 * j); } }
    }
}

constexpr int HG_QH = 0, HG_QT = 17408, HG_KT = 34816, HG_KHT = 52224, HG_VT = 70656, HG_PP = 89088, HG_ST = 98304, HG_TOT = 133120, HG_DV = 135168, HG_END = 135680;
constexpr int RS = 136, RS2 = 72, OFS = 132;
static_assert(HG_END + 64 <= LDS_BYTES - 64, "hgrn lds");
__device__ __forceinline__ f32x4 mfma16(bf16x8 a, bf16x8 b, f32x4 c) { return __builtin_amdgcn_mfma_f32_16x16x32_bf16(a, b, c, 0, 0, 0); }
constexpr int HSEG = 4, HCH = SEQ / 64 / HSEG;
template <bool OUT>
__device__ __forceinline__ void hgrn_scan(LAS unsigned char* lds, bfu* QZVG, const float* lbl, int bh, int seg, float* Ebuf, float* Lbuf, int wave_s, const float* QZ0 = nullptr) {
    int tid_o = tid_from(wave_s); asm volatile("" : "+v"(tid_o)); const int tid = tid_o, lane = tid & 63, wid = __builtin_amdgcn_readfirstlane(tid >> 6), col = tid & 127, rg = tid >> 7, fr = lane & 15, fq = lane >> 4;
    const int b = bh >> 3, h = bh & 7;
    LAS bfu* QH = (LAS bfu*)(lds + HG_QH); LAS bfu* QT = (LAS bfu*)(lds + HG_QT); LAS bfu* KT = (LAS bfu*)(lds + HG_KT); LAS bfu* KHT = (LAS bfu*)(lds + HG_KHT);
    LAS bfu* VT = (LAS bfu*)(lds + HG_VT); LAS bfu* PP = (LAS bfu*)(lds + HG_PP); LAS bfu* ST = (LAS bfu*)(lds + HG_ST);
    LAS float* TOT = (LAS float*)(lds + HG_TOT); LAS float* DV = (LAS float*)(lds + HG_DV); LAS float* OF = (LAS float*)(lds + HG_QT);
    const float l0 = lbl[h * 128 + col], l1 = lbl[1024 + h * 128 + col];
    const float lb = 1.f / (1.f + __expf(l1 - l0)), omlb = 1.f - lb;
    float c0f = 0.f; bool use_c0 = false;
    if constexpr (OUT) { if (QZ0 != nullptr && seg == 0) {
        LAS float* cw = (LAS float*)(lds + HG_END);
        float pr = 0.f; if (tid < 128) { const float q0 = QZ0[(size_t)b * 2 * D + h * 128 + tid], z0 = QZ0[(size_t)b * 2 * D + D + h * 128 + tid]; pr = q0 * (omlb / (1.f + __expf(z0))); }
        pr = wave_sum(pr); if (lane == 0 && wid < 2) cw[wid] = pr;
        LDS_WAIT(); __builtin_amdgcn_s_barrier(); asm volatile("" ::: "memory");
        c0f = cw[0] + cw[1]; use_c0 = true; } }
    bfu* base = QZVG + ((size_t)b * SEQ + (size_t)seg * HCH * 64) * 4096 + h * 128;
    const bfu* pq = base + (size_t)(16 * rg) * 4096 + col; const bfu* pz = pq + 1024; const bfu* pv = pq + 2048;
    const int erow = tid >> 3, eseg = tid & 7;
    const bfu* pg = base + 3072 + (size_t)erow * 4096 + 16 * eseg; bfu* po = base + (size_t)erow * 4096 + 16 * eseg;
    f32x4 Sacc[8];
#pragma unroll
    for (int i = 0; i < 8; ++i) Sacc[i] = (f32x4){0.f, 0.f, 0.f, 0.f};
    float Lacc = 0.f;
    if constexpr (OUT) {
        for (int j = 0; j < seg; ++j) {
            const float* Ej = Ebuf + ((size_t)(bh * HSEG + j) * 64 * 64) * 4 + (size_t)(wid * 8) * 64 * 4; const float* Lj = Lbuf + (size_t)(bh * HSEG + j) * 128;
#pragma unroll
            for (int kb = 0; kb < 8; ++kb) { const f32x4 e = *(const f32x4*)(Ej + ((size_t)kb * 64 + lane) * 4); const f32x4 l4 = *(const f32x4*)(Lj + 16 * kb + 4 * fq);
                f32x4 s = Sacc[kb]; s[0] = s[0] * __expf(l4[0]) + e[0]; s[1] = s[1] * __expf(l4[1]) + e[1]; s[2] = s[2] * __expf(l4[2]) + e[2]; s[3] = s[3] * __expf(l4[3]) + e[3]; Sacc[kb] = s; }
        }
#pragma unroll
        for (int kb = 0; kb < 8; ++kb) *(LAS v2u*)(ST + (16 * wid + fr) * RS + 16 * kb + 4 * fq) = (v2u){pk2(Sacc[kb][0], Sacc[kb][1]), pk2(Sacc[kb][2], Sacc[kb][3])};
    }
    unsigned short zr[16], qr[16], vr[16]; v4u gr0 = (v4u){0u, 0u, 0u, 0u}, gr1 = gr0;
#define HG_LD(p_) (OUT ? __builtin_nontemporal_load(p_) : *(p_))
#define HG_LOAD() do { _Pragma("unroll") for (int j = 0; j < 16; ++j) { zr[j] = HG_LD(pz + (size_t)j * 4096); vr[j] = HG_LD(pv + (size_t)j * 4096); if (OUT) qr[j] = HG_LD(pq + (size_t)j * 4096); else qr[j] = 0; } \
        if (OUT) { gr0 = __builtin_nontemporal_load((const v4u*)pg); gr1 = __builtin_nontemporal_load((const v4u*)(pg + 8)); } pz += (size_t)64 * 4096; pq += (size_t)64 * 4096; pv += (size_t)64 * 4096; pg += (size_t)64 * 4096; } while (0)
    HG_LOAD();
    for (int c = 0; c < HCH; ++c) {
        float kk[16], cum[16], qf[16]; unsigned short vv[16]; const v4u g0 = gr0, g1 = gr1;
        float run = 0.f;
#pragma unroll
        for (int j = 0; j < 16; ++j) { const float z = bf2f(zr[j]); const float k = omlb * __builtin_amdgcn_rcpf(1.f + __expf(z)); run += __logf(1.f - k); cum[j] = run; kk[j] = k; qf[j] = bf2f(qr[j]); vv[j] = vr[j]; }
        TOT[rg * 128 + col] = run;
        if (c + 1 < HCH) HG_LOAD();
        LDS_WAIT(); __builtin_amdgcn_s_barrier(); asm volatile("" ::: "memory");
        const float t0 = TOT[col], t1 = TOT[128 + col], t2 = TOT[256 + col], t3 = TOT[384 + col];
        const float pre = (rg > 0 ? t0 : 0.f) + (rg > 1 ? t1 : 0.f) + (rg > 2 ? t2 : 0.f), tot = (t0 + t1) + (t2 + t3), mid = t0 + t1;
        Lacc += tot;
        unsigned khp[8], vvp[8];
#pragma unroll
        for (int j = 0; j < 16; ++j) { const float cj = pre + cum[j]; const int r = 16 * rg + j;
            if constexpr (OUT) { QH[r * RS + col] = f2b(qf[j] * __expf(cj)); QT[r * RS + col] = f2b(qf[j] * __expf(cj - mid)); KT[r * RS + col] = f2b(kk[j] * __expf(mid - cj)); }
            const unsigned short kh = f2b(kk[j] * __expf(tot - cj));
            if (j & 1) { khp[j >> 1] |= (unsigned)kh << 16; vvp[j >> 1] |= (unsigned)vv[j] << 16; } else { khp[j >> 1] = kh; vvp[j >> 1] = vv[j]; } }
        *(LAS v4u*)(KHT + col * RS2 + 16 * rg) = (v4u){khp[0], khp[1], khp[2], khp[3]}; *(LAS v4u*)(KHT + col * RS2 + 16 * rg + 8) = (v4u){khp[4], khp[5], khp[6], khp[7]};
        *(LAS v4u*)(VT + col * RS2 + 16 * rg) = (v4u){vvp[0], vvp[1], vvp[2], vvp[3]}; *(LAS v4u*)(VT + col * RS2 + 16 * rg + 8) = (v4u){vvp[4], vvp[5], vvp[6], vvp[7]};
        if (rg == 0) DV[col] = __expf(tot);
        LDS_WAIT(); __builtin_amdgcn_s_barrier(); asm volatile("" ::: "memory");
        if constexpr (OUT) {
            const int tb = wid >> 1;
#pragma unroll
            for (int ss = 0; ss < 2; ++ss) { const int sb = 2 * (wid & 1) + ss; f32x4 sc = (f32x4){0.f, 0.f, 0.f, 0.f};
                if (sb <= tb) {
#pragma unroll
                    for (int ks = 0; ks < 4; ++ks) { const bf16x8 a = *(const LAS bf16x8*)(QT + (16 * tb + fr) * RS + 32 * ks + 8 * fq), bq = *(const LAS bf16x8*)(KT + (16 * sb + fr) * RS + 32 * ks + 8 * fq); sc = mfma16(a, bq, sc); } }
#pragma unroll
                for (int i = 0; i < 4; ++i) { const int t = 16 * tb + 4 * fq + i, s = 16 * sb + fr; float pv_ = (sb <= tb && s <= t) ? sc[i] : 0.f; if (use_c0 && c == 0 && t == 0 && s == 0) pv_ = c0f; PP[t * RS2 + s] = f2b(pv_); } }
            LDS_WAIT(); __builtin_amdgcn_s_barrier(); asm volatile("" ::: "memory");
        }
        {   bf16x8 vtf[2];
#pragma unroll
            for (int ks = 0; ks < 2; ++ks) vtf[ks] = *(const LAS bf16x8*)(VT + (16 * wid + fr) * RS2 + 32 * ks + 8 * fq);
            if constexpr (OUT) { bf16x8 stf[4];
#pragma unroll
                for (int ks = 0; ks < 4; ++ks) stf[ks] = *(const LAS bf16x8*)(ST + (16 * wid + fr) * RS + 32 * ks + 8 * fq);
#pragma unroll
                for (int tb = 0; tb < 4; ++tb) { f32x4 o = (f32x4){0.f, 0.f, 0.f, 0.f};
#pragma unroll
                    for (int ks = 0; ks < 4; ++ks) o = mfma16(*(const LAS bf16x8*)(QH + (16 * tb + fr) * RS + 32 * ks + 8 * fq), stf[ks], o);
#pragma unroll
                    for (int ks = 0; ks < 2; ++ks) o = mfma16(*(const LAS bf16x8*)(PP + (16 * tb + fr) * RS2 + 32 * ks + 8 * fq), vtf[ks], o);
#pragma unroll
                    for (int i = 0; i < 4; ++i) OF[(16 * tb + 4 * fq + i) * OFS + 16 * wid + fr] = o[i]; } }
#pragma unroll
            for (int kb = 0; kb < 8; ++kb) { const f32x4 d4 = *(const LAS f32x4*)(DV + 16 * kb + 4 * fq); f32x4 s = Sacc[kb] * d4;
#pragma unroll
                for (int ks = 0; ks < 2; ++ks) s = mfma16(*(const LAS bf16x8*)(KHT + (16 * kb + fr) * RS2 + 32 * ks + 8 * fq), vtf[ks], s);
                Sacc[kb] = s; if constexpr (OUT) *(LAS v2u*)(ST + (16 * wid + fr) * RS + 16 * kb + 4 * fq) = (v2u){pk2(s[0], s[1]), pk2(s[2], s[3])}; }
        }
        if constexpr (OUT) {
            LDS_WAIT(); __builtin_amdgcn_s_barrier(); asm volatile("" ::: "memory");
            f32x4 o4[4]; float ss = 0.f;
#pragma unroll
            for (int j = 0; j < 4; ++j) { o4[j] = *(const LAS f32x4*)(OF + erow * OFS + 16 * eseg + 4 * j); ss += (o4[j].x * o4[j].x + o4[j].y * o4[j].y) + (o4[j].z * o4[j].z + o4[j].w * o4[j].w); }
            ss += __shfl_xor(ss, 1); ss += __shfl_xor(ss, 2); ss += __shfl_xor(ss, 4);
            const float rs = __builtin_amdgcn_rsqf(ss * (1.f / 128.f) + EPS);
            unsigned w[8];
#pragma unroll
            for (int j = 0; j < 4; ++j) { const unsigned ga = (j < 2) ? g0[2 * j] : g1[2 * (j - 2)], gb = (j < 2) ? g0[2 * j + 1] : g1[2 * (j - 2) + 1];
                const float a0 = pg8::bflo(ga), a1 = pg8::bfhi(ga), a2 = pg8::bflo(gb), a3 = pg8::bfhi(gb);
                w[2 * j] = pk2(o4[j].x * rs * a0 * pg8::fsigmoid(a0), o4[j].y * rs * a1 * pg8::fsigmoid(a1)); w[2 * j + 1] = pk2(o4[j].z * rs * a2 * pg8::fsigmoid(a2), o4[j].w * rs * a3 * pg8::fsigmoid(a3)); }
            *(v4u*)po = (v4u){w[0], w[1], w[2], w[3]}; *(v4u*)(po + 8) = (v4u){w[4], w[5], w[6], w[7]}; po += (size_t)64 * 4096;
        }
    }
#undef HG_LOAD
#undef HG_LD
    if constexpr (!OUT) {
        float* Es = Ebuf + ((size_t)(bh * HSEG + seg) * 64 * 64) * 4 + (size_t)(wid * 8) * 64 * 4;
#pragma unroll
        for (int kb = 0; kb < 8; ++kb) *(f32x4*)(Es + ((size_t)kb * 64 + lane) * 4) = Sacc[kb];
        if (rg == 0) Lbuf[(size_t)(bh * HSEG + seg) * 128 + col] = Lacc;
    }
    LDS_WAIT(); __builtin_amdgcn_s_barrier(); asm volatile("" ::: "memory");
}

__device__ __forceinline__ void cumsum_bh(LAS unsigned char* lds, const float* LOGF, float* C, int bh, int wave_s) {
    const int tid = tid_from(wave_s), lane = tid & 63, wid = tid >> 6, b = bh >> 4, h = bh & 15;
    LAS float* wsum = (LAS float*)lds;
    const float* src = LOGF + ((size_t)b * SEQ + 8 * tid) * 16 + h;
    float v[8]; float run = 0.f;
#pragma unroll
    for (int j = 0; j < 8; ++j) { run += src[j * 16]; v[j] = run; }
    float inc = run;
#pragma unroll
    for (int o = 1; o < 64; o <<= 1) { const float t = __shfl_up(inc, o); if (lane >= o) inc += t; }
    if (lane == 63) wsum[wid] = inc;
    LDS_WAIT(); __builtin_amdgcn_s_barrier(); asm volatile("" ::: "memory");
    float off = inc - run;
    for (int w = 0; w < wid; ++w) off += wsum[w];
    float* dst = C + (size_t)bh * SEQ + 8 * tid;
    *(f32x4*)dst = (f32x4){(off + v[0]) * LOG2E, (off + v[1]) * LOG2E, (off + v[2]) * LOG2E, (off + v[3]) * LOG2E};
    *(f32x4*)(dst + 4) = (f32x4){(off + v[4]) * LOG2E, (off + v[5]) * LOG2E, (off + v[6]) * LOG2E, (off + v[7]) * LOG2E};
    LDS_WAIT(); __builtin_amdgcn_s_barrier(); asm volatile("" ::: "memory");
}

#define RLX_AGENT __ATOMIC_RELAXED, __HIP_MEMORY_SCOPE_AGENT
#define XB_TMO      128
#define XB_XCNT(j)  (256  + 64 * (j))
#define XB_XSUB(j)  (1280 + 64 * (j))
#define XB_XGEN(j)  (2304 + 64 * (j))
#define XB_TOP      3328
#define XB_TOPGEN   3392
#define XCD_BAR_WORDS 3456
#define XB_SPIN_CAP (1u << 18)

__device__ __forceinline__ unsigned xb_ld(unsigned* p)              { return __hip_atomic_load(p, __ATOMIC_RELAXED, __HIP_MEMORY_SCOPE_AGENT); }
__device__ __forceinline__ unsigned xb_add(unsigned* p, unsigned v) { return __hip_atomic_fetch_add(p, v, __ATOMIC_RELAXED, __HIP_MEMORY_SCOPE_AGENT); }
__device__ __forceinline__ unsigned xb_xcc_id() { return (unsigned)__builtin_amdgcn_s_getreg((3 << 11) | 20) & 0xFu; }
#define XB_SPIN(cond, bar) do { unsigned _sp = 0; while (cond) { __builtin_amdgcn_s_sleep(1); \
    if ((++_sp & 255u) == 0u) { if (xb_ld(&(bar)[XB_TMO])) break; if (_sp > XB_SPIN_CAP) { atomicAdd(&(bar)[XB_TMO], 1u); break; } } } } while (0)

struct XcdBarrier {
    unsigned* bar; unsigned x;
    volatile LAS unsigned* st;
};

__device__ __forceinline__ XcdBarrier xcd_barrier_post(unsigned* bar, volatile LAS unsigned* st, bool is_t0) {
    XcdBarrier b; b.bar = bar; b.x = xb_xcc_id(); b.st = st;
    if (is_t0) (void)xb_add(&bar[XB_XCNT(b.x)], 1u);
    return b;
}
__device__ __forceinline__ void xcd_barrier_complete(unsigned* bar, unsigned x, unsigned& nloc, unsigned& nx) {
    const unsigned G = gridDim.x * gridDim.y * gridDim.z;
    unsigned sum, cnt, mine, sp = 0u;
    for (;;) {
        sum = 0u; cnt = 0u; mine = 0u;
#pragma unroll
        for (unsigned j = 0; j < 16; ++j) { const unsigned c = xb_ld(&bar[XB_XCNT(j)]); sum += c; cnt += (c > 0u) ? 1u : 0u; mine = (j == x) ? c : mine; }
        if (sum == G) break;
        __builtin_amdgcn_s_sleep(1);
        if ((++sp & 255u) == 0u) { if (xb_ld(&bar[XB_TMO])) break; if (sp > XB_SPIN_CAP) { atomicAdd(&bar[XB_TMO], 1u); break; } }
    }
    nloc = mine > 0u ? mine : 1u; nx = cnt > 0u ? cnt : 1u;
}

__device__ __forceinline__ void xcd_barrier(const XcdBarrier& b, bool is_t0) {
    asm volatile("s_waitcnt vmcnt(0)" ::: "memory");
    __syncthreads();
    if (is_t0) {
        unsigned* bar = b.bar;
        __builtin_amdgcn_s_waitcnt(0);
        unsigned nloc = b.st[0], nx = b.st[1];
        if (nloc == 0u) { xcd_barrier_complete(bar, b.x, nloc, nx); b.st[0] = nloc; b.st[1] = nx; }
        const unsigned old = xb_add(&bar[XB_XSUB(b.x)], 1u);
        const unsigned gen = old / nloc;
        if (old + 1u == (gen + 1u) * nloc) {
            __builtin_amdgcn_fence(__ATOMIC_RELEASE, "agent");
            asm volatile("s_waitcnt vmcnt(0)" ::: "memory");
            const unsigned og = xb_add(&bar[XB_TOP], 1u);
            const unsigned tg = og / nx;
            if (og + 1u == (tg + 1u) * nx) xb_add(&bar[XB_TOPGEN], 1u);
            else XB_SPIN(xb_ld(&bar[XB_TOPGEN]) == tg, bar);
            __builtin_amdgcn_fence(__ATOMIC_ACQUIRE, "agent");
            xb_add(&bar[XB_XGEN(b.x)], 1u);
            asm volatile("s_waitcnt vmcnt(0)" ::: "memory");
        } else {
            XB_SPIN(xb_ld(&bar[XB_XGEN(b.x)]) == gen, bar);
            __builtin_amdgcn_fence(__ATOMIC_ACQUIRE, "agent");
            asm volatile("s_waitcnt vmcnt(0)" ::: "memory");
        }
    }
    __syncthreads();
}

constexpr size_t WS_CTL = E_WEND * 2, CTL_BAR_BYTES = 16384, CTL_BYTES = CTL_BAR_BYTES + 16 * 2048 * 4;
constexpr size_t WS_XB0 = WS_BIG + 176 * MiB, WS_XB1 = WS_LOGF;
constexpr int LDS_BARST = LDS_BYTES - 64;

constexpr size_t WS_T0U = WS_CTL + 147456, WS_T0Y = WS_T0U + (size_t)8 * 2 * FF * 4, WS_T0Q = WS_T0Y + (size_t)8 * D * 4, WS_T0END = WS_T0Q + (size_t)8 * 2 * D * 4;
static_assert(WS_T0U % 256 == 0 && WS_T0END <= WS_P, "token-0 scratch fits below the p copy");
#define WG_BAR() do { LDS_WAIT(); __builtin_amdgcn_s_barrier(); asm volatile("" ::: "memory"); } while (0)
template <int NC, int K, int KS>
__device__ __forceinline__ void t0_gemv(const LAS float* in, LAS float* red, const float* W, int ldw, int N, float* out, int ldo, int bx, int G, int tid) {
    static_assert(NC * KS == 512 && K % KS == 0, "t0_gemv geometry");
    constexpr int KL = K / KS;
    const int col = tid % NC, ks = tid / NC;
    for (int c0 = bx * NC; c0 < N; c0 += G * NC) {
        float acc[8], wv[KL];
        const float* wp = W + (size_t)(ks * KL) * ldw + c0 + col; const LAS float* ip = in + ks * KL;
#pragma unroll
        for (int k = 0; k < KL; ++k) wv[k] = __builtin_nontemporal_load(wp + (size_t)k * ldw);
        constexpr int VEC = (KL % 4 == 0) ? 4 : 2;
        typedef float fvec_t __attribute__((ext_vector_type(VEC)));
#pragma unroll
        for (int r = 0; r < 8; ++r) { float s = 0.f;
#pragma unroll
            for (int k = 0; k < KL; k += VEC) { const fvec_t a = *(const LAS fvec_t*)(ip + r * K + k);
#pragma unroll
                for (int e = 0; e < VEC; ++e) s += a[e] * wv[k + e]; }
            acc[r] = s; }
#pragma unroll
        for (int r = 0; r < 8; ++r) red[(ks * 8 + r) * NC + col] = acc[r];
        WG_BAR();
        if (tid < 8 * NC) { const int r = tid / NC, c = tid % NC; float s = 0.f; for (int q = 0; q < KS; ++q) s += red[(q * 8 + r) * NC + c]; out[(size_t)r * ldo + c0 + c] = s; }
        WG_BAR();
    }
}
__device__ __forceinline__ void t0_stage_a(LAS unsigned char* lds, const float* x, const float* g1, const float* W, float* U, int bx, int G, int tid) {
    LAS float* a = (LAS float*)lds; LAS float* red = (LAS float*)(lds + 8 * D * 4);
    const int lane = tid & 63, w = tid >> 6;
    WG_BAR();
    { const f32x4* xr = (const f32x4*)(x + (size_t)w * SEQ * D) + lane; f32x4 v[4]; float s = 0.f;
#pragma unroll
      for (int j = 0; j < 4; ++j) { v[j] = xr[64 * j]; s += (v[j].x * v[j].x + v[j].y * v[j].y) + (v[j].z * v[j].z + v[j].w * v[j].w); }
      const float r = 1.0f / sqrtf(wave_sum(s) * (1.f / D) + EPS);
#pragma unroll
      for (int j = 0; j < 4; ++j) { const f32x4 g = *((const f32x4*)g1 + lane + 64 * j); *(LAS f32x4*)(a + w * D + 4 * (lane + 64 * j)) = v[j] * r * g; } }
    WG_BAR();
    t0_gemv<32, D, 16>(a, red, W, 2 * FF, 2 * FF, U, 2 * FF, bx, G, tid);
}
__device__ __forceinline__ void t0_stage_b(LAS unsigned char* lds, const float* U, const float* W, float* Y, int bx, int G, int tid) {
    LAS float* act = (LAS float*)lds; LAS float* red = (LAS float*)(lds + 8 * FF * 4);
    WG_BAR();
    for (int i = tid; i < 8 * FF; i += 512) { const int r = i / FF, j = i % FF; const float g = U[(size_t)r * 2 * FF + j], u = U[(size_t)r * 2 * FF + FF + j]; act[i] = g / (1.0f + __expf(-g)) * u; }
    WG_BAR();
    t0_gemv<4, FF, 128>(act, red, W, D, D, Y, D, bx, G, tid);
}
__device__ __forceinline__ void t0_stage_c(LAS unsigned char* lds, const float* x, const float* Y, const float* gpost, const float* gmix, const float* W, float* QZ, int bx, int G, int tid) {
    LAS float* xn = (LAS float*)lds; LAS float* red = (LAS float*)(lds + 8 * D * 4);
    const int lane = tid & 63, w = tid >> 6;
    WG_BAR();
    { const f32x4* xr = (const f32x4*)(x + (size_t)w * SEQ * D) + lane; const f32x4* yr = (const f32x4*)(Y + (size_t)w * D) + lane; f32x4 v[4], y[4]; float s = 0.f;
#pragma unroll
      for (int j = 0; j < 4; ++j) { v[j] = xr[64 * j]; y[j] = yr[64 * j]; s += (y[j].x * y[j].x + y[j].y * y[j].y) + (y[j].z * y[j].z + y[j].w * y[j].w); }
      const float r1 = 0.5f / sqrtf(wave_sum(s) * (1.f / D) + EPS); float s2 = 0.f;
#pragma unroll
      for (int j = 0; j < 4; ++j) { const f32x4 g = *((const f32x4*)gpost + lane + 64 * j); v[j] = v[j] + y[j] * r1 * g; s2 += (v[j].x * v[j].x + v[j].y * v[j].y) + (v[j].z * v[j].z + v[j].w * v[j].w); }
      const float r2 = 1.0f / sqrtf(wave_sum(s2) * (1.f / D) + EPS);
#pragma unroll
      for (int j = 0; j < 4; ++j) { const f32x4 g = *((const f32x4*)gmix + lane + 64 * j); *(LAS f32x4*)(xn + w * D + 4 * (lane + 64 * j)) = v[j] * r2 * g; } }
    WG_BAR();
    t0_gemv<8, D, 64>(xn, red, W, 4 * D, 2 * D, QZ, 2 * D, bx, G, tid);
}

struct Args { const float* in[25]; float* out; unsigned char* ws; int st_lo, st_hi; };
enum { ST_PRO, ST_F1I0, ST_F1O0, ST_RW00, ST_HIN, ST_HS1, ST_HS2, ST_HOUT, ST_RW01, ST_F2I0, ST_F2O0, ST_PP0, ST_RW02, ST_PG0, ST_RW03, ST_KVF, ST_F1I1, ST_CUM, ST_F1O1, ST_RW10, ST_QG, ST_ATT, ST_FOUT, ST_RW11, ST_F2I1, ST_F2O1, ST_PP1, ST_RW12, ST_PG1, ST_RW13, NSTEP };
#ifndef FUSE_MASK
#define FUSE_MASK 0x00
#endif
#define FUSED(b) (((FUSE_MASK) >> (b)) & 1)
__host__ __device__ constexpr bool sync_before(int s) { return !(s == ST_PRO || s == ST_PP0 || s == ST_F1I1 || s == ST_F1O1 || s == ST_PP1); }
enum { K_PRO = 0, K_FFN_IN, K_FFN_OUT, K_RW, K_HGRN_IN, K_HGRN, K_HGRN_OUT, K_PLE_PROJ, K_PLE_GATE, K_KVF, K_CUMSUM, K_QG, K_ATTN, K_FOX_OUT };

__global__ void __launch_bounds__(NWAVES * 64, 2) yoco_fwd(Args args) {
    extern __shared__ __attribute__((aligned(16))) unsigned char lds[];
    cg::grid_group grid = cg::this_grid();
    LAS unsigned char* ldsp = (LAS unsigned char*)lds;
    const int st_lo = args.st_lo, st_hi = args.st_hi;
    const int wave_s = __builtin_amdgcn_readfirstlane((int)(threadIdx.x >> 6));
    if (tid_from(wave_s) < 2) ((volatile LAS unsigned*)(ldsp + LDS_BARST))[tid_from(wave_s)] = 0u;
    __syncthreads();
    (void)xcd_barrier_post((unsigned*)(args.ws + WS_CTL), (volatile LAS unsigned*)(ldsp + LDS_BARST), tid_from(wave_s) == 0);
#define STEP_BEGIN(k) if (st_lo <= (k) && (k) < st_hi) { if ((k) > st_lo && sync_before(k)) { if (st_hi < 0) { asm volatile("s_waitcnt vmcnt(0) lgkmcnt(0)" ::: "memory"); grid.sync(); __builtin_amdgcn_fence(__ATOMIC_ACQUIRE, "agent"); asm volatile("s_waitcnt vmcnt(0)" ::: "memory"); }     \
          else { XcdBarrier xb_; xb_.bar = (unsigned*)(((const __attribute__((address_space(4))) Args*)__builtin_amdgcn_kernarg_segment_ptr())->ws + WS_CTL); xb_.x = xb_xcc_id(); xb_.st = (volatile LAS unsigned*)(ldsp + LDS_BARST); xcd_barrier(xb_, tid_from(wave_s) == 0); } } \
        const __attribute__((address_space(4))) Args* ap = (const __attribute__((address_space(4))) Args*)__builtin_amdgcn_kernarg_segment_ptr(); asm volatile("" : "+s"(ap)); \
        int tid_k = tid_from(wave_s); asm volatile("" : "+v"(tid_k)); const int tid = tid_k, lane = tid & 63, wave = __builtin_amdgcn_readfirstlane(tid >> 6); \
        const int G = gridDim.x, bx = blockIdx.x; unsigned char* ws = ap->ws; bfu* Wb = (bfu*)ws; bfu* PB = (bfu*)(ws + WS_P); float* LOGF = (float*)(ws + WS_LOGF); float* CL = (float*)(ws + WS_C); \
        bfu* AY = (bfu*)(ws + WS_AY); bfu* BIG = (bfu*)(ws + WS_BIG); bfu* PROJ = (bfu*)(ws + WS_PROJ); const int gw = bx * NWAVES + wave, ngw = G * NWAVES; \
        (void)tid; (void)lane; (void)Wb; (void)PB; (void)LOGF; (void)CL; (void)AY; (void)BIG; (void)PROJ; (void)gw; (void)ngw;
#define STEP_END }
#define RUN_GEMM(MODE, A_, LDA_, Bt_, N_, K_, O_, LDC_, O2_, AUX_, SC_) RUN_GEMM_ON(G, bx, MODE, A_, LDA_, Bt_, N_, K_, O_, LDC_, O2_, AUX_, SC_)
#define RUN_GEMM_ON(GS_, CS_, MODE, A_, LDA_, Bt_, N_, K_, O_, LDC_, O2_, AUX_, SC_) do { const pg8::Gemm g{A_, Bt_, T, N_, K_, LDA_}; pg8::StaticOrder S; S.init(T, N_, GS_, CS_); \
        const pg8::Epi<MODE, LDC_> E{O_, O2_, AUX_, LOGF, ap->in[18], SC_}; pg8::gemm_phase<pg8::Epi<MODE, LDC_>, pg8::StaticOrder, true, true, K_, LDA_>(ldsp, g, S, E, wave_s); } while (0)
#define NOB ((bfu*)nullptr)
#define S_FFN_IN(k, L, w)  STEP_BEGIN(k) if ((L) == 0 && (w) == 1) t0_stage_b(ldsp, (const float*)(ws + WS_T0U), ap->in[4], (float*)(ws + WS_T0Y), bx, G, tid); RUN_GEMM(pg8::EP_SWIGLU, AY, D, Wb + ((w) == 1 ? E_W1IN : E_W2IN) + (L) * N_WIN, 2 * FF, D, BIG, FF, NOB, NOB, 1.f); STEP_END
#define RUN_FUSED(PRE, WA, A_, LDA_, Bt_, K_, HIN_, AUX_, GAIN_, SCALE_, BANK_, XB_) do { \
        if (G != 256) { const float qn_ = __builtin_nanf(""); for (int m_ = gw; m_ < T; m_ += ngw) { f32x4* o_ = (f32x4*)(ap->out + (size_t)m_ * D) + lane; for (int j_ = 0; j_ < 4; ++j_) o_[64 * j_] = (f32x4){qn_, qn_, qn_, qn_}; } } \
        else { const pg8::Gemm g{A_, Bt_, T, D, K_, LDA_}; unsigned* cw_ = (unsigned*)(ws + WS_CTL + CTL_BAR_BYTES); \
            unsigned* xb_ = (unsigned*)((XB_) + (size_t)(BANK_) * MiB);     \
            const pg8::PanelSS s1_{xb_, cw_ + ((BANK_) * 2 + 0) * 2048, EPS}, s2_{xb_ + (size_t)T * 4, cw_ + ((BANK_) * 2 + 1) * 2048, EPS}; \
            const pg8::EpiRmsRes<PRE, WA> E{HIN_, ap->out, AY, AUX_, GAIN_, SCALE_, s1_, s2_}; \
            for (int p_ = 0; p_ < 2; ++p_) { const pg8::HalfOrder S{p_, bx}; pg8::gemm_phase<pg8::EpiRmsRes<PRE, WA>, pg8::HalfOrder, false, true, K_, LDA_>(ldsp, g, S, E, wave_s); } } } while (0)
#define S_FFN_OUT(k, L, w) STEP_BEGIN(k) if (FUSED((L) * 4 + ((w) == 1 ? 0 : 2))) RUN_FUSED(0, true, BIG, FF, Wb + ((w) == 1 ? E_W1OUT : E_W2OUT) + (L) * N_WOUT, FF, (((L) == 0 && (w) == 1) ? ap->in[0] : (const float*)ap->out), NOB, \
        ((w) == 1 ? ap->in[5] : ap->in[11]) + (L) * D, 0.5f, (L) * 4 + ((w) == 1 ? 0 : 2), ws + WS_XB0); \
        else RUN_GEMM(pg8::EP_PLAIN, BIG, FF, Wb + ((w) == 1 ? E_W1OUT : E_W2OUT) + (L) * N_WOUT, D, FF, AY, D, NOB, NOB, 1.f); STEP_END
#define S_PLE_PROJ(k, L)   STEP_BEGIN(k) RUN_GEMM(pg8::EP_PLAIN, PB + (size_t)(L) * T * PLE, PLE, Wb + E_WPP + (size_t)(L) * PLE * D, D, PLE, PROJ, D, NOB, NOB, 1.f); STEP_END
#define S_PLE_GATE(k, L)   STEP_BEGIN(k) if (FUSED((L) * 4 + 3)) RUN_FUSED(1, ((L) == 0), AY, D, Wb + E_WPG + (size_t)(L) * D * D, D, (const float*)ap->out, PROJ, ap->in[24] + (L) * D, 1.0f, (L) * 4 + 3, ws + WS_XB0); \
        else RUN_GEMM(pg8::EP_PLEGATE, AY, D, Wb + E_WPG + (size_t)(L) * D * D, D, D, BIG, D, NOB, PROJ, 1.f); STEP_END
#define S_RW(k, L, w, b)   STEP_BEGIN(k) if (!FUSED(b)) { const float* hin = ((L) == 0 && (w) == 0) ? ap->in[0] : ap->out; const bfu* Y = ((w) == 3) ? BIG : AY; \
        const float* gain = ((w) == 0 ? ap->in[5] : (w) == 1 ? ap->in[7] : (w) == 2 ? ap->in[11] : ap->in[24]) + (L) * D; \
        rw_phase<!((L) == 1 && (w) == 3)>(hin, ap->out, Y, AY, gain, ((w) == 0 || (w) == 2) ? 0.5f : 1.0f, gw, ngw, lane); } STEP_END

    STEP_BEGIN(ST_PRO) {
        LAS float* scr = (LAS float*)(ldsp + wave * 16384);
        for (int it = gw;; it += ngw) {
            int r = it;
#define CONV(src, K_, N_, dst, gain, gmask, sw) { constexpr int NI = ((K_) / 64) * (((N_) + 31) / 32); if (r < NI) { conv_item(src, K_, N_, dst, gain, gmask, sw, scr, r, lane); continue; } r -= NI; }
            CONV(ap->in[3], D, 2 * FF, Wb + E_W1IN, ap->in[2], 1023, 1)
            CONV(ap->in[3] + N_WIN, D, 2 * FF, Wb + E_W1IN + N_WIN, ap->in[2] + D, 1023, 1)
            CONV(ap->in[9], D, 2 * FF, Wb + E_W2IN, ap->in[8], 1023, 1)
            CONV(ap->in[9] + N_WIN, D, 2 * FF, Wb + E_W2IN + N_WIN, ap->in[8] + D, 1023, 1)
            CONV(ap->in[4], FF, D, Wb + E_W1OUT, (const float*)nullptr, 0, 0)
            CONV(ap->in[4] + N_WOUT, FF, D, Wb + E_W1OUT + N_WOUT, (const float*)nullptr, 0, 0)
            CONV(ap->in[10], FF, D, Wb + E_W2OUT, (const float*)nullptr, 0, 0)
            CONV(ap->in[10] + N_WOUT, FF, D, Wb + E_W2OUT + N_WOUT, (const float*)nullptr, 0, 0)
            CONV(ap->in[12], D, 4 * D, Wb + E_WHIN, ap->in[6], 1023, 0)
            CONV(ap->in[15], D, D, Wb + E_WHOUT, ap->in[14], 127, 0)
            CONV(ap->in[17], D, NKVF, Wb + E_WKVF, ap->in[16], 1023, 0)
            CONV(ap->in[19], D, 2 * D, Wb + E_WQG, ap->in[6] + D, 1023, 0)
            CONV(ap->in[20], D, D, Wb + E_WFO, (const float*)nullptr, 0, 0)
            CONV(ap->in[22], D, D, Wb + E_WPG, ap->in[21], 1023, 0)
            CONV(ap->in[22] + (size_t)D * D, D, D, Wb + E_WPG + (size_t)D * D, ap->in[21] + D, 1023, 0)
            CONV(ap->in[23], PLE, D, Wb + E_WPP, (const float*)nullptr, 0, 0)
            CONV(ap->in[23] + (size_t)PLE * D, PLE, D, Wb + E_WPP + (size_t)PLE * D, (const float*)nullptr, 0, 0)
#undef CONV
            break;
        }
        {   const float* p = ap->in[1]; const size_t n8 = (size_t)2 * T * PLE / 8;
            for (size_t i = (size_t)bx * 512 + tid; i < n8; i += (size_t)G * 512) { const f32x4 a = __builtin_nontemporal_load((const f32x4*)p + 2 * i), c = __builtin_nontemporal_load((const f32x4*)p + 2 * i + 1);
                __builtin_nontemporal_store((v4u){pk2(a.x, a.y), pk2(a.z, a.w), pk2(c.x, c.y), pk2(c.z, c.w)}, (v4u*)PB + i); } }
        const float* x = ap->in[0];
        for (int m = gw; m < T; m += 2 * ngw) { rms_row_to_bf16(x + (size_t)m * D, AY + (size_t)m * D, lane); if (m + ngw < T) rms_row_to_bf16(x + (size_t)(m + ngw) * D, AY + (size_t)(m + ngw) * D, lane); }
        t0_stage_a(ldsp, x, ap->in[2], ap->in[3], (float*)(ws + WS_T0U), bx, G, tid);
    } STEP_END
    S_FFN_IN(ST_F1I0, 0, 1) S_FFN_OUT(ST_F1O0, 0, 1) S_RW(ST_RW00, 0, 0, 0)
    STEP_BEGIN(ST_HIN) RUN_GEMM(pg8::EP_PLAIN, AY, D, Wb + E_WHIN, 4 * D, D, BIG, 4 * D, NOB, NOB, 1.f); STEP_END
    STEP_BEGIN(ST_HS1) { const float* lbl = ap->in[13]; float* Eb = (float*)AY; float* Lb = (float*)(ws + WS_AY + 32 * MiB);
        for (int it = bx; it < BATCH * 8 * HSEG; it += G) if ((it & 3) != 3) hgrn_scan<false>(ldsp, BIG, lbl, it >> 2, it & 3, Eb, Lb, wave_s);
        const bool side = (G >= 256) ? ((bx & 3) == 3 && bx < 256) : true; const int gs = (G >= 256) ? 64 : G, cs = (G >= 256) ? (bx >> 2) : bx;
        if (side) t0_stage_c(ldsp, ap->in[0], (const float*)(ws + WS_T0Y), ap->in[5], ap->in[6], ap->in[12], (float*)(ws + WS_T0Q), cs, gs, tid); } STEP_END
    STEP_BEGIN(ST_HS2) { const float* lbl = ap->in[13]; float* Eb = (float*)AY; float* Lb = (float*)(ws + WS_AY + 32 * MiB);
        for (int it = bx; it < BATCH * 8 * HSEG; it += G) hgrn_scan<true>(ldsp, BIG, lbl, it >> 2, it & 3, Eb, Lb, wave_s, (const float*)(ws + WS_T0Q)); } STEP_END
    STEP_BEGIN(ST_HOUT) if (FUSED(1)) RUN_FUSED(0, true, BIG, 4 * D, Wb + E_WHOUT, D, (const float*)ap->out, NOB, ap->in[7], 1.0f, 1, ws + WS_XB1);
        else RUN_GEMM(pg8::EP_PLAIN, BIG, 4 * D, Wb + E_WHOUT, D, D, AY, D, NOB, NOB, 1.f); STEP_END
    S_RW(ST_RW01, 0, 1, 1) S_FFN_IN(ST_F2I0, 0, 2) S_FFN_OUT(ST_F2O0, 0, 2) S_PLE_PROJ(ST_PP0, 0) S_RW(ST_RW02, 0, 2, 2) S_PLE_GATE(ST_PG0, 0) S_RW(ST_RW03, 0, 3, 3)
    STEP_BEGIN(ST_KVF) RUN_GEMM(pg8::EP_KVF, AY, D, Wb + E_WKVF, NKVFP, D, (bfu*)(ws + WS_K), D, (bfu*)(ws + WS_V), NOB, 1.f); STEP_END
    S_FFN_IN(ST_F1I1, 1, 1)
    STEP_BEGIN(ST_CUM) { for (int bh = bx; bh < BATCH * 16; bh += G) cumsum_bh(ldsp, LOGF, CL, bh, wave_s); } STEP_END
    S_FFN_OUT(ST_F1O1, 1, 1) S_RW(ST_RW10, 1, 0, 4)
    STEP_BEGIN(ST_QG) RUN_GEMM(pg8::EP_QG, AY, D, Wb + E_WQG, 2 * D, D, (bfu*)(ws + WS_Q), D, (bfu*)(ws + WS_G), NOB, attn_body::C2); STEP_END
    STEP_BEGIN(ST_ATT) {
        const attn_body::AttnTensors AT{(const attn_body::bf16*)(ws + WS_Q), (const attn_body::bf16*)(ws + WS_K), (const attn_body::bf16*)(ws + WS_V), (attn_body::bf16*)(ws + WS_Q), (const attn_body::bf16*)(ws + WS_G), CL};
        const attn_body::StaticOrder S(G, bx);
        attn_body::attn_phase<attn_body::StaticOrder>((char*)lds, AT, S, wave_s);
    } STEP_END
    STEP_BEGIN(ST_FOUT) if (FUSED(5)) RUN_FUSED(0, true, (const bfu*)(ws + WS_Q), D, Wb + E_WFO, D, (const float*)ap->out, NOB, ap->in[7] + D, 1.0f, 5, ws + WS_XB0);
        else RUN_GEMM(pg8::EP_PLAIN, (const bfu*)(ws + WS_Q), D, Wb + E_WFO, D, D, AY, D, NOB, NOB, 1.f); STEP_END
    S_RW(ST_RW11, 1, 1, 5) S_FFN_IN(ST_F2I1, 1, 2) S_FFN_OUT(ST_F2O1, 1, 2) S_PLE_PROJ(ST_PP1, 1) S_RW(ST_RW12, 1, 2, 6) S_PLE_GATE(ST_PG1, 1) S_RW(ST_RW13, 1, 3, 7)
}

#ifndef MK_MULTI
#define MK_MULTI 0
#endif
extern "C" void kernel_launch(void* const* d_in, const int* in_sizes, int n_in, void* d_out, int out_size, void* d_ws, size_t ws_size, hipStream_t stream) {
    static int grid = 0;
    if (grid == 0) {
        if (n_in != 25 || out_size != T * D || ws_size < WS_END) { fprintf(stderr, "kernel_launch: unexpected shapes (n_in %d out %d ws %zu)\n", n_in, out_size, ws_size); grid = -1; return; }
        int dev = 0, cus = 0, per_cu = 0;
        (void)hipGetDevice(&dev); (void)hipDeviceGetAttribute(&cus, hipDeviceAttributeMultiprocessorCount, dev);
        if (hipFuncSetAttribute((const void*)yoco_fwd, hipFuncAttributeMaxDynamicSharedMemorySize, LDS_BYTES) != hipSuccess) { fprintf(stderr, "kernel_launch: hipFuncSetAttribute failed\n"); grid = -1; return; }
        if (hipOccupancyMaxActiveBlocksPerMultiprocessor(&per_cu, (const void*)yoco_fwd, NWAVES * 64, LDS_BYTES) != hipSuccess || per_cu < 1) per_cu = 1;
        (void)hipGetLastError();
        if (cus <= 0) cus = 256;
        grid = cus * per_cu;
    }
    if (grid < 0) return;
    if (hipMemsetAsync((char*)d_ws + WS_CTL, 0, CTL_BYTES, stream) != hipSuccess) { fprintf(stderr, "kernel_launch: memset failed\n"); return; }
    Args a{};
    for (int i = 0; i < 25; ++i) a.in[i] = (const float*)d_in[i];
    a.out = (float*)d_out; a.ws = (unsigned char*)d_ws;
#ifndef ST_CUT
#define ST_CUT NSTEP
    a.st_lo = 0; a.st_hi = ST_CUT;
    void* kargs[] = {&a};
    const hipError_t e = hipLaunchCooperativeKernel((const void*)yoco_fwd, dim3(grid), dim3(NWAVES * 64), kargs, LDS_BYTES, stream);
    if (e != hipSuccess) fprintf(stderr, "kernel_launch: cooperative launch failed: %s (grid %d)\n", hipGetErrorString(e), grid);
#endif
}
```

```cpp
#include <hip/hip_runtime.h>
#include <hip/hip_cooperative_groups.h>
#include <hip/hip_bf16.h>
#include <cstdio>
#include <cstdint>
#include <cmath>
namespace cg = cooperative_groups;
__device__ __forceinline__ int tid_from(int wave_s) { unsigned l; asm volatile("v_mbcnt_lo_u32_b32 %0, -1, 0\n\tv_mbcnt_hi_u32_b32 %0, -1, %0" : "=v"(l)); return wave_s * 64 + (int)l; }
namespace pg8 {
#define PG8_LAS __attribute__((address_space(3)))
typedef unsigned short bf16_t;
typedef short bf16x8 __attribute__((ext_vector_type(8)));
typedef float f32x4 __attribute__((ext_vector_type(4)));
typedef unsigned u32x4 __attribute__((ext_vector_type(4)));
constexpr int BM = 256, BK = 64, HALF = 128, HTB = HALF * BK * 2  , STAGE_BYTES = 8 * HTB, NXCD = 8, WGM = 8;

__host__ __device__ __forceinline__ int lds_byte(int r, int c) { const int st = (r >> 4) * 2 + (c >> 5), rr = r & 15, cc = c & 31, ob = rr * 64 + cc * 2; return st * 1024 + (ob ^ (((ob >> 9) & 1) << 5)); }
__host__ __device__ __forceinline__ void stage_rc(int b, int& R, int& C) { const int st = b / 1024, sb = b % 1024, swz = sb ^ (((sb >> 9) & 1) << 5); R = (st >> 1) * 16 + swz / 64; C = (st & 1) * 32 + (swz % 64) / 2; }
__host__ __device__ __forceinline__ int perm32(int rho) { const int n = rho >> 4, i = rho & 15; return 8 * (i >> 2) + 4 * n + (i & 3); }

struct Unit { int pm, pn; };
struct Gemm { const bf16_t* A; const bf16_t* Bt; int M, N, K, lda; };

struct StaticOrder {
    int nM, nN, nwg, G, c;
    __host__ __device__ void init(int M, int N, int G_, int c_) { nM = M / BM; nN = N / BM; nwg = nM * nN; G = G_; c = c_; }
    __host__ __device__ bool next(int i, Unit& u) const {
        const long L = (long)i * G + c; if (L >= nwg) return false;
        int wgid = (int)L; { const int q = nwg / NXCD, r = nwg % NXCD, xcd = wgid % NXCD, off = wgid / NXCD; wgid = (xcd < r ? xcd * (q + 1) : r * (q + 1) + (xcd - r) * q) + off; }
        const int nig = WGM * nN, gid = wgid / nig, fm = gid * WGM, gsz = (nM - fm) < WGM ? (nM - fm) : WGM;
        u.pm = fm + ((wgid % nig) % gsz); u.pn = (wgid % nig) / gsz; return true;
    }
    __device__ __forceinline__ void a_ready(const Unit&) const {}
    __device__ __forceinline__ void done(const Unit&) const {}
};

typedef float f32x2cv __attribute__((ext_vector_type(2))); typedef __bf16 bf16x2cv __attribute__((ext_vector_type(2)));
__device__ __forceinline__ unsigned cvt_pk_bf16_asm(float lo, float hi) { unsigned r; asm volatile("v_cvt_pk_bf16_f32 %0, %1, %2" : "=v"(r) : "v"(lo), "v"(hi)); return r; }
__device__ __forceinline__ unsigned cvt_pk_bf16(float lo, float hi) { const f32x2cv v = {lo, hi}; const bf16x2cv b = __builtin_convertvector(v, bf16x2cv); return __builtin_bit_cast(unsigned, b); }
enum { EP_PLAIN = 0, EP_SWIGLU = 1, EP_KVF = 2, EP_QG = 3, EP_PLEGATE = 4 };
__device__ __forceinline__ float fsigmoid(float x) { return __builtin_amdgcn_rcpf(1.0f + __builtin_amdgcn_exp2f(-1.4426950408889634f * x)); }
__device__ __forceinline__ float bflo(unsigned w) { return __uint_as_float(w << 16); }
__device__ __forceinline__ float bfhi(unsigned w) { return __uint_as_float(w & 0xffff0000u); }
template <int MODE, int LDC> struct Epi {
    static constexpr bool PERM = true, AFTER_DRAIN = false;
    bf16_t* O; bf16_t* O2; const bf16_t* aux; float* lf; const float* bfp; float scale0; static constexpr int ldc = LDC;
    __device__ __forceinline__ void operator()(const f32x4 (&acc)[2][2][4][2], const Unit& u, int wr, int wc, int fr, int fq) const {
        asm volatile("s_nop 15\n\ts_nop 15" ::: "memory");
        const int row0 = u.pm * BM + wr * 64 + fr;
        if constexpr (MODE == EP_SWIGLU) {
            const int col0 = u.pn * HALF + wc * 32 + 8 * fq;
#pragma unroll
            for (int ai = 0; ai < 2; ++ai)
#pragma unroll
                for (int m = 0; m < 4; ++m) { bf16_t* rowp = O + (size_t)(row0 + ai * HALF + m * 16) * ldc + col0;
                    const f32x4 g0 = acc[ai][0][m][0], g1 = acc[ai][0][m][1], u0 = acc[ai][1][m][0], u1 = acc[ai][1][m][1]; f32x4 v0, v1;
#pragma unroll
                    for (int j = 0; j < 4; ++j) { v0[j] = g0[j] * fsigmoid(g0[j]) * u0[j]; v1[j] = g1[j] * fsigmoid(g1[j]) * u1[j]; }
                    u32x4 w; w.x = cvt_pk_bf16_asm(v0[0], v0[1]); w.y = cvt_pk_bf16_asm(v0[2], v0[3]); w.z = cvt_pk_bf16_asm(v1[0], v1[1]); w.w = cvt_pk_bf16_asm(v1[2], v1[3]);
                    *(u32x4*)rowp = w; }
        } else {
            bf16_t* base = O; int colt = u.pn * BM; int kind = 0; float sc = 1.f;
            if constexpr (MODE == EP_KVF) { if (u.pn >= 8) kind = 2; else if (u.pn >= 4) { base = O2; colt -= 1024; } }
            if constexpr (MODE == EP_QG) { if (u.pn >= 4) { base = O2; colt -= 1024; kind = 1; } else sc = scale0; }
            if (MODE == EP_KVF && kind == 2) {
                if (wc == 0 && fq < 2) {
#pragma unroll
                    for (int ai = 0; ai < 2; ++ai)
#pragma unroll
                        for (int m = 0; m < 4; ++m) { float* lp = lf + (size_t)(row0 + ai * HALF + m * 16) * 16 + 8 * fq;
#pragma unroll
                            for (int n = 0; n < 2; ++n) { const f32x4 a = acc[ai][0][m][n]; f32x4 o;
#pragma unroll
                                for (int j = 0; j < 4; ++j) { const float x = a[j] + bfp[8 * fq + 4 * n + j]; o[j] = fminf(x, 0.f) - __logf(1.0f + __expf(-fabsf(x))); }
                                *(f32x4*)(lp + 4 * n) = o; } }
                }
                return;
            }
            const int col0 = colt + wc * 32 + 8 * fq;
#pragma unroll
            for (int ai = 0; ai < 2; ++ai)
#pragma unroll
                for (int m = 0; m < 4; ++m) { const size_t roff = (size_t)(row0 + ai * HALF + m * 16) * ldc + col0;
#pragma unroll
                    for (int bj = 0; bj < 2; ++bj) { f32x4 v0 = acc[ai][bj][m][0], v1 = acc[ai][bj][m][1];
                        if (MODE == EP_QG && kind == 1) {
#pragma unroll
                            for (int j = 0; j < 4; ++j) { v0[j] = fsigmoid(v0[j]); v1[j] = fsigmoid(v1[j]); } }
                        else if (MODE == EP_QG) { v0 = v0 * sc; v1 = v1 * sc; }
                        if constexpr (MODE == EP_PLEGATE) { const u32x4 pq = __builtin_nontemporal_load((const u32x4*)(aux + roff + bj * HALF));
                            v0[0] = fsigmoid(v0[0]) * bflo(pq.x); v0[1] = fsigmoid(v0[1]) * bfhi(pq.x); v0[2] = fsigmoid(v0[2]) * bflo(pq.y); v0[3] = fsigmoid(v0[3]) * bfhi(pq.y);
                            v1[0] = fsigmoid(v1[0]) * bflo(pq.z); v1[1] = fsigmoid(v1[1]) * bfhi(pq.z); v1[2] = fsigmoid(v1[2]) * bflo(pq.w); v1[3] = fsigmoid(v1[3]) * bfhi(pq.w); }
                        u32x4 w; w.x = cvt_pk_bf16_asm(v0[0], v0[1]); w.y = cvt_pk_bf16_asm(v0[2], v0[3]); w.z = cvt_pk_bf16_asm(v1[0], v1[1]); w.w = cvt_pk_bf16_asm(v1[2], v1[3]);
                        if (MODE == EP_PLAIN && LDC == 4096 && (u.pn < 4 || u.pn >= 12)) __builtin_nontemporal_store(w, (u32x4*)(base + roff + bj * HALF));
                        else *(u32x4*)(base + roff + bj * HALF) = w; } }
        }
    }
};

struct PanelSS {
    unsigned* xbuf;
    unsigned* cnt;
    float eps;
    __device__ __forceinline__ bool run(const f32x4 (&v)[2][2][4][2], const Unit& u, int wr, int wc, int fr, int fq, PG8_LAS unsigned char* lds, int wid, int lane) const {
        PG8_LAS float* P = (PG8_LAS float*)lds;
        PG8_LAS float* S = (PG8_LAS float*)(lds + 4096);
        PG8_LAS unsigned* flag = (PG8_LAS unsigned*)(lds + 4096 + 1024);
#pragma unroll
        for (int ai = 0; ai < 2; ++ai)
#pragma unroll
            for (int m = 0; m < 4; ++m) {
                float s = 0.f;
#pragma unroll
                for (int bj = 0; bj < 2; ++bj)
#pragma unroll
                    for (int n = 0; n < 2; ++n) { const f32x4 x = v[ai][bj][m][n]; s += (x[0] * x[0] + x[1] * x[1]) + (x[2] * x[2] + x[3] * x[3]); }
                s += __shfl_xor(s, 16); s += __shfl_xor(s, 32);
                if (fq == 0) P[(ai * HALF + wr * 64 + m * 16 + fr) * 4 + wc] = s;
            }
        asm volatile("s_waitcnt lgkmcnt(0)" ::: "memory"); __builtin_amdgcn_s_barrier(); asm volatile("" ::: "memory");
        const int row = wid * 32 + (lane & 31);
        if (lane < 32) {
            const float t = (P[row * 4 + 0] + P[row * 4 + 1]) + (P[row * 4 + 2] + P[row * 4 + 3]);
            __hip_atomic_store(xbuf + ((size_t)(u.pm * BM + row) * 4 + u.pn), __float_as_uint(t), __ATOMIC_RELAXED, __HIP_MEMORY_SCOPE_AGENT);
        }
        asm volatile("s_waitcnt vmcnt(0)" ::: "memory");
        if (lane == 0) __hip_atomic_fetch_add(cnt + 16 * u.pm, 1u, __ATOMIC_RELAXED, __HIP_MEMORY_SCOPE_AGENT);
        if (wid == 0) {
            bool dead = false; const unsigned long long t0 = __builtin_amdgcn_s_memrealtime();
            for (;;) {
                if ((unsigned)__builtin_amdgcn_readfirstlane(__hip_atomic_load(cnt + 16 * u.pm, __ATOMIC_RELAXED, __HIP_MEMORY_SCOPE_AGENT)) >= 32u) break;
                if (__builtin_amdgcn_s_memrealtime() - t0 > 20000000ull) { dead = true; break; }
                __builtin_amdgcn_s_sleep(2);
            }
            __builtin_amdgcn_fence(__ATOMIC_ACQUIRE, "agent");
            if (lane == 0) flag[0] = dead ? 1u : 0u;
        }
        asm volatile("s_waitcnt vmcnt(0) lgkmcnt(0)" ::: "memory"); __builtin_amdgcn_s_barrier(); asm volatile("" ::: "memory");
        const bool bad = flag[0] != 0u;
        if (lane < 32) {
            const unsigned* slot = xbuf + (size_t)(u.pm * BM + row) * 4; float q = 0.f;
#pragma unroll
            for (int t = 0; t < 4; ++t) q += __uint_as_float(__hip_atomic_load(slot + t, __ATOMIC_RELAXED, __HIP_MEMORY_SCOPE_AGENT));
            S[row] = __builtin_amdgcn_rsqf(q * (1.0f / 1024.0f) + eps);
        }
        asm volatile("s_waitcnt lgkmcnt(0)" ::: "memory"); __builtin_amdgcn_s_barrier(); asm volatile("" ::: "memory");
        return bad;
    }
};
template <int PRE, bool WRITE_A> struct EpiRmsRes {
    static constexpr bool PERM = false, AFTER_DRAIN = true;
    const float* base; float* out; bf16_t* xn; const bf16_t* aux; const float* gain; float scale; PanelSS st1, st2;
    __device__ __forceinline__ void fused(f32x4 (&acc)[2][2][4][2], const Unit& u, int wr, int wc, int fr, int fq, PG8_LAS unsigned char* lds, int wid, int lane) const {
        typedef unsigned u32x2v __attribute__((ext_vector_type(2)));
        const PG8_LAS float* S = (const PG8_LAS float*)(lds + 4096);
        const int col0 = u.pn * BM + wc * 32 + 4 * fq;
        if constexpr (PRE == 1) {
#pragma unroll
            for (int ai = 0; ai < 2; ++ai)
#pragma unroll
                for (int m = 0; m < 4; ++m) { const size_t off = (size_t)(u.pm * BM + ai * HALF + wr * 64 + m * 16 + fr) * 1024 + col0;
#pragma unroll
                    for (int bj = 0; bj < 2; ++bj)
#pragma unroll
                        for (int n = 0; n < 2; ++n) { const u32x2v pq = *(const u32x2v*)(aux + off + bj * HALF + n * 16); f32x4 a = acc[ai][bj][m][n];
                            a[0] = fsigmoid(a[0]) * bflo(pq.x); a[1] = fsigmoid(a[1]) * bfhi(pq.x); a[2] = fsigmoid(a[2]) * bflo(pq.y); a[3] = fsigmoid(a[3]) * bfhi(pq.y); acc[ai][bj][m][n] = a; }
                    if (m & 1) asm volatile("" ::: "memory"); }
        }
        bool bad = st1.run(acc, u, wr, wc, fr, fq, lds, wid, lane);
        const float qnan = __builtin_nanf("");
        f32x4 gv[2][2];
#pragma unroll
        for (int bj = 0; bj < 2; ++bj)
#pragma unroll
            for (int n = 0; n < 2; ++n) gv[bj][n] = *(const f32x4*)(gain + col0 + bj * HALF + n * 16) * scale;
#pragma unroll
        for (int ai = 0; ai < 2; ++ai)
#pragma unroll
            for (int m = 0; m < 4; ++m) { const int r = ai * HALF + wr * 64 + m * 16 + fr; const float sr = S[r]; const size_t off = (size_t)(u.pm * BM + r) * 1024 + col0;
#pragma unroll
                for (int bj = 0; bj < 2; ++bj)
#pragma unroll
                    for (int n = 0; n < 2; ++n) { const f32x4 bs = *(const f32x4*)(base + off + bj * HALF + n * 16); acc[ai][bj][m][n] = bs + acc[ai][bj][m][n] * sr * gv[bj][n]; }
                asm volatile("" : "+v"(acc[ai][0][m][0]), "+v"(acc[ai][0][m][1]), "+v"(acc[ai][1][m][0]), "+v"(acc[ai][1][m][1]));
                if (m & 1) asm volatile("" ::: "memory"); }
        if constexpr (WRITE_A) bad = st2.run(acc, u, wr, wc, fr, fq, lds, wid, lane) || bad;
#pragma unroll
        for (int ai = 0; ai < 2; ++ai)
#pragma unroll
            for (int m = 0; m < 4; ++m) { const int r = ai * HALF + wr * 64 + m * 16 + fr; const float sr = WRITE_A ? S[r] : 0.f; const size_t off = (size_t)(u.pm * BM + r) * 1024 + col0;
#pragma unroll
                for (int bj = 0; bj < 2; ++bj)
#pragma unroll
                    for (int n = 0; n < 2; ++n) { const f32x4 x1 = acc[ai][bj][m][n]; *(f32x4*)(out + off + bj * HALF + n * 16) = bad ? (f32x4){qnan, qnan, qnan, qnan} : x1;
                        if constexpr (WRITE_A) { const f32x4 o = x1 * sr; u32x2v w; w.x = cvt_pk_bf16(o[0], o[1]); w.y = cvt_pk_bf16(o[2], o[3]);
                            if (bad) { w.x = 0x7fc07fc0u; w.y = 0x7fc07fc0u; } *(u32x2v*)(xn + off + bj * HALF + n * 16) = w; } }
                asm volatile("" ::: "memory"); }
        asm volatile("s_waitcnt lgkmcnt(0)" ::: "memory"); __builtin_amdgcn_s_barrier(); asm volatile("" ::: "memory");
    }
};
struct HalfOrder {
    int p, c;
    __device__ __forceinline__ bool next(int i, Unit& u) const { if (i > 0) return false; const int x = c & 7, k = c >> 3; u.pn = k & 3; u.pm = 64 * p + 8 * (k >> 2) + x; return true; }
    __device__ __forceinline__ void a_ready(const Unit&) const {}
    __device__ __forceinline__ void done(const Unit&) const {}
};

template <class Epi, class Sched, bool ALIGN_EPI, bool SP2, int KC, int LDA>
__device__ __forceinline__ void gemm_phase(PG8_LAS unsigned char* lds, const Gemm g, const Sched& S, const Epi& E, int wave_s) {
    int tid_o = tid_from(wave_s); asm volatile("" : "+v"(tid_o)); const int tid = tid_o, wid = __builtin_amdgcn_readfirstlane(tid >> 6), lane = tid & 63, wr = wid >> 2, wc = wid & 3, fr = lane & 15, fq = lane >> 4;
    constexpr int K = KC, nt = K / BK;
    unsigned voffA[2], voffB[2];
#pragma unroll
    for (int i = 0; i < 2; ++i) { int R, C; stage_rc(tid * 16 + i * 8192, R, C); const int Rb = Epi::PERM ? ((R & ~31) + perm32(R & 31)) : R;
        voffA[i] = (unsigned)(R * LDA + C) * 2u; voffB[i] = (unsigned)(Rb * K + C) * 2u; }
    const size_t kstep = (size_t)(BK * 2);
    const size_t hstep = (size_t)HALF * K * 2;
    const size_t tstep = 2 * hstep; const size_t hstepA = (size_t)HALF * LDA * 2, tstepA = 2 * hstepA;
    const unsigned ldsw = (unsigned)wid * 1024u;
    const int aoff = lds_byte(wr * 64 + fr, fq * 8), boff = lds_byte(wc * 32 + fr, fq * 8);
#define PG8_SA(b, h) (((b) * 2 + (h)) * HTB)
#define PG8_SB(b, h) ((4 + (b) * 2 + (h)) * HTB)
#define PG8_STAGE(bufoff, gbase, voff) do { _Pragma("unroll") for (int _i = 0; _i < 2; ++_i) \
        __builtin_amdgcn_global_load_lds((const unsigned*)((const char*)(gbase) + (voff)[_i]), (PG8_LAS unsigned*)(lds + (bufoff) + ldsw + _i * 8192), 16, 0, 0); } while (0)
#define PG8_LDA(dst, b, h) do { _Pragma("unroll") for (int m = 0; m < 4; ++m) _Pragma("unroll") for (int k = 0; k < 2; ++k) dst[m][k] = *(const PG8_LAS bf16x8*)(lds + PG8_SA(b, h) + aoff + m * 2048 + k * 1024); } while (0)
#define PG8_LDB(dst, b, h) do { _Pragma("unroll") for (int n = 0; n < 2; ++n) _Pragma("unroll") for (int k = 0; k < 2; ++k) dst[n][k] = *(const PG8_LAS bf16x8*)(lds + PG8_SB(b, h) + boff + n * 2048 + k * 1024); } while (0)
#define PG8_MMA(ai, bj, At, Bt) do { __builtin_amdgcn_s_setprio(1); _Pragma("unroll") for (int m = 0; m < 4; ++m) _Pragma("unroll") for (int n = 0; n < 2; ++n) _Pragma("unroll") for (int k = 0; k < 2; ++k) \
        acc[ai][bj][m][n] = __builtin_amdgcn_mfma_f32_16x16x32_bf16(Bt[n][k], At[m][k], acc[ai][bj][m][n], 0, 0, 0); __builtin_amdgcn_s_setprio(0); } while (0)
#define PG8_WAIT_V(n) asm volatile("s_waitcnt vmcnt(" #n ")" ::: "memory")
#define PG8_WAIT_L(n) asm volatile("s_waitcnt lgkmcnt(" #n ")" ::: "memory")
#define PG8_BAR __builtin_amdgcn_s_barrier()
#define PG8_SCHED __builtin_amdgcn_sched_barrier(0)
    Unit cur, nxt; int ui = 0;
    if (!S.next(0, cur)) return;
    f32x4 acc[2][2][4][2];
#pragma unroll
    for (int a = 0; a < 2; ++a)
#pragma unroll
        for (int b = 0; b < 2; ++b)
#pragma unroll
            for (int m = 0; m < 4; ++m)
#pragma unroll
                for (int n = 0; n < 2; ++n) acc[a][b][m][n] = (f32x4){0.f, 0.f, 0.f, 0.f};
    bf16x8 At[4][2], B0[2][2], B1[2][2];
    const char* cA = (const char*)g.A + (size_t)cur.pm * tstepA; const char* cB = (const char*)g.Bt + (size_t)cur.pn * tstep;
    S.a_ready(cur);
    if constexpr (SP2) {
        PG8_STAGE(PG8_SB(0, 0), cB, voffB); PG8_STAGE(PG8_SB(0, 1), cB + hstep, voffB); PG8_STAGE(PG8_SA(0, 0), cA, voffA); PG8_STAGE(PG8_SA(0, 1), cA + hstepA, voffA);
        if (wr == 1) PG8_BAR;
        PG8_WAIT_V(2); PG8_BAR;
        PG8_STAGE(PG8_SB(1, 0), cB + kstep, voffB); PG8_STAGE(PG8_SA(1, 0), cA + kstep, voffA); PG8_STAGE(PG8_SB(1, 1), cB + hstep + kstep, voffB);
        PG8_WAIT_V(6); PG8_BAR;
    } else {
        PG8_STAGE(PG8_SB(0, 0), cB, voffB); PG8_STAGE(PG8_SA(0, 0), cA, voffA); PG8_STAGE(PG8_SB(0, 1), cB + hstep, voffB); PG8_STAGE(PG8_SA(0, 1), cA + hstepA, voffA);
        if (wr == 1) PG8_BAR;
        PG8_WAIT_V(4); PG8_BAR;
        PG8_STAGE(PG8_SB(1, 0), cB + kstep, voffB); PG8_STAGE(PG8_SA(1, 0), cA + kstep, voffA); PG8_STAGE(PG8_SB(1, 1), cB + hstep + kstep, voffB);
        PG8_WAIT_V(6); PG8_BAR;
    }
    for (;;) {
        const bool has_next = S.next(ui + 1, nxt);
        const char* nA = has_next ? (const char*)g.A + (size_t)nxt.pm * tstepA : cA; const char* nB = has_next ? (const char*)g.Bt + (size_t)nxt.pn * tstep : cB;
        for (int t = 0; t < nt; t += 2) {
            const bool last = (t == nt - 2);
            const char* a1 = cA + (size_t)(t + 1) * kstep;
            const char* a2 = last ? nA : cA + (size_t)(t + 2) * kstep; const char* b2 = last ? nB : cB + (size_t)(t + 2) * kstep;
            const char* a3 = a2 + kstep; const char* b3 = b2 + kstep;
            if (last && has_next) S.a_ready(nxt);
            if constexpr (SP2) {
            PG8_LDB(B0, 0, 0); PG8_LDB(B1, 0, 1); PG8_SCHED; PG8_LDA(At, 0, 0); PG8_STAGE(PG8_SA(1, 1), a1 + hstepA, voffA);
            PG8_WAIT_V(8); PG8_WAIT_L(0); PG8_BAR; PG8_MMA(0, 0, At, B0); PG8_MMA(0, 1, At, B1); PG8_BAR; PG8_SCHED;
            PG8_LDA(At, 0, 1); PG8_STAGE(PG8_SB(0, 0), b2, voffB); PG8_STAGE(PG8_SB(0, 1), b2 + hstep, voffB); PG8_STAGE(PG8_SA(0, 0), a2, voffA);
            PG8_WAIT_V(8); PG8_WAIT_L(0); PG8_BAR; PG8_MMA(1, 0, At, B0); PG8_MMA(1, 1, At, B1); PG8_BAR; PG8_SCHED;
            PG8_LDB(B0, 1, 0); PG8_LDB(B1, 1, 1); PG8_SCHED; PG8_LDA(At, 1, 0); PG8_STAGE(PG8_SA(0, 1), a2 + hstepA, voffA);
            PG8_WAIT_V(8); PG8_WAIT_L(0); PG8_BAR; PG8_MMA(0, 0, At, B0); PG8_MMA(0, 1, At, B1); PG8_BAR; PG8_SCHED;
            PG8_LDA(At, 1, 1); PG8_STAGE(PG8_SB(1, 0), b3, voffB); PG8_STAGE(PG8_SB(1, 1), b3 + hstep, voffB); PG8_STAGE(PG8_SA(1, 0), a3, voffA);
            PG8_WAIT_V(8); PG8_WAIT_L(0); PG8_BAR; PG8_MMA(1, 0, At, B0); PG8_MMA(1, 1, At, B1); PG8_BAR; PG8_SCHED;
            } else {
            PG8_LDB(B0, 0, 0); PG8_SCHED; PG8_LDA(At, 0, 0); PG8_STAGE(PG8_SA(1, 1), a1 + hstepA, voffA);
            PG8_WAIT_L(8); PG8_BAR; PG8_WAIT_L(0); PG8_MMA(0, 0, At, B0); PG8_BAR; PG8_SCHED;
            PG8_LDB(B1, 0, 1); PG8_STAGE(PG8_SB(0, 0), b2, voffB);
            PG8_BAR; PG8_WAIT_L(0); PG8_MMA(0, 1, At, B1); PG8_BAR;
            PG8_LDA(At, 0, 1); PG8_STAGE(PG8_SA(0, 0), a2, voffA);
            PG8_BAR; PG8_WAIT_L(0); PG8_MMA(1, 0, At, B0); PG8_BAR; PG8_SCHED;
            PG8_STAGE(PG8_SB(0, 1), b2 + hstep, voffB);
            PG8_WAIT_V(6); PG8_BAR; PG8_MMA(1, 1, At, B1); PG8_BAR;
            PG8_LDB(B0, 1, 0); PG8_SCHED; PG8_LDA(At, 1, 0); PG8_STAGE(PG8_SA(0, 1), a2 + hstepA, voffA);
            PG8_WAIT_L(8); PG8_BAR; PG8_WAIT_L(0); PG8_MMA(0, 0, At, B0); PG8_BAR; PG8_SCHED;
            PG8_LDB(B1, 1, 1); PG8_STAGE(PG8_SB(1, 0), b3, voffB);
            PG8_BAR; PG8_WAIT_L(0); PG8_MMA(0, 1, At, B1); PG8_BAR;
            PG8_LDA(At, 1, 1); PG8_STAGE(PG8_SA(1, 0), a3, voffA);
            PG8_BAR; PG8_WAIT_L(0); PG8_MMA(1, 0, At, B0); PG8_BAR; PG8_SCHED;
            PG8_STAGE(PG8_SB(1, 1), b3 + hstep, voffB);
            PG8_WAIT_V(6); PG8_BAR; PG8_MMA(1, 1, At, B1); PG8_BAR;
            }
        }
        if constexpr (ALIGN_EPI) { if (wr == 0) PG8_BAR; }
        if constexpr (!Epi::AFTER_DRAIN) { E(acc, cur, wr, wc, fr, fq); S.done(cur); }
        if (!has_next) break;
#pragma unroll
        for (int a = 0; a < 2; ++a)
#pragma unroll
            for (int b = 0; b < 2; ++b)
#pragma unroll
                for (int m = 0; m < 4; ++m)
#pragma unroll
                    for (int n = 0; n < 2; ++n) acc[a][b][m][n] = (f32x4){0.f, 0.f, 0.f, 0.f};
        cur = nxt; cA = nA; cB = nB; ++ui;
        if constexpr (ALIGN_EPI) { if (wr == 1) PG8_BAR; }
    }
    PG8_WAIT_V(0);
    if constexpr (!ALIGN_EPI) { if (wr == 0) PG8_BAR; }
    PG8_BAR;
    if constexpr (Epi::AFTER_DRAIN) { E.fused(acc, cur, wr, wc, fr, fq, lds, wid, lane); S.done(cur); }
#undef PG8_SA
#undef PG8_SB
#undef PG8_STAGE
#undef PG8_LDA
#undef PG8_LDB
#undef PG8_MMA
#undef PG8_WAIT_V
#undef PG8_WAIT_L
#undef PG8_BAR
#undef PG8_SCHED
}
}
#include <hip/hip_bf16.h>
#include <cmath>
namespace attn_body {
using bf16=__hip_bfloat16;
using bf16x8=__attribute__((ext_vector_type(8)))short;
using s16x4=__attribute__((ext_vector_type(4)))short;
using f32x16=__attribute__((ext_vector_type(16)))float;
using u32x4=__attribute__((ext_vector_type(4)))unsigned;
constexpr int BATCH=8,NHEAD=16,SEQ=4096,D=64,DM=NHEAD*D;
constexpr int NW=8,QBLK=32,QB=QBLK*NW,KVBLK=64,NQB=SEQ/QB;
constexpr int ATTN_PITCH=DM, ATTN_UNIT_ROWS=QB;
__device__ __forceinline__ int crow(int r,int hi){return (r&3)+8*(r>>2)+4*hi;}
#define SBAR() __builtin_amdgcn_sched_barrier(0)
__device__ __forceinline__ void cmask(f32x16&p0,f32x16&p1,int jb,int qrel,int hi){
  const float NEG=-INFINITY; int kb=64*jb+4*hi;
  #pragma unroll
  for(int r=0;r<16;++r){int kv=kb+(r&3)+8*(r>>2); if(kv>qrel)p0[r]=NEG; if(kv+32>qrel)p1[r]=NEG;}
}

constexpr int NSLOT=3, SLOTB=8192;
constexpr int LDS_K=0, LDS_V=NSLOT*SLOTB, LDS_WS=2*NSLOT*SLOTB, LDS_OST=LDS_WS+NW*64*4, LDS_CB=LDS_OST+NW*4096, LDS_BYTES=LDS_CB+SEQ*4;
constexpr float C2=0.125f*1.4426950408889634f;
__device__ __forceinline__ void glds16(const void*gsrc,unsigned lds_dst){unsigned keep;
  asm volatile("s_mov_b32 %0, m0\n\ts_mov_b32 m0, %2\n\ts_nop 0\n\tglobal_load_lds_dwordx4 %1, off\n\ts_mov_b32 m0, %0":"=&s"(keep):"v"(gsrc),"s"(lds_dst):"memory");}
__device__ __forceinline__ float max3f(float a,float b,float c){float r;asm("v_max3_f32 %0, %1, %2, %3":"=v"(r):"v"(a),"v"(b),"v"(c));return r;}
__device__ __forceinline__ float max2f(float a,float b){float r;asm("v_max_f32_e32 %0, %1, %2":"=v"(r):"v"(a),"v"(b));return r;}
__device__ __forceinline__ float fadd_s(float a,float b){float r;asm("v_add_f32_e32 %0, %1, %2":"=v"(r):"v"(a),"v"(b));return r;}
__device__ __forceinline__ float fsub_s(float a,float b){float r;asm("v_sub_f32_e32 %0, %1, %2":"=v"(r):"v"(a),"v"(b));return r;}
typedef float f32x2_t __attribute__((ext_vector_type(2))); typedef __bf16 bf16x2_t __attribute__((ext_vector_type(2)));
__device__ __forceinline__ unsigned cvtpk_s(float lo,float hi){f32x2_t v={lo,hi};bf16x2_t b=__builtin_convertvector(v,bf16x2_t);return __builtin_bit_cast(unsigned,b);}
#define WAIT_BAR(N) asm volatile("s_waitcnt vmcnt(" #N ") lgkmcnt(0)\n\ts_barrier":::"memory")

__device__ __forceinline__ void qkt(f32x16&p0,f32x16&p1,const char*Kslot,const bf16x8*qr,const f32x16&negm,int r32,int hi){
  const char*kb=Kslot+hi*1024+r32*16;
  #pragma unroll
  for(int d0=0;d0<4;++d0){
    const bf16x8 b0=*reinterpret_cast<const bf16x8*>(kb+d0*2048);
    const bf16x8 b1=*reinterpret_cast<const bf16x8*>(kb+d0*2048+512);
    if(d0==0){p0=__builtin_amdgcn_mfma_f32_32x32x16_bf16(b0,qr[0],negm,0,0,0);p1=__builtin_amdgcn_mfma_f32_32x32x16_bf16(b1,qr[0],negm,0,0,0);}
    else{p0=__builtin_amdgcn_mfma_f32_32x32x16_bf16(b0,qr[d0],p0,0,0,0);p1=__builtin_amdgcn_mfma_f32_32x32x16_bf16(b1,qr[d0],p1,0,0,0);}}
}
typedef __attribute__((address_space(3))) const char* lds_cptr;
typedef short v4i16_t __attribute__((ext_vector_type(4)));
__device__ __forceinline__ void kload8(bf16x8*kf,lds_cptr kp){
  kf[0]=*(const __attribute__((address_space(3))) bf16x8*)(kp);      kf[1]=*(const __attribute__((address_space(3))) bf16x8*)(kp+512);
  kf[2]=*(const __attribute__((address_space(3))) bf16x8*)(kp+2048); kf[3]=*(const __attribute__((address_space(3))) bf16x8*)(kp+2560);
  kf[4]=*(const __attribute__((address_space(3))) bf16x8*)(kp+4096); kf[5]=*(const __attribute__((address_space(3))) bf16x8*)(kp+4608);
  kf[6]=*(const __attribute__((address_space(3))) bf16x8*)(kp+6144); kf[7]=*(const __attribute__((address_space(3))) bf16x8*)(kp+6656);
}
__device__ __forceinline__ void kload2(bf16x8*kf,lds_cptr kp,int j){ kf[2*j]=*(const __attribute__((address_space(3))) bf16x8*)(kp+j*2048); kf[2*j+1]=*(const __attribute__((address_space(3))) bf16x8*)(kp+j*2048+512); }
__device__ __forceinline__ s16x4 vtr(lds_cptr p){ return __builtin_bit_cast(s16x4,__builtin_amdgcn_ds_read_tr16_b64_v4i16((__attribute__((address_space(3))) v4i16_t*)p)); }
__device__ __forceinline__ float rowmax(const f32x16&p0,const f32x16&p1){
  float a=max3f(p0[0],p0[1],p1[0]),b=max3f(p0[2],p0[3],p1[1]);a=max3f(a,p1[2],p1[3]);
  #pragma unroll
  for(int r=4;r<16;r+=4){a=max3f(a,p0[r],p0[r+1]);b=max3f(b,p0[r+2],p0[r+3]);a=max3f(a,p1[r],p1[r+1]);b=max3f(b,p1[r+2],p1[r+3]);}
  const float m=max2f(a,b);
  auto rr=__builtin_amdgcn_permlane32_swap(__float_as_uint(m),__float_as_uint(m),false,false);
  return max2f(__uint_as_float(rr[0]),__uint_as_float(rr[1]));
}
__device__ __forceinline__ void pv(f32x16*o,int vb,bf16x8 pa0,bf16x8 pa1,bf16x8 pa2,bf16x8 pa3){
  #pragma unroll
  for(int d0=0;d0<2;++d0){s16x4 lo[4],hi[4];
    #pragma unroll
    for(int ks=0;ks<4;++ks){
      asm volatile("ds_read_b64_tr_b16 %0,%1 offset:%c2":"=&v"(lo[ks]):"v"(vb),"i"(d0*4096+ks*1024):"memory");
      asm volatile("ds_read_b64_tr_b16 %0,%1 offset:%c2":"=&v"(hi[ks]):"v"(vb),"i"(d0*4096+ks*1024+512):"memory");}
    asm volatile("s_waitcnt lgkmcnt(0)":::"memory");SBAR();
    #define PK(k) (bf16x8){lo[k][0],lo[k][1],lo[k][2],lo[k][3],hi[k][0],hi[k][1],hi[k][2],hi[k][3]}
    o[d0]=__builtin_amdgcn_mfma_f32_32x32x16_bf16(pa0,PK(0),o[d0],0,0,0);
    o[d0]=__builtin_amdgcn_mfma_f32_32x32x16_bf16(pa1,PK(1),o[d0],0,0,0);
    o[d0]=__builtin_amdgcn_mfma_f32_32x32x16_bf16(pa2,PK(2),o[d0],0,0,0);
    o[d0]=__builtin_amdgcn_mfma_f32_32x32x16_bf16(pa3,PK(3),o[d0],0,0,0);
    #undef PK
  }
}

#ifndef ATTN_STORE16
#define ATTN_STORE16(p,v) (*(u32x4*)(p)=(v))
#endif
template<int THRL> __device__ __forceinline__ void attn_unit(int b,int h,int qb,const bf16*Q,const bf16*__restrict__ K,const bf16*__restrict__ V,bf16*O,const bf16*__restrict__ Gt,const float*__restrict__ CL,char*shm,int wave_s){
  int tid_o=tid_from(wave_s); asm volatile("":"+v"(tid_o)); const int tid=tid_o,lane=tid&63,r32=lane&31,hi=lane>>5; const int wid=__builtin_amdgcn_readfirstlane(tid>>6);
  const long rowbase=(long)b*SEQ; const int q0=qb*QB;
  const float*cbh=CL+((long)b*NHEAD+h)*SEQ;
  typedef float f4_t __attribute__((ext_vector_type(4))); f4_t creg0=f4_t{},creg1=f4_t{}; const int n4c=(q0+QB)/4;
  if(tid<n4c)creg0=*(const f4_t*)(cbh+4*tid); if(tid+NW*64<n4c)creg1=*(const f4_t*)(cbh+4*(tid+NW*64));
  const float cq=cbh[q0+wid*QBLK+(lane&31)];
  const bf16*Qw=Q+(rowbase+q0+wid*QBLK)*DM+h*D;
  const bf16*Kh=K+rowbase*DM+h*D,*Vh=V+rowbase*DM+h*D;
  const unsigned lds0=(unsigned)(uintptr_t)shm;
  float*wsf=(float*)(shm+LDS_WS)+wid*64;
  const bf16*ksrc=Kh+(long)lane*DM+wid*8;
  const bf16*vsrc=Vh+(long)(16*(wid&3)+(lane>>2))*DM+(wid>>2)*32+(lane&3)*8;
  const unsigned kdst=lds0+LDS_K+wid*1024, vdst=lds0+LDS_V+wid*1024;
  #define DMA_K(t,slot) glds16(ksrc+(long)(t)*KVBLK*DM,(unsigned)__builtin_amdgcn_readfirstlane(kdst+(slot)))
  #define DMA_V(t,slot) glds16(vsrc+(long)(t)*KVBLK*DM,(unsigned)__builtin_amdgcn_readfirstlane(vdst+(slot)))
  const int vb0=(int)(lds0+LDS_V)+((lane>>4)&1)*32+(lane&3)*8+(4*hi+((lane&15)>>2))*64;
  const char*Kbase=shm+LDS_K; bf16x8 kf[8];
  const lds_cptr shm3=(lds_cptr)shm; const lds_cptr kp0=shm3+LDS_K+hi*1024+r32*16; const lds_cptr vp0=shm3+LDS_V+((lane>>4)&1)*32+(lane&3)*8+(4*hi+((lane&15)>>2))*64;
  const int NT=(q0+QB)/KVBLK;
  DMA_K(0,0);DMA_V(0,0);DMA_K(1,SLOTB);
  bf16x8 qr[4];
  #pragma unroll
  for(int d0=0;d0<4;++d0)qr[d0]=*reinterpret_cast<const bf16x8*>(&Qw[(long)r32*DM+d0*16+hi*8]);
  float mhat=0.f,l_reg=0.f;f32x16 o[2];o[0]=f32x16{};o[1]=f32x16{};f32x16 negm;
  #pragma unroll
  for(int r=0;r<16;++r)negm[r]=cq;
  asm volatile("":"+v"(negm));
  typedef float cf4_t __attribute__((ext_vector_type(4))); const __attribute__((address_space(3))) cf4_t*clds=(const __attribute__((address_space(3))) cf4_t*)((lds_cptr)shm+LDS_CB)+hi;
  #define CBIAS(P0,P1,t) do{ const __attribute__((address_space(3))) cf4_t*cp_=clds+16*(t); _Pragma("unroll") for(int j_=0;j_<4;++j_){ const cf4_t a_=cp_[2*j_], b_=cp_[8+2*j_]; \
      { f32x2_t u0_={P0[4*j_],P0[4*j_+1]},u1_={P0[4*j_+2],P0[4*j_+3]},w0_={P1[4*j_],P1[4*j_+1]},w1_={P1[4*j_+2],P1[4*j_+3]}; \
        u0_=u0_-(f32x2_t){a_[0],a_[1]}; u1_=u1_-(f32x2_t){a_[2],a_[3]}; w0_=w0_-(f32x2_t){b_[0],b_[1]}; w1_=w1_-(f32x2_t){b_[2],b_[3]}; \
        P0[4*j_]=u0_[0];P0[4*j_+1]=u0_[1];P0[4*j_+2]=u1_[0];P0[4*j_+3]=u1_[1]; P1[4*j_]=w0_[0];P1[4*j_+1]=w0_[1];P1[4*j_+2]=w1_[0];P1[4*j_+3]=w1_[1]; } } }while(0)
  const int qrel=wid*QBLK+r32;
  #define CMASK(P0,P1,t) do{int jb_=(t)-(NT-4); if(jb_>=0)cmask(P0,P1,jb_,qrel,hi);}while(0)
  bool resc=false;
  #define START(P0,P1) do{ const float rm=rowmax(P0,P1); resc=false; \
    { const float c63_=((const __attribute__((address_space(3))) float*)((lds_cptr)shm+LDS_CB))[63]; const float dl=rm-(cq-c63_);     \
      mhat=fadd_s(mhat,dl); \
      _Pragma("unroll") for(int r=0;r<16;++r){P0[r]=fsub_s(P0[r],dl);P1[r]=fsub_s(P1[r],dl);} \
      _Pragma("unroll") for(int r=0;r<16;++r)negm[r]=cq-mhat; asm volatile("":"+v"(negm)); } \
    _Pragma("unroll") for(int r=0;r<16;++r)P0[r]=__builtin_amdgcn_exp2f(P0[r]); }while(0)
  #define RESC() do{ if(resc){ asm volatile("s_waitcnt lgkmcnt(0)":::"memory"); \
      _Pragma("unroll") for(int d_=0;d_<2;++d_) _Pragma("unroll") for(int r=0;r<16;++r)o[d_][r]*=wsf[crow(r,hi)]; } }while(0)
  f32x16 pA0,pA1,pB0,pB1;
  int sl_prev=0,sl_cur=0,sl_next=SLOTB;
  #define ROT() do{sl_prev=sl_cur;sl_cur=sl_next;sl_next=(sl_next==(NSLOT-1)*SLOTB)?0:sl_next+SLOTB;}while(0)
  { __attribute__((address_space(3))) f4_t*cl4=(__attribute__((address_space(3))) f4_t*)((lds_cptr)shm+LDS_CB); if(tid<n4c)cl4[tid]=creg0; if(tid+NW*64<n4c)cl4[tid+NW*64]=creg1; }
  DMA_K(2,2*SLOTB);
  WAIT_BAR(3);
  qkt(pA0,pA1,Kbase,qr,negm,r32,hi);asm volatile("s_nop 15\n\ts_nop 7":"+v"(pA0),"+v"(pA1));CMASK(pA0,pA1,0);CBIAS(pA0,pA1,0);
  START(pA0,pA1);
  _Pragma("unroll") for(int r=0;r<16;++r)pA1[r]=__builtin_amdgcn_exp2f(pA1[r]);
  WAIT_BAR(0);
  DMA_K(3,0);DMA_V(1,SLOTB);
  ROT();
  kload8(kf,kp0+sl_cur);
  WAIT_BAR(2);
  s16x4 vlo[8],vhi[8]; u32x4 pw0,pw1,pw2,pw3;
  #define PKW(P,B) cvtpk_s(P[B],P[B+1])
  #define PAF(k) __builtin_bit_cast(bf16x8,pw##k)
  #define VFR(i) (bf16x8){vlo[i][0],vlo[i][1],vlo[i][2],vlo[i][3],vhi[i][0],vhi[i][1],vhi[i][2],vhi[i][3]}
  #define PIN(x) asm volatile("":"+v"(x))
  #define MX3(a,b,c) __builtin_fmaxf(__builtin_fmaxf((a),(b)),(c))
  #define GAPA(MF,A0,A1,A2,A3,W0,W1,PW) do{ MF; sacc+=A0; sacc+=A1; sacc+=A2; sacc+=A3; PIN(sacc); W0; W1; PIN(PW); SBAR(); }while(0)
  #define EX(v) __builtin_amdgcn_exp2f(v)
  #define GAPB(MF,X,B) do{ MF; X[B]=EX(X[B]); X[B+1]=EX(X[B+1]); X[B+2]=EX(X[B+2]); X[B+3]=EX(X[B+3]); PIN(X); SBAR(); }while(0)
  #define VRD(i) do{ vlo[i]=vtr(vp_+(((i)>>2)*4096+((i)&3)*1024)); vhi[i]=vtr(vp_+(((i)>>2)*4096+((i)&3)*1024+512)); }while(0)
  #define KRD(G,j) do{ if(G){ kload2(kf,kp0+sl_next,j); SBAR(); } }while(0)
  #define STEP(C0,C1,P0,P1,t,GK,GV,GL) do{ SBAR(); \
    const lds_cptr vp_=vp0+sl_prev; \
    VRD(0); SBAR(); float sacc=(P0[0]+P0[1]); \
    GAPA(C0=__builtin_amdgcn_mfma_f32_32x32x16_bf16(kf[0],qr[0],negm,0,0,0), P0[2],P0[3],P0[4],P0[5],     pw0[0]=PKW(P0,0), pw0[1]=PKW(P0,2), pw0); \
    VRD(4); SBAR(); GAPA(C1=__builtin_amdgcn_mfma_f32_32x32x16_bf16(kf[1],qr[0],negm,0,0,0), P0[6],P0[7],P0[8],P0[9],     pw0[2]=PKW(P0,4), pw0[3]=PKW(P0,6), pw0); \
    VRD(1); SBAR(); GAPA(C0=__builtin_amdgcn_mfma_f32_32x32x16_bf16(kf[2],qr[1],C0,0,0,0),   P0[10],P0[11],P0[12],P0[13], pw1[0]=PKW(P0,8), pw1[1]=PKW(P0,10), pw1); \
    VRD(5); SBAR(); GAPA(C1=__builtin_amdgcn_mfma_f32_32x32x16_bf16(kf[3],qr[1],C1,0,0,0),   P0[14],P0[15],P1[0],P1[1],   pw1[2]=PKW(P0,12),pw1[3]=PKW(P0,14), pw1); \
    VRD(2); SBAR(); GAPA(C0=__builtin_amdgcn_mfma_f32_32x32x16_bf16(kf[4],qr[2],C0,0,0,0),   P1[2],P1[3],P1[4],P1[5],     pw2[0]=PKW(P1,0), pw2[1]=PKW(P1,2), pw2); \
    VRD(6); SBAR(); GAPA(C1=__builtin_amdgcn_mfma_f32_32x32x16_bf16(kf[5],qr[2],C1,0,0,0),   P1[6],P1[7],P1[8],P1[9],     pw2[2]=PKW(P1,4), pw2[3]=PKW(P1,6), pw2); \
    VRD(3); SBAR(); GAPA(C0=__builtin_amdgcn_mfma_f32_32x32x16_bf16(kf[6],qr[3],C0,0,0,0),   P1[10],P1[11],P1[12],P1[13], pw3[0]=PKW(P1,8), pw3[1]=PKW(P1,10), pw3); \
    VRD(7); SBAR(); GAPA(C1=__builtin_amdgcn_mfma_f32_32x32x16_bf16(kf[7],qr[3],C1,0,0,0),   P1[14],P1[15],0.f,0.f,       pw3[2]=PKW(P1,12),pw3[3]=PKW(P1,14), pw3); \
    l_reg+=sacc; \
    if(GK){DMA_K((t)+3,sl_cur);} if(GV){DMA_V((t)+1,sl_next);} \
    CMASK(C0,C1,t); CBIAS(C0,C1,t); \
    { float a=MX3(C0[0],C0[1],C1[0]),b=MX3(C0[2],C0[3],C1[1]); a=MX3(a,C1[2],C1[3]); \
      _Pragma("unroll") for(int r=4;r<16;r+=4){a=MX3(a,C0[r],C0[r+1]);b=MX3(b,C0[r+2],C0[r+3]);a=MX3(a,C1[r],C1[r+1]);b=MX3(b,C1[r+2],C1[r+3]);} \
      float rm=__builtin_fmaxf(a,b); { auto rr=__builtin_amdgcn_permlane32_swap(__float_as_uint(rm),__float_as_uint(rm),false,false); rm=__builtin_fmaxf(__uint_as_float(rr[0]),__uint_as_float(rr[1])); } \
      resc=false; \
      if(__builtin_expect(__any(rm>(float)THRL),0)){ const float dl=__builtin_fmaxf(rm,0.f); mhat+=dl; \
        _Pragma("unroll") for(int r=0;r<16;++r){C0[r]-=dl;C1[r]-=dl;} \
        _Pragma("unroll") for(int r=0;r<16;++r)negm[r]=cq-mhat; asm volatile("":"+v"(negm)); \
        const float f=__builtin_amdgcn_exp2f(-dl); l_reg*=f; if(hi==0)wsf[r32]=f; resc=true; } } \
    SBAR(); \
    GAPB(o[0]=__builtin_amdgcn_mfma_f32_32x32x16_bf16(PAF(0),VFR(0),o[0],0,0,0), C0,0); \
    GAPB(o[1]=__builtin_amdgcn_mfma_f32_32x32x16_bf16(PAF(0),VFR(4),o[1],0,0,0), C0,4); \
    KRD(GL,0); GAPB(o[0]=__builtin_amdgcn_mfma_f32_32x32x16_bf16(PAF(1),VFR(1),o[0],0,0,0), C0,8); \
    KRD(GL,1); GAPB(o[1]=__builtin_amdgcn_mfma_f32_32x32x16_bf16(PAF(1),VFR(5),o[1],0,0,0), C0,12); \
    KRD(GL,2); GAPB(o[0]=__builtin_amdgcn_mfma_f32_32x32x16_bf16(PAF(2),VFR(2),o[0],0,0,0), C1,0); \
    KRD(GL,3); GAPB(o[1]=__builtin_amdgcn_mfma_f32_32x32x16_bf16(PAF(2),VFR(6),o[1],0,0,0), C1,4); \
    GAPB(o[0]=__builtin_amdgcn_mfma_f32_32x32x16_bf16(PAF(3),VFR(3),o[0],0,0,0), C1,8); \
    GAPB(o[1]=__builtin_amdgcn_mfma_f32_32x32x16_bf16(PAF(3),VFR(7),o[1],0,0,0), C1,12); \
    }while(0)
  int t=1;
  #undef CMASK
  #define CMASK(P0,P1,t) do{}while(0)
  for(;t+5<NT;t+=2){
    STEP(pB0,pB1,pA0,pA1,t,true,true,true);     WAIT_BAR(2); RESC(); ROT();
    STEP(pA0,pA1,pB0,pB1,t+1,true,true,true);   WAIT_BAR(2); RESC(); ROT();
  }
  #undef CMASK
  #define CMASK(P0,P1,t) do{int jb_=(t)-(NT-4); if(jb_>=0)cmask(P0,P1,jb_,qrel,hi);}while(0)
  #define ENDW(tt) do{ if((tt)+3<NT){WAIT_BAR(2);} else if((tt)+2<NT){WAIT_BAR(1);} else {WAIT_BAR(0);} }while(0)
  for(;t+1<NT;t+=2){
    STEP(pB0,pB1,pA0,pA1,t,(t+3<NT),(t+1<NT),(t+1<NT));       ENDW(t);   RESC(); ROT();
    STEP(pA0,pA1,pB0,pB1,t+1,(t+4<NT),(t+2<NT),(t+2<NT));     ENDW(t+1); RESC(); ROT();
  }
  STEP(pB0,pB1,pA0,pA1,NT-1,false,false,false); RESC();
  { float sacc=pB0[0]+pB0[1]; _Pragma("unroll") for(int r=2;r<16;++r)sacc+=pB0[r]; _Pragma("unroll") for(int r=0;r<16;++r)sacc+=pB1[r]; l_reg+=sacc;
    pw0=(u32x4){PKW(pB0,0),PKW(pB0,2),PKW(pB0,4),PKW(pB0,6)};pw1=(u32x4){PKW(pB0,8),PKW(pB0,10),PKW(pB0,12),PKW(pB0,14)};pw2=(u32x4){PKW(pB1,0),PKW(pB1,2),PKW(pB1,4),PKW(pB1,6)};pw3=(u32x4){PKW(pB1,8),PKW(pB1,10),PKW(pB1,12),PKW(pB1,14)};
    SBAR(); pv(o,vb0+sl_cur,PAF(0),PAF(1),PAF(2),PAF(3)); }
  #undef PKW
  #undef PAF
  #undef VFR
  #undef PIN
  #undef MX3
  #undef GAPA
  #undef GAPB
  #undef EX
  #undef VRD
  #undef KRD
  #undef STEP
  #undef ENDW
  u32x4 gq4[4];
  { const bf16*Gw=Gt+(rowbase+q0+wid*QBLK)*DM+h*D;
    #pragma unroll
    for(int i=0;i<4;++i)gq4[i]=*(const u32x4*)(Gw+(long)(i*8+(lane>>3))*DM+(lane&7)*8); }
  {auto rr=__builtin_amdgcn_permlane32_swap(__float_as_uint(l_reg),__float_as_uint(l_reg),false,false);l_reg=__uint_as_float(rr[0])+__uint_as_float(rr[1]);}
  if(hi==0)wsf[32+r32]=l_reg;asm volatile("s_waitcnt lgkmcnt(0)":::"memory");
  float rli[16];
  #pragma unroll
  for(int r=0;r<16;++r)rli[r]=__builtin_amdgcn_rcpf(wsf[32+crow(r,hi)]);
  bf16*Ow=O+(rowbase+q0+wid*QBLK)*DM+h*D;
  { bf16*stg=(bf16*)(shm+LDS_OST)+wid*2048;
    #pragma unroll
    for(int r=0;r<16;++r){const int orow=crow(r,hi);
      #pragma unroll
      for(int d0=0;d0<2;++d0)stg[orow*64+d0*32+r32]=__float2bfloat16(o[d0][r]*rli[r]);}
    asm volatile("s_waitcnt lgkmcnt(0)":::"memory");
    #pragma unroll
    for(int i=0;i<4;++i){const bf16*Gw=Gt+(rowbase+q0+wid*QBLK)*DM+h*D; const int row=i*8+(lane>>3),ch=lane&7; const u32x4 v=*(const u32x4*)(stg+row*64+ch*8); const u32x4 gq=gq4[i]; u32x4 w;
      #pragma unroll
      for(int e=0;e<4;++e){ const float a0=__uint_as_float(v[e]<<16)*__uint_as_float(gq[e]<<16), a1=__uint_as_float(v[e]&0xffff0000u)*__uint_as_float(gq[e]&0xffff0000u); w[e]=cvtpk_s(a0,a1); }
      ATTN_STORE16(Ow+(long)row*DM+ch*8,w);} }
  asm volatile("s_waitcnt lgkmcnt(0)\n\ts_barrier":::"memory");
  #undef CBIAS
  #undef DMA_K
  #undef DMA_V
  #undef CMASK
  #undef START
  #undef RESC
  #undef ROT
}
constexpr int ATTN_LDS_BYTES=LDS_BYTES;
struct AttnTensors { const bf16* Q; const bf16* K; const bf16* V; bf16* O; const bf16* G; const float* CL; };
struct AttnUnit { int bh; int qb; };
struct StaticOrder {
  int vcu, G;
  __device__ __forceinline__ explicit StaticOrder(int grid,int block):vcu((grid%8==0)?(block%8)*(grid/8)+block/8:block),G(grid){}
  __device__ __forceinline__ bool next(int i,AttnUnit&u)const{
    if(G==256){ if(i>=8)return false; const int j=2*(i>>1)+(vcu&1); u.bh=vcu>>1; u.qb=(i&1)?15-j:j; return true; }
    const int idx=i*G+vcu; if(idx>=BATCH*NHEAD*NQB)return false; u.bh=idx/NQB; u.qb=NQB-1-idx%NQB; return true; }
  __device__ __forceinline__ void a_ready(const AttnUnit&)const{}
  __device__ __forceinline__ void done(const AttnUnit&)const{}
};
template<class Sched,int THRL=8> __device__ __forceinline__ void attn_phase(char*lds,const AttnTensors&T,const Sched&S,int wave_s){
  AttnUnit u;
  for(int i=0;S.next(i,u);++i){ S.a_ready(u); attn_unit<THRL>(u.bh/NHEAD,u.bh%NHEAD,u.qb,T.Q,T.K,T.V,T.O,T.G,T.CL,lds,wave_s); S.done(u); }
}
#undef SBAR
#undef WAIT_BAR
}
#define GAS __attribute__((address_space(1)))
#define LAS __attribute__((address_space(3)))
typedef unsigned short bfu;
typedef unsigned v4u __attribute__((ext_vector_type(4)));
typedef unsigned v2u __attribute__((ext_vector_type(2)));
typedef float f32x4 __attribute__((ext_vector_type(4)));
typedef short bf16x8 __attribute__((ext_vector_type(8)));
#define LDS_WAIT() asm volatile("s_waitcnt lgkmcnt(0)" ::: "memory")
constexpr int NWAVES = 8;
constexpr int BATCH = 8, SEQ = 4096, D = 1024, FF = 2816, T = BATCH * SEQ, PLE = 256, NKVF = 2064, NKVFP = 2304;
constexpr float EPS = 1e-6f, LOG2E = 1.4426950408889634f;
constexpr size_t MiB = 1u << 20;
constexpr size_t E_W1IN = 0, N_WIN = (size_t)2 * FF * D, N_WOUT = (size_t)D * FF;
constexpr size_t E_W1OUT = E_W1IN + 2 * N_WIN, E_W2IN = E_W1OUT + 2 * N_WOUT, E_W2OUT = E_W2IN + 2 * N_WIN, E_WHIN = E_W2OUT + 2 * N_WOUT;
constexpr size_t E_WHOUT = E_WHIN + (size_t)4 * D * D, E_WKVF = E_WHOUT + (size_t)D * D, E_WQG = E_WKVF + (size_t)NKVFP * D, E_WFO = E_WQG + (size_t)2 * D * D;
constexpr size_t E_WPG = E_WFO + (size_t)D * D, E_WPP = E_WPG + (size_t)2 * D * D, E_WEND = E_WPP + (size_t)2 * D * PLE;
static_assert(E_WEND * 2 <= 92 * MiB, "weights fit");
constexpr size_t WS_P = 92 * MiB, WS_LOGF = 124 * MiB, WS_C = 126 * MiB, WS_AY = 128 * MiB, WS_BIG = 192 * MiB, WS_PROJ = 448 * MiB, WS_END = 512 * MiB;
constexpr size_t WS_V = WS_BIG + 192 * MiB, WS_K = WS_PROJ, WS_Q = WS_BIG, WS_G = WS_BIG + 64 * MiB;
constexpr int LDS_BYTES = 147456;

__device__ __forceinline__ float wave_sum(float v) {
#pragma unroll
    for (int o = 1; o < 64; o <<= 1) v += __shfl_xor(v, o);
    return v;
}
__device__ __forceinline__ unsigned pk2(float lo, float hi) { return pg8::cvt_pk_bf16(lo, hi); }
__device__ __forceinline__ float bf2f(unsigned short u) { return __uint_as_float((unsigned)u << 16); }
__device__ __forceinline__ unsigned short f2b(float f) { return (unsigned short)(pk2(f, 0.f) & 0xffffu); }

__device__ __forceinline__ void conv_item(const float* W, int K, int N, bfu* WT, const float* gain, int gmask, int sw, LAS float* scr, int item, int lane) {
    const int nblk = (N + 31) / 32, kb = item / nblk, nb = item % nblk, k0 = 64 * kb, n0 = 32 * nb;
    const int nn = n0 + (lane & 31); const bool nok = nn < N;
    const int c = lane & 7;
    f32x4 ga = (f32x4){1.f, 1.f, 1.f, 1.f}, gb = ga;
    if (gain) { ga = *(const f32x4*)(gain + ((k0 + 8 * c) & gmask)); gb = *(const f32x4*)(gain + ((k0 + 8 * c) & gmask) + 4); }
    float wv[32];
#pragma unroll
    for (int i = 0; i < 32; ++i) { const int kk = 2 * i + (lane >> 5); wv[i] = nok ? __builtin_nontemporal_load(W + (size_t)(k0 + kk) * N + nn) : 0.f; }
#pragma unroll
    for (int i = 0; i < 32; ++i) { const int kk = 2 * i + (lane >> 5); scr[kk * 33 + (lane & 31)] = wv[i]; }
    LDS_WAIT(); asm volatile("" ::: "memory");
    int drow0 = n0; if (sw) { const int j0 = (n0 < FF) ? n0 : n0 - FF; drow0 = 256 * (j0 >> 7) + (j0 & 127) + ((n0 < FF) ? 0 : 128); }
#pragma unroll
    for (int j = 0; j < 4; ++j) { const int n = (lane >> 3) + 8 * j; const LAS float* s = scr + (8 * c) * 33 + n;
        v4u o; o.x = pk2(s[0 * 33] * ga[0], s[1 * 33] * ga[1]); o.y = pk2(s[2 * 33] * ga[2], s[3 * 33] * ga[3]); o.z = pk2(s[4 * 33] * gb[0], s[5 * 33] * gb[1]); o.w = pk2(s[6 * 33] * gb[2], s[7 * 33] * gb[3]);
        *(v4u*)(WT + (size_t)(drow0 + n) * K + k0 + 8 * c) = o; }
    LDS_WAIT(); asm volatile("" ::: "memory");
}
__device__ __forceinline__ void rms_row_to_bf16(const float* xrow, bfu* orow, int lane) {
    const f32x4* xr = (const f32x4*)xrow + lane;
    f32x4 v[4]; float s = 0.f;
#pragma unroll
    for (int j = 0; j < 4; ++j) { v[j] = __builtin_nontemporal_load(xr + 64 * j); s += (v[j].x * v[j].x + v[j].y * v[j].y) + (v[j].z * v[j].z + v[j].w * v[j].w); }
    const float r = __builtin_amdgcn_rsqf(wave_sum(s) * (1.f / D) + EPS);
    v2u* o8 = (v2u*)orow + lane;
#pragma unroll
    for (int j = 0; j < 4; ++j) { v2u w; w.x = pk2(v[j].x * r, v[j].y * r); w.y = pk2(v[j].z * r, v[j].w * r); o8[64 * j] = w; }
}
template <bool WRITE_A>
__device__ __forceinline__ void rw_phase(const float* hin, float* hout, const bfu* Y, bfu* A, const float* gain, float scale, int gw, int ngw, int lane) {
    f32x4 g[4];
#pragma unroll
    for (int j = 0; j < 4; ++j) g[j] = *((const f32x4*)gain + lane + 64 * j);
    for (int m0 = gw; m0 < T; m0 += 2 * ngw) {
        f32x4 v[2][4], y[2][4]; float s[2] = {0.f, 0.f}; const int m1 = m0 + ngw; const bool two = m1 < T;
#pragma unroll
        for (int r = 0; r < 2; ++r) { const int m = (r == 0 || two) ? (r == 0 ? m0 : m1) : m0;
            const f32x4* hr = (const f32x4*)(hin + (size_t)m * D) + lane; const v2u* yr = (const v2u*)(Y + (size_t)m * D) + lane;
#pragma unroll
            for (int j = 0; j < 4; ++j) { v[r][j] = __builtin_nontemporal_load(hr + 64 * j); const v2u w = __builtin_nontemporal_load(yr + 64 * j); y[r][j] = (f32x4){pg8::bflo(w.x), pg8::bfhi(w.x), pg8::bflo(w.y), pg8::bfhi(w.y)}; } }
#pragma unroll
        for (int r = 0; r < 2; ++r)
#pragma unroll
            for (int j = 0; j < 4; ++j) s[r] += (y[r][j].x * y[r][j].x + y[r][j].y * y[r][j].y) + (y[r][j].z * y[r][j].z + y[r][j].w * y[r][j].w);
        float s2[2] = {0.f, 0.f};
#pragma unroll
        for (int r = 0; r < 2; ++r) { const float ry = __builtin_amdgcn_rsqf(wave_sum(s[r]) * (1.f / D) + EPS) * scale;
#pragma unroll
            for (int j = 0; j < 4; ++j) { v[r][j] = v[r][j] + y[r][j] * ry * g[j]; s2[r] += (v[r][j].x * v[r][j].x + v[r][j].y * v[r][j].y) + (v[r][j].z * v[r][j].z + v[r][j].w * v[r][j].w); } }
#pragma unroll
        for (int r = 0; r < 2; ++r) { if (r == 1 && !two) break; const int m = r == 0 ? m0 : m1;
            f32x4* ho = (f32x4*)(hout + (size_t)m * D) + lane;
            if constexpr (WRITE_A) { const float r2 = __builtin_amdgcn_rsqf(wave_sum(s2[r]) * (1.f / D) + EPS); v2u* ao = (v2u*)(A + (size_t)m * D) + lane;
#pragma unroll
                for (int j = 0; j < 4; ++j) { __builtin_nontemporal_store(v[r][j], ho + 64 * j); v2u w; w.x = pk2(v[r][j].x * r2, v[r][j].y * r2); w.y = pk2(v[r][j].z * r2, v[r][j].w * r2); ao[64 * j] = w; } }
            else {
#pragma unroll
                for (int j = 0; j < 4; ++j) __builtin_nontemporal_store(v[r][j], ho + 64 * j); } }
    }
}

constexpr int HG_QH = 0, HG_QT = 17408, HG_KT = 34816, HG_KHT = 52224, HG_VT = 70656, HG_PP = 89088, HG_ST = 98304, HG_TOT = 133120, HG_DV = 135168, HG_END = 135680;
constexpr int RS = 136, RS2 = 72, OFS = 132;
static_assert(HG_END + 64 <= LDS_BYTES - 64, "hgrn lds");
__device__ __forceinline__ f32x4 mfma16(bf16x8 a, bf16x8 b, f32x4 c) { return __builtin_amdgcn_mfma_f32_16x16x32_bf16(a, b, c, 0, 0, 0); }
constexpr int HSEG = 4, HCH = SEQ / 64 / HSEG;
template <bool OUT>
__device__ __forceinline__ void hgrn_scan(LAS unsigned char* lds, bfu* QZVG, const float* lbl, int bh, int seg, float* Ebuf, float* Lbuf, int wave_s, const float* QZ0 = nullptr) {
    int tid_o = tid_from(wave_s); asm volatile("" : "+v"(tid_o)); const int tid = tid_o, lane = tid & 63, wid = __builtin_amdgcn_readfirstlane(tid >> 6), col = tid & 127, rg = tid >> 7, fr = lane & 15, fq = lane >> 4;
    const int b = bh >> 3, h = bh & 7;
    LAS bfu* QH = (LAS bfu*)(lds + HG_QH); LAS bfu* QT = (LAS bfu*)(lds + HG_QT); LAS bfu* KT = (LAS bfu*)(lds + HG_KT); LAS bfu* KHT = (LAS bfu*)(lds + HG_KHT);
    LAS bfu* VT = (LAS bfu*)(lds + HG_VT); LAS bfu* PP = (LAS bfu*)(lds + HG_PP); LAS bfu* ST = (LAS bfu*)(lds + HG_ST);
    LAS float* TOT = (LAS float*)(lds + HG_TOT); LAS float* DV = (LAS float*)(lds + HG_DV); LAS float* OF = (LAS float*)(lds + HG_QT);
    const float l0 = lbl[h * 128 + col], l1 = lbl[1024 + h * 128 + col];
    const float lb = 1.f / (1.f + __expf(l1 - l0)), omlb = 1.f - lb;
    float c0f = 0.f; bool use_c0 = false;
    if constexpr (OUT) { if (QZ0 != nullptr && seg == 0) {
        LAS float* cw = (LAS float*)(lds + HG_END);
        float pr = 0.f; if (tid < 128) { const float q0 = QZ0[(size_t)b * 2 * D + h * 128 + tid], z0 = QZ0[(size_t)b * 2 * D + D + h * 128 + tid]; pr = q0 * (omlb / (1.f + __expf(z0))); }
        pr = wave_sum(pr); if (lane == 0 && wid < 2) cw[wid] = pr;
        LDS_WAIT(); __builtin_amdgcn_s_barrier(); asm volatile("" ::: "memory");
        c0f = cw[0] + cw[1]; use_c0 = true; } }
    bfu* base = QZVG + ((size_t)b * SEQ + (size_t)seg * HCH * 64) * 4096 + h * 128;
    const bfu* pq = base + (size_t)(16 * rg) * 4096 + col; const bfu* pz = pq + 1024; const bfu* pv = pq + 2048;
    const int erow = tid >> 3, eseg = tid & 7;
    const bfu* pg = base + 3072 + (size_t)erow * 4096 + 16 * eseg; bfu* po = base + (size_t)erow * 4096 + 16 * eseg;
    f32x4 Sacc[8];
#pragma unroll
    for (int i = 0; i < 8; ++i) Sacc[i] = (f32x4){0.f, 0.f, 0.f, 0.f};
    float Lacc = 0.f;
    if constexpr (OUT) {
        for (int j = 0; j < seg; ++j) {
            const float* Ej = Ebuf + ((size_t)(bh * HSEG + j) * 64 * 64) * 4 + (size_t)(wid * 8) * 64 * 4; const float* Lj = Lbuf + (size_t)(bh * HSEG + j) * 128;
#pragma unroll
            for (int kb = 0; kb < 8; ++kb) { const f32x4 e = *(const f32x4*)(Ej + ((size_t)kb * 64 + lane) * 4); const f32x4 l4 = *(const f32x4*)(Lj + 16 * kb + 4 * fq);
                f32x4 s = Sacc[kb]; s[0] = s[0] * __expf(l4[0]) + e[0]; s[1] = s[1] * __expf(l4[1]) + e[1]; s[2] = s[2] * __expf(l4[2]) + e[2]; s[3] = s[3] * __expf(l4[3]) + e[3]; Sacc[kb] = s; }
        }
#pragma unroll
        for (int kb = 0; kb < 8; ++kb) *(LAS v2u*)(ST + (16 * wid + fr) * RS + 16 * kb + 4 * fq) = (v2u){pk2(Sacc[kb][0], Sacc[kb][1]), pk2(Sacc[kb][2], Sacc[kb][3])};
    }
    unsigned short zr[16], qr[16], vr[16]; v4u gr0 = (v4u){0u, 0u, 0u, 0u}, gr1 = gr0;
#define HG_LD(p_) (OUT ? __builtin_nontemporal_load(p_) : *(p_))
#define HG_LOAD() do { _Pragma("unroll") for (int j = 0; j < 16; ++j) { zr[j] = HG_LD(pz + (size_t)j * 4096); vr[j] = HG_LD(pv + (size_t)j * 4096); if (OUT) qr[j] = HG_LD(pq + (size_t)j * 4096); else qr[j] = 0; } \
        if (OUT) { gr0 = __builtin_nontemporal_load((const v4u*)pg); gr1 = __builtin_nontemporal_load((const v4u*)(pg + 8)); } pz += (size_t)64 * 4096; pq += (size_t)64 * 4096; pv += (size_t)64 * 4096; pg += (size_t)64 * 4096; } while (0)
    HG_LOAD();
    for (int c = 0; c < HCH; ++c) {
        float kk[16], cum[16], qf[16]; unsigned short vv[16]; const v4u g0 = gr0, g1 = gr1;
        float run = 0.f;
#pragma unroll
        for (int j = 0; j < 16; ++j) { const float z = bf2f(zr[j]); const float k = omlb * __builtin_amdgcn_rcpf(1.f + __expf(z)); run += __logf(1.f - k); cum[j] = run; kk[j] = k; qf[j] = bf2f(qr[j]); vv[j] = vr[j]; }
        TOT[rg * 128 + col] = run;
        if (c + 1 < HCH) HG_LOAD();
        LDS_WAIT(); __builtin_amdgcn_s_barrier(); asm volatile("" ::: "memory");
        const float t0 = TOT[col], t1 = TOT[128 + col], t2 = TOT[256 + col], t3 = TOT[384 + col];
        const float pre = (rg > 0 ? t0 : 0.f) + (rg > 1 ? t1 : 0.f) + (rg > 2 ? t2 : 0.f), tot = (t0 + t1) + (t2 + t3), mid = t0 + t1;
        Lacc += tot;
        unsigned khp[8], vvp[8];
#pragma unroll
        for (int j = 0; j < 16; ++j) { const float cj = pre + cum[j]; const int r = 16 * rg + j;
            if constexpr (OUT) { QH[r * RS + col] = f2b(qf[j] * __expf(cj)); QT[r * RS + col] = f2b(qf[j] * __expf(cj - mid)); KT[r * RS + col] = f2b(kk[j] * __expf(mid - cj)); }
            const unsigned short kh = f2b(kk[j] * __expf(tot - cj));
            if (j & 1) { khp[j >> 1] |= (unsigned)kh << 16; vvp[j >> 1] |= (unsigned)vv[j] << 16; } else { khp[j >> 1] = kh; vvp[j >> 1] = vv[j]; } }
        *(LAS v4u*)(KHT + col * RS2 + 16 * rg) = (v4u){khp[0], khp[1], khp[2], khp[3]}; *(LAS v4u*)(KHT + col * RS2 + 16 * rg + 8) = (v4u){khp[4], khp[5], khp[6], khp[7]};
        *(LAS v4u*)(VT + col * RS2 + 16 * rg) = (v4u){vvp[0], vvp[1], vvp[2], vvp[3]}; *(LAS v4u*)(VT + col * RS2 + 16 * rg + 8) = (v4u){vvp[4], vvp[5], vvp[6], vvp[7]};
        if (rg == 0) DV[col] = __expf(tot);
        LDS_WAIT(); __builtin_amdgcn_s_barrier(); asm volatile("" ::: "memory");
        if constexpr (OUT) {
            const int tb = wid >> 1;
#pragma unroll
            for (int ss = 0; ss < 2; ++ss) { const int sb = 2 * (wid & 1) + ss; f32x4 sc = (f32x4){0.f, 0.f, 0.f, 0.f};
                if (sb <= tb) {
#pragma unroll
                    for (int ks = 0; ks < 4; ++ks) { const bf16x8 a = *(const LAS bf16x8*)(QT + (16 * tb + fr) * RS + 32 * ks + 8 * fq), bq = *(const LAS bf16x8*)(KT + (16 * sb + fr) * RS + 32 * ks + 8 * fq); sc = mfma16(a, bq, sc); } }
#pragma unroll
                for (int i = 0; i < 4; ++i) { const int t = 16 * tb + 4 * fq + i, s = 16 * sb + fr; float pv_ = (sb <= tb && s <= t) ? sc[i] : 0.f; if (use_c0 && c == 0 && t == 0 && s == 0) pv_ = c0f; PP[t * RS2 + s] = f2b(pv_); } }
            LDS_WAIT(); __builtin_amdgcn_s_barrier(); asm volatile("" ::: "memory");
        }
        {   bf16x8 vtf[2];
#pragma unroll
            for (int ks = 0; ks < 2; ++ks) vtf[ks] = *(const LAS bf16x8*)(VT + (16 * wid + fr) * RS2 + 32 * ks + 8 * fq);
            if constexpr (OUT) { bf16x8 stf[4];
#pragma unroll
                for (int ks = 0; ks < 4; ++ks) stf[ks] = *(const LAS bf16x8*)(ST + (16 * wid + fr) * RS + 32 * ks + 8 * fq);
#pragma unroll
                for (int tb = 0; tb < 4; ++tb) { f32x4 o = (f32x4){0.f, 0.f, 0.f, 0.f};
#pragma unroll
                    for (int ks = 0; ks < 4; ++ks) o = mfma16(*(const LAS bf16x8*)(QH + (16 * tb + fr) * RS + 32 * ks + 8 * fq), stf[ks], o);
#pragma unroll
                    for (int ks = 0; ks < 2; ++ks) o = mfma16(*(const LAS bf16x8*)(PP + (16 * tb + fr) * RS2 + 32 * ks + 8 * fq), vtf[ks], o);
#pragma unroll
                    for (int i = 0; i < 4; ++i) OF[(16 * tb + 4 * fq + i) * OFS + 16 * wid + fr] = o[i]; } }
#pragma unroll
            for (int kb = 0; kb < 8; ++kb) { const f32x4 d4 = *(const LAS f32x4*)(DV + 16 * kb + 4 * fq); f32x4 s = Sacc[kb] * d4;
#pragma unroll
                for (int ks = 0; ks < 2; ++ks) s = mfma16(*(const LAS bf16x8*)(KHT + (16 * kb + fr) * RS2 + 32 * ks + 8 * fq), vtf[ks], s);
                Sacc[kb] = s; if constexpr (OUT) *(LAS v2u*)(ST + (16 * wid + fr) * RS + 16 * kb + 4 * fq) = (v2u){pk2(s[0], s[1]), pk2(s[2], s[3])}; }
        }
        if constexpr (OUT) {
            LDS_WAIT(); __builtin_amdgcn_s_barrier(); asm volatile("" ::: "memory");
            f32x4 o4[4]; float ss = 0.f;
#pragma unroll
            for (int j = 0; j < 4; ++j) { o4[j] = *(const LAS f32x4*)(OF + erow * OFS + 16 * eseg + 4 * j); ss += (o4[j].x * o4[j].x + o4[j].y * o4[j].y) + (o4[j].z * o4[j].z + o4[j].w * o4[j].w); }
            ss += __shfl_xor(ss, 1); ss += __shfl_xor(ss, 2); ss += __shfl_xor(ss, 4);
            const float rs = __builtin_amdgcn_rsqf(ss * (1.f / 128.f) + EPS);
            unsigned w[8];
#pragma unroll
            for (int j = 0; j < 4; ++j) { const unsigned ga = (j < 2) ? g0[2 * j] : g1[2 * (j - 2)], gb = (j < 2) ? g0[2 * j + 1] : g1[2 * (j - 2) + 1];
                const float a0 = pg8::bflo(ga), a1 = pg8::bfhi(ga), a2 = pg8::bflo(gb), a3 = pg8::bfhi(gb);
                w[2 * j] = pk2(o4[j].x * rs * a0 * pg8::fsigmoid(a0), o4[j].y * rs * a1 * pg8::fsigmoid(a1)); w[2 * j + 1] = pk2(o4[j].z * rs * a2 * pg8::fsigmoid(a2), o4[j].w * rs * a3 * pg8::fsigmoid(a3)); }
            *(v4u*)po = (v4u){w[0], w[1], w[2], w[3]}; *(v4u*)(po + 8) = (v4u){w[4], w[5], w[6], w[7]}; po += (size_t)64 * 4096;
        }
    }
#undef HG_LOAD
#undef HG_LD
    if constexpr (!OUT) {
        float* Es = Ebuf + ((size_t)(bh * HSEG + seg) * 64 * 64) * 4 + (size_t)(wid * 8) * 64 * 4;
#pragma unroll
        for (int kb = 0; kb < 8; ++kb) *(f32x4*)(Es + ((size_t)kb * 64 + lane) * 4) = Sacc[kb];
        if (rg == 0) Lbuf[(size_t)(bh * HSEG + seg) * 128 + col] = Lacc;
    }
    LDS_WAIT(); __builtin_amdgcn_s_barrier(); asm volatile("" ::: "memory");
}

__device__ __forceinline__ void cumsum_bh(LAS unsigned char* lds, const float* LOGF, float* C, int bh, int wave_s) {
    const int tid = tid_from(wave_s), lane = tid & 63, wid = tid >> 6, b = bh >> 4, h = bh & 15;
    LAS float* wsum = (LAS float*)lds;
    const float* src = LOGF + ((size_t)b * SEQ + 8 * tid) * 16 + h;
    float v[8]; float run = 0.f;
#pragma unroll
    for (int j = 0; j < 8; ++j) { run += src[j * 16]; v[j] = run; }
    float inc = run;
#pragma unroll
    for (int o = 1; o < 64; o <<= 1) { const float t = __shfl_up(inc, o); if (lane >= o) inc += t; }
    if (lane == 63) wsum[wid] = inc;
    LDS_WAIT(); __builtin_amdgcn_s_barrier(); asm volatile("" ::: "memory");
    float off = inc - run;
    for (int w = 0; w < wid; ++w) off += wsum[w];
    float* dst = C + (size_t)bh * SEQ + 8 * tid;
    *(f32x4*)dst = (f32x4){(off + v[0]) * LOG2E, (off + v[1]) * LOG2E, (off + v[2]) * LOG2E, (off + v[3]) * LOG2E};
    *(f32x4*)(dst + 4) = (f32x4){(off + v[4]) * LOG2E, (off + v[5]) * LOG2E, (off + v[6]) * LOG2E, (off + v[7]) * LOG2E};
    LDS_WAIT(); __builtin_amdgcn_s_barrier(); asm volatile("" ::: "memory");
}

#define RLX_AGENT __ATOMIC_RELAXED, __HIP_MEMORY_SCOPE_AGENT
#define XB_TMO      128
#define XB_XCNT(j)  (256  + 64 * (j))
#define XB_XSUB(j)  (1280 + 64 * (j))
#define XB_XGEN(j)  (2304 + 64 * (j))
#define XB_TOP      3328
#define XB_TOPGEN   3392
#define XCD_BAR_WORDS 3456
#define XB_SPIN_CAP (1u << 18)

__device__ __forceinline__ unsigned xb_ld(unsigned* p)              { return __hip_atomic_load(p, __ATOMIC_RELAXED, __HIP_MEMORY_SCOPE_AGENT); }
__device__ __forceinline__ unsigned xb_add(unsigned* p, unsigned v) { return __hip_atomic_fetch_add(p, v, __ATOMIC_RELAXED, __HIP_MEMORY_SCOPE_AGENT); }
__device__ __forceinline__ unsigned xb_xcc_id() { return (unsigned)__builtin_amdgcn_s_getreg((3 << 11) | 20) & 0xFu; }
#define XB_SPIN(cond, bar) do { unsigned _sp = 0; while (cond) { __builtin_amdgcn_s_sleep(1); \
    if ((++_sp & 255u) == 0u) { if (xb_ld(&(bar)[XB_TMO])) break; if (_sp > XB_SPIN_CAP) { atomicAdd(&(bar)[XB_TMO], 1u); break; } } } } while (0)

struct XcdBarrier {
    unsigned* bar; unsigned x;
    volatile LAS unsigned* st;
};

__device__ __forceinline__ XcdBarrier xcd_barrier_post(unsigned* bar, volatile LAS unsigned* st, bool is_t0) {
    XcdBarrier b; b.bar = bar; b.x = xb_xcc_id(); b.st = st;
    if (is_t0) (void)xb_add(&bar[XB_XCNT(b.x)], 1u);
    return b;
}
__device__ __forceinline__ void xcd_barrier_complete(unsigned* bar, unsigned x, unsigned& nloc, unsigned& nx) {
    const unsigned G = gridDim.x * gridDim.y * gridDim.z;
    unsigned sum, cnt, mine, sp = 0u;
    for (;;) {
        sum = 0u; cnt = 0u; mine = 0u;
#pragma unroll
        for (unsigned j = 0; j < 16; ++j) { const unsigned c = xb_ld(&bar[XB_XCNT(j)]); sum += c; cnt += (c > 0u) ? 1u : 0u; mine = (j == x) ? c : mine; }
        if (sum == G) break;
        __builtin_amdgcn_s_sleep(1);
        if ((++sp & 255u) == 0u) { if (xb_ld(&bar[XB_TMO])) break; if (sp > XB_SPIN_CAP) { atomicAdd(&bar[XB_TMO], 1u); break; } }
    }
    nloc = mine > 0u ? mine : 1u; nx = cnt > 0u ? cnt : 1u;
}

__device__ __forceinline__ void xcd_barrier(const XcdBarrier& b, bool is_t0) {
    asm volatile("s_waitcnt vmcnt(0)" ::: "memory");
    __syncthreads();
    if (is_t0) {
        unsigned* bar = b.bar;
        __builtin_amdgcn_s_waitcnt(0);
        unsigned nloc = b.st[0], nx = b.st[1];
        if (nloc == 0u) { xcd_barrier_complete(bar, b.x, nloc, nx); b.st[0] = nloc; b.st[1] = nx; }
        const unsigned old = xb_add(&bar[XB_XSUB(b.x)], 1u);
        const unsigned gen = old / nloc;
        if (old + 1u == (gen + 1u) * nloc) {
            __builtin_amdgcn_fence(__ATOMIC_RELEASE, "agent");
            asm volatile("s_waitcnt vmcnt(0)" ::: "memory");
            const unsigned og = xb_add(&bar[XB_TOP], 1u);
            const unsigned tg = og / nx;
            if (og + 1u == (tg + 1u) * nx) xb_add(&bar[XB_TOPGEN], 1u);
            else XB_SPIN(xb_ld(&bar[XB_TOPGEN]) == tg, bar);
            __builtin_amdgcn_fence(__ATOMIC_ACQUIRE, "agent");
            xb_add(&bar[XB_XGEN(b.x)], 1u);
            asm volatile("s_waitcnt vmcnt(0)" ::: "memory");
        } else {
            XB_SPIN(xb_ld(&bar[XB_XGEN(b.x)]) == gen, bar);
            __builtin_amdgcn_fence(__ATOMIC_ACQUIRE, "agent");
            asm volatile("s_waitcnt vmcnt(0)" ::: "memory");
        }
    }
    __syncthreads();
}

constexpr size_t WS_CTL = E_WEND * 2, CTL_BAR_BYTES = 16384, CTL_BYTES = CTL_BAR_BYTES + 16 * 2048 * 4;
constexpr size_t WS_XB0 = WS_BIG + 176 * MiB, WS_XB1 = WS_LOGF;
constexpr int LDS_BARST = LDS_BYTES - 64;

constexpr size_t WS_T0U = WS_CTL + 147456, WS_T0Y = WS_T0U + (size_t)8 * 2 * FF * 4, WS_T0Q = WS_T0Y + (size_t)8 * D * 4, WS_T0END = WS_T0Q + (size_t)8 * 2 * D * 4;
static_assert(WS_T0U % 256 == 0 && WS_T0END <= WS_P, "token-0 scratch fits below the p copy");
#define WG_BAR() do { LDS_WAIT(); __builtin_amdgcn_s_barrier(); asm volatile("" ::: "memory"); } while (0)
template <int NC, int K, int KS>
__device__ __forceinline__ void t0_gemv(const LAS float* in, LAS float* red, const float* W, int ldw, int N, float* out, int ldo, int bx, int G, int tid) {
    static_assert(NC * KS == 512 && K % KS == 0, "t0_gemv geometry");
    constexpr int KL = K / KS;
    const int col = tid % NC, ks = tid / NC;
    for (int c0 = bx * NC; c0 < N; c0 += G * NC) {
        float acc[8], wv[KL];
        const float* wp = W + (size_t)(ks * KL) * ldw + c0 + col; const LAS float* ip = in + ks * KL;
#pragma unroll
        for (int k = 0; k < KL; ++k) wv[k] = __builtin_nontemporal_load(wp + (size_t)k * ldw);
        constexpr int VEC = (KL % 4 == 0) ? 4 : 2;
        typedef float fvec_t __attribute__((ext_vector_type(VEC)));
#pragma unroll
        for (int r = 0; r < 8; ++r) { float s = 0.f;
#pragma unroll
            for (int k = 0; k < KL; k += VEC) { const fvec_t a = *(const LAS fvec_t*)(ip + r * K + k);
#pragma unroll
                for (int e = 0; e < VEC; ++e) s += a[e] * wv[k + e]; }
            acc[r] = s; }
#pragma unroll
        for (int r = 0; r < 8; ++r) red[(ks * 8 + r) * NC + col] = acc[r];
        WG_BAR();
        if (tid < 8 * NC) { const int r = tid / NC, c = tid % NC; float s = 0.f; for (int q = 0; q < KS; ++q) s += red[(q * 8 + r) * NC + c]; out[(size_t)r * ldo + c0 + c] = s; }
        WG_BAR();
    }
}
__device__ __forceinline__ void t0_stage_a(LAS unsigned char* lds, const float* x, const float* g1, const float* W, float* U, int bx, int G, int tid) {
    LAS float* a = (LAS float*)lds; LAS float* red = (LAS float*)(lds + 8 * D * 4);
    const int lane = tid & 63, w = tid >> 6;
    WG_BAR();
    { const f32x4* xr = (const f32x4*)(x + (size_t)w * SEQ * D) + lane; f32x4 v[4]; float s = 0.f;
#pragma unroll
      for (int j = 0; j < 4; ++j) { v[j] = xr[64 * j]; s += (v[j].x * v[j].x + v[j].y * v[j].y) + (v[j].z * v[j].z + v[j].w * v[j].w); }
      const float r = 1.0f / sqrtf(wave_sum(s) * (1.f / D) + EPS);
#pragma unroll
      for (int j = 0; j < 4; ++j) { const f32x4 g = *((const f32x4*)g1 + lane + 64 * j); *(LAS f32x4*)(a + w * D + 4 * (lane + 64 * j)) = v[j] * r * g; } }
    WG_BAR();
    t0_gemv<32, D, 16>(a, red, W, 2 * FF, 2 * FF, U, 2 * FF, bx, G, tid);
}
__device__ __forceinline__ void t0_stage_b(LAS unsigned char* lds, const float* U, const float* W, float* Y, int bx, int G, int tid) {
    LAS float* act = (LAS float*)lds; LAS float* red = (LAS float*)(lds + 8 * FF * 4);
    WG_BAR();
    for (int i = tid; i < 8 * FF; i += 512) { const int r = i / FF, j = i % FF; const float g = U[(size_t)r * 2 * FF + j], u = U[(size_t)r * 2 * FF + FF + j]; act[i] = g / (1.0f + __expf(-g)) * u; }
    WG_BAR();
    t0_gemv<4, FF, 128>(act, red, W, D, D, Y, D, bx, G, tid);
}
__device__ __forceinline__ void t0_stage_c(LAS unsigned char* lds, const float* x, const float* Y, const float* gpost, const float* gmix, const float* W, float* QZ, int bx, int G, int tid) {
    LAS float* xn = (LAS float*)lds; LAS float* red = (LAS float*)(lds + 8 * D * 4);
    const int lane = tid & 63, w = tid >> 6;
    WG_BAR();
    { const f32x4* xr = (const f32x4*)(x + (size_t)w * SEQ * D) + lane; const f32x4* yr = (const f32x4*)(Y + (size_t)w * D) + lane; f32x4 v[4], y[4]; float s = 0.f;
#pragma unroll
      for (int j = 0; j < 4; ++j) { v[j] = xr[64 * j]; y[j] = yr[64 * j]; s += (y[j].x * y[j].x + y[j].y * y[j].y) + (y[j].z * y[j].z + y[j].w * y[j].w); }
      const float r1 = 0.5f / sqrtf(wave_sum(s) * (1.f / D) + EPS); float s2 = 0.f;
#pragma unroll
      for (int j = 0; j < 4; ++j) { const f32x4 g = *((const f32x4*)gpost + lane + 64 * j); v[j] = v[j] + y[j] * r1 * g; s2 += (v[j].x * v[j].x + v[j].y * v[j].y) + (v[j].z * v[j].z + v[j].w * v[j].w); }
      const float r2 = 1.0f / sqrtf(wave_sum(s2) * (1.f / D) + EPS);
#pragma unroll
      for (int j = 0; j < 4; ++j) { const f32x4 g = *((const f32x4*)gmix + lane + 64 * j); *(LAS f32x4*)(xn + w * D + 4 * (lane + 64 * j)) = v[j] * r2 * g; } }
    WG_BAR();
    t0_gemv<8, D, 64>(xn, red, W, 4 * D, 2 * D, QZ, 2 * D, bx, G, tid);
}

struct Args { const float* in[25]; float* out; unsigned char* ws; int st_lo, st_hi; };
enum { ST_PRO, ST_F1I0, ST_F1O0, ST_RW00, ST_HIN, ST_HS1, ST_HS2, ST_HOUT, ST_RW01, ST_F2I0, ST_F2O0, ST_PP0, ST_RW02, ST_PG0, ST_RW03, ST_KVF, ST_F1I1, ST_CUM, ST_F1O1, ST_RW10, ST_QG, ST_ATT, ST_FOUT, ST_RW11, ST_F2I1, ST_F2O1, ST_PP1, ST_RW12, ST_PG1, ST_RW13, NSTEP };
#ifndef FUSE_MASK
#define FUSE_MASK 0x00
#endif
#define FUSED(b) (((FUSE_MASK) >> (b)) & 1)
__host__ __device__ constexpr bool sync_before(int s) { return !(s == ST_PRO || s == ST_PP0 || s == ST_F1I1 || s == ST_F1O1 || s == ST_PP1); }
enum { K_PRO = 0, K_FFN_IN, K_FFN_OUT, K_RW, K_HGRN_IN, K_HGRN, K_HGRN_OUT, K_PLE_PROJ, K_PLE_GATE, K_KVF, K_CUMSUM, K_QG, K_ATTN, K_FOX_OUT };

__global__ void __launch_bounds__(NWAVES * 64, 2) yoco_fwd(Args args) {
    extern __shared__ __attribute__((aligned(16))) unsigned char lds[];
    cg::grid_group grid = cg::this_grid();
    LAS unsigned char* ldsp = (LAS unsigned char*)lds;
    const int st_lo = args.st_lo, st_hi = args.st_hi;
    const int wave_s = __builtin_amdgcn_readfirstlane((int)(threadIdx.x >> 6));
    if (tid_from(wave_s) < 2) ((volatile LAS unsigned*)(ldsp + LDS_BARST))[tid_from(wave_s)] = 0u;
    __syncthreads();
    (void)xcd_barrier_post((unsigned*)(args.ws + WS_CTL), (volatile LAS unsigned*)(ldsp + LDS_BARST), tid_from(wave_s) == 0);
#define STEP_BEGIN(k) if (st_lo <= (k) && (k) < st_hi) { if ((k) > st_lo && sync_before(k)) { if (st_hi < 0) { asm volatile("s_waitcnt vmcnt(0) lgkmcnt(0)" ::: "memory"); grid.sync(); __builtin_amdgcn_fence(__ATOMIC_ACQUIRE, "agent"); asm volatile("s_waitcnt vmcnt(0)" ::: "memory"); }     \
          else { XcdBarrier xb_; xb_.bar = (unsigned*)(((const __attribute__((address_space(4))) Args*)__builtin_amdgcn_kernarg_segment_ptr())->ws + WS_CTL); xb_.x = xb_xcc_id(); xb_.st = (volatile LAS unsigned*)(ldsp + LDS_BARST); xcd_barrier(xb_, tid_from(wave_s) == 0); } } \
        const __attribute__((address_space(4))) Args* ap = (const __attribute__((address_space(4))) Args*)__builtin_amdgcn_kernarg_segment_ptr(); asm volatile("" : "+s"(ap)); \
        int tid_k = tid_from(wave_s); asm volatile("" : "+v"(tid_k)); const int tid = tid_k, lane = tid & 63, wave = __builtin_amdgcn_readfirstlane(tid >> 6); \
        const int G = gridDim.x, bx = blockIdx.x; unsigned char* ws = ap->ws; bfu* Wb = (bfu*)ws; bfu* PB = (bfu*)(ws + WS_P); float* LOGF = (float*)(ws + WS_LOGF); float* CL = (float*)(ws + WS_C); \
        bfu* AY = (bfu*)(ws + WS_AY); bfu* BIG = (bfu*)(ws + WS_BIG); bfu* PROJ = (bfu*)(ws + WS_PROJ); const int gw = bx * NWAVES + wave, ngw = G * NWAVES; \
        (void)tid; (void)lane; (void)Wb; (void)PB; (void)LOGF; (void)CL; (void)AY; (void)BIG; (void)PROJ; (void)gw; (void)ngw;
#define STEP_END }
#define RUN_GEMM(MODE, A_, LDA_, Bt_, N_, K_, O_, LDC_, O2_, AUX_, SC_) RUN_GEMM_ON(G, bx, MODE, A_, LDA_, Bt_, N_, K_, O_, LDC_, O2_, AUX_, SC_)
#define RUN_GEMM_ON(GS_, CS_, MODE, A_, LDA_, Bt_, N_, K_, O_, LDC_, O2_, AUX_, SC_) do { const pg8::Gemm g{A_, Bt_, T, N_, K_, LDA_}; pg8::StaticOrder S; S.init(T, N_, GS_, CS_); \
        const pg8::Epi<MODE, LDC_> E{O_, O2_, AUX_, LOGF, ap->in[18], SC_}; pg8::gemm_phase<pg8::Epi<MODE, LDC_>, pg8::StaticOrder, true, true, K_, LDA_>(ldsp, g, S, E, wave_s); } while (0)
#define NOB ((bfu*)nullptr)
#define S_FFN_IN(k, L, w)  STEP_BEGIN(k) if ((L) == 0 && (w) == 1) t0_stage_b(ldsp, (const float*)(ws + WS_T0U), ap->in[4], (float*)(ws + WS_T0Y), bx, G, tid); RUN_GEMM(pg8::EP_SWIGLU, AY, D, Wb + ((w) == 1 ? E_W1IN : E_W2IN) + (L) * N_WIN, 2 * FF, D, BIG, FF, NOB, NOB, 1.f); STEP_END
#define RUN_FUSED(PRE, WA, A_, LDA_, Bt_, K_, HIN_, AUX_, GAIN_, SCALE_, BANK_, XB_) do { \
        if (G != 256) { const float qn_ = __builtin_nanf(""); for (int m_ = gw; m_ < T; m_ += ngw) { f32x4* o_ = (f32x4*)(ap->out + (size_t)m_ * D) + lane; for (int j_ = 0; j_ < 4; ++j_) o_[64 * j_] = (f32x4){qn_, qn_, qn_, qn_}; } } \
        else { const pg8::Gemm g{A_, Bt_, T, D, K_, LDA_}; unsigned* cw_ = (unsigned*)(ws + WS_CTL + CTL_BAR_BYTES); \
            unsigned* xb_ = (unsigned*)((XB_) + (size_t)(BANK_) * MiB);     \
            const pg8::PanelSS s1_{xb_, cw_ + ((BANK_) * 2 + 0) * 2048, EPS}, s2_{xb_ + (size_t)T * 4, cw_ + ((BANK_) * 2 + 1) * 2048, EPS}; \
            const pg8::EpiRmsRes<PRE, WA> E{HIN_, ap->out, AY, AUX_, GAIN_, SCALE_, s1_, s2_}; \
            for (int p_ = 0; p_ < 2; ++p_) { const pg8::HalfOrder S{p_, bx}; pg8::gemm_phase<pg8::EpiRmsRes<PRE, WA>, pg8::HalfOrder, false, true, K_, LDA_>(ldsp, g, S, E, wave_s); } } } while (0)
#define S_FFN_OUT(k, L, w) STEP_BEGIN(k) if (FUSED((L) * 4 + ((w) == 1 ? 0 : 2))) RUN_FUSED(0, true, BIG, FF, Wb + ((w) == 1 ? E_W1OUT : E_W2OUT) + (L) * N_WOUT, FF, (((L) == 0 && (w) == 1) ? ap->in[0] : (const float*)ap->out), NOB, \
        ((w) == 1 ? ap->in[5] : ap->in[11]) + (L) * D, 0.5f, (L) * 4 + ((w) == 1 ? 0 : 2), ws + WS_XB0); \
        else RUN_GEMM(pg8::EP_PLAIN, BIG, FF, Wb + ((w) == 1 ? E_W1OUT : E_W2OUT) + (L) * N_WOUT, D, FF, AY, D, NOB, NOB, 1.f); STEP_END
#define S_PLE_PROJ(k, L)   STEP_BEGIN(k) RUN_GEMM(pg8::EP_PLAIN, PB + (size_t)(L) * T * PLE, PLE, Wb + E_WPP + (size_t)(L) * PLE * D, D, PLE, PROJ, D, NOB, NOB, 1.f); STEP_END
#define S_PLE_GATE(k, L)   STEP_BEGIN(k) if (FUSED((L) * 4 + 3)) RUN_FUSED(1, ((L) == 0), AY, D, Wb + E_WPG + (size_t)(L) * D * D, D, (const float*)ap->out, PROJ, ap->in[24] + (L) * D, 1.0f, (L) * 4 + 3, ws + WS_XB0); \
        else RUN_GEMM(pg8::EP_PLEGATE, AY, D, Wb + E_WPG + (size_t)(L) * D * D, D, D, BIG, D, NOB, PROJ, 1.f); STEP_END
#define S_RW(k, L, w, b)   STEP_BEGIN(k) if (!FUSED(b)) { const float* hin = ((L) == 0 && (w) == 0) ? ap->in[0] : ap->out; const bfu* Y = ((w) == 3) ? BIG : AY; \
        const float* gain = ((w) == 0 ? ap->in[5] : (w) == 1 ? ap->in[7] : (w) == 2 ? ap->in[11] : ap->in[24]) + (L) * D; \
        rw_phase<!((L) == 1 && (w) == 3)>(hin, ap->out, Y, AY, gain, ((w) == 0 || (w) == 2) ? 0.5f : 1.0f, gw, ngw, lane); } STEP_END

    STEP_BEGIN(ST_PRO) {
        LAS float* scr = (LAS float*)(ldsp + wave * 16384);
        const float* x = ap->in[0]; const float* p = ap->in[1]; const size_t n8 = (size_t)2 * T * PLE / 8, pstep = (size_t)G * 512;
        int m = gw; size_t pi = (size_t)bx * 512 + tid;
        for (int it = gw;; it += ngw) {
            int r = it; bool did = false;
            do {
#define CONV(src, K_, N_, dst, gain, gmask, sw) { constexpr int NI = ((K_) / 64) * (((N_) + 31) / 32); if (r < NI) { conv_item(src, K_, N_, dst, gain, gmask, sw, scr, r, lane); did = true; break; } r -= NI; }
            CONV(ap->in[3], D, 2 * FF, Wb + E_W1IN, ap->in[2], 1023, 1)
            CONV(ap->in[3] + N_WIN, D, 2 * FF, Wb + E_W1IN + N_WIN, ap->in[2] + D, 1023, 1)
            CONV(ap->in[9], D, 2 * FF, Wb + E_W2IN, ap->in[8], 1023, 1)
            CONV(ap->in[9] + N_WIN, D, 2 * FF, Wb + E_W2IN + N_WIN, ap->in[8] + D, 1023, 1)
            CONV(ap->in[4], FF, D, Wb + E_W1OUT, (const float*)nullptr, 0, 0)
            CONV(ap->in[4] + N_WOUT, FF, D, Wb + E_W1OUT + N_WOUT, (const float*)nullptr, 0, 0)
            CONV(ap->in[10], FF, D, Wb + E_W2OUT, (const float*)nullptr, 0, 0)
            CONV(ap->in[10] + N_WOUT, FF, D, Wb + E_W2OUT + N_WOUT, (const float*)nullptr, 0, 0)
            CONV(ap->in[12], D, 4 * D, Wb + E_WHIN, ap->in[6], 1023, 0)
            CONV(ap->in[15], D, D, Wb + E_WHOUT, ap->in[14], 127, 0)
            CONV(ap->in[17], D, NKVF, Wb + E_WKVF, ap->in[16], 1023, 0)
            CONV(ap->in[19], D, 2 * D, Wb + E_WQG, ap->in[6] + D, 1023, 0)
            CONV(ap->in[20], D, D, Wb + E_WFO, (const float*)nullptr, 0, 0)
            CONV(ap->in[22], D, D, Wb + E_WPG, ap->in[21], 1023, 0)
            CONV(ap->in[22] + (size_t)D * D, D, D, Wb + E_WPG + (size_t)D * D, ap->in[21] + D, 1023, 0)
            CONV(ap->in[23], PLE, D, Wb + E_WPP, (const float*)nullptr, 0, 0)
            CONV(ap->in[23] + (size_t)PLE * D, PLE, D, Wb + E_WPP + (size_t)PLE * D, (const float*)nullptr, 0, 0)
#undef CONV
            } while (0);
            if (m < T) { rms_row_to_bf16(x + (size_t)m * D, AY + (size_t)m * D, lane); if (m + ngw < T) rms_row_to_bf16(x + (size_t)(m + ngw) * D, AY + (size_t)(m + ngw) * D, lane); m += 2 * ngw; }
#pragma unroll
            for (int q = 0; q < 2; ++q) if (pi < n8) { const f32x4 a = __builtin_nontemporal_load((const f32x4*)p + 2 * pi), c = __builtin_nontemporal_load((const f32x4*)p + 2 * pi + 1);
                __builtin_nontemporal_store((v4u){pk2(a.x, a.y), pk2(a.z, a.w), pk2(c.x, c.y), pk2(c.z, c.w)}, (v4u*)PB + pi); pi += pstep; }
            if (!did && m >= T && !__any(pi < n8)) break;
        }
        t0_stage_a(ldsp, x, ap->in[2], ap->in[3], (float*)(ws + WS_T0U), bx, G, tid);
    } STEP_END
    S_FFN_IN(ST_F1I0, 0, 1) S_FFN_OUT(ST_F1O0, 0, 1) S_RW(ST_RW00, 0, 0, 0)
    STEP_BEGIN(ST_HIN) RUN_GEMM(pg8::EP_PLAIN, AY, D, Wb + E_WHIN, 4 * D, D, BIG, 4 * D, NOB, NOB, 1.f); STEP_END
    STEP_BEGIN(ST_HS1) { const float* lbl = ap->in[13]; float* Eb = (float*)AY; float* Lb = (float*)(ws + WS_AY + 32 * MiB);
        for (int it = bx; it < BATCH * 8 * HSEG; it += G) if ((it & 3) != 3) hgrn_scan<false>(ldsp, BIG, lbl, it >> 2, it & 3, Eb, Lb, wave_s);
        const bool side = (G >= 256) ? ((bx & 3) == 3 && bx < 256) : true; const int gs = (G >= 256) ? 64 : G, cs = (G >= 256) ? (bx >> 2) : bx;
        if (side) t0_stage_c(ldsp, ap->in[0], (const float*)(ws + WS_T0Y), ap->in[5], ap->in[6], ap->in[12], (float*)(ws + WS_T0Q), cs, gs, tid); } STEP_END
    STEP_BEGIN(ST_HS2) { const float* lbl = ap->in[13]; float* Eb = (float*)AY; float* Lb = (float*)(ws + WS_AY + 32 * MiB);
        for (int it = bx; it < BATCH * 8 * HSEG; it += G) hgrn_scan<true>(ldsp, BIG, lbl, it >> 2, it & 3, Eb, Lb, wave_s, (const float*)(ws + WS_T0Q)); } STEP_END
    STEP_BEGIN(ST_HOUT) if (FUSED(1)) RUN_FUSED(0, true, BIG, 4 * D, Wb + E_WHOUT, D, (const float*)ap->out, NOB, ap->in[7], 1.0f, 1, ws + WS_XB1);
        else RUN_GEMM(pg8::EP_PLAIN, BIG, 4 * D, Wb + E_WHOUT, D, D, AY, D, NOB, NOB, 1.f); STEP_END
    S_RW(ST_RW01, 0, 1, 1) S_FFN_IN(ST_F2I0, 0, 2) S_FFN_OUT(ST_F2O0, 0, 2) S_PLE_PROJ(ST_PP0, 0) S_RW(ST_RW02, 0, 2, 2) S_PLE_GATE(ST_PG0, 0) S_RW(ST_RW03, 0, 3, 3)
    STEP_BEGIN(ST_KVF) RUN_GEMM(pg8::EP_KVF, AY, D, Wb + E_WKVF, NKVFP, D, (bfu*)(ws + WS_K), D, (bfu*)(ws + WS_V), NOB, 1.f); STEP_END
    S_FFN_IN(ST_F1I1, 1, 1)
    STEP_BEGIN(ST_CUM) { for (int bh = bx; bh < BATCH * 16; bh += G) cumsum_bh(ldsp, LOGF, CL, bh, wave_s); } STEP_END
    S_FFN_OUT(ST_F1O1, 1, 1) S_RW(ST_RW10, 1, 0, 4)
    STEP_BEGIN(ST_QG) RUN_GEMM(pg8::EP_QG, AY, D, Wb + E_WQG, 2 * D, D, (bfu*)(ws + WS_Q), D, (bfu*)(ws + WS_G), NOB, attn_body::C2); STEP_END
    STEP_BEGIN(ST_ATT) {
        const attn_body::AttnTensors AT{(const attn_body::bf16*)(ws + WS_Q), (const attn_body::bf16*)(ws + WS_K), (const attn_body::bf16*)(ws + WS_V), (attn_body::bf16*)(ws + WS_Q), (const attn_body::bf16*)(ws + WS_G), CL};
        const attn_body::StaticOrder S(G, bx);
        attn_body::attn_phase<attn_body::StaticOrder>((char*)lds, AT, S, wave_s);
    } STEP_END
    STEP_BEGIN(ST_FOUT) if (FUSED(5)) RUN_FUSED(0, true, (const bfu*)(ws + WS_Q), D, Wb + E_WFO, D, (const float*)ap->out, NOB, ap->in[7] + D, 1.0f, 5, ws + WS_XB0);
        else RUN_GEMM(pg8::EP_PLAIN, (const bfu*)(ws + WS_Q), D, Wb + E_WFO, D, D, AY, D, NOB, NOB, 1.f); STEP_END
    S_RW(ST_RW11, 1, 1, 5) S_FFN_IN(ST_F2I1, 1, 2) S_FFN_OUT(ST_F2O1, 1, 2) S_PLE_PROJ(ST_PP1, 1) S_RW(ST_RW12, 1, 2, 6) S_PLE_GATE(ST_PG1, 1) S_RW(ST_RW13, 1, 3, 7)
}

#ifndef MK_MULTI
#define MK_MULTI 0
#endif
extern "C" void kernel_launch(void* const* d_in, const int* in_sizes, int n_in, void* d_out, int out_size, void* d_ws, size_t ws_size, hipStream_t stream) {
    static int grid = 0;
    if (grid == 0) {
        if (n_in != 25 || out_size != T * D || ws_size < WS_END) { fprintf(stderr, "kernel_launch: unexpected shapes (n_in %d out %d ws %zu)\n", n_in, out_size, ws_size); grid = -1; return; }
        int dev = 0, cus = 0, per_cu = 0;
        (void)hipGetDevice(&dev); (void)hipDeviceGetAttribute(&cus, hipDeviceAttributeMultiprocessorCount, dev);
        if (hipFuncSetAttribute((const void*)yoco_fwd, hipFuncAttributeMaxDynamicSharedMemorySize, LDS_BYTES) != hipSuccess) { fprintf(stderr, "kernel_launch: hipFuncSetAttribute failed\n"); grid = -1; return; }
        if (hipOccupancyMaxActiveBlocksPerMultiprocessor(&per_cu, (const void*)yoco_fwd, NWAVES * 64, LDS_BYTES) != hipSuccess || per_cu < 1) per_cu = 1;
        (void)hipGetLastError();
        if (cus <= 0) cus = 256;
        grid = cus * per_cu;
    }
    if (grid < 0) return;
    if (hipMemsetAsync((char*)d_ws + WS_CTL, 0, CTL_BYTES, stream) != hipSuccess) { fprintf(stderr, "kernel_launch: memset failed\n"); return; }
    Args a{};
    for (int i = 0; i < 25; ++i) a.in[i] = (const float*)d_in[i];
    a.out = (float*)d_out; a.ws = (unsigned char*)d_ws;
#ifndef ST_CUT
#define ST_CUT NSTEP
    a.st_lo = 0; a.st_hi = ST_CUT;
    void* kargs[] = {&a};
    const hipError_t e = hipLaunchCooperativeKernel((const void*)yoco_fwd, dim3(grid), dim3(NWAVES * 64), kargs, LDS_BYTES, stream);
    if (e != hipSuccess) fprintf(stderr, "kernel_launch: cooperative launch failed: %s (grid %d)\n", hipGetErrorString(e), grid);
#endif
}
```
